# Optimizing an MI355X kernel written in HIP

```python
import math
import jax, jax.numpy as jnp
from jax import lax
import numpy as np

D_MODEL = 4096
BATCH = 4
SEQ = 4096
DEPTH = 1

D_FF = 11008
NORM_EPS = 1e-6
GDN_QK_HEADS = 16
GDN_V_HEADS = 32
GDN_HEAD_DIM = 128
GDN_QK_WIDTH = GDN_QK_HEADS * GDN_HEAD_DIM
GDN_V_WIDTH = GDN_V_HEADS * GDN_HEAD_DIM
GDN_CONV = 4
GDN_CHUNK = 64
MOBA_HEADS = 16
MOBA_HEAD_DIM = 128
MOBA_WIDTH = MOBA_HEADS * MOBA_HEAD_DIM
MOBA_BLOCK = 256
MOBA_TOP_K = 3
MOBA_Q_CHUNK = 16
ROPE_THETA = 10000.0
IN_SPLITS = (GDN_QK_WIDTH, GDN_QK_WIDTH, GDN_V_WIDTH, GDN_V_WIDTH, GDN_V_HEADS, GDN_V_HEADS,
             MOBA_WIDTH, MOBA_WIDTH, MOBA_WIDTH, D_MODEL, D_MODEL)
D_IN = sum(IN_SPLITS)

kernel_name = 'hybrid_gdn_moba_macaron_layer'


def rms_norm(x, gain):
    x32 = x.astype(jnp.float32)
    y = x32 * lax.rsqrt(jnp.mean(x32 * x32, axis=-1, keepdims=True) + NORM_EPS)
    return y.astype(x.dtype) * gain


def l2_norm(x):
    x32 = x.astype(jnp.float32)
    return x32 * lax.rsqrt(jnp.sum(x32 * x32, axis=-1, keepdims=True) + NORM_EPS)


def swiglu_ffn(h, w_gate, w_up, w_down):
    return (jax.nn.silu(h @ w_gate) * (h @ w_up)) @ w_down


def causal_depthwise_conv(x, w):
    K = w.shape[0]
    S = x.shape[1]
    xp = jnp.pad(x, ((0, 0), (K - 1, 0), (0, 0)))
    return sum(xp[:, j:j + S] * w[j] for j in range(K))


def rope(x, positions):
    half = x.shape[-1] // 2
    inv_freq = ROPE_THETA ** (-jnp.arange(half, dtype=jnp.float32) / half)
    ang = positions.astype(jnp.float32)[:, None] * inv_freq[None, :]
    cos = jnp.cos(ang)[None, :, None, :]
    sin = jnp.sin(ang)[None, :, None, :]
    x32 = x.astype(jnp.float32)
    x1, x2 = x32[..., :half], x32[..., half:]
    return jnp.concatenate([x1 * cos - x2 * sin, x2 * cos + x1 * sin], axis=-1).astype(x.dtype)


def gated_delta_rule_chunked(q, k, v, g, beta):
    B, H, S, Dk = q.shape
    Dv = v.shape[-1]
    C = GDN_CHUNK
    pad = (-S) % C
    padS = lambda t: jnp.pad(t.astype(jnp.float32), ((0, 0), (0, 0), (0, pad)) + ((0, 0),) * (t.ndim - 3))
    q, k, v, g, beta = padS(q), padS(k), padS(v), padS(g), padS(beta)
    NC = (S + pad) // C
    q = q * (Dk ** -0.5)
    q = q.reshape(B, H, NC, C, Dk)
    k = k.reshape(B, H, NC, C, Dk)
    v = v.reshape(B, H, NC, C, Dv)
    beta = beta.reshape(B, H, NC, C)
    g_cum = jnp.cumsum(g.reshape(B, H, NC, C), axis=-1)
    tril = jnp.tril(jnp.ones((C, C), dtype=bool))
    strict = jnp.tril(jnp.ones((C, C), dtype=bool), -1)
    diff = g_cum[..., :, None] - g_cum[..., None, :]
    decay = jnp.where(tril, jnp.exp(jnp.where(tril, diff, 0.0)), 0.0)
    k_beta = k * beta[..., None]
    v_beta = v * beta[..., None]
    L = jnp.where(strict, jnp.einsum('bhncd,bhnsd->bhncs', k_beta, k) * decay, 0.0)
    eye = jnp.eye(C, dtype=jnp.float32)
    T = lax.linalg.triangular_solve(eye + L, jnp.broadcast_to(eye, L.shape),
                                    left_side=True, lower=True, unit_diagonal=True)
    u = T @ v_beta
    w = T @ (k_beta * jnp.exp(g_cum)[..., None])
    attn_intra = jnp.where(tril, jnp.einsum('bhncd,bhnsd->bhncs', q, k) * decay, 0.0)

    def step(state, xs):
        q_c, k_c, u_c, w_c, a_c, g_c = xs
        v_new = u_c - w_c @ state
        o = (q_c * jnp.exp(g_c)[..., None]) @ state + a_c @ v_new
        g_last = g_c[..., -1]
        k_dec = k_c * jnp.exp(g_last[..., None] - g_c)[..., None]
        state = state * jnp.exp(g_last)[..., None, None] + jnp.einsum('bhcd,bhce->bhde', k_dec, v_new)
        return state, o

    front = lambda t: jnp.moveaxis(t, 2, 0)
    state0 = jnp.zeros((B, H, Dk, Dv), jnp.float32)
    _, o = lax.scan(step, state0, (front(q), front(k), front(u), front(w), front(attn_intra), front(g_cum)))
    o = jnp.moveaxis(o, 0, 2).reshape(B, H, NC * C, Dv)[:, :, :S]
    return o


def gated_deltanet(q, k, v, z, a, b, conv_w, A_log, dt_bias, o_norm):
    B, S, _ = q.shape
    qkv = jax.nn.silu(causal_depthwise_conv(jnp.concatenate([q, k, v], axis=-1), conv_w))
    q = qkv[..., :GDN_QK_WIDTH]
    k = qkv[..., GDN_QK_WIDTH:2 * GDN_QK_WIDTH]
    v = qkv[..., 2 * GDN_QK_WIDTH:]
    rep = GDN_V_HEADS // GDN_QK_HEADS
    q = jnp.repeat(l2_norm(q.reshape(B, S, GDN_QK_HEADS, GDN_HEAD_DIM)), rep, axis=2)
    k = jnp.repeat(l2_norm(k.reshape(B, S, GDN_QK_HEADS, GDN_HEAD_DIM)), rep, axis=2)
    v = v.reshape(B, S, GDN_V_HEADS, GDN_HEAD_DIM)
    g = -jnp.exp(A_log.astype(jnp.float32)) * jax.nn.softplus(a.astype(jnp.float32) + dt_bias.astype(jnp.float32))
    beta = jax.nn.sigmoid(b.astype(jnp.float32))
    o = gated_delta_rule_chunked(q.transpose(0, 2, 1, 3), k.transpose(0, 2, 1, 3), v.transpose(0, 2, 1, 3),
                                 g.transpose(0, 2, 1), beta.transpose(0, 2, 1))
    o = o.transpose(0, 2, 1, 3)
    o = rms_norm(o, o_norm) * jax.nn.silu(z.reshape(B, S, GDN_V_HEADS, GDN_HEAD_DIM).astype(jnp.float32))
    return o.reshape(B, S, GDN_V_WIDTH).astype(z.dtype)


def moba_attention(q, k, v, q_norm, k_norm):
    B, S, _ = q.shape
    H, D = MOBA_HEADS, MOBA_HEAD_DIM
    pos = jnp.arange(S)
    q = rope(rms_norm(q.reshape(B, S, H, D), q_norm), pos).transpose(0, 2, 1, 3)
    k = rope(rms_norm(k.reshape(B, S, H, D), k_norm), pos).transpose(0, 2, 1, 3)
    v = v.reshape(B, S, H, D).transpose(0, 2, 1, 3)
    nb = -(-S // MOBA_BLOCK)
    pad = nb * MOBA_BLOCK - S
    kb = jnp.pad(k, ((0, 0), (0, 0), (0, pad), (0, 0))).reshape(B, H, nb, MOBA_BLOCK, D)
    vb = jnp.pad(v, ((0, 0), (0, 0), (0, pad), (0, 0))).reshape(B, H, nb, MOBA_BLOCK, D)
    k_mean = jnp.mean(kb.astype(jnp.float32), axis=3)
    gate = jnp.einsum('bhsd,bhnd->bhsn', q.astype(jnp.float32), k_mean)
    q_blk = pos // MOBA_BLOCK
    past = jnp.arange(nb)[None, :] < q_blk[:, None]
    gate = jnp.where(past, gate, -jnp.inf)
    n_sel = min(MOBA_TOP_K, nb)
    _, top_idx = lax.top_k(gate, n_sel)
    sel_valid = jnp.arange(n_sel)[None, :] < q_blk[:, None]

    Qc = MOBA_Q_CHUNK
    n_chunks = S // Qc
    to_chunks = lambda t: jnp.moveaxis(t.reshape((B, H, n_chunks, Qc) + t.shape[3:]), 2, 0)
    q_c_all = to_chunks(q)
    idx_c_all = to_chunks(top_idx)
    valid_c_all = sel_valid.reshape(n_chunks, Qc, n_sel)
    b_ix = jnp.arange(B)[:, None, None, None]
    h_ix = jnp.arange(H)[None, :, None, None]
    scale = D ** -0.5

    def attend(args):
        c, q_c, idx, valid = args
        start = c * Qc
        own = start // MOBA_BLOCK
        k_own = lax.dynamic_slice_in_dim(kb, own, 1, axis=2)[:, :, 0]
        v_own = lax.dynamic_slice_in_dim(vb, own, 1, axis=2)[:, :, 0]
        k_sel = kb[b_ix, h_ix, idx]
        v_sel = vb[b_ix, h_ix, idx]
        s_sel = jnp.einsum('bhqd,bhqnkd->bhqnk', q_c, k_sel).astype(jnp.float32) * scale
        s_sel = jnp.where(valid[None, None, :, :, None], s_sel, -jnp.inf)
        s_own = jnp.einsum('bhqd,bhkd->bhqk', q_c, k_own).astype(jnp.float32) * scale
        q_pos = start + jnp.arange(Qc)
        k_pos = own * MOBA_BLOCK + jnp.arange(MOBA_BLOCK)
        s_own = jnp.where(k_pos[None, :] <= q_pos[:, None], s_own, -jnp.inf)
        s = jnp.concatenate([s_sel.reshape(B, H, Qc, n_sel * MOBA_BLOCK), s_own], axis=-1)
        p = jax.nn.softmax(s, axis=-1).astype(v.dtype)
        p_sel = p[..., :n_sel * MOBA_BLOCK].reshape(B, H, Qc, n_sel, MOBA_BLOCK)
        p_own = p[..., n_sel * MOBA_BLOCK:]
        return (jnp.einsum('bhqnk,bhqnkd->bhqd', p_sel, v_sel)
                + jnp.einsum('bhqk,bhkd->bhqd', p_own, v_own))

    o = lax.map(attend, (jnp.arange(n_chunks), q_c_all, idx_c_all, valid_c_all))
    o = jnp.moveaxis(o, 0, 2).reshape(B, H, S, D).transpose(0, 2, 1, 3)
    return o.reshape(B, S, MOBA_WIDTH)


def setup_inputs(seed: int = 0) -> dict:
    key = jax.random.key(seed)
    ks = jax.random.split(key, 20)
    f32 = jnp.float32
    L = DEPTH
    normal = lambda k, shape, fan_in: jax.random.normal(k, shape, f32) * (fan_in ** -0.5)
    gain = lambda k, shape: 1.0 + 0.02 * jax.random.normal(k, shape, f32)
    x = jax.random.normal(ks[0], (BATCH, SEQ, D_MODEL), f32)
    dt = jnp.exp(jax.random.uniform(ks[10], (L, GDN_V_HEADS), f32, math.log(1e-3), math.log(1e-1)))
    return {
        'x': x,
        'ffn1_norm': gain(ks[1], (L, D_MODEL)),
        'ffn1_w_gate': normal(ks[2], (L, D_MODEL, D_FF), D_MODEL),
        'ffn1_w_up': normal(ks[3], (L, D_MODEL, D_FF), D_MODEL),
        'ffn1_w_down': normal(ks[4], (L, D_FF, D_MODEL), D_FF),
        'mix_norm': gain(ks[5], (L, D_MODEL)),
        'w_in': normal(ks[6], (L, D_MODEL, D_IN), D_MODEL),
        'gdn_conv_w': normal(ks[7], (L, GDN_CONV, 2 * GDN_QK_WIDTH + GDN_V_WIDTH), GDN_CONV),
        'gdn_A_log': jnp.log(jax.random.uniform(ks[8], (L, GDN_V_HEADS), f32, 1.0, 16.0)),
        'gdn_dt_bias': dt + jnp.log(-jnp.expm1(-dt)),
        'gdn_o_norm': gain(ks[9], (L, GDN_HEAD_DIM)),
        'moba_q_norm': gain(ks[11], (L, MOBA_HEAD_DIM)),
        'moba_k_norm': gain(ks[12], (L, MOBA_HEAD_DIM)),
        'w_branch_gdn': normal(ks[13], (L, GDN_V_WIDTH, D_MODEL), GDN_V_WIDTH),
        'w_branch_moba': normal(ks[14], (L, MOBA_WIDTH, D_MODEL), MOBA_WIDTH),
        'w_out': normal(ks[15], (L, D_MODEL, D_MODEL), D_MODEL),
        'ffn2_norm': gain(ks[16], (L, D_MODEL)),
        'ffn2_w_gate': normal(ks[17], (L, D_MODEL, D_FF), D_MODEL),
        'ffn2_w_up': normal(ks[18], (L, D_MODEL, D_FF), D_MODEL),
        'ffn2_w_down': normal(ks[19], (L, D_FF, D_MODEL), D_FF),
    }


def reference(x, ffn1_norm, ffn1_w_gate, ffn1_w_up, ffn1_w_down, mix_norm, w_in, gdn_conv_w, gdn_A_log,
              gdn_dt_bias, gdn_o_norm, moba_q_norm, moba_k_norm, w_branch_gdn, w_branch_moba, w_out,
              ffn2_norm, ffn2_w_gate, ffn2_w_up, ffn2_w_down):
    offsets = np.cumsum(IN_SPLITS)[:-1].tolist()
    for l in range(DEPTH):
        h = rms_norm(x, ffn1_norm[l])
        x = x + 0.5 * swiglu_ffn(h, ffn1_w_gate[l], ffn1_w_up[l], ffn1_w_down[l])
        h = rms_norm(x, mix_norm[l])
        proj = h @ w_in[l]
        gq, gk, gv, gz, ga, gb, mq, mk, mv, gate_gdn, gate_moba = jnp.split(proj, offsets, axis=-1)
        o_gdn = gated_deltanet(gq, gk, gv, gz, ga, gb, gdn_conv_w[l], gdn_A_log[l], gdn_dt_bias[l], gdn_o_norm[l])
        o_moba = moba_attention(mq, mk, mv, moba_q_norm[l], moba_k_norm[l])
        y = (jax.nn.sigmoid(gate_gdn) * (o_gdn @ w_branch_gdn[l])
             + jax.nn.sigmoid(gate_moba) * (o_moba @ w_branch_moba[l]))
        x = x + y @ w_out[l]
        h = rms_norm(x, ffn2_norm[l])
        x = x + 0.5 * swiglu_ffn(h, ffn2_w_gate[l], ffn2_w_up[l], ffn2_w_down[l])
    return x
```

```cpp
#include <hip/hip_runtime.h>
#include <cstdio>
#include <cstdint>
#include <cmath>
namespace pg8 {
#define PG8_LAS __attribute__((address_space(3)))
typedef unsigned short bf16_t;
typedef short bf16x8 __attribute__((ext_vector_type(8)));
typedef float f32x4 __attribute__((ext_vector_type(4)));
typedef unsigned u32x4 __attribute__((ext_vector_type(4)));
constexpr int BM = 256, BK = 64, HALF = 128, HTB = HALF * BK * 2  , STAGE_BYTES = 8 * HTB, NXCD = 8, WGM = 8;

__host__ __device__ __forceinline__ int lds_byte(int r, int c) { const int st = (r >> 4) * 2 + (c >> 5), rr = r & 15, cc = c & 31, ob = rr * 64 + cc * 2; return st * 1024 + (ob ^ (((ob >> 9) & 1) << 5)); }
__host__ __device__ __forceinline__ void stage_rc(int b, int& R, int& C) { const int st = b / 1024, sb = b % 1024, swz = sb ^ (((sb >> 9) & 1) << 5); R = (st >> 1) * 16 + swz / 64; C = (st & 1) * 32 + (swz % 64) / 2; }
__host__ __device__ __forceinline__ int perm32(int rho) { const int n = rho >> 4, i = rho & 15; return 8 * (i >> 2) + 4 * n + (i & 3); }

struct Unit { int pm, pn; };
struct Gemm { const bf16_t* A; const bf16_t* Bt; int M, N, K; };

struct StaticOrder {
    int nM, nN, nwg, G, c;
    __host__ __device__ void init(int M, int N, int G_, int c_) { nM = M / BM; nN = N / BM; nwg = nM * nN; G = G_; c = c_; }
    __host__ __device__ bool next(int i, Unit& u) const {
        const long L = (long)i * G + c; if (L >= nwg) return false;
        int wgid = (int)L; { const int q = nwg / NXCD, r = nwg % NXCD, xcd = wgid % NXCD, off = wgid / NXCD; wgid = (xcd < r ? xcd * (q + 1) : r * (q + 1) + (xcd - r) * q) + off; }
        const int nig = WGM * nN, gid = wgid / nig, fm = gid * WGM, gsz = (nM - fm) < WGM ? (nM - fm) : WGM;
        u.pm = fm + ((wgid % nig) % gsz); u.pn = (wgid % nig) / gsz; return true;
    }
    __device__ __forceinline__ void a_ready(const Unit&) const {}
    __device__ __forceinline__ void done(const Unit&) const {}
};
__device__ __forceinline__ unsigned cvt_pk_bf16(float lo, float hi) { unsigned r; asm volatile("v_cvt_pk_bf16_f32 %0, %1, %2" : "=v"(r) : "v"(lo), "v"(hi)); return r; }
__device__ __forceinline__ float sigmoid_fast(float x) { return __builtin_amdgcn_rcpf(1.0f + __expf(-x)); }
__device__ __forceinline__ float bf_lo(unsigned w) { return __uint_as_float(w << 16); }
__device__ __forceinline__ float bf_hi(unsigned w) { return __uint_as_float(w & 0xffff0000u); }
struct EpiSwiGLU {
    static constexpr bool PERM = true, AFTER_DRAIN = false;
    bf16_t* O; int ldc;
    __device__ __forceinline__ void operator()(const f32x4 (&acc)[2][2][4][2], const Unit& u, int wr, int wc, int fr, int fq) const {
        const int row0 = u.pm * BM + wr * 64 + fr, col0 = u.pn * HALF + wc * 32 + 8 * fq;
#pragma unroll
        for (int ai = 0; ai < 2; ++ai)
#pragma unroll
            for (int m = 0; m < 4; ++m) { bf16_t* rowp = O + (size_t)(row0 + ai * HALF + m * 16) * ldc + col0;
                f32x4 v0, v1;
#pragma unroll
                for (int j = 0; j < 4; ++j) { const float g0 = acc[ai][0][m][0][j], g1 = acc[ai][0][m][1][j];
                    v0[j] = g0 * sigmoid_fast(g0) * acc[ai][1][m][0][j]; v1[j] = g1 * sigmoid_fast(g1) * acc[ai][1][m][1][j]; }
                u32x4 w; w.x = cvt_pk_bf16(v0[0], v0[1]); w.y = cvt_pk_bf16(v0[2], v0[3]); w.z = cvt_pk_bf16(v1[0], v1[1]); w.w = cvt_pk_bf16(v1[2], v1[3]);
                *(u32x4*)rowp = w; }
    }
};
struct EpiResid {
    static constexpr bool PERM = false, AFTER_DRAIN = false;
    const float* base; float* out; int ldc; float scale;
    __device__ __forceinline__ void operator()(const f32x4 (&acc)[2][2][4][2], const Unit& u, int wr, int wc, int fr, int fq) const {
        const int row0 = u.pm * BM + wr * 64 + fr, col0 = u.pn * BM + wc * 32 + 4 * fq;
#pragma unroll
        for (int ai = 0; ai < 2; ++ai)
#pragma unroll
            for (int m = 0; m < 4; ++m) { const size_t off = (size_t)(row0 + ai * HALF + m * 16) * ldc + col0;
#pragma unroll
                for (int bj = 0; bj < 2; ++bj)
#pragma unroll
                    for (int n = 0; n < 2; ++n) { const f32x4 b = *(const f32x4*)(base + off + bj * HALF + n * 16); *(f32x4*)(out + off + bj * HALF + n * 16) = b + acc[ai][bj][m][n] * scale; } }
    }
};
struct EpiProj {
    static constexpr bool PERM = true, AFTER_DRAIN = false;
    bf16_t* O; int ldc; float* AB; int n_main;
    __device__ __forceinline__ void operator()(const f32x4 (&acc)[2][2][4][2], const Unit& u, int wr, int wc, int fr, int fq) const {
        const int row0 = u.pm * BM + wr * 64 + fr;
        if (u.pn < n_main) {
            const int col0 = u.pn * BM + wc * 32 + 8 * fq;
#pragma unroll
            for (int ai = 0; ai < 2; ++ai)
#pragma unroll
                for (int m = 0; m < 4; ++m) { bf16_t* rowp = O + (size_t)(row0 + ai * HALF + m * 16) * ldc + col0;
#pragma unroll
                    for (int bj = 0; bj < 2; ++bj) { const f32x4 v0 = acc[ai][bj][m][0], v1 = acc[ai][bj][m][1];
                        u32x4 w; w.x = cvt_pk_bf16(v0[0], v0[1]); w.y = cvt_pk_bf16(v0[2], v0[3]); w.z = cvt_pk_bf16(v1[0], v1[1]); w.w = cvt_pk_bf16(v1[2], v1[3]);
                        *(u32x4*)(rowp + bj * HALF) = w; } }
        } else if (wc < 2) {
#pragma unroll
            for (int ai = 0; ai < 2; ++ai)
#pragma unroll
                for (int m = 0; m < 4; ++m) { float* p = AB + (size_t)(row0 + ai * HALF + m * 16) * 64 + wc * 32 + 8 * fq;
                    *(f32x4*)p = acc[ai][0][m][0]; *(f32x4*)(p + 4) = acc[ai][0][m][1]; }
        }
    }
};
template <bool FIRST> struct EpiGate {
    static constexpr bool PERM = true, AFTER_DRAIN = false;
    float* Y1; bf16_t* Y; int ldy; const bf16_t* gate; int ldg;
    __device__ __forceinline__ void operator()(const f32x4 (&acc)[2][2][4][2], const Unit& u, int wr, int wc, int fr, int fq) const {
        const int row0 = u.pm * BM + wr * 64 + fr, col0 = u.pn * BM + wc * 32 + 8 * fq;
#pragma unroll
        for (int ai = 0; ai < 2; ++ai)
#pragma unroll
            for (int m = 0; m < 4; ++m) { const size_t row = (size_t)(row0 + ai * HALF + m * 16);
#pragma unroll
                for (int bj = 0; bj < 2; ++bj) { const u32x4 gw = *(const u32x4*)(gate + row * ldg + col0 + bj * HALF);
                    f32x4 s0, s1; s0[0] = sigmoid_fast(bf_lo(gw.x)); s0[1] = sigmoid_fast(bf_hi(gw.x)); s0[2] = sigmoid_fast(bf_lo(gw.y)); s0[3] = sigmoid_fast(bf_hi(gw.y));
                    s1[0] = sigmoid_fast(bf_lo(gw.z)); s1[1] = sigmoid_fast(bf_hi(gw.z)); s1[2] = sigmoid_fast(bf_lo(gw.w)); s1[3] = sigmoid_fast(bf_hi(gw.w));
                    f32x4 v0 = acc[ai][bj][m][0] * s0, v1 = acc[ai][bj][m][1] * s1;
                    float* yp = Y1 + row * ldy + col0 + bj * HALF;
                    if (FIRST) { *(f32x4*)yp = v0; *(f32x4*)(yp + 4) = v1; }
                    else { v0 += *(const f32x4*)yp; v1 += *(const f32x4*)(yp + 4);
                        u32x4 w; w.x = cvt_pk_bf16(v0[0], v0[1]); w.y = cvt_pk_bf16(v0[2], v0[3]); w.z = cvt_pk_bf16(v1[0], v1[1]); w.w = cvt_pk_bf16(v1[2], v1[3]);
                        *(u32x4*)(Y + row * ldy + col0 + bj * HALF) = w; } } }
    }
};
template <class Epi, class Sched, bool ALIGN_EPI = false, bool SP2 = false>
__device__ __forceinline__ void gemm_phase(PG8_LAS unsigned char* lds, const Gemm g, const Sched& S, const Epi& E) {
    const int tid = threadIdx.x, wid = __builtin_amdgcn_readfirstlane(tid >> 6), lane = tid & 63, wr = wid >> 2, wc = wid & 3, fr = lane & 15, fq = lane >> 4;
    const int K = g.K, nt = K / BK;
    unsigned voffA[2], voffB[2];
#pragma unroll
    for (int i = 0; i < 2; ++i) { int R, C; stage_rc(tid * 16 + i * 8192, R, C); const int Rb = Epi::PERM ? ((R & ~31) + perm32(R & 31)) : R;
        voffA[i] = (unsigned)(R * K + C) * 2u; voffB[i] = (unsigned)(Rb * K + C) * 2u; }
    const size_t kstep = (size_t)(BK * 2);
    const size_t hstep = (size_t)HALF * K * 2;
    const size_t tstep = 2 * hstep;
    const unsigned ldsw = (unsigned)wid * 1024u;
    const int aoff = lds_byte(wr * 64 + fr, fq * 8), boff = lds_byte(wc * 32 + fr, fq * 8);
#define PG8_SA(b, h) (((b) * 2 + (h)) * HTB)
#define PG8_SB(b, h) ((4 + (b) * 2 + (h)) * HTB)
#define PG8_STAGE(bufoff, gbase, voff) do { _Pragma("unroll") for (int _i = 0; _i < 2; ++_i) \
        __builtin_amdgcn_global_load_lds((const unsigned*)((const char*)(gbase) + (voff)[_i]), (PG8_LAS unsigned*)(lds + (bufoff) + ldsw + _i * 8192), 16, 0, 0); } while (0)
#define PG8_LDA(dst, b, h) do { _Pragma("unroll") for (int m = 0; m < 4; ++m) _Pragma("unroll") for (int k = 0; k < 2; ++k) dst[m][k] = *(const PG8_LAS bf16x8*)(lds + PG8_SA(b, h) + aoff + m * 2048 + k * 1024); } while (0)
#define PG8_LDB(dst, b, h) do { _Pragma("unroll") for (int n = 0; n < 2; ++n) _Pragma("unroll") for (int k = 0; k < 2; ++k) dst[n][k] = *(const PG8_LAS bf16x8*)(lds + PG8_SB(b, h) + boff + n * 2048 + k * 1024); } while (0)
#define PG8_MMA(ai, bj, At, Bt) do { __builtin_amdgcn_s_setprio(1); _Pragma("unroll") for (int m = 0; m < 4; ++m) _Pragma("unroll") for (int n = 0; n < 2; ++n) _Pragma("unroll") for (int k = 0; k < 2; ++k) \
        acc[ai][bj][m][n] = __builtin_amdgcn_mfma_f32_16x16x32_bf16(Bt[n][k], At[m][k], acc[ai][bj][m][n], 0, 0, 0); __builtin_amdgcn_s_setprio(0); } while (0)
#define PG8_WAIT_V(n) asm volatile("s_waitcnt vmcnt(" #n ")" ::: "memory")
#define PG8_WAIT_L(n) asm volatile("s_waitcnt lgkmcnt(" #n ")" ::: "memory")
#define PG8_BAR __builtin_amdgcn_s_barrier()
#define PG8_SCHED __builtin_amdgcn_sched_barrier(0)
    Unit cur, nxt; int ui = 0;
    if (!S.next(0, cur)) return;
    f32x4 acc[2][2][4][2];
#pragma unroll
    for (int a = 0; a < 2; ++a)
#pragma unroll
        for (int b = 0; b < 2; ++b)
#pragma unroll
            for (int m = 0; m < 4; ++m)
#pragma unroll
                for (int n = 0; n < 2; ++n) acc[a][b][m][n] = (f32x4){0.f, 0.f, 0.f, 0.f};
    bf16x8 At[4][2], B0[2][2], B1[2][2];
    const char* cA = (const char*)g.A + (size_t)cur.pm * tstep; const char* cB = (const char*)g.Bt + (size_t)cur.pn * tstep;
    S.a_ready(cur);
    if constexpr (SP2) {
        PG8_STAGE(PG8_SB(0, 0), cB, voffB); PG8_STAGE(PG8_SB(0, 1), cB + hstep, voffB); PG8_STAGE(PG8_SA(0, 0), cA, voffA); PG8_STAGE(PG8_SA(0, 1), cA + hstep, voffA);
        if (wr == 1) PG8_BAR;
        PG8_WAIT_V(2); PG8_BAR;
        PG8_STAGE(PG8_SB(1, 0), cB + kstep, voffB); PG8_STAGE(PG8_SA(1, 0), cA + kstep, voffA); PG8_STAGE(PG8_SB(1, 1), cB + hstep + kstep, voffB);
        PG8_WAIT_V(6); PG8_BAR;
    } else {
        PG8_STAGE(PG8_SB(0, 0), cB, voffB); PG8_STAGE(PG8_SA(0, 0), cA, voffA); PG8_STAGE(PG8_SB(0, 1), cB + hstep, voffB); PG8_STAGE(PG8_SA(0, 1), cA + hstep, voffA);
        if (wr == 1) PG8_BAR;
        PG8_WAIT_V(4); PG8_BAR;
        PG8_STAGE(PG8_SB(1, 0), cB + kstep, voffB); PG8_STAGE(PG8_SA(1, 0), cA + kstep, voffA); PG8_STAGE(PG8_SB(1, 1), cB + hstep + kstep, voffB);
        PG8_WAIT_V(6); PG8_BAR;
    }
    for (;;) {
        const bool has_next = S.next(ui + 1, nxt);
        const char* nA = has_next ? (const char*)g.A + (size_t)nxt.pm * tstep : cA; const char* nB = has_next ? (const char*)g.Bt + (size_t)nxt.pn * tstep : cB;
        for (int t = 0; t < nt; t += 2) {
            const bool last = (t == nt - 2);
            const char* a1 = cA + (size_t)(t + 1) * kstep;
            const char* a2 = last ? nA : cA + (size_t)(t + 2) * kstep; const char* b2 = last ? nB : cB + (size_t)(t + 2) * kstep;
            const char* a3 = a2 + kstep; const char* b3 = b2 + kstep;
            if (last && has_next) S.a_ready(nxt);
            if constexpr (SP2) {
            PG8_LDB(B0, 0, 0); PG8_LDB(B1, 0, 1); PG8_SCHED; PG8_LDA(At, 0, 0); PG8_STAGE(PG8_SA(1, 1), a1 + hstep, voffA);
            PG8_WAIT_V(8); PG8_WAIT_L(0); PG8_BAR; PG8_MMA(0, 0, At, B0); PG8_MMA(0, 1, At, B1); PG8_BAR; PG8_SCHED;
            PG8_LDA(At, 0, 1); PG8_STAGE(PG8_SB(0, 0), b2, voffB); PG8_STAGE(PG8_SB(0, 1), b2 + hstep, voffB); PG8_STAGE(PG8_SA(0, 0), a2, voffA);
            PG8_WAIT_V(8); PG8_WAIT_L(0); PG8_BAR; PG8_MMA(1, 0, At, B0); PG8_MMA(1, 1, At, B1); PG8_BAR; PG8_SCHED;
            PG8_LDB(B0, 1, 0); PG8_LDB(B1, 1, 1); PG8_SCHED; PG8_LDA(At, 1, 0); PG8_STAGE(PG8_SA(0, 1), a2 + hstep, voffA);
            PG8_WAIT_V(8); PG8_WAIT_L(0); PG8_BAR; PG8_MMA(0, 0, At, B0); PG8_MMA(0, 1, At, B1); PG8_BAR; PG8_SCHED;
            PG8_LDA(At, 1, 1); PG8_STAGE(PG8_SB(1, 0), b3, voffB); PG8_STAGE(PG8_SB(1, 1), b3 + hstep, voffB); PG8_STAGE(PG8_SA(1, 0), a3, voffA);
            PG8_WAIT_V(8); PG8_WAIT_L(0); PG8_BAR; PG8_MMA(1, 0, At, B0); PG8_MMA(1, 1, At, B1); PG8_BAR; PG8_SCHED;
            } else {
            PG8_LDB(B0, 0, 0); PG8_SCHED; PG8_LDA(At, 0, 0); PG8_STAGE(PG8_SA(1, 1), a1 + hstep, voffA);
            PG8_WAIT_L(8); PG8_BAR; PG8_WAIT_L(0); PG8_MMA(0, 0, At, B0); PG8_BAR; PG8_SCHED;
            PG8_LDB(B1, 0, 1); PG8_STAGE(PG8_SB(0, 0), b2, voffB);
            PG8_BAR; PG8_WAIT_L(0); PG8_MMA(0, 1, At, B1); PG8_BAR;
            PG8_LDA(At, 0, 1); PG8_STAGE(PG8_SA(0, 0), a2, voffA);
            PG8_BAR; PG8_WAIT_L(0); PG8_MMA(1, 0, At, B0); PG8_BAR; PG8_SCHED;
            PG8_STAGE(PG8_SB(0, 1), b2 + hstep, voffB);
            PG8_WAIT_V(6); PG8_BAR; PG8_MMA(1, 1, At, B1); PG8_BAR;
            PG8_LDB(B0, 1, 0); PG8_SCHED; PG8_LDA(At, 1, 0); PG8_STAGE(PG8_SA(0, 1), a2 + hstep, voffA);
            PG8_WAIT_L(8); PG8_BAR; PG8_WAIT_L(0); PG8_MMA(0, 0, At, B0); PG8_BAR; PG8_SCHED;
            PG8_LDB(B1, 1, 1); PG8_STAGE(PG8_SB(1, 0), b3, voffB);
            PG8_BAR; PG8_WAIT_L(0); PG8_MMA(0, 1, At, B1); PG8_BAR;
            PG8_LDA(At, 1, 1); PG8_STAGE(PG8_SA(1, 0), a3, voffA);
            PG8_BAR; PG8_WAIT_L(0); PG8_MMA(1, 0, At, B0); PG8_BAR; PG8_SCHED;
            PG8_STAGE(PG8_SB(1, 1), b3 + hstep, voffB);
            PG8_WAIT_V(6); PG8_BAR; PG8_MMA(1, 1, At, B1); PG8_BAR;
            }
        }
        if constexpr (ALIGN_EPI) { if (wr == 0) PG8_BAR; }
        if constexpr (!Epi::AFTER_DRAIN) { E(acc, cur, wr, wc, fr, fq); S.done(cur); }
        if (!has_next) break;
#pragma unroll
        for (int a = 0; a < 2; ++a)
#pragma unroll
            for (int b = 0; b < 2; ++b)
#pragma unroll
                for (int m = 0; m < 4; ++m)
#pragma unroll
                    for (int n = 0; n < 2; ++n) acc[a][b][m][n] = (f32x4){0.f, 0.f, 0.f, 0.f};
        cur = nxt; cA = nA; cB = nB; ++ui;
        if constexpr (ALIGN_EPI) { if (wr == 1) PG8_BAR; }
    }
    PG8_WAIT_V(0);
    if constexpr (!ALIGN_EPI) { if (wr == 0) PG8_BAR; }
    PG8_BAR;
    if constexpr (Epi::AFTER_DRAIN) { E.fused(acc, cur, wr, wc, fr, fq, lds, wid, lane); S.done(cur); }
#undef PG8_SA
#undef PG8_SB
#undef PG8_STAGE
#undef PG8_LDA
#undef PG8_LDB
#undef PG8_MMA
#undef PG8_WAIT_V
#undef PG8_WAIT_L
#undef PG8_BAR
#undef PG8_SCHED
}
}
#ifndef MK_SINGLE
#define MK_SINGLE 0
#endif
constexpr int NWAVES = 8;
constexpr int BATCH = 4, SEQ = 4096, DM = 4096, FF = 11008, M = BATCH * SEQ;
constexpr int PROJ_LD = 26624, NPROJ = 26880;
constexpr int PC_GQ = 0, PC_GK = 2048, PC_GV = 4096, PC_GZ = 8192, PC_MQ = 12288, PC_MK = 14336, PC_MV = 16384, PC_GG = 18432, PC_MG = 22528;
constexpr float NORM_EPS = 1e-6f;
constexpr int N_PHASES = 14;

constexpr size_t MiB = 1u << 20;
constexpr size_t WS_CTL = 0, CTL_ZERO_BYTES = 1 * MiB;
constexpr size_t WS_KMEAN = 1 * MiB, WS_ROPE = 2 * MiB, WS_AB = 4 * MiB, WS_G = 8 * MiB, WS_BETA = 10 * MiB;
constexpr size_t WS_WGU = 16 * MiB, WS_WD = 188 * MiB;
constexpr size_t WS_H = 274 * MiB;
constexpr size_t WS_WB = 402 * MiB;
constexpr size_t WS_BIG = 612 * MiB;
constexpr size_t WS_OG = 1444 * MiB, WS_OM = 1572 * MiB, WS_WBG = 1636 * MiB, WS_WBM = 1668 * MiB, WS_WO = 1684 * MiB, WS_END = 1716 * MiB;
constexpr size_t WS_QN = 16 * MiB, WS_KN = 80 * MiB, WS_VP = 144 * MiB;
constexpr size_t WS_MQ = 402 * MiB, WS_MK = 466 * MiB, WS_MV = 530 * MiB;
constexpr size_t WS_Y1 = 16 * MiB;
static_assert(WS_WGU + (size_t)22016 * 4096 * 2 <= WS_WD && WS_WD + (size_t)4096 * 11008 * 2 <= WS_H && WS_H + (size_t)M * DM * 2 <= WS_WB, "ws map 1");
static_assert(WS_WB + (size_t)NPROJ * DM * 2 <= WS_BIG && WS_BIG + (size_t)M * PROJ_LD * 2 <= WS_OG && WS_MV + (size_t)M * 2048 * 2 <= WS_BIG && WS_Y1 + (size_t)M * DM * 4 <= WS_H, "ws map 2");
constexpr int CW_BAR = 4096;

constexpr int RING_BYTES = 131072, TR_STRIDE = 16640, MISC_OFF = 143360, LDS_BYTES = 147456;
static_assert(8 * TR_STRIDE <= MISC_OFF, "LDS map");

#define GAS __attribute__((address_space(1)))
#define LAS __attribute__((address_space(3)))
typedef unsigned short bf16;
typedef unsigned v4u __attribute__((ext_vector_type(4)));
typedef unsigned v2u __attribute__((ext_vector_type(2)));
typedef float f32x4 __attribute__((ext_vector_type(4)));
typedef float f32x2 __attribute__((ext_vector_type(2)));
#define LDS_WAIT() asm volatile("s_waitcnt lgkmcnt(0)" ::: "memory")
#define VM_WAIT() asm volatile("s_waitcnt vmcnt(0)" ::: "memory")
__device__ __forceinline__ unsigned f2bf(float f) { unsigned u = __builtin_bit_cast(unsigned, f); return (u + 0x7fffu + ((u >> 16) & 1u)) >> 16; }
__device__ __forceinline__ unsigned pk2(float lo, float hi) { return f2bf(lo) | (f2bf(hi) << 16); }
__device__ __forceinline__ float bf2f(unsigned short b) { return __uint_as_float(((unsigned)b) << 16); }
__device__ __forceinline__ float blo(unsigned w) { return __uint_as_float(w << 16); }
__device__ __forceinline__ float bhi(unsigned w) { return __uint_as_float(w & 0xffff0000u); }
__device__ __forceinline__ float wave_sum(float v) {
#pragma unroll
    for (int o = 1; o < 64; o <<= 1) v += __shfl_xor(v, o);
    return v;
}
__device__ __forceinline__ float wave_max(float v) {
#pragma unroll
    for (int o = 1; o < 64; o <<= 1) v = fmaxf(v, __shfl_xor(v, o));
    return v;
}
#define XB_TMO      128
#define XB_XCNT(j)  (256  + 64 * (j))
#define XB_XSUB(j)  (1280 + 64 * (j))
#define XB_XGEN(j)  (2304 + 64 * (j))
#define XB_TOP      3328
#define XB_TOPGEN   3392
#define XCD_BAR_WORDS 3456
#define XB_SPIN_CAP (1u << 18)

__device__ __forceinline__ unsigned xb_ld(unsigned* p)              { return __hip_atomic_load(p, __ATOMIC_RELAXED, __HIP_MEMORY_SCOPE_AGENT); }
__device__ __forceinline__ unsigned xb_add(unsigned* p, unsigned v) { return __hip_atomic_fetch_add(p, v, __ATOMIC_RELAXED, __HIP_MEMORY_SCOPE_AGENT); }
__device__ __forceinline__ unsigned xb_xcc_id() { return (unsigned)__builtin_amdgcn_s_getreg((3 << 11) | 20) & 0xFu; }
#define XB_SPIN(cond, bar) do { unsigned _sp = 0; while (cond) { __builtin_amdgcn_s_sleep(1); \
    if ((++_sp & 255u) == 0u) { if (xb_ld(&(bar)[XB_TMO])) break; if (_sp > XB_SPIN_CAP) { atomicAdd(&(bar)[XB_TMO], 1u); break; } } } } while (0)

struct XcdBarrier {
    unsigned* bar; unsigned x;
    volatile LAS unsigned* st;
};

__device__ __forceinline__ XcdBarrier xcd_barrier_post(unsigned* bar, volatile LAS unsigned* st) {
    XcdBarrier b; b.bar = bar; b.x = xb_xcc_id(); b.st = st;
    if (threadIdx.x == 0) (void)xb_add(&bar[XB_XCNT(b.x)], 1u);
    return b;
}
__device__ __forceinline__ void xcd_barrier_complete(unsigned* bar, unsigned x, unsigned& nloc, unsigned& nx) {
    const unsigned G = gridDim.x * gridDim.y * gridDim.z;
    unsigned sum, cnt, mine, sp = 0u;
    for (;;) {
        sum = 0u; cnt = 0u; mine = 0u;
#pragma unroll
        for (unsigned j = 0; j < 16; ++j) { const unsigned c = xb_ld(&bar[XB_XCNT(j)]); sum += c; cnt += (c > 0u) ? 1u : 0u; mine = (j == x) ? c : mine; }
        if (sum == G) break;
        __builtin_amdgcn_s_sleep(1);
        if ((++sp & 255u) == 0u) { if (xb_ld(&bar[XB_TMO])) break; if (sp > XB_SPIN_CAP) { atomicAdd(&bar[XB_TMO], 1u); break; } }
    }
    nloc = mine > 0u ? mine : 1u; nx = cnt > 0u ? cnt : 1u;
}

__device__ __forceinline__ void xcd_barrier(const XcdBarrier& b) {
    asm volatile("s_waitcnt vmcnt(0)" ::: "memory");
    __syncthreads();
    if (threadIdx.x == 0) {
        unsigned* bar = b.bar;
        __builtin_amdgcn_s_waitcnt(0);
        unsigned nloc = b.st[0], nx = b.st[1];
        if (nloc == 0u) { xcd_barrier_complete(bar, b.x, nloc, nx); b.st[0] = nloc; b.st[1] = nx; }
        const unsigned old = xb_add(&bar[XB_XSUB(b.x)], 1u);
        const unsigned gen = old / nloc;
        if (old + 1u == (gen + 1u) * nloc) {
            __builtin_amdgcn_fence(__ATOMIC_RELEASE, "agent");
            asm volatile("s_waitcnt vmcnt(0)" ::: "memory");
            const unsigned og = xb_add(&bar[XB_TOP], 1u);
            const unsigned tg = og / nx;
            if (og + 1u == (tg + 1u) * nx) xb_add(&bar[XB_TOPGEN], 1u);
            else XB_SPIN(xb_ld(&bar[XB_TOPGEN]) == tg, bar);
            __builtin_amdgcn_fence(__ATOMIC_ACQUIRE, "agent");
            xb_add(&bar[XB_XGEN(b.x)], 1u);
            asm volatile("s_waitcnt vmcnt(0)" ::: "memory");
        } else {
            XB_SPIN(xb_ld(&bar[XB_XGEN(b.x)]) == gen, bar);
            __builtin_amdgcn_fence(__ATOMIC_ACQUIRE, "agent");
            asm volatile("s_waitcnt vmcnt(0)" ::: "memory");
        }
    }
    __syncthreads();
}
struct Frame {
    LAS unsigned char* lds;
    volatile LAS unsigned* MISC;
    unsigned* ctl;
    int tid, lane, wave, vcu, G; unsigned char* wsb;
    const float* in[20]; float* out;
    bf16 *WGU, *WD, *H, *WB, *PROJ, *ACT, *OG, *OM, *WBG, *WBM, *WO, *QN, *KN, *VP, *MQ, *MK, *MV;
    float *KMEAN, *AB, *GG, *BETA, *Y1; f32x2* ROPE;
};

template <int MODE> __device__ __forceinline__ int rowmap(int n0) {
    if (MODE == 0) return n0;
    if (MODE == 1) return 256 * (n0 >> 7) + (n0 & 127);
    if (MODE == 2) return 256 * (n0 >> 7) + 128 + (n0 & 127);
    return n0 < 12288 ? n0 : (n0 < 12352 ? 26624 + (n0 - 12288) : n0 - 64);
}
template <int MODE> __device__ __forceinline__ void tr_item(const float* W, int K, int N, bf16* WT, LAS float* scr, int item, int lane) {
    const int nblk = N >> 6, kb = item / nblk, nb = item - kb * nblk, k0 = kb << 6, n0 = nb << 6;
    const float* src = W + (size_t)k0 * N + n0 + lane;
#pragma unroll 16
    for (int i = 0; i < 64; ++i) scr[i * 65 + lane] = src[(size_t)i * N];
    LDS_WAIT();
    const int c = lane & 7, r = lane >> 3, drow = rowmap<MODE>(n0);
#pragma unroll
    for (int j = 0; j < 8; ++j) { const int n = r + 8 * j; const LAS float* s = scr + (8 * c) * 65 + n;
        v4u o; o.x = pk2(s[0], s[65]); o.y = pk2(s[130], s[195]); o.z = pk2(s[260], s[325]); o.w = pk2(s[390], s[455]);
        *(v4u*)(WT + (size_t)(drow + n) * K + k0 + 8 * c) = o; }
    LDS_WAIT();
}
__device__ __forceinline__ void convert_ffn(Frame& F, const float* wg, const float* wu, const float* wd) {
    LAS float* scr = (LAS float*)(F.lds + F.wave * TR_STRIDE);
    const int gw = F.vcu * NWAVES + F.wave, NGW = F.G * NWAVES;
    constexpr int I1 = (DM / 64) * (FF / 64);
    for (int it = gw; it < 3 * I1; it += NGW) {
        if (it < I1) tr_item<1>(wg, DM, FF, F.WGU, scr, it, F.lane);
        else if (it < 2 * I1) tr_item<2>(wu, DM, FF, F.WGU, scr, it - I1, F.lane);
        else tr_item<0>(wd, FF, DM, F.WD, scr, it - 2 * I1, F.lane);
    }
}
__device__ __forceinline__ void convert_win(Frame& F) {
    LAS float* scr = (LAS float*)(F.lds + F.wave * TR_STRIDE);
    const int gw = F.vcu * NWAVES + F.wave, NGW = F.G * NWAVES;
    constexpr int I1 = (DM / 64) * (26688 / 64);
    for (int it = gw; it < I1; it += NGW) tr_item<3>(F.in[6], DM, 26688, F.WB, scr, it, F.lane);
}
__device__ __forceinline__ void convert_branch(Frame& F) {
    LAS float* scr = (LAS float*)(F.lds + F.wave * TR_STRIDE);
    const int gw = F.vcu * NWAVES + F.wave, NGW = F.G * NWAVES;
    constexpr int IG = 64 * 64, IM = 32 * 64;
    for (int it = gw; it < 2 * IG + IM; it += NGW) {
        if (it < IG) tr_item<0>(F.in[13], 4096, 4096, F.WBG, scr, it, F.lane);
        else if (it < IG + IM) tr_item<0>(F.in[14], 2048, 4096, F.WBM, scr, it - IG, F.lane);
        else tr_item<0>(F.in[15], 4096, 4096, F.WO, scr, it - IG - IM, F.lane);
    }
}
__device__ __forceinline__ void rms_rows(Frame& F, const float* X, const float* gain, bf16* O) {
    const int gw = F.vcu * NWAVES + F.wave, NGW = F.G * NWAVES;
    for (int m = gw; m < M; m += NGW) {
        const f32x4* xr = (const f32x4*)(X + (size_t)m * DM) + F.lane; const f32x4* gr = (const f32x4*)gain + F.lane;
        f32x4 v[16]; float s = 0.f;
#pragma unroll
        for (int j = 0; j < 16; ++j) { v[j] = xr[64 * j]; s += (v[j].x * v[j].x + v[j].y * v[j].y) + (v[j].z * v[j].z + v[j].w * v[j].w); }
        const float r = 1.0f / sqrtf(wave_sum(s) * (1.0f / DM) + NORM_EPS);
        v2u* o8 = (v2u*)(O + (size_t)m * DM) + F.lane;
#pragma unroll
        for (int j = 0; j < 16; ++j) { const f32x4 g = gr[64 * j]; v2u w; w.x = pk2(v[j].x * r * g.x, v[j].y * r * g.y); w.y = pk2(v[j].z * r * g.z, v[j].w * r * g.w); o8[64 * j] = w; }
    }
}
__device__ __forceinline__ void rope_table(Frame& F) {
    const int gt = F.vcu * NWAVES * 64 + F.tid, NT = F.G * NWAVES * 64;
    for (int idx = gt; idx < SEQ * 64; idx += NT) {
        const int s = idx >> 6, i = idx & 63;
        double f = 1.0, bs = 0.8659643233600653; int e = i;
        while (e) { if (e & 1) f *= bs; bs *= bs; e >>= 1; }
        const float inv = (float)f; const float ang = (float)s * inv;
        const double a = (double)ang; const double k = __builtin_rint(a * 0.15915494309189535);
        double r = __builtin_fma(-k, 6.283185307179586, a); r = __builtin_fma(-k, 2.4492935982947064e-16, r);
        const double q = r * 0.25, q2 = q * q;
        const double sn = q * (1.0 + q2 * (-1.0 / 6 + q2 * (1.0 / 120 + q2 * (-1.0 / 5040 + q2 * (1.0 / 362880 + q2 * (-1.0 / 39916800 + q2 * (1.0 / 6227020800.0)))))));
        const double cs = 1.0 + q2 * (-0.5 + q2 * (1.0 / 24 + q2 * (-1.0 / 720 + q2 * (1.0 / 40320 + q2 * (-1.0 / 3628800 + q2 * (1.0 / 479001600 + q2 * (-1.0 / 87178291200.0)))))));
        const double s2 = 2.0 * sn * cs, c2 = 1.0 - 2.0 * sn * sn, s4 = 2.0 * s2 * c2, c4 = 1.0 - 2.0 * s2 * s2;
        F.ROPE[idx] = (f32x2){(float)c4, (float)s4};
    }
}
__device__ __forceinline__ void prep_moba(Frame& F) {
    LAS float* red = (LAS float*)F.lds;
    const int w = F.wave, lane = F.lane;
    for (int item = blockIdx.x; item < BATCH * 16 * 16 * 3; item += F.G) {
        const int which = item % 3; int r = item / 3; const int h = r & 15; r >>= 4; const int j = r & 15; const int b = r >> 4;
        const int colbase = (which == 0 ? PC_MQ : which == 1 ? PC_MK : PC_MV) + h * 128;
        bf16* dst = (bf16*)(F.wsb + (which == 0 ? WS_MQ : which == 1 ? WS_MK : WS_MV)) + ((size_t)(b * 16 + h) * SEQ + j * 256) * 128;
        const bf16* src = F.PROJ + (size_t)(b * SEQ + j * 256) * PROJ_LD + colbase;
        float ks1 = 0.f, ks2 = 0.f;
        if (which == 2) {
            for (int i = 0; i < 32; ++i) { const int tt = w * 32 + i; *(unsigned*)(dst + tt * 128 + 2 * lane) = *(const unsigned*)(src + (size_t)tt * PROJ_LD + 2 * lane); }
        } else {
            const float* gq = F.in[11]; const float* gk = F.in[12]; const float gq1 = gq[lane], gq2 = gq[lane + 64], gk1 = gk[lane], gk2 = gk[lane + 64]; const float g1 = which == 0 ? gq1 : gk1, g2 = which == 0 ? gq2 : gk2;
            for (int i = 0; i < 32; ++i) { const int tt = w * 32 + i, s = j * 256 + tt;
                const float x1 = bf2f(src[(size_t)tt * PROJ_LD + lane]), x2 = bf2f(src[(size_t)tt * PROJ_LD + lane + 64]);
                const float rr = 1.0f / sqrtf(wave_sum(x1 * x1 + x2 * x2) * (1.0f / 128) + NORM_EPS);
                const float y1 = x1 * rr * g1, y2 = x2 * rr * g2; const f32x2 cs = F.ROPE[s * 64 + lane];
                const float o1 = y1 * cs.x - y2 * cs.y, o2 = y2 * cs.x + y1 * cs.y;
                dst[tt * 128 + lane] = (bf16)f2bf(o1); dst[tt * 128 + lane + 64] = (bf16)f2bf(o2); ks1 += o1; ks2 += o2; }
        }
        red[w * 128 + lane] = ks1; red[w * 128 + lane + 64] = ks2;
        __syncthreads();
        if (which == 1 && F.tid < 128) { float s = 0.f;
#pragma unroll
            for (int ww = 0; ww < 8; ++ww) s += red[ww * 128 + F.tid];
            F.KMEAN[((size_t)(b * 16 + h) * 16 + j) * 128 + F.tid] = s * (1.0f / 256); }
        __syncthreads();
    }
}
__device__ __forceinline__ void prep_gdn(Frame& F) {
    const int gw = F.vcu * NWAVES + F.wave, NGW = F.G * NWAVES, lane = F.lane;
    const float* cw = F.in[7];
    for (int item = gw; item < M * 64; item += NGW) {
        const int grp = item & 63, t = item >> 6, s = t & (SEQ - 1), c = grp * 128 + 2 * lane;
        const bf16* src = F.PROJ + (size_t)t * PROJ_LD + c;
        float a0 = 0.f, a1 = 0.f;
#pragma unroll
        for (int j = 0; j < 4; ++j) { const int ds = j - 3;
            if (s + ds >= 0) { const unsigned v = *(const unsigned*)(src + (ptrdiff_t)ds * PROJ_LD); const f32x2 wv = *(const f32x2*)(cw + j * 8192 + c); a0 += wv.x * blo(v); a1 += wv.y * bhi(v); } }
        a0 = a0 / (1.0f + __expf(-a0)); a1 = a1 / (1.0f + __expf(-a1));
        if (grp < 32) { const float r = 1.0f / sqrtf(wave_sum(a0 * a0 + a1 * a1) + NORM_EPS); a0 *= r; a1 *= r; }
        bf16* dst = (bf16*)(F.wsb + (grp < 16 ? WS_QN : grp < 32 ? WS_KN : WS_VP)) + (grp < 16 ? (size_t)t * 2048 + grp * 128 : (grp < 32 ? (size_t)t * 2048 + (grp - 16) * 128 : (size_t)t * 4096 + (grp - 32) * 128));
        *(unsigned*)(dst + 2 * lane) = pk2(a0, a1);
    }
    const int gt = F.vcu * NWAVES * 64 + F.tid, NT = F.G * NWAVES * 64;
    for (int idx = gt; idx < M * 32; idx += NT) { const int hv = idx & 31, t = idx >> 5;
        const float a = F.AB[(size_t)t * 64 + hv], bb = F.AB[(size_t)t * 64 + 32 + hv];
        const float x = a + F.in[9][hv]; const float sp = fmaxf(x, 0.f) + log1pf(expf(-fabsf(x)));
        F.GG[idx] = -expf(F.in[8][hv]) * sp; F.BETA[idx] = 1.0f / (1.0f + expf(-bb)); }
}
__device__ __forceinline__ void gdn_seq(Frame& F, int seq) {
    const int b = seq >> 5, hv = seq & 31, hq = hv >> 1, w = F.wave, lane = F.lane, jj = lane & 15, p = lane >> 4, tid = F.tid;
    LAS float* qs = (LAS float*)F.lds; LAS float* ks = qs + 64 * 128; LAS float* vs = ks + 64 * 128; LAS float* os = vs + 64 * 128;
    LAS float* egs = (LAS float*)(F.lds + RING_BYTES); LAS float* bts = egs + 64;
    const float* onorm = F.in[10];
    float S[32];
#pragma unroll
    for (int i = 0; i < 32; ++i) S[i] = 0.f;
    for (int c = 0; c < SEQ / 64; ++c) {
        const int t0 = b * SEQ + c * 64;
        { const int tt = tid >> 3, seg = tid & 7;
          const v4u* qp = (const v4u*)(F.QN + (size_t)(t0 + tt) * 2048 + hq * 128 + seg * 16);
          const v4u* kp = (const v4u*)(F.KN + (size_t)(t0 + tt) * 2048 + hq * 128 + seg * 16);
          const v4u* vp = (const v4u*)(F.VP + (size_t)(t0 + tt) * 4096 + hv * 128 + seg * 16);
          const float sc = 0.08838834764831845f;
#pragma unroll
          for (int h2 = 0; h2 < 2; ++h2) { const v4u q4 = qp[h2], k4 = kp[h2], v4 = vp[h2]; const int o = tt * 128 + seg * 16 + h2 * 8;
              *(LAS f32x4*)(qs + o) = (f32x4){blo(q4.x) * sc, bhi(q4.x) * sc, blo(q4.y) * sc, bhi(q4.y) * sc}; *(LAS f32x4*)(qs + o + 4) = (f32x4){blo(q4.z) * sc, bhi(q4.z) * sc, blo(q4.w) * sc, bhi(q4.w) * sc};
              *(LAS f32x4*)(ks + o) = (f32x4){blo(k4.x), bhi(k4.x), blo(k4.y), bhi(k4.y)}; *(LAS f32x4*)(ks + o + 4) = (f32x4){blo(k4.z), bhi(k4.z), blo(k4.w), bhi(k4.w)};
              *(LAS f32x4*)(vs + o) = (f32x4){blo(v4.x), bhi(v4.x), blo(v4.y), bhi(v4.y)}; *(LAS f32x4*)(vs + o + 4) = (f32x4){blo(v4.z), bhi(v4.z), blo(v4.w), bhi(v4.w)}; }
          if (tid < 64) { egs[tid] = expf(F.GG[(size_t)(t0 + tid) * 32 + hv]); bts[tid] = F.BETA[(size_t)(t0 + tid) * 32 + hv]; } }
        __syncthreads();
        for (int t = 0; t < 64; ++t) {
            const float eg = egs[t], bt = bts[t];
            const LAS float* kr = ks + t * 128 + 32 * p; const LAS float* qr = qs + t * 128 + 32 * p;
            float kk[32];
#pragma unroll
            for (int i = 0; i < 32; i += 4) { const f32x4 k4 = *(const LAS f32x4*)(kr + i); kk[i] = k4.x; kk[i + 1] = k4.y; kk[i + 2] = k4.z; kk[i + 3] = k4.w; }
            float kvp = 0.f;
#pragma unroll
            for (int i = 0; i < 32; ++i) kvp = fmaf(S[i], kk[i], kvp);
            kvp += __shfl_xor(kvp, 16); kvp += __shfl_xor(kvp, 32);
            const float delta = (vs[t * 128 + 16 * w + jj] - eg * kvp) * bt;
            float op = 0.f;
#pragma unroll
            for (int i = 0; i < 32; i += 4) { const f32x4 q4 = *(const LAS f32x4*)(qr + i);
                S[i] = fmaf(eg, S[i], kk[i] * delta); S[i + 1] = fmaf(eg, S[i + 1], kk[i + 1] * delta); S[i + 2] = fmaf(eg, S[i + 2], kk[i + 2] * delta); S[i + 3] = fmaf(eg, S[i + 3], kk[i + 3] * delta);
                op = fmaf(S[i], q4.x, op); op = fmaf(S[i + 1], q4.y, op); op = fmaf(S[i + 2], q4.z, op); op = fmaf(S[i + 3], q4.w, op); }
            op += __shfl_xor(op, 16); op += __shfl_xor(op, 32);
            if (p == 0) os[t * 128 + 16 * w + jj] = op;
        }
        __syncthreads();
#pragma unroll
        for (int i = 0; i < 8; ++i) { const int tt = 8 * w + i; const f32x2 o2 = *(const LAS f32x2*)(os + tt * 128 + 2 * lane);
            const float r = 1.0f / sqrtf(wave_sum(o2.x * o2.x + o2.y * o2.y) * (1.0f / 128) + NORM_EPS);
            const unsigned zw = *(const unsigned*)(F.PROJ + (size_t)(t0 + tt) * PROJ_LD + PC_GZ + hv * 128 + 2 * lane);
            const float z0 = blo(zw), z1 = bhi(zw); const f32x2 gn = *(const f32x2*)(onorm + 2 * lane);
            const float y0 = o2.x * r * gn.x * (z0 / (1.0f + __expf(-z0))), y1 = o2.y * r * gn.y * (z1 / (1.0f + __expf(-z1)));
            *(unsigned*)(F.OG + (size_t)(t0 + tt) * 4096 + hv * 128 + 2 * lane) = pk2(y0, y1); }
        __syncthreads();
    }
}
__device__ __forceinline__ void moba_query(Frame& F, int item, LAS float* qf, LAS float* pl) {
    const int lane = F.lane, s = item & (SEQ - 1), bh = item >> 12, qblk = s >> 8, spos = s & 255;
    { const unsigned u = *(const unsigned*)(F.MQ + (size_t)item * 128 + 2 * lane); *(LAS f32x2*)(qf + 2 * lane) = (f32x2){blo(u), bhi(u)}; }
    LDS_WAIT();
    float gate = -INFINITY;
    if (lane < qblk) { const f32x4* km = (const f32x4*)(F.KMEAN + ((size_t)bh * 16 + lane) * 128); float a = 0.f;
        for (int d = 0; d < 32; ++d) { const f32x4 k4 = km[d]; const f32x4 q4 = *(const LAS f32x4*)(qf + 4 * d); a += (k4.x * q4.x + k4.y * q4.y) + (k4.z * q4.z + k4.w * q4.w); }
        gate = a; }
    int sel0 = 0, sel1 = 0, sel2 = 0;
#pragma unroll
    for (int r = 0; r < 3; ++r) { const float mx = wave_max(gate); const unsigned long long bal = __ballot(gate == mx && mx > -INFINITY);
        const int idx = bal ? (int)__builtin_ctzll(bal) : 0; if (r == 0) sel0 = idx; else if (r == 1) sel1 = idx; else sel2 = idx; if (lane == idx && bal) gate = -INFINITY; }
    const int nsel = qblk < 3 ? qblk : 3;
    const float scale = 0.08838834764831845f;
    const bf16* Kb = F.MK + (size_t)bh * SEQ * 128; const bf16* Vb = F.MV + (size_t)bh * SEQ * 128;
    float sc[16]; float mx = -INFINITY;
#pragma unroll
    for (int i = 0; i < 16; ++i) { const int sb = i >> 2, kk = (i & 3) * 64 + lane;
        const int kb = sb == 0 ? sel0 : sb == 1 ? sel1 : sb == 2 ? sel2 : qblk;
        const bool valid = sb < 3 ? (sb < nsel) : (kk <= spos);
        float v = -INFINITY;
        if (valid) { const v4u* kr = (const v4u*)(Kb + (size_t)(kb * 256 + kk) * 128); float a = 0.f;
#pragma unroll 4
            for (int d = 0; d < 16; ++d) { const v4u k4 = kr[d]; const f32x4 qa = *(const LAS f32x4*)(qf + 8 * d), qb = *(const LAS f32x4*)(qf + 8 * d + 4);
                a += (blo(k4.x) * qa.x + bhi(k4.x) * qa.y) + (blo(k4.y) * qa.z + bhi(k4.y) * qa.w) + (blo(k4.z) * qb.x + bhi(k4.z) * qb.y) + (blo(k4.w) * qb.z + bhi(k4.w) * qb.w); }
            v = a * scale; }
        sc[i] = v; mx = fmaxf(mx, v); }
    mx = wave_max(mx);
    float sum = 0.f;
#pragma unroll
    for (int i = 0; i < 16; ++i) { const float pv = (sc[i] == -INFINITY) ? 0.f : __expf(sc[i] - mx); pl[i * 64 + lane] = pv; sum += pv; }
    sum = wave_sum(sum);
    LDS_WAIT();
    const int g4 = lane >> 4, dl = lane & 15;
    float acc[8];
#pragma unroll
    for (int i = 0; i < 8; ++i) acc[i] = 0.f;
    for (int sb = 0; sb < 4; ++sb) {
        if (sb < 3 && sb >= nsel) continue;
        const int kb = sb == 0 ? sel0 : sb == 1 ? sel1 : sb == 2 ? sel2 : qblk;
        const int nk = sb == 3 ? spos + 1 : 256;
        for (int k4 = 0; k4 < nk; k4 += 4) { const int kk = k4 + g4;
            const float pv = pl[sb * 256 + kk]; const v4u vv = *(const v4u*)(Vb + (size_t)(kb * 256 + kk) * 128 + dl * 8);
            acc[0] = fmaf(pv, blo(vv.x), acc[0]); acc[1] = fmaf(pv, bhi(vv.x), acc[1]); acc[2] = fmaf(pv, blo(vv.y), acc[2]); acc[3] = fmaf(pv, bhi(vv.y), acc[3]);
            acc[4] = fmaf(pv, blo(vv.z), acc[4]); acc[5] = fmaf(pv, bhi(vv.z), acc[5]); acc[6] = fmaf(pv, blo(vv.w), acc[6]); acc[7] = fmaf(pv, bhi(vv.w), acc[7]); }
    }
#pragma unroll
    for (int i = 0; i < 8; ++i) { acc[i] += __shfl_xor(acc[i], 16); acc[i] += __shfl_xor(acc[i], 32); }
    if (g4 == 0) { const float inv = 1.0f / sum; const int b = bh >> 4, h = bh & 15;
        v4u o; o.x = pk2(acc[0] * inv, acc[1] * inv); o.y = pk2(acc[2] * inv, acc[3] * inv); o.z = pk2(acc[4] * inv, acc[5] * inv); o.w = pk2(acc[6] * inv, acc[7] * inv);
        *(v4u*)(F.OM + (size_t)(b * SEQ + s) * 2048 + h * 128 + dl * 8) = o; }
    LDS_WAIT();
}
struct Args { const float* in[20]; float* out; unsigned char* ws; int ph_lo, ph_hi, li, pad; };
__global__ void __launch_bounds__(NWAVES * 64, 2) fwd(Args args) {
    extern __shared__ __attribute__((aligned(16))) unsigned char lds[];
    Frame F;
    F.lds = (LAS unsigned char*)lds;
    F.MISC = (volatile LAS unsigned*)(F.lds + MISC_OFF);
    F.tid = threadIdx.x; F.lane = F.tid & 63; F.wave = __builtin_amdgcn_readfirstlane(F.tid >> 6);
    F.G = gridDim.x; { const int bx = blockIdx.x; F.vcu = (F.G % 8 == 0) ? (bx % 8) * (F.G / 8) + bx / 8 : bx; }
    unsigned char* ws = args.ws;
    F.ctl = (unsigned*)(ws + WS_CTL); F.wsb = ws;
#pragma unroll
    for (int i = 0; i < 20; ++i) F.in[i] = args.in[i];
    F.out = args.out;
    F.WGU = (bf16*)(ws + WS_WGU); F.WD = (bf16*)(ws + WS_WD); F.H = (bf16*)(ws + WS_H); F.WB = (bf16*)(ws + WS_WB); F.PROJ = (bf16*)(ws + WS_BIG); F.ACT = (bf16*)(ws + WS_BIG);
    F.OG = (bf16*)(ws + WS_OG); F.OM = (bf16*)(ws + WS_OM); F.WBG = (bf16*)(ws + WS_WBG); F.WBM = (bf16*)(ws + WS_WBM); F.WO = (bf16*)(ws + WS_WO);
    F.QN = (bf16*)(ws + WS_QN); F.KN = (bf16*)(ws + WS_KN); F.VP = (bf16*)(ws + WS_VP); F.MQ = (bf16*)(ws + WS_MQ); F.MK = (bf16*)(ws + WS_MK); F.MV = (bf16*)(ws + WS_MV);
    F.KMEAN = (float*)(ws + WS_KMEAN); F.AB = (float*)(ws + WS_AB); F.GG = (float*)(ws + WS_G); F.BETA = (float*)(ws + WS_BETA); F.Y1 = (float*)(ws + WS_Y1); F.ROPE = (f32x2*)(ws + WS_ROPE);
    for (int u = F.tid; u < (LDS_BYTES - MISC_OFF) / 4; u += NWAVES * 64) ((LAS unsigned*)(F.lds + MISC_OFF))[u] = 0u;
    __syncthreads();
    XcdBarrier bar; bar.bar = (unsigned*)(F.ctl + CW_BAR); bar.x = 0; bar.st = nullptr;
#if MK_SINGLE
    bar = xcd_barrier_post((unsigned*)(F.ctl + CW_BAR), F.MISC + 8);
#define GRID_BAR() xcd_barrier(bar)
#else
#define GRID_BAR() do { } while (0)
#endif
    const int lo = args.ph_lo, hi = args.ph_hi;
#define IN(k) (lo <= (k) && (k) < hi)
#define BOTH(k) (IN(k) && IN((k) + 1))
    typedef pg8::bf16_t pb;
    if (IN(0)) { convert_ffn(F, F.in[2], F.in[3], F.in[4]); rms_rows(F, F.in[0], F.in[1], F.H); rope_table(F); if (BOTH(0)) GRID_BAR(); }
    if (IN(1)) { pg8::Gemm g{(const pb*)F.H, (const pb*)F.WGU, M, 2 * FF, DM}; pg8::StaticOrder S; S.init(M, 2 * FF, F.G, (int)blockIdx.x);
        pg8::EpiSwiGLU E{(pb*)F.ACT, FF}; pg8::gemm_phase<pg8::EpiSwiGLU, pg8::StaticOrder, true, true>(F.lds, g, S, E); if (BOTH(1)) GRID_BAR(); }
    if (IN(2)) { pg8::Gemm g{(const pb*)F.ACT, (const pb*)F.WD, M, DM, FF}; pg8::StaticOrder S; S.init(M, DM, F.G, (int)blockIdx.x);
        pg8::EpiResid E{F.in[0], F.out, DM, 0.5f}; pg8::gemm_phase<pg8::EpiResid, pg8::StaticOrder, true, true>(F.lds, g, S, E); if (BOTH(2)) GRID_BAR(); }
    if (IN(3)) { convert_win(F); rms_rows(F, F.out, F.in[5], F.H); if (BOTH(3)) GRID_BAR(); }
    if (IN(4)) { pg8::Gemm g{(const pb*)F.H, (const pb*)F.WB, M, NPROJ, DM}; pg8::StaticOrder S; S.init(M, NPROJ, F.G, (int)blockIdx.x);
        pg8::EpiProj E{(pb*)F.PROJ, PROJ_LD, F.AB, PROJ_LD / 256}; pg8::gemm_phase<pg8::EpiProj, pg8::StaticOrder, true, true>(F.lds, g, S, E); if (BOTH(4)) GRID_BAR(); }
    if (IN(5)) { prep_moba(F); prep_gdn(F); convert_branch(F); if (BOTH(5)) GRID_BAR(); }
    if (IN(6)) { for (int seq = blockIdx.x; seq < BATCH * 32; seq += F.G) gdn_seq(F, seq); }
    if (IN(7)) { LAS float* qf = (LAS float*)(F.lds + F.wave * 4608); LAS float* pl = qf + 128;
        __syncthreads();
        for (int it = blockIdx.x * NWAVES + F.wave; it < BATCH * 16 * SEQ; it += F.G * NWAVES) moba_query(F, it, qf, pl);
        if (BOTH(7)) GRID_BAR(); }
    if (IN(8)) { pg8::Gemm g{(const pb*)F.OG, (const pb*)F.WBG, M, DM, 4096}; pg8::StaticOrder S; S.init(M, DM, F.G, (int)blockIdx.x);
        pg8::EpiGate<true> E{F.Y1, (pb*)F.H, DM, (const pb*)F.PROJ + PC_GG, PROJ_LD}; pg8::gemm_phase<pg8::EpiGate<true>, pg8::StaticOrder, true, true>(F.lds, g, S, E); }
    if (IN(9)) { pg8::Gemm g{(const pb*)F.OM, (const pb*)F.WBM, M, DM, 2048}; pg8::StaticOrder S; S.init(M, DM, F.G, (int)blockIdx.x);
        pg8::EpiGate<false> E{F.Y1, (pb*)F.H, DM, (const pb*)F.PROJ + PC_MG, PROJ_LD}; pg8::gemm_phase<pg8::EpiGate<false>, pg8::StaticOrder, true, true>(F.lds, g, S, E); if (BOTH(9)) GRID_BAR(); }
    if (IN(10)) { pg8::Gemm g{(const pb*)F.H, (const pb*)F.WO, M, DM, DM}; pg8::StaticOrder S; S.init(M, DM, F.G, (int)blockIdx.x);
        pg8::EpiResid E{F.out, F.out, DM, 1.0f}; pg8::gemm_phase<pg8::EpiResid, pg8::StaticOrder, true, true>(F.lds, g, S, E); if (BOTH(10)) GRID_BAR(); }
    if (IN(11)) { convert_ffn(F, F.in[17], F.in[18], F.in[19]); rms_rows(F, F.out, F.in[16], F.H); if (BOTH(11)) GRID_BAR(); }
    if (IN(12)) { pg8::Gemm g{(const pb*)F.H, (const pb*)F.WGU, M, 2 * FF, DM}; pg8::StaticOrder S; S.init(M, 2 * FF, F.G, (int)blockIdx.x);
        pg8::EpiSwiGLU E{(pb*)F.ACT, FF}; pg8::gemm_phase<pg8::EpiSwiGLU, pg8::StaticOrder, true, true>(F.lds, g, S, E); if (BOTH(12)) GRID_BAR(); }
    if (IN(13)) { pg8::Gemm g{(const pb*)F.ACT, (const pb*)F.WD, M, DM, FF}; pg8::StaticOrder S; S.init(M, DM, F.G, (int)blockIdx.x);
        pg8::EpiResid E{F.out, F.out, DM, 0.5f}; pg8::gemm_phase<pg8::EpiResid, pg8::StaticOrder, true, true>(F.lds, g, S, E); }
#undef IN
#undef BOTH
}

extern "C" void kernel_launch(void* const* d_in, const int* in_sizes, int n_in, void* d_out, int out_size, void* d_ws, size_t ws_size, hipStream_t stream) {
    static int grid = 0;
    if (grid == 0) {
        if (n_in != 20 || out_size != M * DM || ws_size < WS_END) { fprintf(stderr, "kernel_launch: unexpected shapes (n_in %d out %d ws %zu)\n", n_in, out_size, ws_size); grid = -1; return; }
        int dev = 0, cus = 0;
        if (hipGetDevice(&dev) != hipSuccess || hipDeviceGetAttribute(&cus, hipDeviceAttributeMultiprocessorCount, dev) != hipSuccess) { grid = -1; return; }
        if (hipFuncSetAttribute((const void*)fwd, hipFuncAttributeMaxDynamicSharedMemorySize, LDS_BYTES) != hipSuccess) { fprintf(stderr, "kernel_launch: hipFuncSetAttribute failed\n"); grid = -1; return; }
        (void)hipGetLastError();
        grid = cus;
    }
    if (grid < 0) return;
    (void)hipMemsetAsync((char*)d_ws + WS_CTL, 0, CTL_ZERO_BYTES, stream);
    Args a{};
    for (int i = 0; i < 20; ++i) a.in[i] = (const float*)d_in[i];
    a.out = (float*)d_out; a.ws = (unsigned char*)d_ws;
#if MK_SINGLE
    a.ph_lo = 0; a.ph_hi = N_PHASES; a.li = 0;
    hipLaunchKernelGGL(fwd, dim3(grid), dim3(NWAVES * 64), LDS_BYTES, stream, a);
#else
    for (int p = 0; p < N_PHASES; ++p) { a.ph_lo = p; a.ph_hi = p + 1; a.li = p;
        hipLaunchKernelGGL(fwd, dim3(grid), dim3(NWAVES * 64), LDS_BYTES, stream, a); }
#endif
}
```

```cpp
#include <hip/hip_runtime.h>
#include <cstdio>
#include <cstdint>
#include <cmath>
namespace pg8 {
#define PG8_LAS __attribute__((address_space(3)))
typedef unsigned short bf16_t;
typedef short bf16x8 __attribute__((ext_vector_type(8)));
typedef float f32x4 __attribute__((ext_vector_type(4)));
typedef unsigned u32x4 __attribute__((ext_vector_type(4)));
constexpr int BM = 256, BK = 64, HALF = 128, HTB = HALF * BK * 2  , STAGE_BYTES = 8 * HTB, NXCD = 8, WGM = 8;

__host__ __device__ __forceinline__ int lds_byte(int r, int c) { const int st = (r >> 4) * 2 + (c >> 5), rr = r & 15, cc = c & 31, ob = rr * 64 + cc * 2; return st * 1024 + (ob ^ (((ob >> 9) & 1) << 5)); }
__host__ __device__ __forceinline__ void stage_rc(int b, int& R, int& C) { const int st = b / 1024, sb = b % 1024, swz = sb ^ (((sb >> 9) & 1) << 5); R = (st >> 1) * 16 + swz / 64; C = (st & 1) * 32 + (swz % 64) / 2; }
__host__ __device__ __forceinline__ int perm32(int rho) { const int n = rho >> 4, i = rho & 15; return 8 * (i >> 2) + 4 * n + (i & 3); }

struct Unit { int pm, pn; };
struct Gemm { const bf16_t* A; const bf16_t* Bt; int M, N, K; int sA; int nb16; };

struct StaticOrder {
    int nM, nN, nwg, G, c;
    __host__ __device__ void init(int M, int N, int G_, int c_) { nM = M / BM; nN = N / BM; nwg = nM * nN; G = G_; c = c_; }
    __host__ __device__ bool next(int i, Unit& u) const {
        const long L = (long)i * G + c; if (L >= nwg) return false;
        int wgid = (int)L; { const int q = nwg / NXCD, r = nwg % NXCD, xcd = wgid % NXCD, off = wgid / NXCD; wgid = (xcd < r ? xcd * (q + 1) : r * (q + 1) + (xcd - r) * q) + off; }
        const int nig = WGM * nN, gid = wgid / nig, fm = gid * WGM, gsz = (nM - fm) < WGM ? (nM - fm) : WGM;
        u.pm = fm + ((wgid % nig) % gsz); u.pn = (wgid % nig) / gsz; return true;
    }
    __device__ __forceinline__ void a_ready(const Unit&) const {}
    __device__ __forceinline__ void done(const Unit&) const {}
};
struct StaggerOrder : StaticOrder {
    int R0, c0;
    __host__ __device__ void init2(int M, int N, int G_, int c_, int R0_, int c0_) { init(M, N, G_, c_); R0 = R0_; c0 = c0_; }
    __host__ __device__ bool next(int i, Unit& u) const {
        long L;
        if (i < R0) L = (long)i * G + c; else { if (c < c0) return false; L = (long)R0 * G + (long)(i - R0) * (G - c0) + (c - c0); }
        if (L >= nwg) return false;
        int wgid = (int)L; { const int q = nwg / NXCD, r = nwg % NXCD, xcd = wgid % NXCD, off = wgid / NXCD; wgid = (xcd < r ? xcd * (q + 1) : r * (q + 1) + (xcd - r) * q) + off; }
        const int nig = WGM * nN, gid = wgid / nig, fm = gid * WGM, gsz = (nM - fm) < WGM ? (nM - fm) : WGM;
        u.pm = fm + ((wgid % nig) % gsz); u.pn = (wgid % nig) / gsz; return true;
    }
};
__device__ __forceinline__ unsigned cvt_pk_bf16(float lo, float hi) { unsigned r; asm volatile("v_cvt_pk_bf16_f32 %0, %1, %2" : "=v"(r) : "v"(lo), "v"(hi)); return r; }
__device__ __forceinline__ float sigmoid_fast(float x) { return __builtin_amdgcn_rcpf(1.0f + __expf(-x)); }
__device__ __forceinline__ float bf_lo(unsigned w) { return __uint_as_float(w << 16); }
__device__ __forceinline__ float bf_hi(unsigned w) { return __uint_as_float(w & 0xffff0000u); }
__device__ __forceinline__ float row_rstd(const unsigned long long* SS, size_t row) { const float s = (float)SS[row] * (1.0f / 16777216.0f); return 1.0f / sqrtf(s * (1.0f / 4096.0f) + 1e-6f); }
__device__ __forceinline__ float fq_sum(float v) {
    auto a = __builtin_amdgcn_permlane16_swap(__float_as_uint(v), __float_as_uint(v), false, false); v = __uint_as_float(a[0]) + __uint_as_float(a[1]);
    auto b = __builtin_amdgcn_permlane32_swap(__float_as_uint(v), __float_as_uint(v), false, false); return __uint_as_float(b[0]) + __uint_as_float(b[1]); }
__device__ __forceinline__ unsigned pk4_e4m3(float a, float b, float c, float d) { int w = 0; w = __builtin_amdgcn_cvt_pk_fp8_f32(a, b, w, false); w = __builtin_amdgcn_cvt_pk_fp8_f32(c, d, w, true); return (unsigned)w; }
__device__ __forceinline__ void had32_lanes(float (&x)[8], int fq) {
#pragma unroll
    for (int h = 1; h < 8; h <<= 1)
#pragma unroll
        for (int i = 0; i < 8; ++i) if (!(i & h)) { const float a = x[i], b = x[i + h]; x[i] = a + b; x[i + h] = a - b; }
#pragma unroll
    for (int i = 0; i < 8; ++i) { auto a = __builtin_amdgcn_permlane16_swap(__float_as_uint(x[i]), __float_as_uint(x[i]), false, false);
        const float lo = __uint_as_float(a[0]), hi = __uint_as_float(a[1]); x[i] = (fq & 1) ? lo - hi : lo + hi; }
#pragma unroll
    for (int i = 0; i < 8; ++i) { auto b = __builtin_amdgcn_permlane32_swap(__float_as_uint(x[i]), __float_as_uint(x[i]), false, false);
        const float lo = __uint_as_float(b[0]), hi = __uint_as_float(b[1]); x[i] = ((fq & 2) ? lo - hi : lo + hi) * 0.17677669529663687f; }
}
__device__ __forceinline__ float fq_max(float v) {
    auto a = __builtin_amdgcn_permlane16_swap(__float_as_uint(v), __float_as_uint(v), false, false); v = fmaxf(__uint_as_float(a[0]), __uint_as_float(a[1]));
    auto b = __builtin_amdgcn_permlane32_swap(__float_as_uint(v), __float_as_uint(v), false, false); return fmaxf(__uint_as_float(b[0]), __uint_as_float(b[1])); }
template <bool I8, bool HAD = false> struct EpiSwiGLUT {
    static constexpr bool PERM = true, AFTER_DRAIN = false;
    bf16_t* O; int ldc; const float* RS; const float* CS; unsigned* RM;
    __device__ __forceinline__ void operator()(const f32x4 (&acc)[2][2][4][2], const Unit& u, int wr, int wc, int fr, int fq) const {
        const unsigned row0 = u.pm * BM + wr * 64 + fr; const int col0 = u.pn * HALF + wc * 32 + 8 * fq;
        float rs[8]; f32x4 cg0, cg1, cu0, cu1;
        if constexpr (I8) {
#pragma unroll
            for (int i = 0; i < 8; ++i) rs[i] = RS[row0 + (i >> 2) * HALF + (i & 3) * 16] * (1.0f / 127.0f);
            const float* cp = CS + u.pn * BM + wc * 32 + 8 * fq; cg0 = *(const f32x4*)cp; cg1 = *(const f32x4*)(cp + 4); cu0 = *(const f32x4*)(cp + HALF); cu1 = *(const f32x4*)(cp + HALF + 4);
        }
#pragma unroll
        for (int ai = 0; ai < 2; ++ai)
#pragma unroll
            for (int m = 0; m < 4; ++m) { const unsigned row = row0 + ai * HALF + m * 16; bf16_t* rowp = O + (size_t)row * ldc + col0;
                float x[8];
#pragma unroll
                for (int j = 0; j < 4; ++j) { float g0, g1, u0, u1;
                    if constexpr (I8) { const float r = rs[ai * 4 + m];
                        g0 = (float)__float_as_int(acc[ai][0][m][0][j]) * (r * cg0[j]); g1 = (float)__float_as_int(acc[ai][0][m][1][j]) * (r * cg1[j]);
                        u0 = (float)__float_as_int(acc[ai][1][m][0][j]) * (r * cu0[j]); u1 = (float)__float_as_int(acc[ai][1][m][1][j]) * (r * cu1[j]); }
                    else { g0 = acc[ai][0][m][0][j]; g1 = acc[ai][0][m][1][j]; u0 = acc[ai][1][m][0][j]; u1 = acc[ai][1][m][1][j]; }
                    x[j] = g0 * sigmoid_fast(g0) * u0; x[4 + j] = g1 * sigmoid_fast(g1) * u1; }
                if constexpr (HAD) had32_lanes(x, fq);
                u32x4 w; w.x = cvt_pk_bf16(x[0], x[1]); w.y = cvt_pk_bf16(x[2], x[3]); w.z = cvt_pk_bf16(x[4], x[5]); w.w = cvt_pk_bf16(x[6], x[7]); *(u32x4*)rowp = w;
                if constexpr (HAD) {
                    float mx = fmaxf(fmaxf(fmaxf(fabsf(x[0]), fabsf(x[1])), fmaxf(fabsf(x[2]), fabsf(x[3]))), fmaxf(fmaxf(fabsf(x[4]), fabsf(x[5])), fmaxf(fabsf(x[6]), fabsf(x[7]))));
                    mx = fq_max(mx);
                    if (fq == 0) atomicMax(RM + row, __float_as_uint(mx)); } }
    }
};
template <bool NORM, bool FP8COPY, bool I8 = false> struct EpiResidT {
    static constexpr bool PERM = true, AFTER_DRAIN = false;
    const float* base; float* out; int ldc; float scale; bf16_t* Hb; unsigned char* H8; unsigned long long* SS; const float* RS; const float* CS;
    __device__ __forceinline__ void operator()(const f32x4 (&acc)[2][2][4][2], const Unit& u, int wr, int wc, int fr, int fq) const {
        const unsigned row0 = u.pm * BM + wr * 64 + fr, col0 = u.pn * BM + wc * 32 + 8 * fq;
        const char* bp = (const char*)base; char* op = (char*)out; char* hp = (char*)Hb; char* h8 = (char*)H8; char* sp = (char*)SS;
        f32x4 cb[4], nb[4]; float rs[8]; f32x4 cs[2][2];
        if constexpr (I8) {
#pragma unroll
            for (int i = 0; i < 8; ++i) rs[i] = RS[row0 + (i >> 2) * HALF + (i & 3) * 16] * (scale / 127.0f);
            const float* cp = CS + col0; cs[0][0] = *(const f32x4*)cp; cs[0][1] = *(const f32x4*)(cp + 4); cs[1][0] = *(const f32x4*)(cp + HALF); cs[1][1] = *(const f32x4*)(cp + HALF + 4);
        }
#define EPI_LD(dst, i) do { const unsigned o_ = ((row0 + ((i) >> 2) * HALF + ((i) & 3) * 16) * (unsigned)ldc + col0) * 4u; \
            dst[0] = *(const f32x4*)(bp + o_); dst[1] = *(const f32x4*)(bp + (o_ + 16u)); dst[2] = *(const f32x4*)(bp + (o_ + 512u)); dst[3] = *(const f32x4*)(bp + (o_ + 528u)); } while (0)
        EPI_LD(cb, 0);
#pragma unroll
        for (int i = 0; i < 8; ++i) { const int ai = i >> 2, m = i & 3; const unsigned row = row0 + ai * HALF + m * 16, off = row * (unsigned)ldc + col0; float ss = 0.f;
            if (i + 1 < 8) EPI_LD(nb, i + 1);
#pragma unroll
            for (int bj = 0; bj < 2; ++bj) { const unsigned o = off + bj * HALF;
                f32x4 v0, v1;
                if constexpr (I8) { const float r = rs[i];
#pragma unroll
                    for (int j = 0; j < 4; ++j) { const float a0 = acc[ai][bj][m][0][j], a1 = acc[ai][bj][m][1][j];
                        v0[j] = cb[2 * bj][j] + (float)__float_as_int(a0) * (r * cs[bj][0][j]); v1[j] = cb[2 * bj + 1][j] + (float)__float_as_int(a1) * (r * cs[bj][1][j]); } }
                else { v0 = cb[2 * bj] + acc[ai][bj][m][0] * scale; v1 = cb[2 * bj + 1] + acc[ai][bj][m][1] * scale; }
                *(f32x4*)(op + o * 4u) = v0; *(f32x4*)(op + (o * 4u + 16u)) = v1;
                if constexpr (NORM) {
                    ss += (v0[0] * v0[0] + v0[1] * v0[1]) + (v0[2] * v0[2] + v0[3] * v0[3]) + (v1[0] * v1[0] + v1[1] * v1[1]) + (v1[2] * v1[2] + v1[3] * v1[3]);
                    u32x4 w; w.x = cvt_pk_bf16(v0[0], v0[1]); w.y = cvt_pk_bf16(v0[2], v0[3]); w.z = cvt_pk_bf16(v1[0], v1[1]); w.w = cvt_pk_bf16(v1[2], v1[3]);
                    *(u32x4*)(hp + o * 2u) = w;
                    if constexpr (FP8COPY) { typedef unsigned u32x2 __attribute__((ext_vector_type(2))); u32x2 w8; w8.x = pk4_e4m3(v0[0], v0[1], v0[2], v0[3]); w8.y = pk4_e4m3(v1[0], v1[1], v1[2], v1[3]); *(u32x2*)(h8 + o) = w8; } } }
            if constexpr (NORM) {
                ss = fq_sum(ss) * 16777216.0f;
                const unsigned hi = (unsigned)(ss * 2.3283064365386963e-10f), lo = (unsigned)(ss - (float)hi * 4294967296.0f);
                if (fq == 0) atomicAdd((unsigned long long*)(sp + row * 8u), ((unsigned long long)hi << 32) | lo); }
#pragma unroll
            for (int q = 0; q < 4; ++q) cb[q] = nb[q]; }
#undef EPI_LD
    }
};
typedef EpiResidT<false, false> EpiResid;
typedef EpiResidT<false, false, true> EpiResid8;
template <bool FP8COPY> using EpiResidN = EpiResidT<true, FP8COPY>;
template <bool I8, long oA, int ldA, int nA, long oB, int ldB, int nB, long oC, int ldC, int nC> struct EpiProjT {
    static constexpr bool PERM = true, AFTER_DRAIN = false;
    bf16_t* base; float* AB; const float* RS; const float* CS;
    __device__ __forceinline__ void operator()(const f32x4 (&acc)[2][2][4][2], const Unit& u, int wr, int wc, int fr, int fq) const {
        const int row0 = u.pm * BM + wr * 64 + fr;
        if (u.pn < nA + nB + nC) {
            const int sg = u.pn < nA ? 0 : (u.pn < nA + nB ? 1 : 2); bf16_t* O = base + (sg == 0 ? oA : (sg == 1 ? oB : oC)); const int ldc = sg == 0 ? ldA : (sg == 1 ? ldB : ldC);
            const int col0 = (sg == 0 ? u.pn : (sg == 1 ? u.pn - nA : u.pn - nA - nB)) * BM + wc * 32 + 8 * fq;
            float rs[8]; f32x4 cs[2][2];
            if constexpr (I8) {
#pragma unroll
                for (int i = 0; i < 8; ++i) rs[i] = RS[row0 + (i >> 2) * HALF + (i & 3) * 16] * (1.0f / 127.0f);
                const float* cp = CS + u.pn * BM + wc * 32 + 8 * fq; cs[0][0] = *(const f32x4*)cp; cs[0][1] = *(const f32x4*)(cp + 4); cs[1][0] = *(const f32x4*)(cp + HALF); cs[1][1] = *(const f32x4*)(cp + HALF + 4);
            }
#pragma unroll
            for (int ai = 0; ai < 2; ++ai)
#pragma unroll
                for (int m = 0; m < 4; ++m) { const size_t row = (size_t)(row0 + ai * HALF + m * 16); bf16_t* rowp = O + row * ldc + col0;
#pragma unroll
                    for (int bj = 0; bj < 2; ++bj) { f32x4 v0 = acc[ai][bj][m][0], v1 = acc[ai][bj][m][1];
                        if constexpr (I8) { const float r = rs[ai * 4 + m];
#pragma unroll
                            for (int j = 0; j < 4; ++j) { const float a0 = v0[j], a1 = v1[j]; v0[j] = (float)__float_as_int(a0) * (r * cs[bj][0][j]); v1[j] = (float)__float_as_int(a1) * (r * cs[bj][1][j]); } }
                        u32x4 w; w.x = cvt_pk_bf16(v0[0], v0[1]); w.y = cvt_pk_bf16(v0[2], v0[3]); w.z = cvt_pk_bf16(v1[0], v1[1]); w.w = cvt_pk_bf16(v1[2], v1[3]);
                        *(u32x4*)(rowp + bj * HALF) = w; } }
        } else if (wc < 2) {
#pragma unroll
            for (int ai = 0; ai < 2; ++ai)
#pragma unroll
                for (int m = 0; m < 4; ++m) { const size_t row = (size_t)(row0 + ai * HALF + m * 16); float* p = AB + row * 64 + wc * 32 + 8 * fq;
                    *(f32x4*)p = acc[ai][0][m][0]; *(f32x4*)(p + 4) = acc[ai][0][m][1]; }
        }
    }
};
template <bool FIRST> struct EpiGate {
    static constexpr bool PERM = true, AFTER_DRAIN = false;
    bf16_t* Y; int ldy; const bf16_t* gate; int ldg;
    __device__ __forceinline__ void operator()(const f32x4 (&acc)[2][2][4][2], const Unit& u, int wr, int wc, int fr, int fq) const {
        const unsigned row0 = u.pm * BM + wr * 64 + fr, col0 = u.pn * BM + wc * 32 + 8 * fq;
        const char* gp = (const char*)gate; char* yb = (char*)Y;
        u32x4 cg[2], ng[2], cy[2], ny[2];
#define EPI_LD(dg, dy, i) do { const unsigned r_ = row0 + ((i) >> 2) * HALF + ((i) & 3) * 16; const unsigned og_ = (r_ * (unsigned)ldg + col0) * 2u, oy_ = (r_ * (unsigned)ldy + col0) * 2u; \
            dg[0] = *(const u32x4*)(gp + og_); dg[1] = *(const u32x4*)(gp + (og_ + 256u)); if (!FIRST) { dy[0] = *(const u32x4*)(yb + oy_); dy[1] = *(const u32x4*)(yb + (oy_ + 256u)); } } while (0)
        EPI_LD(cg, cy, 0);
#pragma unroll
        for (int i = 0; i < 8; ++i) { const int ai = i >> 2, m = i & 3; const unsigned row = row0 + ai * HALF + m * 16;
            if (i + 1 < 8) EPI_LD(ng, ny, i + 1);
#pragma unroll
            for (int bj = 0; bj < 2; ++bj) { const u32x4 gw = cg[bj];
                f32x4 s0, s1; s0[0] = sigmoid_fast(bf_lo(gw.x)); s0[1] = sigmoid_fast(bf_hi(gw.x)); s0[2] = sigmoid_fast(bf_lo(gw.y)); s0[3] = sigmoid_fast(bf_hi(gw.y));
                s1[0] = sigmoid_fast(bf_lo(gw.z)); s1[1] = sigmoid_fast(bf_hi(gw.z)); s1[2] = sigmoid_fast(bf_lo(gw.w)); s1[3] = sigmoid_fast(bf_hi(gw.w));
                f32x4 v0 = acc[ai][bj][m][0] * s0, v1 = acc[ai][bj][m][1] * s1;
                if (!FIRST) { const u32x4 p = cy[bj]; v0[0] += bf_lo(p.x); v0[1] += bf_hi(p.x); v0[2] += bf_lo(p.y); v0[3] += bf_hi(p.y); v1[0] += bf_lo(p.z); v1[1] += bf_hi(p.z); v1[2] += bf_lo(p.w); v1[3] += bf_hi(p.w); }
                u32x4 w; w.x = cvt_pk_bf16(v0[0], v0[1]); w.y = cvt_pk_bf16(v0[2], v0[3]); w.z = cvt_pk_bf16(v1[0], v1[1]); w.w = cvt_pk_bf16(v1[2], v1[3]);
                *(u32x4*)(yb + ((row * (unsigned)ldy + col0) * 2u + bj * 256u)) = w; }
#pragma unroll
            for (int q = 0; q < 2; ++q) { cg[q] = ng[q]; if (!FIRST) cy[q] = ny[q]; } }
#undef EPI_LD
    }
};
template <class Epi, class Sched, bool ALIGN_EPI = false, bool SP2 = false, int FM = 0>
__device__ __forceinline__ void gemm_phase(PG8_LAS unsigned char* lds, const Gemm g, const Sched& S, const Epi& E) {
    int tid_o = threadIdx.x; asm volatile("" : "+v"(tid_o));
    const int tid = tid_o, wid = __builtin_amdgcn_readfirstlane(tid >> 6), lane = tid & 63, wr = wid >> 2, wc = wid & 3, fr = lane & 15, fq = lane >> 4;
    constexpr bool F8 = (FM == 1 || FM == 2); static_assert(FM != 2 || SP2, "mixed rows: SP2 only");
    constexpr int ES = (FM == 1 || FM == 3) ? 1 : 2;
    const int K = g.K, nt = K * ES / (BK * 2);
    const int f8_sw = 0x79797979, f8_sh = g.sA;
    unsigned voffA[2], voffB[2];
#pragma unroll
    for (int i = 0; i < 2; ++i) { int R, C; stage_rc(tid * 16 + i * 8192, R, C); const int Rb = Epi::PERM ? ((R & ~31) + perm32(R & 31)) : R;
        voffA[i] = (unsigned)(R * K) * ES + (unsigned)C * 2u; voffB[i] = (unsigned)(Rb * K) * ES + (unsigned)C * 2u; }
    const size_t kstep = (size_t)(BK * 2);
    const size_t hstep = (size_t)HALF * K * ES;
    const size_t tstep = 2 * hstep;
    const unsigned ldsw = (unsigned)wid * 1024u;
    const int aoff = lds_byte(wr * 64 + fr, fq * 8), boff = lds_byte(wc * 32 + fr, fq * 8);
#define PG8_SA(b, h) (((b) * 2 + (h)) * HTB)
#define PG8_SB(b, h) ((4 + (b) * 2 + (h)) * HTB)
#define PG8_STAGE(bufoff, gbase, voff) do { _Pragma("unroll") for (int _i = 0; _i < 2; ++_i) \
        __builtin_amdgcn_global_load_lds((const unsigned*)((const char*)(gbase) + (voff)[_i]), (PG8_LAS unsigned*)(lds + (bufoff) + ldsw + _i * 8192), 16, 0, 0); } while (0)
#define PG8_LDA(dst, b, h) do { _Pragma("unroll") for (int m = 0; m < 4; ++m) _Pragma("unroll") for (int k = 0; k < 2; ++k) dst[m][k] = *(const PG8_LAS bf16x8*)(lds + PG8_SA(b, h) + aoff + m * 2048 + k * 1024); } while (0)
#define PG8_LDB(dst, b, h) do { _Pragma("unroll") for (int n = 0; n < 2; ++n) _Pragma("unroll") for (int k = 0; k < 2; ++k) dst[n][k] = *(const PG8_LAS bf16x8*)(lds + PG8_SB(b, h) + boff + n * 2048 + k * 1024); } while (0)
#define PG8_MMA(ai, bj, At, Bt, F8X) do { __builtin_amdgcn_s_setprio(1); \
        if constexpr ((int)(F8X) == 1) { typedef int v4i_ __attribute__((ext_vector_type(4))); typedef int v8i_ __attribute__((ext_vector_type(8))); \
            const v8i_ b80 = __builtin_shufflevector(__builtin_bit_cast(v4i_, Bt[0][0]), __builtin_bit_cast(v4i_, Bt[0][1]), 0, 1, 2, 3, 4, 5, 6, 7); \
            const v8i_ b81 = __builtin_shufflevector(__builtin_bit_cast(v4i_, Bt[1][0]), __builtin_bit_cast(v4i_, Bt[1][1]), 0, 1, 2, 3, 4, 5, 6, 7); \
            const v8i_ a80 = __builtin_shufflevector(__builtin_bit_cast(v4i_, At[0][0]), __builtin_bit_cast(v4i_, At[0][1]), 0, 1, 2, 3, 4, 5, 6, 7); \
            const v8i_ a81 = __builtin_shufflevector(__builtin_bit_cast(v4i_, At[1][0]), __builtin_bit_cast(v4i_, At[1][1]), 0, 1, 2, 3, 4, 5, 6, 7); \
            const v8i_ a82 = __builtin_shufflevector(__builtin_bit_cast(v4i_, At[2][0]), __builtin_bit_cast(v4i_, At[2][1]), 0, 1, 2, 3, 4, 5, 6, 7); \
            const v8i_ a83 = __builtin_shufflevector(__builtin_bit_cast(v4i_, At[3][0]), __builtin_bit_cast(v4i_, At[3][1]), 0, 1, 2, 3, 4, 5, 6, 7); \
              \
            asm volatile("s_nop 1\n\t" \
                "v_mfma_scale_f32_16x16x128_f8f6f4 %0, %8, %10, %0, %14, %15 op_sel_hi:[0,0,0]\n\tv_mfma_scale_f32_16x16x128_f8f6f4 %1, %9, %10, %1, %14, %15 op_sel_hi:[0,0,0]\n\t" \
                "v_mfma_scale_f32_16x16x128_f8f6f4 %2, %8, %11, %2, %14, %15 op_sel_hi:[0,0,0]\n\tv_mfma_scale_f32_16x16x128_f8f6f4 %3, %9, %11, %3, %14, %15 op_sel_hi:[0,0,0]\n\t" \
                "v_mfma_scale_f32_16x16x128_f8f6f4 %4, %8, %12, %4, %14, %15 op_sel_hi:[0,0,0]\n\tv_mfma_scale_f32_16x16x128_f8f6f4 %5, %9, %12, %5, %14, %15 op_sel_hi:[0,0,0]\n\t" \
                "v_mfma_scale_f32_16x16x128_f8f6f4 %6, %8, %13, %6, %14, %15 op_sel_hi:[0,0,0]\n\tv_mfma_scale_f32_16x16x128_f8f6f4 %7, %9, %13, %7, %14, %15 op_sel_hi:[0,0,0]" \
                : "+v"(acc[ai][bj][0][0]), "+v"(acc[ai][bj][0][1]), "+v"(acc[ai][bj][1][0]), "+v"(acc[ai][bj][1][1]), "+v"(acc[ai][bj][2][0]), "+v"(acc[ai][bj][2][1]), "+v"(acc[ai][bj][3][0]), "+v"(acc[ai][bj][3][1]) \
                : "v"(b80), "v"(b81), "v"(a80), "v"(a81), "v"(a82), "v"(a83), "v"(f8_sw), "v"(f8_sh)); } \
        else if constexpr ((int)(F8X) == 3) { typedef int v4i_ __attribute__((ext_vector_type(4))); \
            _Pragma("unroll") for (int m = 0; m < 4; ++m) _Pragma("unroll") for (int n = 0; n < 2; ++n) _Pragma("unroll") for (int k = 0; k < 2; ++k) \
            acc[ai][bj][m][n] = __builtin_bit_cast(f32x4, __builtin_amdgcn_mfma_i32_16x16x64_i8(__builtin_bit_cast(v4i_, Bt[n][k]), __builtin_bit_cast(v4i_, At[m][k]), __builtin_bit_cast(v4i_, acc[ai][bj][m][n]), 0, 0, 0)); } \
        else { _Pragma("unroll") for (int m = 0; m < 4; ++m) _Pragma("unroll") for (int n = 0; n < 2; ++n) _Pragma("unroll") for (int k = 0; k < 2; ++k) \
            acc[ai][bj][m][n] = __builtin_amdgcn_mfma_f32_16x16x32_bf16(Bt[n][k], At[m][k], acc[ai][bj][m][n], 0, 0, 0); } \
        __builtin_amdgcn_s_setprio(0); } while (0)
#define PG8_WAIT_V(n) asm volatile("s_waitcnt vmcnt(" #n ")" ::: "memory")
#define PG8_WAIT_L(n) asm volatile("s_waitcnt lgkmcnt(" #n ")" ::: "memory")
#define PG8_BAR __builtin_amdgcn_s_barrier()
#define PG8_SCHED __builtin_amdgcn_sched_barrier(0)
#define PG8_KT2(F8X) do { \
            PG8_LDB(B0, 0, 0); PG8_LDB(B1, 0, 1); PG8_SCHED; PG8_LDA(At, 0, 0); PG8_STAGE(PG8_SA(1, 1), a1 + hstep, voffA); \
            PG8_WAIT_V(8); PG8_WAIT_L(0); PG8_BAR; PG8_MMA(0, 0, At, B0, F8X); PG8_MMA(0, 1, At, B1, F8X); PG8_BAR; PG8_SCHED; \
            PG8_LDA(At, 0, 1); PG8_STAGE(PG8_SB(0, 0), b2, voffB); PG8_STAGE(PG8_SB(0, 1), b2 + hstep, voffB); PG8_STAGE(PG8_SA(0, 0), a2, voffA); \
            PG8_WAIT_V(8); PG8_WAIT_L(0); PG8_BAR; PG8_MMA(1, 0, At, B0, F8X); PG8_MMA(1, 1, At, B1, F8X); PG8_BAR; PG8_SCHED; \
            PG8_LDB(B0, 1, 0); PG8_LDB(B1, 1, 1); PG8_SCHED; PG8_LDA(At, 1, 0); PG8_STAGE(PG8_SA(0, 1), a2 + hstep, voffA); \
            PG8_WAIT_V(8); PG8_WAIT_L(0); PG8_BAR; PG8_MMA(0, 0, At, B0, F8X); PG8_MMA(0, 1, At, B1, F8X); PG8_BAR; PG8_SCHED; \
            PG8_LDA(At, 1, 1); PG8_STAGE(PG8_SB(1, 0), b3, voffB); PG8_STAGE(PG8_SB(1, 1), b3 + hstep, voffB); PG8_STAGE(PG8_SA(1, 0), a3, voffA); \
            PG8_WAIT_V(8); PG8_WAIT_L(0); PG8_BAR; PG8_MMA(1, 0, At, B0, F8X); PG8_MMA(1, 1, At, B1, F8X); PG8_BAR; PG8_SCHED; } while (0)
    Unit cur, nxt; int ui = 0;
    if (!S.next(0, cur)) return;
    f32x4 acc[2][2][4][2];
#pragma unroll
    for (int a = 0; a < 2; ++a)
#pragma unroll
        for (int b = 0; b < 2; ++b)
#pragma unroll
            for (int m = 0; m < 4; ++m)
#pragma unroll
                for (int n = 0; n < 2; ++n) acc[a][b][m][n] = (f32x4){0.f, 0.f, 0.f, 0.f};
    bf16x8 At[4][2], B0[2][2], B1[2][2];
    const char* cA = (const char*)g.A + (size_t)cur.pm * tstep; const char* cB = (const char*)g.Bt + (size_t)cur.pn * tstep;
    S.a_ready(cur);
    if constexpr (SP2) {
        PG8_STAGE(PG8_SB(0, 0), cB, voffB); PG8_STAGE(PG8_SB(0, 1), cB + hstep, voffB); PG8_STAGE(PG8_SA(0, 0), cA, voffA); PG8_STAGE(PG8_SA(0, 1), cA + hstep, voffA);
        if (wr == 1) PG8_BAR;
        PG8_WAIT_V(2); PG8_BAR;
        PG8_STAGE(PG8_SB(1, 0), cB + kstep, voffB); PG8_STAGE(PG8_SA(1, 0), cA + kstep, voffA); PG8_STAGE(PG8_SB(1, 1), cB + hstep + kstep, voffB);
        PG8_WAIT_V(6); PG8_BAR;
    } else {
        PG8_STAGE(PG8_SB(0, 0), cB, voffB); PG8_STAGE(PG8_SA(0, 0), cA, voffA); PG8_STAGE(PG8_SB(0, 1), cB + hstep, voffB); PG8_STAGE(PG8_SA(0, 1), cA + hstep, voffA);
        if (wr == 1) PG8_BAR;
        PG8_WAIT_V(4); PG8_BAR;
        PG8_STAGE(PG8_SB(1, 0), cB + kstep, voffB); PG8_STAGE(PG8_SA(1, 0), cA + kstep, voffA); PG8_STAGE(PG8_SB(1, 1), cB + hstep + kstep, voffB);
        PG8_WAIT_V(6); PG8_BAR;
    }
    for (;;) {
        const bool has_next = S.next(ui + 1, nxt);
        const char* nA = has_next ? (const char*)g.A + (size_t)nxt.pm * tstep : cA; const char* nB = has_next ? (const char*)g.Bt + (size_t)nxt.pn * tstep : cB;
        int t = 0;
        if constexpr (FM == 2) {
            for (; t < g.nb16; t += 2) {
                const char* a1 = cA + (size_t)(t + 1) * kstep; const char* a2 = cA + (size_t)(t + 2) * kstep; const char* b2 = cB + (size_t)(t + 2) * kstep;
                const char* a3 = a2 + kstep; const char* b3 = b2 + kstep;
                PG8_KT2(false);
            }
        }
        for (; t < nt; t += 2) {
            const bool last = (t == nt - 2);
            const char* a1 = cA + (size_t)(t + 1) * kstep;
            const char* a2 = last ? nA : cA + (size_t)(t + 2) * kstep; const char* b2 = last ? nB : cB + (size_t)(t + 2) * kstep;
            const char* a3 = a2 + kstep; const char* b3 = b2 + kstep;
            if (last && has_next) S.a_ready(nxt);
            if constexpr (SP2) {
                PG8_KT2(FM == 2 ? 1 : FM);
            } else {
            PG8_LDB(B0, 0, 0); PG8_SCHED; PG8_LDA(At, 0, 0); PG8_STAGE(PG8_SA(1, 1), a1 + hstep, voffA);
            PG8_WAIT_L(8); PG8_BAR; PG8_WAIT_L(0); PG8_MMA(0, 0, At, B0, FM); PG8_BAR; PG8_SCHED;
            PG8_LDB(B1, 0, 1); PG8_STAGE(PG8_SB(0, 0), b2, voffB);
            PG8_BAR; PG8_WAIT_L(0); PG8_MMA(0, 1, At, B1, FM); PG8_BAR;
            PG8_LDA(At, 0, 1); PG8_STAGE(PG8_SA(0, 0), a2, voffA);
            PG8_BAR; PG8_WAIT_L(0); PG8_MMA(1, 0, At, B0, FM); PG8_BAR; PG8_SCHED;
            PG8_STAGE(PG8_SB(0, 1), b2 + hstep, voffB);
            PG8_WAIT_V(6); PG8_BAR; PG8_MMA(1, 1, At, B1, FM); PG8_BAR;
            PG8_LDB(B0, 1, 0); PG8_SCHED; PG8_LDA(At, 1, 0); PG8_STAGE(PG8_SA(0, 1), a2 + hstep, voffA);
            PG8_WAIT_L(8); PG8_BAR; PG8_WAIT_L(0); PG8_MMA(0, 0, At, B0, FM); PG8_BAR; PG8_SCHED;
            PG8_LDB(B1, 1, 1); PG8_STAGE(PG8_SB(1, 0), b3, voffB);
            PG8_BAR; PG8_WAIT_L(0); PG8_MMA(0, 1, At, B1, FM); PG8_BAR;
            PG8_LDA(At, 1, 1); PG8_STAGE(PG8_SA(1, 0), a3, voffA);
            PG8_BAR; PG8_WAIT_L(0); PG8_MMA(1, 0, At, B0, FM); PG8_BAR; PG8_SCHED;
            PG8_STAGE(PG8_SB(1, 1), b3 + hstep, voffB);
            PG8_WAIT_V(6); PG8_BAR; PG8_MMA(1, 1, At, B1, FM); PG8_BAR;
            }
        }
        if constexpr (F8) asm volatile("s_nop 15\n\ts_nop 15" ::: "memory");
        if constexpr (ALIGN_EPI) { if (wr == 0) PG8_BAR; }
        if constexpr (!Epi::AFTER_DRAIN) { E(acc, cur, wr, wc, fr, fq); S.done(cur); }
        if (!has_next) break;
#pragma unroll
        for (int a = 0; a < 2; ++a)
#pragma unroll
            for (int b = 0; b < 2; ++b)
#pragma unroll
                for (int m = 0; m < 4; ++m)
#pragma unroll
                    for (int n = 0; n < 2; ++n) acc[a][b][m][n] = (f32x4){0.f, 0.f, 0.f, 0.f};
        cur = nxt; cA = nA; cB = nB; ++ui;
        if constexpr (ALIGN_EPI) { if (wr == 1) PG8_BAR; }
    }
    PG8_WAIT_V(0);
    if constexpr (!ALIGN_EPI) { if (wr == 0) PG8_BAR; }
    PG8_BAR;
    if constexpr (Epi::AFTER_DRAIN) { E.fused(acc, cur, wr, wc, fr, fq, lds, wid, lane); S.done(cur); }
#undef PG8_SA
#undef PG8_SB
#undef PG8_STAGE
#undef PG8_LDA
#undef PG8_LDB
#undef PG8_MMA
#undef PG8_KT2
#undef PG8_WAIT_V
#undef PG8_WAIT_L
#undef PG8_BAR
#undef PG8_SCHED
}
}
#ifndef MK_SINGLE
#define MK_SINGLE 1
#endif
constexpr int NWAVES = 8;
constexpr int BATCH = 4, SEQ = 4096, DM = 4096, FF = 11008, M = BATCH * SEQ;
constexpr int NPROJ = 16640, NGATE = 10240, PA_LD = 14336, PB_LD = 12288;
constexpr int PA_GQ = 0, PA_GK = 2048, PA_GV = 4096, PA_MQ = 8192, PA_MK = 10240, PA_MV = 12288, PB_GZ = 0, PB_GG = 4096, PB_MG = 8192;
constexpr float NORM_EPS = 1e-6f;
constexpr int KB16 = 11008, KF8 = FF - KB16, ACT2_PITCH = 2 * KB16 + KF8;
static_assert(KB16 % 128 == 0 && KF8 % 256 == 0, "mixed K split");
constexpr int N_PHASES = 14;

constexpr size_t MiB = 1u << 20;
constexpr size_t WS_CTL = 0, CTL_ZERO_BYTES = 64 * 1024;
constexpr size_t WS_KMEAN = 1 * MiB, WS_ROPE = 2 * MiB, WS_AB = 4 * MiB, WS_G = 8 * MiB, WS_BETA = 10 * MiB;
constexpr size_t WS_WGU = 16 * MiB, WS_WD = 188 * MiB;
constexpr size_t WS_H = 274 * MiB;
constexpr size_t WS_WB = 402 * MiB;
constexpr size_t WS_BIG = 612 * MiB, WS_PB = 1060 * MiB;
constexpr size_t WS_OG = 1444 * MiB, WS_OM = 1572 * MiB, WS_WBG = 1636 * MiB, WS_WBM = 1668 * MiB, WS_WO = 1684 * MiB, WS_H8 = 1716 * MiB, WS_END = 1780 * MiB;
constexpr size_t WS_W8 = 548 * MiB;
constexpr size_t WS_QN = 16 * MiB, WS_KN = 80 * MiB, WS_VP = 144 * MiB, WS_KNT = 274 * MiB;
constexpr size_t WS_U = 612 * MiB, WS_W = 740 * MiB, WS_AT = 868 * MiB, WS_GC = 932 * MiB;
constexpr size_t WS_MQ = 402 * MiB, WS_MK = 466 * MiB, WS_MV = 530 * MiB;
constexpr size_t WS_Y1 = 16 * MiB;
static_assert(WS_WGU + (size_t)22016 * 4096 * 2 <= WS_WD && WS_WD + (size_t)4096 * 11008 * 2 <= WS_H && WS_H + (size_t)M * DM * 2 <= WS_WB, "ws map 1");
static_assert(WS_WB + (size_t)NPROJ * DM * 2 <= WS_BIG && WS_BIG + (size_t)M * PA_LD * 2 <= WS_PB && WS_PB + (size_t)M * PB_LD * 2 <= WS_OG && WS_MV + (size_t)M * 2048 * 2 <= WS_BIG && WS_Y1 + (size_t)M * DM * 4 <= WS_H && WS_GC + (size_t)8192 * 64 * 4 <= WS_PB, "ws map 2");
constexpr int CW_BAR = 4096, CW_Q = 64;

constexpr int RING_BYTES = 131072, TR_STRIDE = 16640, PREP_STRIDE = 17408, MISC_OFF = 159744, LDS_BYTES = 163840;
static_assert(8 * TR_STRIDE <= MISC_OFF, "LDS map");

#define GAS __attribute__((address_space(1)))
#define LAS __attribute__((address_space(3)))
typedef unsigned short bf16;
typedef unsigned v4u __attribute__((ext_vector_type(4)));
typedef unsigned v2u __attribute__((ext_vector_type(2)));
typedef float f32x4 __attribute__((ext_vector_type(4)));
typedef float f32x2 __attribute__((ext_vector_type(2)));
#define LDS_WAIT() asm volatile("s_waitcnt lgkmcnt(0)" ::: "memory")
#define VM_WAIT() asm volatile("s_waitcnt vmcnt(0)" ::: "memory")
__device__ __forceinline__ unsigned f2bf(float f) { unsigned u = __builtin_bit_cast(unsigned, f); return (u + 0x7fffu + ((u >> 16) & 1u)) >> 16; }
typedef __bf16 bf16x2_t __attribute__((ext_vector_type(2)));
__device__ __forceinline__ unsigned cvtpk(float lo, float hi) { f32x2 v = {lo, hi}; bf16x2_t b = __builtin_convertvector(v, bf16x2_t); return __builtin_bit_cast(unsigned, b); }
__device__ __forceinline__ unsigned pk2(float lo, float hi) { return cvtpk(lo, hi); }
__device__ __forceinline__ float bf2f(unsigned short b) { return __uint_as_float(((unsigned)b) << 16); }
__device__ __forceinline__ float blo(unsigned w) { return __uint_as_float(w << 16); }
__device__ __forceinline__ float bhi(unsigned w) { return __uint_as_float(w & 0xffff0000u); }
template <int CTRL, int RM> __device__ __forceinline__ float dpp_f(float v) { return __int_as_float(__builtin_amdgcn_update_dpp(0, __float_as_int(v), CTRL, RM, 0xf, true)); }
__device__ __forceinline__ float row_sum16(float v) { v += dpp_f<0xB1, 0xf>(v); v += dpp_f<0x4E, 0xf>(v); v += dpp_f<0x141, 0xf>(v); v += dpp_f<0x140, 0xf>(v); return v; }
__device__ __forceinline__ float half_sum32(float v) { v = row_sum16(v); v += dpp_f<0x142, 0xa>(v); return v; }
__device__ __forceinline__ float rd_lane(float v, int l) { return __int_as_float(__builtin_amdgcn_readlane(__float_as_int(v), l)); }
__device__ __forceinline__ float wave_sum(float v) { v = half_sum32(v); return rd_lane(v, 31) + rd_lane(v, 63); }
__device__ __forceinline__ float wave_max(float v) {
#pragma unroll
    for (int o = 1; o < 64; o <<= 1) v = fmaxf(v, __shfl_xor(v, o));
    return v;
}
__device__ __forceinline__ float xhalf_max(float v) { auto rr = __builtin_amdgcn_permlane32_swap(__float_as_uint(v), __float_as_uint(v), false, false); return fmaxf(__uint_as_float(rr[0]), __uint_as_float(rr[1])); }
__device__ __forceinline__ float xhalf_sum(float v) { auto rr = __builtin_amdgcn_permlane32_swap(__float_as_uint(v), __float_as_uint(v), false, false); return __uint_as_float(rr[0]) + __uint_as_float(rr[1]); }
#define XB_TMO      128
#define XB_XCNT(j)  (256  + 64 * (j))
#define XB_XSUB(j)  (1280 + 64 * (j))
#define XB_XGEN(j)  (2304 + 64 * (j))
#define XB_TOP      3328
#define XB_TOPGEN   3392
#define XCD_BAR_WORDS 3456
#define XB_SPIN_CAP (1u << 18)

__device__ __forceinline__ unsigned xb_ld(unsigned* p)              { return __hip_atomic_load(p, __ATOMIC_RELAXED, __HIP_MEMORY_SCOPE_AGENT); }
__device__ __forceinline__ unsigned xb_add(unsigned* p, unsigned v) { return __hip_atomic_fetch_add(p, v, __ATOMIC_RELAXED, __HIP_MEMORY_SCOPE_AGENT); }
__device__ __forceinline__ unsigned xb_xcc_id() { return (unsigned)__builtin_amdgcn_s_getreg((3 << 11) | 20) & 0xFu; }
#define XB_SPIN(cond, bar) do { unsigned _sp = 0; while (cond) { __builtin_amdgcn_s_sleep(1); \
    if ((++_sp & 255u) == 0u) { if (xb_ld(&(bar)[XB_TMO])) break; if (_sp > XB_SPIN_CAP) { atomicAdd(&(bar)[XB_TMO], 1u); break; } } } } while (0)

struct XcdBarrier {
    unsigned* bar; unsigned x;
    volatile LAS unsigned* st;
};

__device__ __forceinline__ XcdBarrier xcd_barrier_post(unsigned* bar, volatile LAS unsigned* st) {
    XcdBarrier b; b.bar = bar; b.x = xb_xcc_id(); b.st = st;
    if (threadIdx.x == 0) (void)xb_add(&bar[XB_XCNT(b.x)], 1u);
    return b;
}
__device__ __forceinline__ void xcd_barrier_complete(unsigned* bar, unsigned x, unsigned& nloc, unsigned& nx) {
    const unsigned G = gridDim.x * gridDim.y * gridDim.z;
    unsigned sum, cnt, mine, sp = 0u;
    for (;;) {
        sum = 0u; cnt = 0u; mine = 0u;
#pragma unroll
        for (unsigned j = 0; j < 16; ++j) { const unsigned c = xb_ld(&bar[XB_XCNT(j)]); sum += c; cnt += (c > 0u) ? 1u : 0u; mine = (j == x) ? c : mine; }
        if (sum == G) break;
        __builtin_amdgcn_s_sleep(1);
        if ((++sp & 255u) == 0u) { if (xb_ld(&bar[XB_TMO])) break; if (sp > XB_SPIN_CAP) { atomicAdd(&bar[XB_TMO], 1u); break; } }
    }
    nloc = mine > 0u ? mine : 1u; nx = cnt > 0u ? cnt : 1u;
}

__device__ __forceinline__ void xcd_barrier(const XcdBarrier& b) {
    asm volatile("s_waitcnt vmcnt(0)" ::: "memory");
    __syncthreads();
    if (threadIdx.x == 0) {
        unsigned* bar = b.bar;
        __builtin_amdgcn_s_waitcnt(0);
        unsigned nloc = b.st[0], nx = b.st[1];
        if (nloc == 0u) { xcd_barrier_complete(bar, b.x, nloc, nx); b.st[0] = nloc; b.st[1] = nx; }
        const unsigned old = xb_add(&bar[XB_XSUB(b.x)], 1u);
        const unsigned gen = old / nloc;
        if (old + 1u == (gen + 1u) * nloc) {
            __builtin_amdgcn_fence(__ATOMIC_RELEASE, "agent");
            asm volatile("s_waitcnt vmcnt(0)" ::: "memory");
            const unsigned og = xb_add(&bar[XB_TOP], 1u);
            const unsigned tg = og / nx;
            if (og + 1u == (tg + 1u) * nx) xb_add(&bar[XB_TOPGEN], 1u);
            else XB_SPIN(xb_ld(&bar[XB_TOPGEN]) == tg, bar);
            __builtin_amdgcn_fence(__ATOMIC_ACQUIRE, "agent");
            xb_add(&bar[XB_XGEN(b.x)], 1u);
            asm volatile("s_waitcnt vmcnt(0)" ::: "memory");
        } else {
            XB_SPIN(xb_ld(&bar[XB_XGEN(b.x)]) == gen, bar);
            __builtin_amdgcn_fence(__ATOMIC_ACQUIRE, "agent");
            asm volatile("s_waitcnt vmcnt(0)" ::: "memory");
        }
    }
    __syncthreads();
}
struct Frame {
    LAS unsigned char* lds;
    volatile LAS unsigned* MISC;
    unsigned* ctl;
    int tid, lane, wave, vcu, G; unsigned char* wsb;
    const float* in[20]; float* out;
    __device__ __forceinline__ bf16* WGU() const { return (bf16*)(wsb + WS_WGU); }
    __device__ __forceinline__ bf16* WD() const { return (bf16*)(wsb + WS_WD); }
    __device__ __forceinline__ bf16* H() const { return (bf16*)(wsb + WS_H); }
    __device__ __forceinline__ bf16* WB() const { return (bf16*)(wsb + WS_WB); }
    __device__ __forceinline__ bf16* PA() const { return (bf16*)(wsb + WS_BIG); }
    __device__ __forceinline__ bf16* PB() const { return (bf16*)(wsb + WS_PB); }
    __device__ __forceinline__ bf16* ACT() const { return (bf16*)(wsb + WS_BIG); }
    __device__ __forceinline__ bf16* OG() const { return (bf16*)(wsb + WS_OG); }
    __device__ __forceinline__ bf16* OM() const { return (bf16*)(wsb + WS_OM); }
    __device__ __forceinline__ bf16* WBG() const { return (bf16*)(wsb + WS_WBG); }
    __device__ __forceinline__ bf16* WBM() const { return (bf16*)(wsb + WS_WBM); }
    __device__ __forceinline__ bf16* WO() const { return (bf16*)(wsb + WS_WO); }
    __device__ __forceinline__ bf16* QN() const { return (bf16*)(wsb + WS_QN); }
    __device__ __forceinline__ bf16* KN() const { return (bf16*)(wsb + WS_KN); }
    __device__ __forceinline__ bf16* VP() const { return (bf16*)(wsb + WS_VP); }
    __device__ __forceinline__ bf16* KNT() const { return (bf16*)(wsb + WS_KNT); }
    __device__ __forceinline__ bf16* MQ() const { return (bf16*)(wsb + WS_MQ); }
    __device__ __forceinline__ bf16* MK() const { return (bf16*)(wsb + WS_MK); }
    __device__ __forceinline__ bf16* MV() const { return (bf16*)(wsb + WS_MV); }
    __device__ __forceinline__ bf16* U() const { return (bf16*)(wsb + WS_U); }
    __device__ __forceinline__ bf16* W() const { return (bf16*)(wsb + WS_W); }
    __device__ __forceinline__ bf16* AT() const { return (bf16*)(wsb + WS_AT); }
    __device__ __forceinline__ bf16* KMH() const { return (bf16*)(wsb + WS_KMEAN); }
    __device__ __forceinline__ bf16* KML() const { return (bf16*)(wsb + (WS_KMEAN + 262144)); }
    __device__ __forceinline__ float* AB() const { return (float*)(wsb + WS_AB); }
    __device__ __forceinline__ float* GG() const { return (float*)(wsb + WS_G); }
    __device__ __forceinline__ float* BETA() const { return (float*)(wsb + WS_BETA); }
    __device__ __forceinline__ float* Y1() const { return (float*)(wsb + WS_Y1); }
    __device__ __forceinline__ float* GC() const { return (float*)(wsb + WS_GC); }
    __device__ __forceinline__ f32x2* ROPE() const { return (f32x2*)(wsb + WS_ROPE); }
    __device__ __forceinline__ unsigned char* H8() const { return wsb + WS_H8; }
    __device__ __forceinline__ unsigned char* W8() const { return wsb + WS_W8; }
    __device__ __forceinline__ unsigned* CM(int f) const { return (unsigned*)(wsb + WS_CTL + (256 + 128 * f) * 1024); }
    __device__ __forceinline__ unsigned* CMW() const { return (unsigned*)(wsb + WS_CTL + 640 * 1024); }
    __device__ __forceinline__ unsigned* RM(int f) const { return (unsigned*)(wsb + WS_CTL + (768 + 64 * f) * 1024); }
    __device__ __forceinline__ unsigned* CMD(int f) const { return (unsigned*)(wsb + WS_CTL + (896 + 16 * f) * 1024); }
    __device__ __forceinline__ unsigned char* ACT8() const { return wsb + WS_PB; }
    __device__ __forceinline__ float* RS() const { return (float*)(wsb + WS_CTL + 512 * 1024); }
};

template <int MODE> __device__ __forceinline__ int rowmap(int n0) {
    if (MODE == 0) return n0;
    if (MODE == 1) return 256 * (n0 >> 7) + (n0 & 127);
    if (MODE == 2) return 256 * (n0 >> 7) + 128 + (n0 & 127);
    if (MODE == 3) return n0 < 8192 ? n0 : (n0 < 12288 ? n0 + 4096 : (n0 < 12352 ? 16384 + (n0 - 12288) : n0 - 4160));
    return n0 - 16448;
}
__device__ __forceinline__ bool win_i8(int n0) { return n0 >= 16448; }
__device__ __forceinline__ const float* tr_src(const float* W, int N, int item, int lane, int nblk_ = 0) { const int nblk = nblk_ ? nblk_ : (N >> 6), kb = item / nblk, nb = item - kb * nblk; return W + (size_t)(kb << 6) * N + (nb << 6) + lane; }
__device__ __forceinline__ void tr_load(const float* src, int N, float (&v)[64]) {
#pragma unroll
    for (int j = 0; j < 64; ++j) v[j] = __builtin_nontemporal_load(src + (size_t)j * N);
}
__device__ __forceinline__ void tr_put(LAS float* scr, const float (&v)[64], int lane) {
#pragma unroll
    for (int j = 0; j < 64; ++j) scr[j * 65 + lane] = v[j];
    LDS_WAIT();
}
template <int MODE> __device__ __forceinline__ void tr_out(int K, int N, bf16* WT, LAS float* scr, int item, int lane, int nblk_ = 0) {
    const int nblk = nblk_ ? nblk_ : (N >> 6), kb = item / nblk, nb = item - kb * nblk, k0 = kb << 6, n0 = nb << 6;
    const int c = lane & 7, r = lane >> 3, drow = rowmap<MODE>(n0);
#pragma unroll
    for (int j = 0; j < 8; ++j) { const int n = r + 8 * j; const LAS float* s = scr + (8 * c) * 65 + n;
        v4u o; o.x = pk2(s[0], s[65]); o.y = pk2(s[130], s[195]); o.z = pk2(s[260], s[325]); o.w = pk2(s[390], s[455]);
        *(v4u*)(WT + (size_t)(drow + n) * K + k0 + 8 * c) = o; }
    LDS_WAIT();
}
__device__ __forceinline__ unsigned pk4_fp8(float a, float b, float c, float d) { int w = 0; w = __builtin_amdgcn_cvt_pk_fp8_f32(a, b, w, false); w = __builtin_amdgcn_cvt_pk_fp8_f32(c, d, w, true); return (unsigned)w; }
__device__ __forceinline__ void tr_out8(int K, int N, unsigned char* WT, int drow, LAS float* scr, int item, int lane) {
    const int nblk = N >> 6, kb = item / nblk, nb = item - kb * nblk, k0 = kb << 6, n0 = nb << 6;
    const int c = lane & 7, r = lane >> 3;
#pragma unroll
    for (int j = 0; j < 8; ++j) { const int n = r + 8 * j; const LAS float* sp = scr + (8 * c) * 65 + n;
        v2u o; o.x = pk4_fp8(sp[0] * 64.f, sp[65] * 64.f, sp[130] * 64.f, sp[195] * 64.f); o.y = pk4_fp8(sp[260] * 64.f, sp[325] * 64.f, sp[390] * 64.f, sp[455] * 64.f);
        *(v2u*)(WT + (size_t)(drow + n0 + n) * K + k0 + 8 * c) = o; }
    LDS_WAIT();
}
__device__ __forceinline__ unsigned pk4_i8(float a, float b, float c, float d) {
    const float MG = 12582912.0f;
    const unsigned ya = __float_as_uint(a + MG), yb = __float_as_uint(b + MG), yc = __float_as_uint(c + MG), yd = __float_as_uint(d + MG);
    const unsigned t01 = __builtin_amdgcn_perm(yb, ya, 0x0c0c0400u), t23 = __builtin_amdgcn_perm(yd, yc, 0x0c0c0400u);
    return __builtin_amdgcn_perm(t23, t01, 0x05040100u); }
template <int MODE> __device__ __forceinline__ void tr_q_i8(int N, const unsigned* CM, int item, int lane, float (&q)[8]) {
    const int nblk = N >> 6, kb = item / nblk, nb = item - kb * nblk, n0 = nb << 6, r = lane >> 3, drow = rowmap<MODE>(n0);
#pragma unroll
    for (int j = 0; j < 8; ++j) q[j] = 127.0f / fmaxf(__uint_as_float(CM[drow + r + 8 * j]), 1e-30f);
}
template <int MODE> __device__ __forceinline__ void tr_out_i8(int K, int N, unsigned char* WT, const float (&q)[8], LAS float* scr, int item, int lane) {
    const int nblk = N >> 6, kb = item / nblk, nb = item - kb * nblk, k0 = kb << 6, n0 = nb << 6;
    const int c = lane & 7, r = lane >> 3, drow = rowmap<MODE>(n0);
#pragma unroll
    for (int j = 0; j < 8; ++j) { const int n = r + 8 * j; const LAS float* sp = scr + (8 * c) * 65 + n; const float qq = q[j];
        v2u o; o.x = pk4_i8(sp[0] * qq, sp[65] * qq, sp[130] * qq, sp[195] * qq); o.y = pk4_i8(sp[260] * qq, sp[325] * qq, sp[390] * qq, sp[455] * qq);
        *(v2u*)(WT + (size_t)(drow + n) * K + k0 + 8 * c) = o; }
    LDS_WAIT();
}
__device__ __forceinline__ void colmax_ffn(Frame& F, const float* wg, const float* wu, unsigned* CM) {
    const int gw = F.vcu * NWAVES + F.wave, NGW = F.G * NWAVES, lane = F.lane;
    constexpr int I1 = (DM / 64) * (FF / 64);
    for (int it = gw; it < 2 * I1; it += NGW) {
        const bool up = it >= I1; const int item = up ? it - I1 : it; const int nb = item % (FF / 64), n0 = nb << 6;
        const float* s = tr_src(up ? wu : wg, FF, item, lane);
        float v[64]; tr_load(s, FF, v);
        float mx = 0.f;
#pragma unroll
        for (int j = 0; j < 64; ++j) mx = fmaxf(mx, fabsf(v[j]));
        atomicMax(CM + (up ? rowmap<2>(n0) : rowmap<1>(n0)) + lane, __float_as_uint(mx));
    }
}
__device__ __forceinline__ void strip_quant_i8(Frame& F, const float* W, int N, int c0, int drow0, unsigned char* WT, float* CS) {
    LAS float* xch = (LAS float*)(F.lds + 150528);
    int lane_a = threadIdx.x & 63; asm volatile("" : "+v"(lane_a));
    const int r0 = F.wave * 512;
    const char* bu = (const char*)W + ((size_t)r0 * N + c0) * 4;
    const unsigned voff = (unsigned)(32 * (lane_a >> 5) * N + (lane_a & 31)) * 4u;
    unsigned v[128]; float mx = 0.f; float ta[32], tb[32];
#define SQ_LOAD(t, i) do { _Pragma("unroll") for (int j = 0; j < 32; ++j) t[j] = __builtin_nontemporal_load((const float*)(bu + (size_t)(64 * (i) + j) * N * 4 + voff)); } while (0)
#define SQ_PACK(t, i) do { _Pragma("unroll") for (int j = 0; j < 16; ++j) { unsigned w = pk2(t[2 * j], t[2 * j + 1]); mx = fmaxf(mx, fmaxf(fabsf(blo(w)), fabsf(bhi(w)))); asm volatile("" : "+v"(w)); v[16 * (i) + j] = w; }   \
        __builtin_amdgcn_sched_barrier(0); } while (0)
    SQ_LOAD(ta, 0);
#pragma unroll
    for (int i = 0; i < 8; i += 2) {
        SQ_LOAD(tb, i + 1); SQ_PACK(ta, i);
        if (i + 2 < 8) SQ_LOAD(ta, i + 2);
        SQ_PACK(tb, i + 1); }
#undef SQ_LOAD
#undef SQ_PACK
    int lane = threadIdx.x & 63; asm volatile("" : "+v"(lane));
    const int col = lane & 31, half = lane >> 5;
    mx = xhalf_max(mx);
    if (lane < 32) xch[F.wave * 32 + lane] = mx;
    __syncthreads();
    float cm = 0.f;
#pragma unroll
    for (int w = 0; w < 8; ++w) cm = fmaxf(cm, xch[w * 32 + col]);
    __syncthreads();
    if (F.wave == 0 && lane < 32) CS[drow0 + col] = cm;
    const float q = 127.0f / fmaxf(cm, 1e-30f);
    unsigned char* dst = WT + (size_t)(drow0 + col) * DM + r0 + 32 * half;
#pragma unroll
    for (int i = 0; i < 8; ++i) { v4u o0, o1;
        o0.x = pk4_i8(blo(v[16 * i + 0]) * q, bhi(v[16 * i + 0]) * q, blo(v[16 * i + 1]) * q, bhi(v[16 * i + 1]) * q); o0.y = pk4_i8(blo(v[16 * i + 2]) * q, bhi(v[16 * i + 2]) * q, blo(v[16 * i + 3]) * q, bhi(v[16 * i + 3]) * q);
        o0.z = pk4_i8(blo(v[16 * i + 4]) * q, bhi(v[16 * i + 4]) * q, blo(v[16 * i + 5]) * q, bhi(v[16 * i + 5]) * q); o0.w = pk4_i8(blo(v[16 * i + 6]) * q, bhi(v[16 * i + 6]) * q, blo(v[16 * i + 7]) * q, bhi(v[16 * i + 7]) * q);
        o1.x = pk4_i8(blo(v[16 * i + 8]) * q, bhi(v[16 * i + 8]) * q, blo(v[16 * i + 9]) * q, bhi(v[16 * i + 9]) * q); o1.y = pk4_i8(blo(v[16 * i + 10]) * q, bhi(v[16 * i + 10]) * q, blo(v[16 * i + 11]) * q, bhi(v[16 * i + 11]) * q);
        o1.z = pk4_i8(blo(v[16 * i + 12]) * q, bhi(v[16 * i + 12]) * q, blo(v[16 * i + 13]) * q, bhi(v[16 * i + 13]) * q); o1.w = pk4_i8(blo(v[16 * i + 14]) * q, bhi(v[16 * i + 14]) * q, blo(v[16 * i + 15]) * q, bhi(v[16 * i + 15]) * q);
        *(v4u*)(dst + 64 * i) = o0; *(v4u*)(dst + 64 * i + 16) = o1; }
}
__device__ __forceinline__ void strip_quant_wd(Frame& F, const float* W, int c0, unsigned char* WT, float* CS) {
    LAS float* xch = (LAS float*)(F.lds + 150528);
    int lane_a = threadIdx.x & 63; asm volatile("" : "+v"(lane_a));
    const int wave = F.wave, g0 = wave < 4 ? wave * 22 : 88 + (wave - 4) * 21, ng = wave < 4 ? 22 : 21;
    const char* bu = (const char*)W + ((size_t)(g0 * 64) * DM + c0) * 4;
    const int qa = lane_a >> 4; const unsigned voff = (unsigned)(16 * qa * DM + (lane_a & 15)) * 4u;
    unsigned v[176]; float mx = 0.f; float ta[16], tb[16];
#define WD_LOAD(t, i) do { _Pragma("unroll") for (int j = 0; j < 16; ++j) t[j] = __builtin_nontemporal_load((const float*)(bu + (size_t)(64 * (i) + j) * DM * 4 + voff)); } while (0)
#define WD_ROT(t, i) do { \
        _Pragma("unroll") for (int h = 1; h < 16; h <<= 1) _Pragma("unroll") for (int j = 0; j < 16; ++j) if (!(j & h)) { const float a = t[j], b = t[j + h]; t[j] = a + b; t[j + h] = a - b; } \
        _Pragma("unroll") for (int j = 0; j < 16; ++j) { auto a = __builtin_amdgcn_permlane16_swap(__float_as_uint(t[j]), __float_as_uint(t[j]), false, false); \
            const float lo = __uint_as_float(a[0]), hi = __uint_as_float(a[1]); t[j] = (qa & 1) ? lo - hi : lo + hi; } \
        _Pragma("unroll") for (int j = 0; j < 16; ++j) { auto b = __builtin_amdgcn_permlane32_swap(__float_as_uint(t[j]), __float_as_uint(t[j]), false, false); \
            const float lo = __uint_as_float(b[0]), hi = __uint_as_float(b[1]); t[j] = ((qa & 2) ? lo - hi : lo + hi) * 0.125f; } \
        _Pragma("unroll") for (int j = 0; j < 8; ++j) { unsigned w = pk2(t[2 * j], t[2 * j + 1]); mx = fmaxf(mx, fmaxf(fabsf(blo(w)), fabsf(bhi(w)))); asm volatile("" : "+v"(w)); v[8 * (i) + j] = w; } \
        __builtin_amdgcn_sched_barrier(0); } while (0)
    WD_LOAD(ta, 0);
#pragma unroll
    for (int i = 0; i < 16; i += 2) {
        WD_LOAD(tb, i + 1);
        WD_ROT(ta, i);
        if (i + 2 < 16) WD_LOAD(ta, i + 2);
        WD_ROT(tb, i + 1);
    }
#pragma unroll
    for (int i = 16; i < 22; ++i) {
        if (i < ng) { WD_LOAD(ta, i); WD_ROT(ta, i); } else {
#pragma unroll
            for (int j = 0; j < 8; ++j) v[8 * i + j] = 0u; }
    }
#undef WD_LOAD
#undef WD_ROT
    int lane = threadIdx.x & 63; asm volatile("" : "+v"(lane));
    const int col = lane & 15, q4 = lane >> 4;
    { auto a = __builtin_amdgcn_permlane16_swap(__float_as_uint(mx), __float_as_uint(mx), false, false); mx = fmaxf(__uint_as_float(a[0]), __uint_as_float(a[1]));
      auto b = __builtin_amdgcn_permlane32_swap(__float_as_uint(mx), __float_as_uint(mx), false, false); mx = fmaxf(__uint_as_float(b[0]), __uint_as_float(b[1])); }
    if (lane < 16) xch[wave * 16 + lane] = mx;
    __syncthreads();
    float cm = 0.f;
#pragma unroll
    for (int w = 0; w < 8; ++w) cm = fmaxf(cm, xch[w * 16 + col]);
    __syncthreads();
    if (wave == 0 && lane < 16) CS[c0 + col] = cm;
    const float qq = 127.0f / fmaxf(cm, 1e-30f);
    unsigned char* dst = WT + (size_t)(c0 + col) * FF + (size_t)g0 * 64 + 16 * q4;
#pragma unroll
    for (int i = 0; i < 22; ++i) if (i < ng) { v4u o;
        o.x = pk4_i8(blo(v[8 * i + 0]) * qq, bhi(v[8 * i + 0]) * qq, blo(v[8 * i + 1]) * qq, bhi(v[8 * i + 1]) * qq); o.y = pk4_i8(blo(v[8 * i + 2]) * qq, bhi(v[8 * i + 2]) * qq, blo(v[8 * i + 3]) * qq, bhi(v[8 * i + 3]) * qq);
        o.z = pk4_i8(blo(v[8 * i + 4]) * qq, bhi(v[8 * i + 4]) * qq, blo(v[8 * i + 5]) * qq, bhi(v[8 * i + 5]) * qq); o.w = pk4_i8(blo(v[8 * i + 6]) * qq, bhi(v[8 * i + 6]) * qq, blo(v[8 * i + 7]) * qq, bhi(v[8 * i + 7]) * qq);
        *(v4u*)(dst + 64 * i) = o; }
}
__device__ __forceinline__ void quant_wd(Frame& F, const float* wd, float* CS) { for (int s = blockIdx.x; s < DM / 16; s += F.G) strip_quant_wd(F, wd, 16 * s, (unsigned char*)F.WD(), CS); }
__device__ __forceinline__ void quant_ffn_gu(Frame& F, const float* wg, const float* wu, float* CS) {
    for (int s = blockIdx.x; s < 2 * (FF / 32); s += F.G) { const bool up = s >= FF / 32; const int c0 = (up ? s - FF / 32 : s) * 32;
        strip_quant_i8(F, up ? wu : wg, FF, c0, up ? rowmap<2>(c0) : rowmap<1>(c0), (unsigned char*)F.WGU(), CS); }
}
__device__ __forceinline__ void fwht32x2(float (&v)[64]) {
#pragma unroll
    for (int h = 1; h < 64; h <<= 1)
#pragma unroll
        for (int j = 0; j < 64; ++j) if (!(j & h)) { const float a = v[j], b = v[j + h]; v[j] = a + b; v[j + h] = a - b; }
#pragma unroll
    for (int j = 0; j < 64; ++j) v[j] *= 0.125f;
}
__device__ __forceinline__ void colmax_wd(Frame& F, const float* wd, unsigned* CMD) {
    const int gw = F.vcu * NWAVES + F.wave, NGW = F.G * NWAVES, lane = F.lane;
    constexpr int I2 = (FF / 64) * (DM / 64);
    for (int it = gw; it < I2; it += NGW) { const int n0 = (it % (DM / 64)) << 6;
        float v[64]; tr_load(tr_src(wd, DM, it, lane), DM, v);
        fwht32x2(v);
        float mx = 0.f;
#pragma unroll
        for (int j = 0; j < 64; ++j) mx = fmaxf(mx, fabsf(v[j]));
        atomicMax(CMD + n0 + lane, __float_as_uint(mx));
    }
}
__device__ __forceinline__ void requant_rows(Frame& F, const bf16* A, unsigned char* A8, float* RS) {
    const int gw = F.vcu * NWAVES + F.wave, NGW = F.G * NWAVES;
    constexpr int NV = FF / 8;
    const float s1 = (F.lane & 1) ? -1.0f : 1.0f, s2 = (F.lane & 2) ? -1.0f : 1.0f, s4 = (F.lane & 4) ? -1.0f : 1.0f;
    for (int m = gw; m < M; m += NGW) {
        const v4u* src = (const v4u*)(A + (size_t)m * FF); v2u* dst = (v2u*)(A8 + (size_t)m * FF);
        v4u w[22];
#pragma unroll
        for (int j = 0; j < 22; ++j) { const int idx = F.lane + 64 * j; w[j] = (v4u){0u, 0u, 0u, 0u}; if (idx < NV) w[j] = src[idx]; }
        float mx = 0.f;
#pragma unroll
        for (int j = 0; j < 22; ++j) {
            float x[8] = {blo(w[j].x), bhi(w[j].x), blo(w[j].y), bhi(w[j].y), blo(w[j].z), bhi(w[j].z), blo(w[j].w), bhi(w[j].w)};
#pragma unroll
            for (int h = 1; h < 8; h <<= 1)
#pragma unroll
                for (int i = 0; i < 8; ++i) if (!(i & h)) { const float a = x[i], b = x[i + h]; x[i] = a + b; x[i + h] = a - b; }
#pragma unroll
            for (int i = 0; i < 8; ++i) x[i] = __builtin_fmaf(s1, x[i], dpp_f<0xB1, 0xf>(x[i]));
#pragma unroll
            for (int i = 0; i < 8; ++i) x[i] = __builtin_fmaf(s2, x[i], dpp_f<0x4E, 0xf>(x[i]));
#pragma unroll
            for (int i = 0; i < 8; ++i) x[i] = __builtin_fmaf(s4, x[i], __int_as_float(__builtin_amdgcn_ds_swizzle(__float_as_int(x[i]), 0x101F))) * 0.125f;
            w[j].x = pk2(x[0], x[1]); w[j].y = pk2(x[2], x[3]); w[j].z = pk2(x[4], x[5]); w[j].w = pk2(x[6], x[7]);
            mx = fmaxf(mx, fmaxf(fmaxf(fmaxf(fabsf(blo(w[j].x)), fabsf(bhi(w[j].x))), fmaxf(fabsf(blo(w[j].y)), fabsf(bhi(w[j].y)))), fmaxf(fmaxf(fabsf(blo(w[j].z)), fabsf(bhi(w[j].z))), fmaxf(fabsf(blo(w[j].w)), fabsf(bhi(w[j].w))))));
        }
        mx = fmaxf(wave_max(mx), 1e-30f);
        const float q = 127.0f / mx;
#pragma unroll
        for (int j = 0; j < 22; ++j) { const int idx = F.lane + 64 * j;
            if (idx < NV) { v2u o; o.x = pk4_i8(blo(w[j].x) * q, bhi(w[j].x) * q, blo(w[j].y) * q, bhi(w[j].y) * q); o.y = pk4_i8(blo(w[j].z) * q, bhi(w[j].z) * q, blo(w[j].w) * q, bhi(w[j].w) * q); dst[idx] = o; } }
        if (F.lane == 0) RS[m] = mx * (1.0f / 127.0f);
    }
}
template <class SRC, class XF, class PRE, class OUT> __device__ __forceinline__ void tr_pipeline(int it0, int itEnd, int step, LAS float* scr, int lane, SRC srcf, XF xf, PRE pref, OUT outf) {
    if (it0 >= itEnd) return;
    float v[64]; const float* s; int N;
    srcf(it0, s, N); tr_load(s, N, v);
    for (int it = it0;;) {
        xf(it, v);
        tr_put(scr, v, lane);
        float q[8]; pref(it, q);
        const int nx = it + step;
        if (nx < itEnd) { srcf(nx, s, N); tr_load(s, N, v); }
        outf(it, q);
        if (nx >= itEnd) break;
        it = nx;
    }
}
__device__ __forceinline__ void convert_wd(Frame& F, const float* wd, const unsigned* CMD) {
    LAS float* scr = (LAS float*)(F.lds + F.wave * TR_STRIDE);
    const int gw = F.vcu * NWAVES + F.wave, NGW = F.G * NWAVES, lane = F.lane;
    constexpr int I2 = (FF / 64) * (DM / 64);
    unsigned char* wdt = (unsigned char*)F.WD();
    tr_pipeline(gw, I2, NGW, scr, lane,
        [&](int it, const float*& s, int& N) { s = tr_src(wd, DM, it, lane); N = DM; },
        [&](int, float (&v)[64]) { fwht32x2(v); },
        [&](int it, float (&q)[8]) { tr_q_i8<0>(DM, CMD, it, lane, q); },
        [&](int it, const float (&q)[8]) { tr_out_i8<0>(FF, DM, wdt, q, scr, it, lane); });
}
__device__ __forceinline__ void convert_win(Frame& F) {
    LAS float* scr = (LAS float*)(F.lds + F.wave * TR_STRIDE);
    const int gw = F.vcu * NWAVES + F.wave, NGW = F.G * NWAVES, lane = F.lane;
    constexpr int NB = 16448 / 64, I1 = (DM / 64) * NB;
    const float* win = F.in[6]; bf16* wb = F.WB();
    tr_pipeline(gw, I1, NGW, scr, lane,
        [&](int it, const float*& s, int& N) { s = tr_src(win, 26688, it, lane, NB); N = 26688; },
        [&](int, float (&)[64]) {},
        [&](int, float (&)[8]) {},
        [&](int it, const float (&)[8]) { tr_out<3>(DM, 26688, wb, scr, it, lane, NB); });
    __syncthreads();
    for (int s = blockIdx.x; s < (26688 - 16448) / 32; s += F.G) { const int c0 = 16448 + 32 * s; strip_quant_i8(F, win, 26688, c0, c0 - 16448, F.W8(), (float*)F.CMW()); }
}
__device__ __forceinline__ void colmax_win(Frame& F) {
    const int gw = F.vcu * NWAVES + F.wave, NGW = F.G * NWAVES, lane = F.lane;
    constexpr int NB = 26688 / 64, I1 = (DM / 64) * NB;
    unsigned* cm = F.CMW();
    for (int it = gw; it < I1; it += NGW) { const int n0 = (it % NB) << 6;
        if (!win_i8(n0)) continue;
        float v[64]; tr_load(tr_src(F.in[6], 26688, it, lane), 26688, v);
        float mx = 0.f;
#pragma unroll
        for (int j = 0; j < 64; ++j) mx = fmaxf(mx, fabsf(v[j]));
        atomicMax(cm + rowmap<4>(n0) + lane, __float_as_uint(mx));
    }
}
__device__ __forceinline__ void convert_branch(Frame& F) {
    LAS float* scr = (LAS float*)(F.lds + F.wave * TR_STRIDE);
    const int gw = F.vcu * NWAVES + F.wave, NGW = F.G * NWAVES, lane = F.lane;
    constexpr int IG = 64 * 64, IM = 32 * 64;
    const float* w13 = F.in[13]; const float* w14 = F.in[14]; const float* w15 = F.in[15]; bf16* wbg = F.WBG(); unsigned char* wbm = (unsigned char*)F.WBM(); bf16* wo = F.WO();
    tr_pipeline(gw, 2 * IG + IM, NGW, scr, lane,
        [&](int it, const float*& s, int& N) { N = 4096; if (it < IG) s = tr_src(w13, 4096, it, lane); else if (it < IG + IM) s = tr_src(w14, 4096, it - IG, lane); else s = tr_src(w15, 4096, it - IG - IM, lane); },
        [&](int, float (&)[64]) {},
        [&](int, float (&)[8]) {},
        [&](int it, const float (&)[8]) { if (it < IG) tr_out<0>(4096, 4096, wbg, scr, it, lane);
                      else if (it < IG + IM) tr_out8(2048, 4096, wbm, 0, scr, it - IG, lane);
                      else tr_out<0>(4096, 4096, wo, scr, it - IG - IM, lane); });
}
__device__ __forceinline__ void rms_rows(Frame& F, const float* X, const float* gain, bf16* O, unsigned char* O8 = nullptr) {
    LAS f32x4* gl = (LAS f32x4*)(F.lds + 8 * TR_STRIDE);
    for (int i = F.tid; i < DM / 4; i += NWAVES * 64) gl[i] = ((const f32x4*)gain)[i];
    __syncthreads();
    const int gw = F.vcu * NWAVES + F.wave, NGW = F.G * NWAVES;
    int m = gw; if (m >= M) return;
    f32x4 v[16], nv[16];
    { const f32x4* xr = (const f32x4*)(X + (size_t)m * DM) + F.lane;
#pragma unroll
      for (int j = 0; j < 16; ++j) v[j] = xr[64 * j]; }
    for (;;) {
        const int mn = m + NGW;
        if (mn < M) { const f32x4* xr = (const f32x4*)(X + (size_t)mn * DM) + F.lane;
#pragma unroll
            for (int j = 0; j < 16; ++j) nv[j] = xr[64 * j]; }
        float s = 0.f;
#pragma unroll
        for (int j = 0; j < 16; ++j) s += (v[j].x * v[j].x + v[j].y * v[j].y) + (v[j].z * v[j].z + v[j].w * v[j].w);
        const float r = 1.0f / sqrtf(wave_sum(s) * (1.0f / DM) + NORM_EPS);
        v2u* o8 = (v2u*)(O + (size_t)m * DM) + F.lane;
#pragma unroll
        for (int j = 0; j < 16; ++j) { const f32x4 g = gl[F.lane + 64 * j]; const float a = v[j].x * r * g.x, b = v[j].y * r * g.y, c = v[j].z * r * g.z, d = v[j].w * r * g.w;
            v2u w; w.x = pk2(a, b); w.y = pk2(c, d); o8[64 * j] = w;
            if (O8) ((unsigned*)(O8 + (size_t)m * DM))[F.lane + 64 * j] = pk4_fp8(a, b, c, d); }
        if (mn >= M) break;
#pragma unroll
        for (int j = 0; j < 16; ++j) v[j] = nv[j];
        m = mn;
    }
}
__device__ __forceinline__ void rms_rows_i8(Frame& F, const float* X, const float* gain, unsigned char* O, float* RS, bf16* Ob = nullptr) {
    LAS f32x4* gl = (LAS f32x4*)(F.lds + 8 * TR_STRIDE);
    for (int i = F.tid; i < DM / 4; i += NWAVES * 64) gl[i] = ((const f32x4*)gain)[i];
    __syncthreads();
    const int gw = F.vcu * NWAVES + F.wave, NGW = F.G * NWAVES;
    int m = gw; if (m >= M) return;
    f32x4 v[16], nv[16];
    { const f32x4* xr = (const f32x4*)(X + (size_t)m * DM) + F.lane;
#pragma unroll
      for (int j = 0; j < 16; ++j) v[j] = xr[64 * j]; }
    for (;;) {
        const int mn = m + NGW;
        if (mn < M) { const f32x4* xr = (const f32x4*)(X + (size_t)mn * DM) + F.lane;
#pragma unroll
            for (int j = 0; j < 16; ++j) nv[j] = xr[64 * j]; }
        float s = 0.f;
#pragma unroll
        for (int j = 0; j < 16; ++j) s += (v[j].x * v[j].x + v[j].y * v[j].y) + (v[j].z * v[j].z + v[j].w * v[j].w);
        const float r = 1.0f / sqrtf(wave_sum(s) * (1.0f / DM) + NORM_EPS);
        float mx = 0.f;
#pragma unroll
        for (int j = 0; j < 16; ++j) { const f32x4 g = gl[F.lane + 64 * j]; v[j].x *= r * g.x; v[j].y *= r * g.y; v[j].z *= r * g.z; v[j].w *= r * g.w;
            mx = fmaxf(fmaxf(mx, fmaxf(fabsf(v[j].x), fabsf(v[j].y))), fmaxf(fabsf(v[j].z), fabsf(v[j].w))); }
        if (Ob) { v2u* ob = (v2u*)(Ob + (size_t)m * DM) + F.lane;
#pragma unroll
            for (int j = 0; j < 16; ++j) { v2u w; w.x = pk2(v[j].x, v[j].y); w.y = pk2(v[j].z, v[j].w); ob[64 * j] = w; } }
        mx = fmaxf(wave_max(mx), 1e-30f);
        const float q = 127.0f / mx;
        unsigned* o = (unsigned*)(O + (size_t)m * DM) + F.lane;
#pragma unroll
        for (int j = 0; j < 16; ++j) o[64 * j] = pk4_i8(v[j].x * q, v[j].y * q, v[j].z * q, v[j].w * q);
        if (F.lane == 0) RS[m] = mx * (1.0f / 127.0f);
        if (mn >= M) break;
#pragma unroll
        for (int j = 0; j < 16; ++j) v[j] = nv[j];
        m = mn;
    }
}
__device__ __forceinline__ void rope_table(Frame& F) {
    const int gt = F.vcu * NWAVES * 64 + F.tid, NT = F.G * NWAVES * 64;
    for (int idx = gt; idx < SEQ * 64; idx += NT) {
        const int s = idx >> 6, i = idx & 63;
        double f = 1.0, bs = 0.8659643233600653; int e = i;
        while (e) { if (e & 1) f *= bs; bs *= bs; e >>= 1; }
        const float inv = (float)f; const float ang = (float)s * inv;
        const double a = (double)ang; const double k = __builtin_rint(a * 0.15915494309189535);
        double r = __builtin_fma(-k, 6.283185307179586, a); r = __builtin_fma(-k, 2.4492935982947064e-16, r);
        const double q = r * 0.25, q2 = q * q;
        const double sn = q * (1.0 + q2 * (-1.0 / 6 + q2 * (1.0 / 120 + q2 * (-1.0 / 5040 + q2 * (1.0 / 362880 + q2 * (-1.0 / 39916800 + q2 * (1.0 / 6227020800.0)))))));
        const double cs = 1.0 + q2 * (-0.5 + q2 * (1.0 / 24 + q2 * (-1.0 / 720 + q2 * (1.0 / 40320 + q2 * (-1.0 / 3628800 + q2 * (1.0 / 479001600 + q2 * (-1.0 / 87178291200.0)))))));
        const double s2 = 2.0 * sn * cs, c2 = 1.0 - 2.0 * sn * sn, s4 = 2.0 * s2 * c2, c4 = 1.0 - 2.0 * s2 * s2;
        F.ROPE()[idx] = (f32x2){(float)c4, (float)s4};
    }
}
__device__ __forceinline__ void prep_moba(Frame& F) {
    LAS float* red = (LAS float*)F.lds;
    const int w = F.wave, lane = F.lane, l = lane & 31, hh = lane >> 5;
    for (int item = blockIdx.x; item < BATCH * 16 * 16 * 3; item += F.G) {
        const int which = item % 3; int r = item / 3; const int h = r & 15; r >>= 4; const int j = r & 15; const int b = r >> 4;
        const int colbase = (which == 0 ? PA_MQ : which == 1 ? PA_MK : PA_MV) + h * 128;
        bf16* dst = (bf16*)(F.wsb + (which == 0 ? WS_MQ : which == 1 ? WS_MK : WS_MV)) + ((size_t)(b * 16 + h) * SEQ + j * 256) * 128;
        const bf16* src = F.PA() + (size_t)(b * SEQ + j * 256) * PA_LD + colbase;
        float k1a = 0.f, k1b = 0.f, k2a = 0.f, k2b = 0.f;
        if (which == 2) {
            LAS unsigned short* tl = (LAS unsigned short*)(F.lds + 4096);
#pragma unroll 8
            for (int i = 0; i < 32; ++i) { const int tt = w * 32 + i; const unsigned v = *(const unsigned*)(src + (size_t)tt * PA_LD + 2 * lane);
                tl[(2 * lane) * 258 + tt] = (unsigned short)(v & 0xffffu); tl[(2 * lane + 1) * 258 + tt] = (unsigned short)(v >> 16); }
            __syncthreads();
            bf16* vt = F.MV() + (size_t)(b * 16 + h) * 128 * SEQ + j * 256;
#pragma unroll 4
            for (int i = 0; i < 16; ++i) { const int d = w * 16 + i; const LAS unsigned* rp = (const LAS unsigned*)(tl + d * 258) + 2 * lane;
                *(v2u*)(vt + (size_t)d * SEQ + 4 * lane) = (v2u){rp[0], rp[1]}; }
        } else {
            const float* gq = F.in[11]; const float* gk = F.in[12];
            const f32x2 gqa = *(const f32x2*)(gq + 2 * l), gqb = *(const f32x2*)(gq + 64 + 2 * l), gka = *(const f32x2*)(gk + 2 * l), gkb = *(const f32x2*)(gk + 64 + 2 * l);
            const f32x2 g1 = which == 0 ? gqa : gka, g2 = which == 0 ? gqb : gkb;
#pragma unroll 4
            for (int it = 0; it < 16; ++it) { const int tt = w * 32 + 2 * it + hh, s = j * 256 + tt;
                const unsigned u1 = *(const unsigned*)(src + (size_t)tt * PA_LD + 2 * l), u2 = *(const unsigned*)(src + (size_t)tt * PA_LD + 64 + 2 * l);
                const f32x4 cs = *(const f32x4*)((const float*)F.ROPE() + (size_t)(s * 64 + 2 * l) * 2);
                const float x1a = blo(u1), x1b = bhi(u1), x2a = blo(u2), x2b = bhi(u2);
                const float hs = half_sum32((x1a * x1a + x1b * x1b) + (x2a * x2a + x2b * x2b));
                const float tot = hh ? rd_lane(hs, 63) : rd_lane(hs, 31);
                const float rr = 1.0f / sqrtf(tot * (1.0f / 128) + NORM_EPS);
                const float y1a = x1a * rr * g1.x, y1b = x1b * rr * g1.y, y2a = x2a * rr * g2.x, y2b = x2b * rr * g2.y;
                const float o1a = y1a * cs.x - y2a * cs.y, o2a = y2a * cs.x + y1a * cs.y, o1b = y1b * cs.z - y2b * cs.w, o2b = y2b * cs.z + y1b * cs.w;
                *(unsigned*)(dst + tt * 128 + 2 * l) = pk2(o1a, o1b); *(unsigned*)(dst + tt * 128 + 64 + 2 * l) = pk2(o2a, o2b);
                k1a += o1a; k1b += o1b; k2a += o2a; k2b += o2b; }
            k1a = xhalf_sum(k1a); k1b = xhalf_sum(k1b); k2a = xhalf_sum(k2a); k2b = xhalf_sum(k2b);
        }
        if (hh == 0) { *(LAS f32x2*)(red + w * 128 + 2 * l) = (f32x2){k1a, k1b}; *(LAS f32x2*)(red + w * 128 + 64 + 2 * l) = (f32x2){k2a, k2b}; }
        __syncthreads();
        if (which == 1 && F.tid < 128) { float s = 0.f;
#pragma unroll
            for (int ww = 0; ww < 8; ++ww) s += red[ww * 128 + F.tid];
            const float km = s * (1.0f / 256); const unsigned hi = f2bf(km); const float rem = km - __uint_as_float(hi << 16);
            F.KMH()[((size_t)(b * 16 + h) * 16 + j) * 128 + F.tid] = (bf16)hi; F.KML()[((size_t)(b * 16 + h) * 16 + j) * 128 + F.tid] = (bf16)f2bf(rem); }
        __syncthreads();
    }
}
__device__ __forceinline__ float bf_el(const v4u& x, int i) { const unsigned w = (i >> 1) == 0 ? x.x : (i >> 1) == 1 ? x.y : (i >> 1) == 2 ? x.z : x.w; return (i & 1) ? bhi(w) : blo(w); }
__device__ __forceinline__ void prep_gdn(Frame& F) {
    const int gw = F.vcu * NWAVES + F.wave, NGW = F.G * NWAVES, lane = F.lane, q = lane >> 4, li = lane & 15;
    const float* cw = F.in[7];
    LAS unsigned short* tl = (LAS unsigned short*)(F.lds + F.wave * PREP_STRIDE);
    for (int item = gw; item < BATCH * 64 * 64; item += NGW) {
        const int grp = item & 63, c = (item >> 6) & 63, b = item >> 12, t0 = b * SEQ + c * 64, ch = grp * 128 + 8 * li;
        float wt[4][8];
#pragma unroll
        for (int j = 0; j < 4; ++j) { const f32x4 wa = *(const f32x4*)(cw + j * 8192 + ch), wb = *(const f32x4*)(cw + j * 8192 + ch + 4);
            wt[j][0] = wa.x; wt[j][1] = wa.y; wt[j][2] = wa.z; wt[j][3] = wa.w; wt[j][4] = wb.x; wt[j][5] = wb.y; wt[j][6] = wb.z; wt[j][7] = wb.w; }
        const bf16* src = F.PA() + (size_t)(t0 + 16 * q) * PA_LD + ch;
        v4u xm3 = (v4u){0u, 0u, 0u, 0u}, xm2 = xm3, xm1 = xm3;
        if (c > 0 || q > 0) { xm3 = *(const v4u*)(src - 3 * (ptrdiff_t)PA_LD); xm2 = *(const v4u*)(src - 2 * (ptrdiff_t)PA_LD); xm1 = *(const v4u*)(src - (ptrdiff_t)PA_LD); }
#pragma unroll 4
        for (int s = 0; s < 16; ++s) { const int tt = 16 * q + s;
            const v4u x0 = *(const v4u*)(src + (size_t)s * PA_LD);
            float a[8]; float ss = 0.f;
#pragma unroll
            for (int i = 0; i < 8; ++i) { float v = wt[0][i] * bf_el(xm3, i) + wt[1][i] * bf_el(xm2, i) + wt[2][i] * bf_el(xm1, i) + wt[3][i] * bf_el(x0, i);
                v = v * __builtin_amdgcn_rcpf(1.0f + __expf(-v)); a[i] = v; ss += v * v; }
            xm3 = xm2; xm2 = xm1; xm1 = x0;
            if (grp < 32) { const float rr = __builtin_amdgcn_rsqf(row_sum16(ss) + NORM_EPS);
#pragma unroll
                for (int i = 0; i < 8; ++i) a[i] *= rr; }
            const v4u pk = (v4u){cvtpk(a[0], a[1]), cvtpk(a[2], a[3]), cvtpk(a[4], a[5]), cvtpk(a[6], a[7])};
            if (grp < 16) *(v4u*)(F.QN() + (size_t)(t0 + tt) * 2048 + grp * 128 + 8 * li) = pk;
            else { if (grp < 32) *(v4u*)(F.KN() + (size_t)(t0 + tt) * 2048 + (grp - 16) * 128 + 8 * li) = pk;
                   LAS unsigned short* tp = tl + (8 * li) * 68 + tt;
                   tp[0] = (unsigned short)(pk.x & 0xffffu); tp[68] = (unsigned short)(pk.x >> 16); tp[136] = (unsigned short)(pk.y & 0xffffu); tp[204] = (unsigned short)(pk.y >> 16);
                   tp[272] = (unsigned short)(pk.z & 0xffffu); tp[340] = (unsigned short)(pk.z >> 16); tp[408] = (unsigned short)(pk.w & 0xffffu); tp[476] = (unsigned short)(pk.w >> 16); }
        }
        if (grp >= 16) {
            LDS_WAIT();
            bf16* dst = (bf16*)(F.wsb + (grp < 32 ? WS_KNT : WS_VP)) + (grp < 32 ? ((size_t)(b * 16 + grp - 16) * 64 + c) : ((size_t)(b * 32 + grp - 32) * 64 + c)) * 8192;
#pragma unroll 4
            for (int i = 0; i < 16; ++i) { const int row = 8 * i + (lane >> 3), chk = lane & 7; const LAS v2u* rp = (const LAS v2u*)(tl + row * 68 + 8 * chk);
                const v2u lo = rp[0], hi = rp[1]; *(v4u*)(dst + row * 64 + 8 * chk) = (v4u){lo.x, lo.y, hi.x, hi.y}; }
            LDS_WAIT();
        }
    }
    const int gt = F.vcu * NWAVES * 64 + F.tid, NT = F.G * NWAVES * 64;
    for (int idx = gt; idx < M * 32; idx += NT) { const int hv = idx & 31, t = idx >> 5;
        const float a = F.AB()[(size_t)t * 64 + hv], bb = F.AB()[(size_t)t * 64 + 32 + hv];
        const float x = a + F.in[9][hv]; const float sp = fmaxf(x, 0.f) + log1pf(expf(-fabsf(x)));
        F.GG()[idx] = -expf(F.in[8][hv]) * sp; F.BETA()[idx] = 1.0f / (1.0f + expf(-bb)); }
}
typedef short bf16x8 __attribute__((ext_vector_type(8)));
typedef float f32x16 __attribute__((ext_vector_type(16)));
#define MFMA32(a, b, c) __builtin_amdgcn_mfma_f32_32x32x16_bf16((a), (b), (c), 0, 0, 0)
constexpr int MB_KT = 17408, MB_BUF = 34816;

__device__ __forceinline__ void moba_stage_load(const bf16* Kb, const bf16* Vb, int kpos0, int tid, v4u (&kr)[2], v4u (&vr)[2]) {
    const v4u* kp = (const v4u*)(Kb + (size_t)(kpos0 + (tid >> 3)) * 128 + (tid & 7) * 16); kr[0] = kp[0]; kr[1] = kp[1];
    const v4u* vp = (const v4u*)(Vb + (size_t)(tid >> 2) * SEQ + kpos0 + (tid & 3) * 16); vr[0] = vp[0]; vr[1] = vp[1];
}
__device__ __forceinline__ void moba_stage_store(LAS unsigned char* buf, int tid, const v4u (&kr)[2], const v4u (&vr)[2]) {
    LAS unsigned char* kd = buf + (tid >> 3) * 272 + (tid & 7) * 32; *(LAS v4u*)kd = kr[0]; *(LAS v4u*)(kd + 16) = kr[1];
    LAS unsigned char* vd = buf + MB_KT + (tid >> 2) * 136 + (tid & 3) * 32;
    *(LAS v2u*)vd = (v2u){vr[0].x, vr[0].y}; *(LAS v2u*)(vd + 8) = (v2u){vr[0].z, vr[0].w}; *(LAS v2u*)(vd + 16) = (v2u){vr[1].x, vr[1].y}; *(LAS v2u*)(vd + 24) = (v2u){vr[1].z, vr[1].w};
}
__device__ __forceinline__ void moba_unit(Frame& F, int bh, int j) {
    const int w = F.wave, lane = F.lane, r = lane & 31, h = lane >> 5, tid = F.tid;
    LAS unsigned char* L = F.lds;
    const bf16* Qb = F.MQ() + ((size_t)bh * SEQ + j * 256 + 32 * w) * 128;
    const bf16* Kb = F.MK() + (size_t)bh * SEQ * 128;
    const bf16* Vb = F.MV() + (size_t)bh * 128 * SEQ;
    bf16x8 qf[8];
#pragma unroll
    for (int ks = 0; ks < 8; ++ks) qf[ks] = *(const bf16x8*)(Qb + r * 128 + 16 * ks + 8 * h);
    unsigned selmask = 0u;
    if (j > 0) {
        f32x16 g;
#pragma unroll
        for (int i = 0; i < 16; ++i) g[i] = 0.f;
        const bf16* kmh = F.KMH() + ((size_t)bh * 16 + (r & 15)) * 128 + 8 * h; const bf16* kml = F.KML() + ((size_t)bh * 16 + (r & 15)) * 128 + 8 * h;
        bf16x8 ah[8], al[8];
#pragma unroll
        for (int ks = 0; ks < 8; ++ks) { ah[ks] = *(const bf16x8*)(kmh + 16 * ks); al[ks] = *(const bf16x8*)(kml + 16 * ks); }
#pragma unroll
        for (int ks = 0; ks < 8; ++ks) { g = MFMA32(ah[ks], qf[ks], g); g = MFMA32(al[ks], qf[ks], g); }
        unsigned key[16];
#pragma unroll
        for (int i = 0; i < 8; ++i) { const int base = (i & 3) + 8 * (i >> 2); const int n0 = base + 4 * h, n1 = base + 4 * (1 - h);
            auto rr = __builtin_amdgcn_permlane32_swap(__float_as_uint(g[i]), __float_as_uint(g[i]), false, false);
            const unsigned u0 = __float_as_uint(g[i]), u1 = h ? rr[0] : rr[1];
            const unsigned s0 = u0 ^ ((u0 >> 31) ? 0xffffffffu : 0x80000000u), s1 = u1 ^ ((u1 >> 31) ? 0xffffffffu : 0x80000000u);
            key[i] = n0 < j ? ((s0 & ~15u) | (unsigned)(15 - n0)) : 0u; key[8 + i] = n1 < j ? ((s1 & ~15u) | (unsigned)(15 - n1)) : 0u; }
#pragma unroll
        for (int rd = 0; rd < 3; ++rd) { unsigned best = key[0];
#pragma unroll
            for (int i = 1; i < 16; ++i) best = best > key[i] ? best : key[i];
            if (best != 0u) selmask |= 1u << (15u - (best & 15u));
#pragma unroll
            for (int i = 0; i < 16; ++i) key[i] = (key[i] == best) ? 0u : key[i]; }
    }
    f32x16 o[4];
#pragma unroll
    for (int b4 = 0; b4 < 4; ++b4)
#pragma unroll
        for (int i = 0; i < 16; ++i) o[b4][i] = 0.f;
    float m_run = -INFINITY, l_run = 0.f;
    const int nT = 4 * (j + 1), qpos = 32 * w + r;
    constexpr float C = 0.08838834764831845f * 1.4426950408889634f;
    v4u kr[2], vr[2];
    __syncthreads();
    moba_stage_load(Kb, Vb, j * 256, tid, kr, vr); moba_stage_store(L, tid, kr, vr);
    __syncthreads();
    for (int tt = 0; tt < nT; ++tt) {
        const bool own = tt < 4; const int blk = own ? j : ((tt - 4) >> 2), sub64 = own ? tt : ((tt - 4) & 3);
        if (tt + 1 < nT) { const int t1 = tt + 1; const int kp1 = (t1 < 4) ? j * 256 + 64 * t1 : ((t1 - 4) >> 2) * 256 + 64 * ((t1 - 4) & 3); moba_stage_load(Kb, Vb, kp1, tid, kr, vr); }
        {
        LAS unsigned char* Kt = L + (tt & 1) * MB_BUF; LAS unsigned char* Vt = Kt + MB_KT;
        const bool lane_sel = own ? true : (((selmask >> blk) & 1u) != 0u);
        const bool skip = own ? (64 * sub64 > 32 * w + 31) : (__ballot(lane_sel) == 0ull);
        if (!skip) {
            f32x16 x0, x1;
#pragma unroll
            for (int i = 0; i < 16; ++i) { x0[i] = 0.f; x1[i] = 0.f; }
#define MB_LDK(dst, g) do { dst[0] = *(const LAS bf16x8*)(Kt + r * 272 + 64 * (g) + 16 * h); dst[1] = *(const LAS bf16x8*)(Kt + (32 + r) * 272 + 64 * (g) + 16 * h); \
                            dst[2] = *(const LAS bf16x8*)(Kt + r * 272 + 64 * (g) + 32 + 16 * h); dst[3] = *(const LAS bf16x8*)(Kt + (32 + r) * 272 + 64 * (g) + 32 + 16 * h); } while (0)
#define MB_QK(src, g) do { x0 = MFMA32(src[0], qf[2 * (g)], x0); x1 = MFMA32(src[1], qf[2 * (g)], x1); x0 = MFMA32(src[2], qf[2 * (g) + 1], x0); x1 = MFMA32(src[3], qf[2 * (g) + 1], x1); } while (0)
            { bf16x8 fa[4], fb[4];
              MB_LDK(fa, 0); MB_LDK(fb, 1); __builtin_amdgcn_sched_barrier(0);
              MB_QK(fa, 0); MB_LDK(fa, 2); __builtin_amdgcn_sched_barrier(0);
              MB_QK(fb, 1); MB_LDK(fb, 3); __builtin_amdgcn_sched_barrier(0);
              MB_QK(fa, 2); __builtin_amdgcn_sched_barrier(0);
              MB_QK(fb, 3); }
#undef MB_LDK
#undef MB_QK
            if (own && (64 * sub64 + 63 > 32 * w)) {
#pragma unroll
                for (int i = 0; i < 16; ++i) { const int key0 = 64 * sub64 + (i & 3) + 8 * (i >> 2) + 4 * h;
                    x0[i] = (key0 <= qpos) ? x0[i] : -INFINITY; x1[i] = (key0 + 32 <= qpos) ? x1[i] : -INFINITY; }
            }
            float mx = fmaxf(x0[0], x1[0]);
#pragma unroll
            for (int i = 1; i < 16; ++i) mx = fmaxf(fmaxf(mx, x0[i]), x1[i]);
            mx = xhalf_max(mx);
            mx = lane_sel ? mx : -INFINITY;
            const float m_new = fmaxf(m_run, mx);
            if (__any(m_new != m_run)) {
                const float alpha = __builtin_amdgcn_exp2f((m_run - m_new) * C);
                l_run *= alpha;
#pragma unroll
                for (int b4 = 0; b4 < 4; ++b4)
#pragma unroll
                    for (int i = 0; i < 16; ++i) o[b4][i] *= alpha;
                m_run = m_new;
            }
            const float mC = -m_run * C;
            float rs = 0.f;
#pragma unroll
            for (int i = 0; i < 16; ++i) { x0[i] = __builtin_amdgcn_exp2f(fmaf(x0[i], C, mC)); x1[i] = __builtin_amdgcn_exp2f(fmaf(x1[i], C, mC)); rs += x0[i] + x1[i]; }
            rs = xhalf_sum(rs);
            l_run += lane_sel ? rs : 0.f;
            const unsigned pmask = lane_sel ? 0xffffffffu : 0u;
            bf16x8 pb[4];
#pragma unroll
            for (int st = 0; st < 4; ++st) { v4u pw; const int s8 = 8 * (st & 1);
                if (st < 2) { pw.x = cvtpk(x0[s8], x0[s8 + 1]); pw.y = cvtpk(x0[s8 + 2], x0[s8 + 3]); pw.z = cvtpk(x0[s8 + 4], x0[s8 + 5]); pw.w = cvtpk(x0[s8 + 6], x0[s8 + 7]); }
                else { pw.x = cvtpk(x1[s8], x1[s8 + 1]); pw.y = cvtpk(x1[s8 + 2], x1[s8 + 3]); pw.z = cvtpk(x1[s8 + 4], x1[s8 + 5]); pw.w = cvtpk(x1[s8 + 6], x1[s8 + 7]); }
                pw.x &= pmask; pw.y &= pmask; pw.z &= pmask; pw.w &= pmask; pb[st] = __builtin_bit_cast(bf16x8, pw); }
#define MB_LDV(dst, st) do { _Pragma("unroll") for (int b4 = 0; b4 < 4; ++b4) { const LAS unsigned char* vp = Vt + (32 * b4 + r) * 136 + (16 * (st) + 4 * h) * 2; \
                const v2u lo = *(const LAS v2u*)vp, hi = *(const LAS v2u*)(vp + 16); dst[b4] = __builtin_bit_cast(bf16x8, (v4u){lo.x, lo.y, hi.x, hi.y}); } } while (0)
#define MB_PV(src, st) do { _Pragma("unroll") for (int b4 = 0; b4 < 4; ++b4) o[b4] = MFMA32(src[b4], pb[st], o[b4]); } while (0)
            { bf16x8 va[4], vb[4];
              MB_LDV(va, 0); MB_LDV(vb, 1); __builtin_amdgcn_sched_barrier(0);
              MB_PV(va, 0); MB_LDV(va, 2); __builtin_amdgcn_sched_barrier(0);
              MB_PV(vb, 1); MB_LDV(vb, 3); __builtin_amdgcn_sched_barrier(0);
              MB_PV(va, 2); __builtin_amdgcn_sched_barrier(0);
              MB_PV(vb, 3); }
#undef MB_LDV
#undef MB_PV
        }
        }
        if (tt + 1 < nT) moba_stage_store(L + ((tt + 1) & 1) * MB_BUF, tid, kr, vr);
        __syncthreads();
    }
    const float inv = 16.0f / l_run; const int b = bh >> 4, hh = bh & 15;
    unsigned char* orow = (unsigned char*)F.OM() + (size_t)(b * SEQ + j * 256 + 32 * w + r) * 2048 + hh * 128;
#pragma unroll
    for (int b4 = 0; b4 < 4; ++b4)
#pragma unroll
        for (int gq = 0; gq < 4; ++gq) *(unsigned*)(orow + 32 * b4 + 8 * gq + 4 * h) = pk4_fp8(o[b4][4 * gq] * inv, o[b4][4 * gq + 1] * inv, o[b4][4 * gq + 2] * inv, o[b4][4 * gq + 3] * inv);
}
__device__ __forceinline__ void moba_phase(Frame& F) {
    for (int p = blockIdx.x; p < BATCH * 16 * 8; p += F.G) { const int bh = p >> 3, jj = p & 7; moba_unit(F, bh, 15 - jj); moba_unit(F, bh, jj); }
}
__device__ __forceinline__ int crow(int reg, int h) { return (reg & 3) + 8 * (reg >> 2) + 4 * h; }
__device__ __forceinline__ float rdlane(float v, int l) { return __int_as_float(__builtin_amdgcn_readlane(__float_as_int(v), l)); }
template <int TB, int CB> __device__ __forceinline__ float lsel(const f32x16& L00, const f32x16& L10, const f32x16& L11, int reg, int ln) {
    return TB == 0 ? rdlane(L00[reg], ln) : (CB == 0 ? rdlane(L10[reg], ln) : rdlane(L11[reg], ln)); }
__device__ __forceinline__ void sub_step(float& acc, float lv, int ln, float xk) { int tmp;
    asm volatile("s_nop 0\n\tv_readlane_b32 %1, %2, %3\n\ts_nop 1\n\tv_fma_f32 %0, -%1, %4, %0" : "+v"(acc), "=&s"(tmp) : "v"(lv), "s"(ln), "v"(xk)); }
__device__ __forceinline__ void sub_step4(float& a0, float& a1, float& a2, float& a3, float l0, float l1, float l2, float l3, int n0, int n1, int n2, int n3, float x0, float x1, float x2, float x3) {
    int t0, t1, t2, t3;
    asm volatile("s_nop 0\n\tv_readlane_b32 %4, %8, %12\n\tv_readlane_b32 %5, %9, %13\n\tv_readlane_b32 %6, %10, %14\n\tv_readlane_b32 %7, %11, %15\n\t"
                 "v_fma_f32 %0, -%4, %16, %0\n\tv_fma_f32 %1, -%5, %17, %1\n\tv_fma_f32 %2, -%6, %18, %2\n\tv_fma_f32 %3, -%7, %19, %3"
                 : "+v"(a0), "+v"(a1), "+v"(a2), "+v"(a3), "=&s"(t0), "=&s"(t1), "=&s"(t2), "=&s"(t3)
                 : "v"(l0), "v"(l1), "v"(l2), "v"(l3), "s"(n0), "s"(n1), "s"(n2), "s"(n3), "v"(x0), "v"(x1), "v"(x2), "v"(x3));
}
__device__ __forceinline__ v4u pack8(const float (&x)[8]) { v4u p; p.x = cvtpk(x[0], x[1]); p.y = cvtpk(x[2], x[3]); p.z = cvtpk(x[4], x[5]); p.w = cvtpk(x[6], x[7]); return p; }

__device__ __forceinline__ void t_frags(const float (&X)[64], float sv, bf16x8 (&F0)[4], bf16x8 (&F1)[4]) {
#pragma unroll
    for (int ks = 0; ks < 4; ++ks) {
        float lo[8], hi[8];
#pragma unroll
        for (int jj = 0; jj < 8; ++jj) { lo[jj] = X[16 * ks + jj] * rdlane(sv, 16 * ks + jj); hi[jj] = X[16 * ks + 8 + jj] * rdlane(sv, 16 * ks + 8 + jj); }
        const v4u pl = pack8(lo), ph = pack8(hi); v4u f0, f1;
        { auto rr = __builtin_amdgcn_permlane32_swap(pl.x, ph.x, false, false); f0.x = rr[0]; f1.x = rr[1]; }
        { auto rr = __builtin_amdgcn_permlane32_swap(pl.y, ph.y, false, false); f0.y = rr[0]; f1.y = rr[1]; }
        { auto rr = __builtin_amdgcn_permlane32_swap(pl.z, ph.z, false, false); f0.z = rr[0]; f1.z = rr[1]; }
        { auto rr = __builtin_amdgcn_permlane32_swap(pl.w, ph.w, false, false); f0.w = rr[0]; f1.w = rr[1]; }
        F0[ks] = __builtin_bit_cast(bf16x8, f0); F1[ks] = __builtin_bit_cast(bf16x8, f1);
    }
}
__device__ __forceinline__ void gdn_local_task(Frame& F, int task, LAS float* sm) {
    int lane_o = F.lane; asm volatile("" : "+v"(lane_o));
    const int lane = lane_o, r = lane & 31, h = lane >> 5;
    const int c = task & 63, bhv = task >> 6, hv = bhv & 31, b = bhv >> 5, hq = hv >> 1;
    const int t0 = b * SEQ + c * 64; const size_t tq = (size_t)(b * 16 + hq) * 64 + c;
    const float g = F.GG()[(size_t)(t0 + lane) * 32 + hv], bt = F.BETA()[(size_t)(t0 + lane) * 32 + hv];
    float gc = g;
#pragma unroll
    for (int o = 1; o < 64; o <<= 1) { const float t = __int_as_float(__builtin_amdgcn_ds_bpermute(4 * ((lane - o) & 63), __float_as_int(gc))); gc += (lane >= o) ? t : 0.f; }
    sm[lane] = gc; sm[64 + lane] = bt;
    F.GC()[(size_t)task * 64 + lane] = gc;
    LDS_WAIT();
    bf16x8 kf[2][8];
#pragma unroll
    for (int tb = 0; tb < 2; ++tb)
#pragma unroll
        for (int ks = 0; ks < 8; ++ks) kf[tb][ks] = *(const bf16x8*)(F.KN() + (size_t)(t0 + 32 * tb + r) * 2048 + hq * 128 + 16 * ks + 8 * h);
    f32x16 L00, L10, L11;
#pragma unroll
    for (int i = 0; i < 16; ++i) { L00[i] = 0.f; L10[i] = 0.f; L11[i] = 0.f; }
#pragma unroll
    for (int ks = 0; ks < 8; ++ks) { L00 = MFMA32(kf[0][ks], kf[0][ks], L00); L10 = MFMA32(kf[1][ks], kf[0][ks], L10); L11 = MFMA32(kf[1][ks], kf[1][ks], L11); }
    const float gci0 = sm[r], gci1 = sm[32 + r];
#pragma unroll
    for (int reg = 0; reg < 16; ++reg) { const int kr = crow(reg, h); const float gk0 = sm[kr], bk0 = sm[64 + kr], gk1 = sm[32 + kr], bk1 = sm[96 + kr];
        L00[reg] = (r < kr) ? L00[reg] * bk0 * __expf(gk0 - gci0) : 0.f;
        L10[reg] = L10[reg] * bk1 * __expf(gk1 - gci0);
        L11[reg] = (r < kr) ? L11[reg] * bk1 * __expf(gk1 - gci1) : 0.f; }
    { bf16* at = F.AT() + (size_t)task * 4096; const float sc = 0.08838834764831845f;
      { bf16x8 qf[8];
#pragma unroll
        for (int ks = 0; ks < 8; ++ks) qf[ks] = *(const bf16x8*)(F.QN() + (size_t)(t0 + r) * 2048 + hq * 128 + 16 * ks + 8 * h);
        f32x16 A00;
#pragma unroll
        for (int i = 0; i < 16; ++i) A00[i] = 0.f;
#pragma unroll
        for (int ks = 0; ks < 8; ++ks) A00 = MFMA32(kf[0][ks], qf[ks], A00);
#pragma unroll
        for (int g4 = 0; g4 < 4; ++g4) { float v[4];
#pragma unroll
            for (int t = 0; t < 4; ++t) { const int reg = 4 * g4 + t, jr = crow(reg, h); v[t] = (jr <= r) ? A00[reg] * sc * __expf(gci0 - sm[jr]) : 0.f; }
            *(v2u*)(at + r * 64 + 8 * g4 + 4 * h) = (v2u){cvtpk(v[0], v[1]), cvtpk(v[2], v[3])}; } }
      { bf16x8 qf[8];
#pragma unroll
        for (int ks = 0; ks < 8; ++ks) qf[ks] = *(const bf16x8*)(F.QN() + (size_t)(t0 + 32 + r) * 2048 + hq * 128 + 16 * ks + 8 * h);
        f32x16 A01, A11;
#pragma unroll
        for (int i = 0; i < 16; ++i) { A01[i] = 0.f; A11[i] = 0.f; }
#pragma unroll
        for (int ks = 0; ks < 8; ++ks) { A01 = MFMA32(kf[0][ks], qf[ks], A01); A11 = MFMA32(kf[1][ks], qf[ks], A11); }
#pragma unroll
        for (int g4 = 0; g4 < 4; ++g4) { float v[4], u[4];
#pragma unroll
            for (int t = 0; t < 4; ++t) { const int reg = 4 * g4 + t, jr = crow(reg, h); v[t] = A01[reg] * sc * __expf(gci1 - sm[jr]); u[t] = (jr <= r) ? A11[reg] * sc * __expf(gci1 - sm[32 + jr]) : 0.f; }
            *(v2u*)(at + (32 + r) * 64 + 8 * g4 + 4 * h) = (v2u){cvtpk(v[0], v[1]), cvtpk(v[2], v[3])};
            *(v2u*)(at + (32 + r) * 64 + 32 + 8 * g4 + 4 * h) = (v2u){cvtpk(u[0], u[1]), cvtpk(u[2], u[3])}; } } }
    asm volatile("" ::: "memory"); __builtin_amdgcn_sched_barrier(0);
    bf16x8 vfr[2][4];
    { const bf16* vt = F.VP() + (size_t)task * 8192;
#pragma unroll
      for (int db = 0; db < 2; ++db)
#pragma unroll
          for (int ks = 0; ks < 4; ++ks) vfr[db][ks] = *(const bf16x8*)(vt + (32 * db + r) * 64 + 16 * ks + 8 * h); }
    float X[64];
    asm volatile("s_nop 7" ::: "memory");
#define GL_LV(k, i) (((k) < 32) ? L00[(((k) & 31) & 3) + 4 * (((k) & 31) >> 3)] : (((i) < 32) ? L10[(((k) & 31) & 3) + 4 * (((k) & 31) >> 3)] : L11[(((k) & 31) & 3) + 4 * (((k) & 31) >> 3)]))
#define GL_LN(k, i) (((i) & 31) + 32 * ((((k) & 31) >> 2) & 1))
#pragma unroll
    for (int i = 63; i >= 0; --i) {
        float a0 = (lane == i) ? 1.f : 0.f, a1 = 0.f, a2 = 0.f, a3 = 0.f;
        const int n4 = (63 - i) >> 2;
#pragma unroll
        for (int g = 0; g < n4; ++g) { const int k = i + 1 + 4 * g;
            sub_step4(a0, a1, a2, a3, GL_LV(k, i), GL_LV(k + 1, i), GL_LV(k + 2, i), GL_LV(k + 3, i), GL_LN(k, i), GL_LN(k + 1, i), GL_LN(k + 2, i), GL_LN(k + 3, i), X[k], X[k + 1], X[k + 2], X[k + 3]); }
#pragma unroll
        for (int k = i + 1 + 4 * n4; k < 64; ++k) sub_step(a0, GL_LV(k, i), GL_LN(k, i), X[k]);
        X[i] = (a0 + a1) + (a2 + a3);
    }
#undef GL_LV
#undef GL_LN
    asm volatile("" ::: "memory"); __builtin_amdgcn_sched_barrier(0);
    bf16x8 F0[4], F1[4];
    t_frags(X, bt, F0, F1);
    { bf16* ub = F.U() + (size_t)task * 8192;
#pragma unroll
      for (int db = 0; db < 4; ++db) { f32x16 u0, u1;
#pragma unroll
          for (int i = 0; i < 16; ++i) { u0[i] = 0.f; u1[i] = 0.f; }
#pragma unroll
          for (int ks = 0; ks < 4; ++ks) { const bf16x8 vf = db < 2 ? vfr[db & 1][ks] : *(const bf16x8*)(F.VP() + (size_t)task * 8192 + (32 * db + r) * 64 + 16 * ks + 8 * h); if (ks < 2) u0 = MFMA32(F0[ks], vf, u0); u1 = MFMA32(F1[ks], vf, u1); }
          v4u* d0 = (v4u*)(ub + ((0 * 4 + db) * 64 + lane) * 16); v4u* d1 = (v4u*)(ub + ((1 * 4 + db) * 64 + lane) * 16);
          { float a[8], bb[8];
#pragma unroll
            for (int i = 0; i < 8; ++i) { a[i] = u0[i]; bb[i] = u0[8 + i]; }
            d0[0] = pack8(a); d0[1] = pack8(bb);
#pragma unroll
            for (int i = 0; i < 8; ++i) { a[i] = u1[i]; bb[i] = u1[8 + i]; }
            d1[0] = pack8(a); d1[1] = pack8(bb); } } }
    asm volatile("" ::: "memory"); __builtin_amdgcn_sched_barrier(0);
    t_frags(X, bt * __expf(gc), F0, F1);
    { const bf16* kt = F.KNT() + tq * 8192; bf16* wb = F.W() + (size_t)task * 8192;
#pragma unroll
      for (int a = 0; a < 4; ++a) { f32x16 w0, w1;
#pragma unroll
          for (int i = 0; i < 16; ++i) { w0[i] = 0.f; w1[i] = 0.f; }
#pragma unroll
          for (int ks = 0; ks < 4; ++ks) { const bf16x8 ktf = *(const bf16x8*)(kt + (32 * a + r) * 64 + 16 * ks + 8 * h); if (ks < 2) w0 = MFMA32(ktf, F0[ks], w0); w1 = MFMA32(ktf, F1[ks], w1); }
#pragma unroll
          for (int g4 = 0; g4 < 4; ++g4) {
              *(v2u*)(wb + r * 128 + 32 * a + 8 * g4 + 4 * h) = (v2u){cvtpk(w0[4 * g4], w0[4 * g4 + 1]), cvtpk(w0[4 * g4 + 2], w0[4 * g4 + 3])};
              *(v2u*)(wb + (32 + r) * 128 + 32 * a + 8 * g4 + 4 * h) = (v2u){cvtpk(w1[4 * g4], w1[4 * g4 + 1]), cvtpk(w1[4 * g4 + 2], w1[4 * g4 + 3])}; } } }
    LDS_WAIT();
}
__device__ __forceinline__ void gdn_local_phase(Frame& F) {
    LAS float* sm = (LAS float*)(F.lds + F.wave * 512);
    const int gw = F.vcu * NWAVES + F.wave, NGW = F.G * NWAVES;
    for (int task = gw; task < BATCH * 32 * 64; task += NGW) gdn_local_task(F, task, sm);
}

constexpr int SC_W = 0, SC_Q = 16896, SC_A = 33792, SC_KT = 42496, SC_E1 = 59904, SC_E2 = 60160, SC_BUF = 60416, SC_OT = 2 * SC_BUF, SC_OTB = 16896;
static_assert(SC_OT + 2 * SC_OTB <= MISC_OFF, "scan LDS map");
__device__ __forceinline__ bf16x8 frag8(const LAS unsigned char* p) { const v2u lo = *(const LAS v2u*)p, hi = *(const LAS v2u*)(p + 16); return __builtin_bit_cast(bf16x8, (v4u){lo.x, lo.y, hi.x, hi.y}); }
__device__ __forceinline__ void st16(LAS unsigned char* p, v4u v) { *(LAS v2u*)p = (v2u){v.x, v.y}; *(LAS v2u*)(p + 8) = (v2u){v.z, v.w}; }
struct ScanRegs { v4u rw[4], rq[4], ra[2], rk[4]; float gcv, glv; };
__device__ __forceinline__ void scan_issue(Frame& F, int lt, size_t task, size_t tq, int t0, int hq, ScanRegs& R) {
#pragma unroll
    for (int i = 0; i < 4; ++i) { const int idx = lt + 256 * i, row = idx >> 4, ch = idx & 15;
        R.rw[i] = *(const v4u*)(F.W() + task * 8192 + row * 128 + ch * 8); R.rq[i] = *(const v4u*)(F.QN() + (size_t)(t0 + row) * 2048 + hq * 128 + ch * 8); }
#pragma unroll
    for (int i = 0; i < 2; ++i) { const int idx = lt + 256 * i, row = idx >> 3, ch = idx & 7; R.ra[i] = *(const v4u*)(F.AT() + task * 4096 + row * 64 + ch * 8); }
#pragma unroll
    for (int i = 0; i < 4; ++i) { const int idx = lt + 256 * i, row = idx >> 3, ch = idx & 7; R.rk[i] = *(const v4u*)(F.KNT() + tq * 8192 + row * 64 + ch * 8); }
    R.gcv = 0.f; R.glv = 0.f;
    if (lt < 64) { R.gcv = F.GC()[task * 64 + lt]; R.glv = F.GC()[task * 64 + 63]; }
}
__device__ __forceinline__ void scan_store(int lt, const ScanRegs& R, LAS unsigned char* buf) {
#pragma unroll
    for (int i = 0; i < 4; ++i) { const int idx = lt + 256 * i, row = idx >> 4, ch = idx & 15; st16(buf + SC_W + row * 264 + ch * 16, R.rw[i]); st16(buf + SC_Q + row * 264 + ch * 16, R.rq[i]); }
#pragma unroll
    for (int i = 0; i < 2; ++i) { const int idx = lt + 256 * i, row = idx >> 3, ch = idx & 7; st16(buf + SC_A + row * 136 + ch * 16, R.ra[i]); }
#pragma unroll
    for (int i = 0; i < 4; ++i) { const int idx = lt + 256 * i, row = idx >> 3, ch = idx & 7; st16(buf + SC_KT + row * 136 + ch * 16, R.rk[i]); }
    if (lt < 64) { ((LAS float*)(buf + SC_E1))[lt] = __expf(R.gcv) * 0.08838834764831845f; ((LAS float*)(buf + SC_E2))[lt] = __expf(R.glv - R.gcv); }
}
__device__ __forceinline__ void scan_finalize(Frame& F, LAS unsigned char* L, int c, int t0, int lw, int lane, int hv, f32x2 gn, const unsigned (&zw)[16]) {
    const LAS unsigned char* ot = L + SC_OT + (c & 1) * SC_OTB;
#pragma unroll
    for (int hb = 0; hb < 2; ++hb) {
        float o0[8], o1[8], ss[8];
#pragma unroll
        for (int i = 0; i < 8; ++i) { const unsigned ow = *(const LAS unsigned*)(ot + (16 * lw + 8 * hb + i) * 264 + 4 * lane); o0[i] = blo(ow); o1[i] = bhi(ow); ss[i] = o0[i] * o0[i] + o1[i] * o1[i]; }
#pragma unroll
        for (int i = 0; i < 8; ++i) ss[i] = wave_sum(ss[i]);
#pragma unroll
        for (int i = 0; i < 8; ++i) { const float rr = __builtin_amdgcn_rsqf(ss[i] * (1.0f / 128) + NORM_EPS); const float z0 = blo(zw[8 * hb + i]), z1 = bhi(zw[8 * hb + i]);
            const float y0 = o0[i] * rr * gn.x * (z0 * __builtin_amdgcn_rcpf(1.0f + __expf(-z0))), y1 = o1[i] * rr * gn.y * (z1 * __builtin_amdgcn_rcpf(1.0f + __expf(-z1)));
            *(unsigned*)(F.OG() + (size_t)(t0 + 16 * lw + 8 * hb + i) * 4096 + hv * 128 + 2 * lane) = pk2(y0, y1); }
    }
}
__device__ __forceinline__ void gdn_scan_seq(Frame& F, int seq) {
    int tid_o = F.tid; asm volatile("" : "+v"(tid_o));
    const int tid = tid_o, w = __builtin_amdgcn_readfirstlane(tid >> 6), lane = tid & 63, r = lane & 31, h = lane >> 5;
    const int b = seq >> 5, hv = seq & 31, hq = hv >> 1;
    LAS unsigned char* L = F.lds;
    const size_t task0 = (size_t)seq * 64, tq0 = (size_t)(b * 16 + hq) * 64;
    __syncthreads();
    if (w >= 4) {
        const int lt = tid - 256, lw = w - 4;
        const float* onorm = F.in[10]; const f32x2 gn = *(const f32x2*)(onorm + 2 * lane);
        ScanRegs R0, R1;
        scan_issue(F, lt, task0, tq0, b * SEQ, hq, R0); scan_issue(F, lt, task0 + 1, tq0 + 1, b * SEQ + 64, hq, R1);
        scan_store(lt, R0, L);
        __syncthreads();
#define SCAN_LOADER_STEP(c, RA, RB) do { \
            const int t0 = b * SEQ + (c) * 64; \
            unsigned zw[16]; \
            _Pragma("unroll") for (int i = 0; i < 16; ++i) zw[i] = *(const unsigned*)(F.PB() + (size_t)(t0 + 16 * lw + i) * PB_LD + PB_GZ + hv * 128 + 2 * lane); \
            if ((c) + 2 < 64) scan_issue(F, lt, task0 + (c) + 2, tq0 + (c) + 2, b * SEQ + ((c) + 2) * 64, hq, RA); \
            if ((c) + 1 < 64) scan_store(lt, RB, L + (((c) + 1) & 1) * SC_BUF); \
            __syncthreads(); \
            scan_finalize(F, L, (c), t0, lw, lane, hv, gn, zw); } while (0)
        for (int c = 0; c < 64; c += 2) {
            SCAN_LOADER_STEP(c, R0, R1);
            SCAN_LOADER_STEP(c + 1, R1, R0);
        }
#undef SCAN_LOADER_STEP
    } else {
        f32x16 Sx[4];
#pragma unroll
        for (int a = 0; a < 4; ++a)
#pragma unroll
            for (int i = 0; i < 16; ++i) Sx[a][i] = 0.f;
        v4u ur[4];
        { const v4u* up = (const v4u*)(F.U() + task0 * 8192 + ((0 * 4 + w) * 64 + lane) * 16); ur[0] = up[0]; ur[1] = up[1];
          const v4u* up1 = (const v4u*)(F.U() + task0 * 8192 + ((1 * 4 + w) * 64 + lane) * 16); ur[2] = up1[0]; ur[3] = up1[1]; }
        __syncthreads();
        for (int c = 0; c < 64; ++c) {
            const LAS unsigned char* buf = L + (c & 1) * SC_BUF; const LAS float* e1 = (const LAS float*)(buf + SC_E1); const LAS float* e2 = (const LAS float*)(buf + SC_E2);
            bf16x8 Sb[4][2];
#pragma unroll
            for (int a = 0; a < 4; ++a)
#pragma unroll
                for (int s = 0; s < 2; ++s) { float t[8];
#pragma unroll
                    for (int jj = 0; jj < 8; ++jj) t[jj] = Sx[a][8 * s + jj];
                    Sb[a][s] = __builtin_bit_cast(bf16x8, pack8(t)); }
            f32x16 vn[2];
#define SC_LD4(dst, off, gi) do { _Pragma("unroll") for (int q_ = 0; q_ < 4; ++q_) dst[q_] = frag8(buf + (off) + (32 * ((gi) >> 1) + r) * 264 + (32 * (2 * ((gi) & 1) + (q_ >> 1)) + 16 * (q_ & 1) + 4 * h) * 2); } while (0)
#define SC_MM4(acc, src, gi) do { _Pragma("unroll") for (int q_ = 0; q_ < 4; ++q_) acc = MFMA32(src[q_], Sb[2 * ((gi) & 1) + (q_ >> 1)][q_ & 1], acc); } while (0)
            { f32x16 y0, y1;
#pragma unroll
              for (int i = 0; i < 16; ++i) { y0[i] = 0.f; y1[i] = 0.f; }
              bf16x8 fa[4], fb[4];
              SC_LD4(fa, SC_W, 0); SC_LD4(fb, SC_W, 1); __builtin_amdgcn_sched_barrier(0);
              SC_MM4(y0, fa, 0); SC_LD4(fa, SC_W, 2); __builtin_amdgcn_sched_barrier(0);
              SC_MM4(y0, fb, 1); SC_LD4(fb, SC_W, 3); __builtin_amdgcn_sched_barrier(0);
              SC_MM4(y1, fa, 2); __builtin_amdgcn_sched_barrier(0);
              SC_MM4(y1, fb, 3);
#pragma unroll
              for (int tb = 0; tb < 2; ++tb) { const v4u ua = ur[2 * tb], ub = ur[2 * tb + 1]; const f32x16& y = tb ? y1 : y0;
                vn[tb][0] = blo(ua.x) - y[0]; vn[tb][1] = bhi(ua.x) - y[1]; vn[tb][2] = blo(ua.y) - y[2]; vn[tb][3] = bhi(ua.y) - y[3];
                vn[tb][4] = blo(ua.z) - y[4]; vn[tb][5] = bhi(ua.z) - y[5]; vn[tb][6] = blo(ua.w) - y[6]; vn[tb][7] = bhi(ua.w) - y[7];
                vn[tb][8] = blo(ub.x) - y[8]; vn[tb][9] = bhi(ub.x) - y[9]; vn[tb][10] = blo(ub.y) - y[10]; vn[tb][11] = bhi(ub.y) - y[11];
                vn[tb][12] = blo(ub.z) - y[12]; vn[tb][13] = bhi(ub.z) - y[13]; vn[tb][14] = blo(ub.w) - y[14]; vn[tb][15] = bhi(ub.w) - y[15]; } }
            if (c + 1 < 64) { const v4u* up = (const v4u*)(F.U() + (task0 + c + 1) * 8192 + ((0 * 4 + w) * 64 + lane) * 16); ur[0] = up[0]; ur[1] = up[1];
                const v4u* up1 = (const v4u*)(F.U() + (task0 + c + 1) * 8192 + ((1 * 4 + w) * 64 + lane) * 16); ur[2] = up1[0]; ur[3] = up1[1]; }
            bf16x8 Vb[2][2], Vb2[2][2];
#pragma unroll
            for (int tb = 0; tb < 2; ++tb)
#pragma unroll
                for (int s = 0; s < 2; ++s) { float t[8], t2[8];
                    const f32x4 ea = *(const LAS f32x4*)(e2 + 32 * tb + 16 * s + 4 * h), eb = *(const LAS f32x4*)(e2 + 32 * tb + 16 * s + 8 + 4 * h);
#pragma unroll
                    for (int jj = 0; jj < 4; ++jj) { t[jj] = vn[tb][8 * s + jj]; t[4 + jj] = vn[tb][8 * s + 4 + jj]; t2[jj] = t[jj] * ea[jj]; t2[4 + jj] = t[4 + jj] * eb[jj]; }
                    Vb[tb][s] = __builtin_bit_cast(bf16x8, pack8(t)); Vb2[tb][s] = __builtin_bit_cast(bf16x8, pack8(t2)); }
            LAS unsigned char* ot = L + SC_OT + (c & 1) * SC_OTB;
            { f32x16 y0, y1;
#pragma unroll
              for (int i = 0; i < 16; ++i) { y0[i] = 0.f; y1[i] = 0.f; }
              bf16x8 fa[4], fb[4], at[6];
              SC_LD4(fa, SC_Q, 0); SC_LD4(fb, SC_Q, 1); __builtin_amdgcn_sched_barrier(0);
              SC_MM4(y0, fa, 0); SC_LD4(fa, SC_Q, 2); __builtin_amdgcn_sched_barrier(0);
              SC_MM4(y0, fb, 1); SC_LD4(fb, SC_Q, 3); __builtin_amdgcn_sched_barrier(0);
              SC_MM4(y1, fa, 2);
#pragma unroll
              for (int s2 = 0; s2 < 2; ++s2) { at[s2] = frag8(buf + SC_A + r * 136 + (16 * s2 + 4 * h) * 2); at[2 + s2] = frag8(buf + SC_A + (32 + r) * 136 + (16 * s2 + 4 * h) * 2); at[4 + s2] = frag8(buf + SC_A + (32 + r) * 136 + (32 + 16 * s2 + 4 * h) * 2); }
              __builtin_amdgcn_sched_barrier(0);
              SC_MM4(y1, fb, 3);
#pragma unroll
              for (int g4 = 0; g4 < 4; ++g4) { const f32x4 ea = *(const LAS f32x4*)(e1 + 8 * g4 + 4 * h), eb = *(const LAS f32x4*)(e1 + 32 + 8 * g4 + 4 * h);
#pragma unroll
                  for (int t = 0; t < 4; ++t) { y0[4 * g4 + t] *= ea[t]; y1[4 * g4 + t] *= eb[t]; } }
              y0 = MFMA32(at[0], Vb[0][0], y0); y0 = MFMA32(at[1], Vb[0][1], y0);
              y1 = MFMA32(at[2], Vb[0][0], y1); y1 = MFMA32(at[3], Vb[0][1], y1); y1 = MFMA32(at[4], Vb[1][0], y1); y1 = MFMA32(at[5], Vb[1][1], y1);
#pragma unroll
              for (int reg = 0; reg < 16; reg += 2) { const unsigned p0 = cvtpk(y0[reg], y0[reg + 1]), p1 = cvtpk(y1[reg], y1[reg + 1]);
                  *(LAS unsigned short*)(ot + crow(reg, h) * 264 + (32 * w + r) * 2) = (unsigned short)(p0 & 0xffffu); *(LAS unsigned short*)(ot + crow(reg + 1, h) * 264 + (32 * w + r) * 2) = (unsigned short)(p0 >> 16);
                  *(LAS unsigned short*)(ot + (32 + crow(reg, h)) * 264 + (32 * w + r) * 2) = (unsigned short)(p1 & 0xffffu); *(LAS unsigned short*)(ot + (32 + crow(reg + 1, h)) * 264 + (32 * w + r) * 2) = (unsigned short)(p1 >> 16); } }
            { const float eg0 = e1[63] * 11.313708498984761f;
#define SC_LDK(dst, a) do { _Pragma("unroll") for (int q_ = 0; q_ < 4; ++q_) dst[q_] = frag8(buf + SC_KT + (32 * (a) + r) * 136 + (32 * (q_ >> 1) + 16 * (q_ & 1) + 4 * h) * 2); } while (0)
#define SC_MMK(a, src) do { _Pragma("unroll") for (int q_ = 0; q_ < 4; ++q_) Sx[a] = MFMA32(src[q_], Vb2[q_ >> 1][q_ & 1], Sx[a]); } while (0)
              bf16x8 fa[4], fb[4];
              SC_LDK(fa, 0); SC_LDK(fb, 1);
#pragma unroll
              for (int a = 0; a < 4; ++a)
#pragma unroll
                  for (int i = 0; i < 16; ++i) Sx[a][i] *= eg0;
              __builtin_amdgcn_sched_barrier(0);
              SC_MMK(0, fa); SC_LDK(fa, 2); __builtin_amdgcn_sched_barrier(0);
              SC_MMK(1, fb); SC_LDK(fb, 3); __builtin_amdgcn_sched_barrier(0);
              SC_MMK(2, fa); __builtin_amdgcn_sched_barrier(0);
              SC_MMK(3, fb); }
#undef SC_LDK
#undef SC_MMK
#undef SC_LD4
#undef SC_MM4
            __syncthreads();
        }
    }
}
__device__ __forceinline__ void moba_queue(Frame& F) {
    const unsigned x0 = xb_xcc_id() & 7u;
    for (unsigned k = 0; k < 8u;) {
        const unsigned x = (x0 + k) & 7u;
        __syncthreads();
        if (F.tid == 0) F.MISC[0] = __hip_atomic_fetch_add(F.ctl + CW_Q + 64 * x, 1u, __ATOMIC_RELAXED, __HIP_MEMORY_SCOPE_AGENT);
        __syncthreads();
        const unsigned q = F.MISC[0];
        if (q >= 64u) { ++k; continue; }
        const int bh = (int)((q >> 3) * 8u + x), jj = (int)(q & 7u); moba_unit(F, bh, 15 - jj); moba_unit(F, bh, jj);
    }
}
struct Args { const float* in[20]; float* out; unsigned char* ws; int ph_lo, ph_hi, li, pad; };
__global__ void __launch_bounds__(NWAVES * 64, 2) fwd(Args args) {
    extern __shared__ __attribute__((aligned(16))) unsigned char lds[];
    Frame F;
    F.lds = (LAS unsigned char*)lds;
    F.MISC = (volatile LAS unsigned*)(F.lds + MISC_OFF);
    F.tid = threadIdx.x; F.lane = F.tid & 63; F.wave = __builtin_amdgcn_readfirstlane(F.tid >> 6);
    F.G = gridDim.x; { const int bx = blockIdx.x; F.vcu = (F.G % 8 == 0) ? (bx % 8) * (F.G / 8) + bx / 8 : bx; }
    unsigned char* ws = args.ws;
    F.ctl = (unsigned*)(ws + WS_CTL); F.wsb = ws;
#pragma unroll
    for (int i = 0; i < 20; ++i) F.in[i] = args.in[i];
    F.out = args.out;
    for (int u = F.tid; u < (LDS_BYTES - MISC_OFF) / 4; u += NWAVES * 64) ((LAS unsigned*)(F.lds + MISC_OFF))[u] = 0u;
    __syncthreads();
    XcdBarrier bar; bar.bar = (unsigned*)(F.ctl + CW_BAR); bar.x = 0; bar.st = nullptr;
#if MK_SINGLE
    bar = xcd_barrier_post((unsigned*)(F.ctl + CW_BAR), F.MISC + 8);
#define GRID_BAR() xcd_barrier(bar)
#else
#define GRID_BAR() do { } while (0)
#endif
    const int lo = args.ph_lo, hi = args.ph_hi;
#define IN(k) (lo <= (k) && (k) < hi)
#define BOTH(k) (IN(k) && IN((k) + 1))
#ifndef PROBE_REP
#define PROBE_REP -1
#endif
#define REFRESH() do { int t_ = threadIdx.x; asm volatile("" : "+v"(t_)); F.tid = t_; F.lane = t_ & 63; F.wave = __builtin_amdgcn_readfirstlane(t_ >> 6); } while (0)
#define REP(k) _Pragma("unroll") for (int rep_ = 0; rep_ < ((PROBE_REP == (k)) ? 2 : 1); ++rep_)
    typedef pg8::bf16_t pb;
    REP(0) if (IN(0)) { REFRESH(); quant_ffn_gu(F, F.in[2], F.in[3], (float*)F.CM(0)); quant_wd(F, F.in[4], (float*)F.CMD(0)); rope_table(F);
        rms_rows_i8(F, F.in[0], F.in[1], (unsigned char*)F.H(), F.RS()); if (BOTH(0)) GRID_BAR(); }
    REP(1) if (IN(1)) { pg8::Gemm g{(const pb*)F.H(), (const pb*)F.WGU(), M, 2 * FF, DM}; pg8::StaticOrder S; S.init(M, 2 * FF, F.G, (int)blockIdx.x);
        pg8::EpiSwiGLUT<true> E{(pb*)F.ACT(), FF, F.RS(), (const float*)F.CM(0), F.RM(0)}; pg8::gemm_phase<pg8::EpiSwiGLUT<true>, pg8::StaticOrder, true, true, 3>(F.lds, g, S, E); if (BOTH(1)) GRID_BAR(); }
    REP(2) if (IN(2)) { REFRESH(); requant_rows(F, F.ACT(), F.ACT8(), F.RS()); GRID_BAR();
        pg8::Gemm g{(const pb*)F.ACT8(), (const pb*)F.WD(), M, DM, FF}; pg8::StaticOrder S; S.init(M, DM, F.G, (int)blockIdx.x);
        pg8::EpiResid8 E{F.in[0], F.out, DM, 0.5f, nullptr, nullptr, nullptr, F.RS(), (const float*)F.CMD(0)}; pg8::gemm_phase<pg8::EpiResid8, pg8::StaticOrder, true, true, 3>(F.lds, g, S, E); if (BOTH(2)) GRID_BAR(); }
    REP(3) if (IN(3)) { REFRESH(); convert_win(F); rms_rows_i8(F, F.out, F.in[5], F.H8(), F.RS(), F.H()); if (BOTH(3)) GRID_BAR(); }
    REP(4) if (IN(4)) { { pg8::Gemm g{(const pb*)F.H(), (const pb*)F.WB(), M, NPROJ, DM, 0}; pg8::StaticOrder S; S.init(M, NPROJ, F.G, (int)blockIdx.x);
          typedef pg8::EpiProjT<false, 0, PA_LD, 48, (long)((WS_PB - WS_BIG) / 2), PB_LD, 16, 0, PB_LD, 0> EP; EP E{(pb*)F.PA(), F.AB(), nullptr, nullptr}; pg8::gemm_phase<EP, pg8::StaticOrder, true, true>(F.lds, g, S, E); }
        { pg8::Gemm g{(const pb*)F.H8(), (const pb*)F.W8(), M, NGATE, DM, 0}; pg8::StaggerOrder S;
          { const int nb = (M / 256) * (NPROJ / 256), n8 = (M / 256) * (NGATE / 256), G = F.G; int c0 = nb % G, R0 = (n8 - 2 * (G - c0)) / G; if ((G & 7) || (c0 & 7) || R0 < 0) { c0 = 0; R0 = 0; }
            S.init2(M, NGATE, G, (int)blockIdx.x, R0, c0); }
          typedef pg8::EpiProjT<true, PA_MV, PA_LD, 8, (long)((WS_PB - WS_BIG) / 2) + PB_GG, PB_LD, 32, 0, PB_LD, 0> EP8; EP8 E{(pb*)F.PA(), F.AB(), F.RS(), (const float*)F.CMW()};
          pg8::gemm_phase<EP8, pg8::StaggerOrder, true, true, 3>(F.lds, g, S, E); }
        if (BOTH(4)) GRID_BAR(); }
    REP(5) if (IN(5)) { REFRESH(); prep_moba(F); prep_gdn(F); __syncthreads(); convert_branch(F); if (BOTH(5)) GRID_BAR(); }
    REP(6) if (IN(6)) { REFRESH(); gdn_local_phase(F); if (BOTH(6)) GRID_BAR(); }
    REP(7) if (IN(7)) { REFRESH(); for (int seq = blockIdx.x; seq < BATCH * 32; seq += F.G) gdn_scan_seq(F, seq); moba_queue(F); if (BOTH(7)) GRID_BAR(); }
    REP(8) if (IN(8)) { pg8::Gemm g{(const pb*)F.OG(), (const pb*)F.WBG(), M, DM, 4096}; pg8::StaticOrder S; S.init(M, DM, F.G, (int)blockIdx.x);
        pg8::EpiGate<true> E{(pb*)F.H(), DM, (const pb*)F.PB() + PB_GG, PB_LD}; pg8::gemm_phase<pg8::EpiGate<true>, pg8::StaticOrder, true, true>(F.lds, g, S, E); }
    REP(9) if (IN(9)) { pg8::Gemm g{(const pb*)F.OM(), (const pb*)F.WBM(), M, DM, 2048, 0x7b7b7b7b}; pg8::StaticOrder S; S.init(M, DM, F.G, (int)blockIdx.x);
        pg8::EpiGate<false> E{(pb*)F.H(), DM, (const pb*)F.PB() + PB_MG, PB_LD}; pg8::gemm_phase<pg8::EpiGate<false>, pg8::StaticOrder, true, true, true>(F.lds, g, S, E); if (BOTH(9)) GRID_BAR(); }
    REP(10) if (IN(10)) { pg8::Gemm g{(const pb*)F.H(), (const pb*)F.WO(), M, DM, DM}; pg8::StaticOrder S; S.init(M, DM, F.G, (int)blockIdx.x);
        pg8::EpiResid E{F.out, F.out, DM, 1.0f, nullptr, nullptr, nullptr, nullptr, nullptr}; pg8::gemm_phase<pg8::EpiResid, pg8::StaticOrder, true, true>(F.lds, g, S, E); if (BOTH(10)) GRID_BAR(); }
    REP(11) if (IN(11)) { REFRESH(); quant_ffn_gu(F, F.in[17], F.in[18], (float*)F.CM(1)); quant_wd(F, F.in[19], (float*)F.CMD(1)); rms_rows_i8(F, F.out, F.in[16], (unsigned char*)F.H(), F.RS()); if (BOTH(11)) GRID_BAR(); }
    REP(12) if (IN(12)) { pg8::Gemm g{(const pb*)F.H(), (const pb*)F.WGU(), M, 2 * FF, DM}; pg8::StaticOrder S; S.init(M, 2 * FF, F.G, (int)blockIdx.x);
        pg8::EpiSwiGLUT<true> E{(pb*)F.ACT(), FF, F.RS(), (const float*)F.CM(1), F.RM(1)}; pg8::gemm_phase<pg8::EpiSwiGLUT<true>, pg8::StaticOrder, true, true, 3>(F.lds, g, S, E); if (BOTH(12)) GRID_BAR(); }
    REP(13) if (IN(13)) { REFRESH(); requant_rows(F, F.ACT(), F.ACT8(), F.RS()); GRID_BAR();
        pg8::Gemm g{(const pb*)F.ACT8(), (const pb*)F.WD(), M, DM, FF}; pg8::StaticOrder S; S.init(M, DM, F.G, (int)blockIdx.x);
        pg8::EpiResid8 E{F.out, F.out, DM, 0.5f, nullptr, nullptr, nullptr, F.RS(), (const float*)F.CMD(1)}; pg8::gemm_phase<pg8::EpiResid8, pg8::StaticOrder, true, true, 3>(F.lds, g, S, E); }
#undef IN
#undef BOTH
}

extern "C" void kernel_launch(void* const* d_in, const int* in_sizes, int n_in, void* d_out, int out_size, void* d_ws, size_t ws_size, hipStream_t stream) {
    static int grid = 0;
    if (grid == 0) {
        if (n_in != 20 || out_size != M * DM || ws_size < WS_END) { fprintf(stderr, "kernel_launch: unexpected shapes (n_in %d out %d ws %zu)\n", n_in, out_size, ws_size); grid = -1; return; }
        int dev = 0, cus = 0;
        if (hipGetDevice(&dev) != hipSuccess || hipDeviceGetAttribute(&cus, hipDeviceAttributeMultiprocessorCount, dev) != hipSuccess) { grid = -1; return; }
        if (hipFuncSetAttribute((const void*)fwd, hipFuncAttributeMaxDynamicSharedMemorySize, LDS_BYTES) != hipSuccess) { fprintf(stderr, "kernel_launch: hipFuncSetAttribute failed\n"); grid = -1; return; }
        (void)hipGetLastError();
        grid = cus;
    }
    if (grid < 0) return;
    (void)hipMemsetAsync((char*)d_ws + WS_CTL, 0, CTL_ZERO_BYTES, stream);
    Args a{};
    for (int i = 0; i < 20; ++i) a.in[i] = (const float*)d_in[i];
    a.out = (float*)d_out; a.ws = (unsigned char*)d_ws;
#if MK_SINGLE
    a.ph_lo = 0; a.ph_hi = N_PHASES; a.li = 0;
    hipLaunchKernelGGL(fwd, dim3(grid), dim3(NWAVES * 64), LDS_BYTES, stream, a);
#else
    for (int p = 0; p < N_PHASES; ++p) { a.ph_lo = p; a.ph_hi = p + 1; a.li = p;
        hipLaunchKernelGGL(fwd, dim3(grid), dim3(NWAVES * 64), LDS_BYTES, stream, a); }
#endif
}
```

```cpp
#include <hip/hip_runtime.h>
#include <cstdio>
#include <cstdint>
#include <cmath>
namespace pg8 {
#define PG8_LAS __attribute__((address_space(3)))
typedef unsigned short bf16_t;
typedef short bf16x8 __attribute__((ext_vector_type(8)));
typedef float f32x4 __attribute__((ext_vector_type(4)));
typedef unsigned u32x4 __attribute__((ext_vector_type(4)));
constexpr int BM = 256, BK = 64, HALF = 128, HTB = HALF * BK * 2  , STAGE_BYTES = 8 * HTB, NXCD = 8, WGM = 8;

__host__ __device__ __forceinline__ int lds_byte(int r, int c) { const int st = (r >> 4) * 2 + (c >> 5), rr = r & 15, cc = c & 31, ob = rr * 64 + cc * 2; return st * 1024 + (ob ^ (((ob >> 9) & 1) << 5)); }
__host__ __device__ __forceinline__ void stage_rc(int b, int& R, int& C) { const int st = b / 1024, sb = b % 1024, swz = sb ^ (((sb >> 9) & 1) << 5); R = (st >> 1) * 16 + swz / 64; C = (st & 1) * 32 + (swz % 64) / 2; }
__host__ __device__ __forceinline__ int perm32(int rho) { const int n = rho >> 4, i = rho & 15; return 8 * (i >> 2) + 4 * n + (i & 3); }

struct Unit { int pm, pn; };
struct Gemm { const bf16_t* A; const bf16_t* Bt; int M, N, K; int sA; int nb16; };

struct StaticOrder {
    int nM, nN, nwg, G, c;
    __host__ __device__ void init(int M, int N, int G_, int c_) { nM = M / BM; nN = N / BM; nwg = nM * nN; G = G_; c = c_; }
    __host__ __device__ bool next(int i, Unit& u) const {
        const long L = (long)i * G + c; if (L >= nwg) return false;
        int wgid = (int)L; { const int q = nwg / NXCD, r = nwg % NXCD, xcd = wgid % NXCD, off = wgid / NXCD; wgid = (xcd < r ? xcd * (q + 1) : r * (q + 1) + (xcd - r) * q) + off; }
        const int nig = WGM * nN, gid = wgid / nig, fm = gid * WGM, gsz = (nM - fm) < WGM ? (nM - fm) : WGM;
        u.pm = fm + ((wgid % nig) % gsz); u.pn = (wgid % nig) / gsz; return true;
    }
    __device__ __forceinline__ void a_ready(const Unit&) const {}
    __device__ __forceinline__ void done(const Unit&) const {}
};
struct StaggerOrder : StaticOrder {
    int R0, c0;
    __host__ __device__ void init2(int M, int N, int G_, int c_, int R0_, int c0_) { init(M, N, G_, c_); R0 = R0_; c0 = c0_; }
    __host__ __device__ bool next(int i, Unit& u) const {
        long L;
        if (i < R0) L = (long)i * G + c; else { if (c < c0) return false; L = (long)R0 * G + (long)(i - R0) * (G - c0) + (c - c0); }
        if (L >= nwg) return false;
        int wgid = (int)L; { const int q = nwg / NXCD, r = nwg % NXCD, xcd = wgid % NXCD, off = wgid / NXCD; wgid = (xcd < r ? xcd * (q + 1) : r * (q + 1) + (xcd - r) * q) + off; }
        const int nig = WGM * nN, gid = wgid / nig, fm = gid * WGM, gsz = (nM - fm) < WGM ? (nM - fm) : WGM;
        u.pm = fm + ((wgid % nig) % gsz); u.pn = (wgid % nig) / gsz; return true;
    }
};
__device__ __forceinline__ unsigned cvt_pk_bf16(float lo, float hi) { unsigned r; asm volatile("v_cvt_pk_bf16_f32 %0, %1, %2" : "=v"(r) : "v"(lo), "v"(hi)); return r; }
__device__ __forceinline__ float sigmoid_fast(float x) { return __builtin_amdgcn_rcpf(1.0f + __expf(-x)); }
__device__ __forceinline__ float bf_lo(unsigned w) { return __uint_as_float(w << 16); }
__device__ __forceinline__ float bf_hi(unsigned w) { return __uint_as_float(w & 0xffff0000u); }
__device__ __forceinline__ float row_rstd(const unsigned long long* SS, size_t row) { const float s = (float)SS[row] * (1.0f / 16777216.0f); return 1.0f / sqrtf(s * (1.0f / 4096.0f) + 1e-6f); }
__device__ __forceinline__ float fq_sum(float v) {
    auto a = __builtin_amdgcn_permlane16_swap(__float_as_uint(v), __float_as_uint(v), false, false); v = __uint_as_float(a[0]) + __uint_as_float(a[1]);
    auto b = __builtin_amdgcn_permlane32_swap(__float_as_uint(v), __float_as_uint(v), false, false); return __uint_as_float(b[0]) + __uint_as_float(b[1]); }
__device__ __forceinline__ unsigned pk4_e4m3(float a, float b, float c, float d) { int w = 0; w = __builtin_amdgcn_cvt_pk_fp8_f32(a, b, w, false); w = __builtin_amdgcn_cvt_pk_fp8_f32(c, d, w, true); return (unsigned)w; }
__device__ __forceinline__ void had32_lanes(float (&x)[8], int fq) {
#pragma unroll
    for (int h = 1; h < 8; h <<= 1)
#pragma unroll
        for (int i = 0; i < 8; ++i) if (!(i & h)) { const float a = x[i], b = x[i + h]; x[i] = a + b; x[i + h] = a - b; }
#pragma unroll
    for (int i = 0; i < 8; ++i) { auto a = __builtin_amdgcn_permlane16_swap(__float_as_uint(x[i]), __float_as_uint(x[i]), false, false);
        const float lo = __uint_as_float(a[0]), hi = __uint_as_float(a[1]); x[i] = (fq & 1) ? lo - hi : lo + hi; }
#pragma unroll
    for (int i = 0; i < 8; ++i) { auto b = __builtin_amdgcn_permlane32_swap(__float_as_uint(x[i]), __float_as_uint(x[i]), false, false);
        const float lo = __uint_as_float(b[0]), hi = __uint_as_float(b[1]); x[i] = ((fq & 2) ? lo - hi : lo + hi) * 0.17677669529663687f; }
}
__device__ __forceinline__ float fq_max(float v) {
    auto a = __builtin_amdgcn_permlane16_swap(__float_as_uint(v), __float_as_uint(v), false, false); v = fmaxf(__uint_as_float(a[0]), __uint_as_float(a[1]));
    auto b = __builtin_amdgcn_permlane32_swap(__float_as_uint(v), __float_as_uint(v), false, false); return fmaxf(__uint_as_float(b[0]), __uint_as_float(b[1])); }
template <bool I8, bool HAD = false> struct EpiSwiGLUT {
    static constexpr bool PERM = true, AFTER_DRAIN = false;
    bf16_t* O; int ldc; const float* RS; const float* CS; unsigned* RM;
    __device__ __forceinline__ void operator()(const f32x4 (&acc)[2][2][4][2], const Unit& u, int wr, int wc, int fr, int fq) const {
        const unsigned row0 = u.pm * BM + wr * 64 + fr; const int col0 = u.pn * HALF + wc * 32 + 8 * fq;
        float rs[8]; f32x4 cg0, cg1, cu0, cu1;
        if constexpr (I8) {
#pragma unroll
            for (int i = 0; i < 8; ++i) rs[i] = RS[row0 + (i >> 2) * HALF + (i & 3) * 16] * (1.0f / 127.0f);
            const float* cp = CS + u.pn * BM + wc * 32 + 8 * fq; cg0 = *(const f32x4*)cp; cg1 = *(const f32x4*)(cp + 4); cu0 = *(const f32x4*)(cp + HALF); cu1 = *(const f32x4*)(cp + HALF + 4);
        }
#pragma unroll
        for (int ai = 0; ai < 2; ++ai)
#pragma unroll
            for (int m = 0; m < 4; ++m) { const unsigned row = row0 + ai * HALF + m * 16; bf16_t* rowp = O + (size_t)row * ldc + col0;
                float x[8];
#pragma unroll
                for (int j = 0; j < 4; ++j) { float g0, g1, u0, u1;
                    if constexpr (I8) { const float r = rs[ai * 4 + m];
                        g0 = (float)__float_as_int(acc[ai][0][m][0][j]) * (r * cg0[j]); g1 = (float)__float_as_int(acc[ai][0][m][1][j]) * (r * cg1[j]);
                        u0 = (float)__float_as_int(acc[ai][1][m][0][j]) * (r * cu0[j]); u1 = (float)__float_as_int(acc[ai][1][m][1][j]) * (r * cu1[j]); }
                    else { g0 = acc[ai][0][m][0][j]; g1 = acc[ai][0][m][1][j]; u0 = acc[ai][1][m][0][j]; u1 = acc[ai][1][m][1][j]; }
                    x[j] = g0 * sigmoid_fast(g0) * u0; x[4 + j] = g1 * sigmoid_fast(g1) * u1; }
                if constexpr (HAD) had32_lanes(x, fq);
                u32x4 w; w.x = cvt_pk_bf16(x[0], x[1]); w.y = cvt_pk_bf16(x[2], x[3]); w.z = cvt_pk_bf16(x[4], x[5]); w.w = cvt_pk_bf16(x[6], x[7]); *(u32x4*)rowp = w;
                if constexpr (HAD) {
                    float mx = fmaxf(fmaxf(fmaxf(fabsf(x[0]), fabsf(x[1])), fmaxf(fabsf(x[2]), fabsf(x[3]))), fmaxf(fmaxf(fabsf(x[4]), fabsf(x[5])), fmaxf(fabsf(x[6]), fabsf(x[7]))));
                    mx = fq_max(mx);
                    if (fq == 0) atomicMax(RM + row, __float_as_uint(mx)); } }
    }
};
template <bool NORM, bool FP8COPY, bool I8 = false> struct EpiResidT {
    static constexpr bool PERM = true, AFTER_DRAIN = false;
    const float* base; float* out; int ldc; float scale; bf16_t* Hb; unsigned char* H8; unsigned long long* SS; const float* RS; const float* CS;
    __device__ __forceinline__ void operator()(const f32x4 (&acc)[2][2][4][2], const Unit& u, int wr, int wc, int fr, int fq) const {
        const unsigned row0 = u.pm * BM + wr * 64 + fr, col0 = u.pn * BM + wc * 32 + 8 * fq;
        const char* bp = (const char*)base; char* op = (char*)out; char* hp = (char*)Hb; char* h8 = (char*)H8; char* sp = (char*)SS;
        f32x4 cb[4], nb[4]; float rs[8]; f32x4 cs[2][2];
        if constexpr (I8) {
#pragma unroll
            for (int i = 0; i < 8; ++i) rs[i] = RS[row0 + (i >> 2) * HALF + (i & 3) * 16] * (scale / 127.0f);
            const float* cp = CS + col0; cs[0][0] = *(const f32x4*)cp; cs[0][1] = *(const f32x4*)(cp + 4); cs[1][0] = *(const f32x4*)(cp + HALF); cs[1][1] = *(const f32x4*)(cp + HALF + 4);
        }
#define EPI_LD(dst, i) do { const unsigned o_ = ((row0 + ((i) >> 2) * HALF + ((i) & 3) * 16) * (unsigned)ldc + col0) * 4u; \
            dst[0] = *(const f32x4*)(bp + o_); dst[1] = *(const f32x4*)(bp + (o_ + 16u)); dst[2] = *(const f32x4*)(bp + (o_ + 512u)); dst[3] = *(const f32x4*)(bp + (o_ + 528u)); } while (0)
        EPI_LD(cb, 0);
#pragma unroll
        for (int i = 0; i < 8; ++i) { const int ai = i >> 2, m = i & 3; const unsigned row = row0 + ai * HALF + m * 16, off = row * (unsigned)ldc + col0; float ss = 0.f;
            if (i + 1 < 8) EPI_LD(nb, i + 1);
#pragma unroll
            for (int bj = 0; bj < 2; ++bj) { const unsigned o = off + bj * HALF;
                f32x4 v0, v1;
                if constexpr (I8) { const float r = rs[i];
#pragma unroll
                    for (int j = 0; j < 4; ++j) { const float a0 = acc[ai][bj][m][0][j], a1 = acc[ai][bj][m][1][j];
                        v0[j] = cb[2 * bj][j] + (float)__float_as_int(a0) * (r * cs[bj][0][j]); v1[j] = cb[2 * bj + 1][j] + (float)__float_as_int(a1) * (r * cs[bj][1][j]); } }
                else { v0 = cb[2 * bj] + acc[ai][bj][m][0] * scale; v1 = cb[2 * bj + 1] + acc[ai][bj][m][1] * scale; }
                *(f32x4*)(op + o * 4u) = v0; *(f32x4*)(op + (o * 4u + 16u)) = v1;
                if constexpr (NORM) {
                    ss += (v0[0] * v0[0] + v0[1] * v0[1]) + (v0[2] * v0[2] + v0[3] * v0[3]) + (v1[0] * v1[0] + v1[1] * v1[1]) + (v1[2] * v1[2] + v1[3] * v1[3]);
                    u32x4 w; w.x = cvt_pk_bf16(v0[0], v0[1]); w.y = cvt_pk_bf16(v0[2], v0[3]); w.z = cvt_pk_bf16(v1[0], v1[1]); w.w = cvt_pk_bf16(v1[2], v1[3]);
                    *(u32x4*)(hp + o * 2u) = w;
                    if constexpr (FP8COPY) { typedef unsigned u32x2 __attribute__((ext_vector_type(2))); u32x2 w8; w8.x = pk4_e4m3(v0[0], v0[1], v0[2], v0[3]); w8.y = pk4_e4m3(v1[0], v1[1], v1[2], v1[3]); *(u32x2*)(h8 + o) = w8; } } }
            if constexpr (NORM) {
                ss = fq_sum(ss) * 16777216.0f;
                const unsigned hi = (unsigned)(ss * 2.3283064365386963e-10f), lo = (unsigned)(ss - (float)hi * 4294967296.0f);
                if (fq == 0) atomicAdd((unsigned long long*)(sp + row * 8u), ((unsigned long long)hi << 32) | lo); }
#pragma unroll
            for (int q = 0; q < 4; ++q) cb[q] = nb[q]; }
#undef EPI_LD
    }
};
typedef EpiResidT<false, false> EpiResid;
typedef EpiResidT<false, false, true> EpiResid8;
template <bool FP8COPY> using EpiResidN = EpiResidT<true, FP8COPY>;
template <bool I8, long oA, int ldA, int nA, long oB, int ldB, int nB, long oC, int ldC, int nC> struct EpiProjT {
    static constexpr bool PERM = true, AFTER_DRAIN = false;
    bf16_t* base; float* AB; const float* RS; const float* CS;
    __device__ __forceinline__ void operator()(const f32x4 (&acc)[2][2][4][2], const Unit& u, int wr, int wc, int fr, int fq) const {
        const int row0 = u.pm * BM + wr * 64 + fr;
        if (u.pn < nA + nB + nC) {
            const int sg = u.pn < nA ? 0 : (u.pn < nA + nB ? 1 : 2); bf16_t* O = base + (sg == 0 ? oA : (sg == 1 ? oB : oC)); const int ldc = sg == 0 ? ldA : (sg == 1 ? ldB : ldC);
            const int col0 = (sg == 0 ? u.pn : (sg == 1 ? u.pn - nA : u.pn - nA - nB)) * BM + wc * 32 + 8 * fq;
            float rs[8]; f32x4 cs[2][2];
            if constexpr (I8) {
#pragma unroll
                for (int i = 0; i < 8; ++i) rs[i] = RS[row0 + (i >> 2) * HALF + (i & 3) * 16] * (1.0f / 127.0f);
                const float* cp = CS + u.pn * BM + wc * 32 + 8 * fq; cs[0][0] = *(const f32x4*)cp; cs[0][1] = *(const f32x4*)(cp + 4); cs[1][0] = *(const f32x4*)(cp + HALF); cs[1][1] = *(const f32x4*)(cp + HALF + 4);
            }
#pragma unroll
            for (int ai = 0; ai < 2; ++ai)
#pragma unroll
                for (int m = 0; m < 4; ++m) { const size_t row = (size_t)(row0 + ai * HALF + m * 16); bf16_t* rowp = O + row * ldc + col0;
#pragma unroll
                    for (int bj = 0; bj < 2; ++bj) { f32x4 v0 = acc[ai][bj][m][0], v1 = acc[ai][bj][m][1];
                        if constexpr (I8) { const float r = rs[ai * 4 + m];
#pragma unroll
                            for (int j = 0; j < 4; ++j) { const float a0 = v0[j], a1 = v1[j]; v0[j] = (float)__float_as_int(a0) * (r * cs[bj][0][j]); v1[j] = (float)__float_as_int(a1) * (r * cs[bj][1][j]); } }
                        u32x4 w; w.x = cvt_pk_bf16(v0[0], v0[1]); w.y = cvt_pk_bf16(v0[2], v0[3]); w.z = cvt_pk_bf16(v1[0], v1[1]); w.w = cvt_pk_bf16(v1[2], v1[3]);
                        *(u32x4*)(rowp + bj * HALF) = w; } }
        } else if (wc < 2) {
#pragma unroll
            for (int ai = 0; ai < 2; ++ai)
#pragma unroll
                for (int m = 0; m < 4; ++m) { const size_t row = (size_t)(row0 + ai * HALF + m * 16); float* p = AB + row * 64 + wc * 32 + 8 * fq;
                    *(f32x4*)p = acc[ai][0][m][0]; *(f32x4*)(p + 4) = acc[ai][0][m][1]; }
        }
    }
};
template <bool FIRST> struct EpiGate {
    static constexpr bool PERM = true, AFTER_DRAIN = false;
    bf16_t* Y; int ldy; const bf16_t* gate; int ldg;
    __device__ __forceinline__ void operator()(const f32x4 (&acc)[2][2][4][2], const Unit& u, int wr, int wc, int fr, int fq) const {
        const unsigned row0 = u.pm * BM + wr * 64 + fr, col0 = u.pn * BM + wc * 32 + 8 * fq;
        const char* gp = (const char*)gate; char* yb = (char*)Y;
        u32x4 cg[2], ng[2], cy[2], ny[2];
#define EPI_LD(dg, dy, i) do { const unsigned r_ = row0 + ((i) >> 2) * HALF + ((i) & 3) * 16; const unsigned og_ = (r_ * (unsigned)ldg + col0) * 2u, oy_ = (r_ * (unsigned)ldy + col0) * 2u; \
            dg[0] = *(const u32x4*)(gp + og_); dg[1] = *(const u32x4*)(gp + (og_ + 256u)); if (!FIRST) { dy[0] = *(const u32x4*)(yb + oy_); dy[1] = *(const u32x4*)(yb + (oy_ + 256u)); } } while (0)
        EPI_LD(cg, cy, 0);
#pragma unroll
        for (int i = 0; i < 8; ++i) { const int ai = i >> 2, m = i & 3; const unsigned row = row0 + ai * HALF + m * 16;
            if (i + 1 < 8) EPI_LD(ng, ny, i + 1);
#pragma unroll
            for (int bj = 0; bj < 2; ++bj) { const u32x4 gw = cg[bj];
                f32x4 s0, s1; s0[0] = sigmoid_fast(bf_lo(gw.x)); s0[1] = sigmoid_fast(bf_hi(gw.x)); s0[2] = sigmoid_fast(bf_lo(gw.y)); s0[3] = sigmoid_fast(bf_hi(gw.y));
                s1[0] = sigmoid_fast(bf_lo(gw.z)); s1[1] = sigmoid_fast(bf_hi(gw.z)); s1[2] = sigmoid_fast(bf_lo(gw.w)); s1[3] = sigmoid_fast(bf_hi(gw.w));
                f32x4 v0 = acc[ai][bj][m][0] * s0, v1 = acc[ai][bj][m][1] * s1;
                if (!FIRST) { const u32x4 p = cy[bj]; v0[0] += bf_lo(p.x); v0[1] += bf_hi(p.x); v0[2] += bf_lo(p.y); v0[3] += bf_hi(p.y); v1[0] += bf_lo(p.z); v1[1] += bf_hi(p.z); v1[2] += bf_lo(p.w); v1[3] += bf_hi(p.w); }
                u32x4 w; w.x = cvt_pk_bf16(v0[0], v0[1]); w.y = cvt_pk_bf16(v0[2], v0[3]); w.z = cvt_pk_bf16(v1[0], v1[1]); w.w = cvt_pk_bf16(v1[2], v1[3]);
                *(u32x4*)(yb + ((row * (unsigned)ldy + col0) * 2u + bj * 256u)) = w; }
#pragma unroll
            for (int q = 0; q < 2; ++q) { cg[q] = ng[q]; if (!FIRST) cy[q] = ny[q]; } }
#undef EPI_LD
    }
};
template <class Epi, class Sched, bool ALIGN_EPI = false, bool SP2 = false, int FM = 0>
__device__ __forceinline__ void gemm_phase(PG8_LAS unsigned char* lds, const Gemm g, const Sched& S, const Epi& E) {
    int tid_o = threadIdx.x; asm volatile("" : "+v"(tid_o));
    const int tid = tid_o, wid = __builtin_amdgcn_readfirstlane(tid >> 6), lane = tid & 63, wr = wid >> 2, wc = wid & 3, fr = lane & 15, fq = lane >> 4;
    constexpr bool F8 = (FM == 1 || FM == 2); static_assert(FM != 2 || SP2, "mixed rows: SP2 only");
    constexpr int ES = (FM == 1 || FM == 3) ? 1 : 2;
    const int K = g.K, nt = K * ES / (BK * 2);
    const int f8_sw = 0x79797979, f8_sh = g.sA;
    unsigned voffA[2], voffB[2];
#pragma unroll
    for (int i = 0; i < 2; ++i) { int R, C; stage_rc(tid * 16 + i * 8192, R, C); const int Rb = Epi::PERM ? ((R & ~31) + perm32(R & 31)) : R;
        voffA[i] = (unsigned)(R * K) * ES + (unsigned)C * 2u; voffB[i] = (unsigned)(Rb * K) * ES + (unsigned)C * 2u; }
    const size_t kstep = (size_t)(BK * 2);
    const size_t hstep = (size_t)HALF * K * ES;
    const size_t tstep = 2 * hstep;
    const unsigned ldsw = (unsigned)wid * 1024u;
    const int aoff = lds_byte(wr * 64 + fr, fq * 8), boff = lds_byte(wc * 32 + fr, fq * 8);
#define PG8_SA(b, h) (((b) * 2 + (h)) * HTB)
#define PG8_SB(b, h) ((4 + (b) * 2 + (h)) * HTB)
#define PG8_STAGE(bufoff, gbase, voff) do { _Pragma("unroll") for (int _i = 0; _i < 2; ++_i) \
        __builtin_amdgcn_global_load_lds((const unsigned*)((const char*)(gbase) + (voff)[_i]), (PG8_LAS unsigned*)(lds + (bufoff) + ldsw + _i * 8192), 16, 0, 0); } while (0)
#define PG8_LDA(dst, b, h) do { _Pragma("unroll") for (int m = 0; m < 4; ++m) _Pragma("unroll") for (int k = 0; k < 2; ++k) dst[m][k] = *(const PG8_LAS bf16x8*)(lds + PG8_SA(b, h) + aoff + m * 2048 + k * 1024); } while (0)
#define PG8_LDB(dst, b, h) do { _Pragma("unroll") for (int n = 0; n < 2; ++n) _Pragma("unroll") for (int k = 0; k < 2; ++k) dst[n][k] = *(const PG8_LAS bf16x8*)(lds + PG8_SB(b, h) + boff + n * 2048 + k * 1024); } while (0)
#define PG8_MMA(ai, bj, At, Bt, F8X) do { __builtin_amdgcn_s_setprio(1); \
        if constexpr ((int)(F8X) == 1) { typedef int v4i_ __attribute__((ext_vector_type(4))); typedef int v8i_ __attribute__((ext_vector_type(8))); \
            const v8i_ b80 = __builtin_shufflevector(__builtin_bit_cast(v4i_, Bt[0][0]), __builtin_bit_cast(v4i_, Bt[0][1]), 0, 1, 2, 3, 4, 5, 6, 7); \
            const v8i_ b81 = __builtin_shufflevector(__builtin_bit_cast(v4i_, Bt[1][0]), __builtin_bit_cast(v4i_, Bt[1][1]), 0, 1, 2, 3, 4, 5, 6, 7); \
            const v8i_ a80 = __builtin_shufflevector(__builtin_bit_cast(v4i_, At[0][0]), __builtin_bit_cast(v4i_, At[0][1]), 0, 1, 2, 3, 4, 5, 6, 7); \
            const v8i_ a81 = __builtin_shufflevector(__builtin_bit_cast(v4i_, At[1][0]), __builtin_bit_cast(v4i_, At[1][1]), 0, 1, 2, 3, 4, 5, 6, 7); \
            const v8i_ a82 = __builtin_shufflevector(__builtin_bit_cast(v4i_, At[2][0]), __builtin_bit_cast(v4i_, At[2][1]), 0, 1, 2, 3, 4, 5, 6, 7); \
            const v8i_ a83 = __builtin_shufflevector(__builtin_bit_cast(v4i_, At[3][0]), __builtin_bit_cast(v4i_, At[3][1]), 0, 1, 2, 3, 4, 5, 6, 7); \
              \
            asm volatile("s_nop 1\n\t" \
                "v_mfma_scale_f32_16x16x128_f8f6f4 %0, %8, %10, %0, %14, %15 op_sel_hi:[0,0,0]\n\tv_mfma_scale_f32_16x16x128_f8f6f4 %1, %9, %10, %1, %14, %15 op_sel_hi:[0,0,0]\n\t" \
                "v_mfma_scale_f32_16x16x128_f8f6f4 %2, %8, %11, %2, %14, %15 op_sel_hi:[0,0,0]\n\tv_mfma_scale_f32_16x16x128_f8f6f4 %3, %9, %11, %3, %14, %15 op_sel_hi:[0,0,0]\n\t" \
                "v_mfma_scale_f32_16x16x128_f8f6f4 %4, %8, %12, %4, %14, %15 op_sel_hi:[0,0,0]\n\tv_mfma_scale_f32_16x16x128_f8f6f4 %5, %9, %12, %5, %14, %15 op_sel_hi:[0,0,0]\n\t" \
                "v_mfma_scale_f32_16x16x128_f8f6f4 %6, %8, %13, %6, %14, %15 op_sel_hi:[0,0,0]\n\tv_mfma_scale_f32_16x16x128_f8f6f4 %7, %9, %13, %7, %14, %15 op_sel_hi:[0,0,0]" \
                : "+v"(acc[ai][bj][0][0]), "+v"(acc[ai][bj][0][1]), "+v"(acc[ai][bj][1][0]), "+v"(acc[ai][bj][1][1]), "+v"(acc[ai][bj][2][0]), "+v"(acc[ai][bj][2][1]), "+v"(acc[ai][bj][3][0]), "+v"(acc[ai][bj][3][1]) \
                : "v"(b80), "v"(b81), "v"(a80), "v"(a81), "v"(a82), "v"(a83), "v"(f8_sw), "v"(f8_sh)); } \
        else if constexpr ((int)(F8X) == 3) { typedef int v4i_ __attribute__((ext_vector_type(4))); \
            _Pragma("unroll") for (int m = 0; m < 4; ++m) _Pragma("unroll") for (int n = 0; n < 2; ++n) _Pragma("unroll") for (int k = 0; k < 2; ++k) \
            acc[ai][bj][m][n] = __builtin_bit_cast(f32x4, __builtin_amdgcn_mfma_i32_16x16x64_i8(__builtin_bit_cast(v4i_, Bt[n][k]), __builtin_bit_cast(v4i_, At[m][k]), __builtin_bit_cast(v4i_, acc[ai][bj][m][n]), 0, 0, 0)); } \
        else { _Pragma("unroll") for (int m = 0; m < 4; ++m) _Pragma("unroll") for (int n = 0; n < 2; ++n) _Pragma("unroll") for (int k = 0; k < 2; ++k) \
            acc[ai][bj][m][n] = __builtin_amdgcn_mfma_f32_16x16x32_bf16(Bt[n][k], At[m][k], acc[ai][bj][m][n], 0, 0, 0); } \
        __builtin_amdgcn_s_setprio(0); } while (0)
#define PG8_WAIT_V(n) asm volatile("s_waitcnt vmcnt(" #n ")" ::: "memory")
#define PG8_WAIT_L(n) asm volatile("s_waitcnt lgkmcnt(" #n ")" ::: "memory")
#define PG8_BAR __builtin_amdgcn_s_barrier()
#define PG8_SCHED __builtin_amdgcn_sched_barrier(0)
#define PG8_KT2(F8X) do { \
            PG8_LDB(B0, 0, 0); PG8_LDB(B1, 0, 1); PG8_SCHED; PG8_LDA(At, 0, 0); PG8_STAGE(PG8_SA(1, 1), a1 + hstep, voffA); \
            PG8_WAIT_V(8); PG8_WAIT_L(0); PG8_BAR; PG8_MMA(0, 0, At, B0, F8X); PG8_MMA(0, 1, At, B1, F8X); PG8_BAR; PG8_SCHED; \
            PG8_LDA(At, 0, 1); PG8_STAGE(PG8_SB(0, 0), b2, voffB); PG8_STAGE(PG8_SB(0, 1), b2 + hstep, voffB); PG8_STAGE(PG8_SA(0, 0), a2, voffA); \
            PG8_WAIT_V(8); PG8_WAIT_L(0); PG8_BAR; PG8_MMA(1, 0, At, B0, F8X); PG8_MMA(1, 1, At, B1, F8X); PG8_BAR; PG8_SCHED; \
            PG8_LDB(B0, 1, 0); PG8_LDB(B1, 1, 1); PG8_SCHED; PG8_LDA(At, 1, 0); PG8_STAGE(PG8_SA(0, 1), a2 + hstep, voffA); \
            PG8_WAIT_V(8); PG8_WAIT_L(0); PG8_BAR; PG8_MMA(0, 0, At, B0, F8X); PG8_MMA(0, 1, At, B1, F8X); PG8_BAR; PG8_SCHED; \
            PG8_LDA(At, 1, 1); PG8_STAGE(PG8_SB(1, 0), b3, voffB); PG8_STAGE(PG8_SB(1, 1), b3 + hstep, voffB); PG8_STAGE(PG8_SA(1, 0), a3, voffA); \
            PG8_WAIT_V(8); PG8_WAIT_L(0); PG8_BAR; PG8_MMA(1, 0, At, B0, F8X); PG8_MMA(1, 1, At, B1, F8X); PG8_BAR; PG8_SCHED; } while (0)
    Unit cur, nxt; int ui = 0;
    if (!S.next(0, cur)) return;
    f32x4 acc[2][2][4][2];
#pragma unroll
    for (int a = 0; a < 2; ++a)
#pragma unroll
        for (int b = 0; b < 2; ++b)
#pragma unroll
            for (int m = 0; m < 4; ++m)
#pragma unroll
                for (int n = 0; n < 2; ++n) acc[a][b][m][n] = (f32x4){0.f, 0.f, 0.f, 0.f};
    bf16x8 At[4][2], B0[2][2], B1[2][2];
    const char* cA = (const char*)g.A + (size_t)cur.pm * tstep; const char* cB = (const char*)g.Bt + (size_t)cur.pn * tstep;
    S.a_ready(cur);
    if constexpr (SP2) {
        PG8_STAGE(PG8_SB(0, 0), cB, voffB); PG8_STAGE(PG8_SB(0, 1), cB + hstep, voffB); PG8_STAGE(PG8_SA(0, 0), cA, voffA); PG8_STAGE(PG8_SA(0, 1), cA + hstep, voffA);
        if (wr == 1) PG8_BAR;
        PG8_WAIT_V(2); PG8_BAR;
        PG8_STAGE(PG8_SB(1, 0), cB + kstep, voffB); PG8_STAGE(PG8_SA(1, 0), cA + kstep, voffA); PG8_STAGE(PG8_SB(1, 1), cB + hstep + kstep, voffB);
        PG8_WAIT_V(6); PG8_BAR;
    } else {
        PG8_STAGE(PG8_SB(0, 0), cB, voffB); PG8_STAGE(PG8_SA(0, 0), cA, voffA); PG8_STAGE(PG8_SB(0, 1), cB + hstep, voffB); PG8_STAGE(PG8_SA(0, 1), cA + hstep, voffA);
        if (wr == 1) PG8_BAR;
        PG8_WAIT_V(4); PG8_BAR;
        PG8_STAGE(PG8_SB(1, 0), cB + kstep, voffB); PG8_STAGE(PG8_SA(1, 0), cA + kstep, voffA); PG8_STAGE(PG8_SB(1, 1), cB + hstep + kstep, voffB);
        PG8_WAIT_V(6); PG8_BAR;
    }
    for (;;) {
        const bool has_next = S.next(ui + 1, nxt);
        const char* nA = has_next ? (const char*)g.A + (size_t)nxt.pm * tstep : cA; const char* nB = has_next ? (const char*)g.Bt + (size_t)nxt.pn * tstep : cB;
        int t = 0;
        if constexpr (FM == 2) {
            for (; t < g.nb16; t += 2) {
                const char* a1 = cA + (size_t)(t + 1) * kstep; const char* a2 = cA + (size_t)(t + 2) * kstep; const char* b2 = cB + (size_t)(t + 2) * kstep;
                const char* a3 = a2 + kstep; const char* b3 = b2 + kstep;
                PG8_KT2(false);
            }
        }
        for (; t < nt; t += 2) {
            const bool last = (t == nt - 2);
            const char* a1 = cA + (size_t)(t + 1) * kstep;
            const char* a2 = last ? nA : cA + (size_t)(t + 2) * kstep; const char* b2 = last ? nB : cB + (size_t)(t + 2) * kstep;
            const char* a3 = a2 + kstep; const char* b3 = b2 + kstep;
            if (last && has_next) S.a_ready(nxt);
            if constexpr (SP2) {
                PG8_KT2(FM == 2 ? 1 : FM);
            } else {
            PG8_LDB(B0, 0, 0); PG8_SCHED; PG8_LDA(At, 0, 0); PG8_STAGE(PG8_SA(1, 1), a1 + hstep, voffA);
            PG8_WAIT_L(8); PG8_BAR; PG8_WAIT_L(0); PG8_MMA(0, 0, At, B0, FM); PG8_BAR; PG8_SCHED;
            PG8_LDB(B1, 0, 1); PG8_STAGE(PG8_SB(0, 0), b2, voffB);
            PG8_BAR; PG8_WAIT_L(0); PG8_MMA(0, 1, At, B1, FM); PG8_BAR;
            PG8_LDA(At, 0, 1); PG8_STAGE(PG8_SA(0, 0), a2, voffA);
            PG8_BAR; PG8_WAIT_L(0); PG8_MMA(1, 0, At, B0, FM); PG8_BAR; PG8_SCHED;
            PG8_STAGE(PG8_SB(0, 1), b2 + hstep, voffB);
            PG8_WAIT_V(6); PG8_BAR; PG8_MMA(1, 1, At, B1, FM); PG8_BAR;
            PG8_LDB(B0, 1, 0); PG8_SCHED; PG8_LDA(At, 1, 0); PG8_STAGE(PG8_SA(0, 1), a2 + hstep, voffA);
            PG8_WAIT_L(8); PG8_BAR; PG8_WAIT_L(0); PG8_MMA(0, 0, At, B0, FM); PG8_BAR; PG8_SCHED;
            PG8_LDB(B1, 1, 1); PG8_STAGE(PG8_SB(1, 0), b3, voffB);
            PG8_BAR; PG8_WAIT_L(0); PG8_MMA(0, 1, At, B1, FM); PG8_BAR;
            PG8_LDA(At, 1, 1); PG8_STAGE(PG8_SA(1, 0), a3, voffA);
            PG8_BAR; PG8_WAIT_L(0); PG8_MMA(1, 0, At, B0, FM); PG8_BAR; PG8_SCHED;
            PG8_STAGE(PG8_SB(1, 1), b3 + hstep, voffB);
            PG8_WAIT_V(6); PG8_BAR; PG8_MMA(1, 1, At, B1, FM); PG8_BAR;
            }
        }
        if constexpr (F8) asm volatile("s_nop 15\n\ts_nop 15" ::: "memory");
        if constexpr (ALIGN_EPI) { if (wr == 0) PG8_BAR; }
        if constexpr (!Epi::AFTER_DRAIN) { E(acc, cur, wr, wc, fr, fq); S.done(cur); }
        if (!has_next) break;
#pragma unroll
        for (int a = 0; a < 2; ++a)
#pragma unroll
            for (int b = 0; b < 2; ++b)
#pragma unroll
                for (int m = 0; m < 4; ++m)
#pragma unroll
                    for (int n = 0; n < 2; ++n) acc[a][b][m][n] = (f32x4){0.f, 0.f, 0.f, 0.f};
        cur = nxt; cA = nA; cB = nB; ++ui;
        if constexpr (ALIGN_EPI) { if (wr == 1) PG8_BAR; }
    }
    PG8_WAIT_V(0);
    if constexpr (!ALIGN_EPI) { if (wr == 0) PG8_BAR; }
    PG8_BAR;
    if constexpr (Epi::AFTER_DRAIN) { E.fused(acc, cur, wr, wc, fr, fq, lds, wid, lane); S.done(cur); }
#undef PG8_SA
#undef PG8_SB
#undef PG8_STAGE
#undef PG8_LDA
#undef PG8_LDB
#undef PG8_MMA
#undef PG8_KT2
#undef PG8_WAIT_V
#undef PG8_WAIT_L
#undef PG8_BAR
#undef PG8_SCHED
}
}
#ifndef MK_SINGLE
#define MK_SINGLE 1
#endif
constexpr int NWAVES = 8;
constexpr int BATCH = 4, SEQ = 4096, DM = 4096, FF = 11008, M = BATCH * SEQ;
constexpr int NPROJ = 16640, NGATE = 10240, PA_LD = 14336, PB_LD = 12288;
constexpr int PA_GQ = 0, PA_GK = 2048, PA_GV = 4096, PA_MQ = 8192, PA_MK = 10240, PA_MV = 12288, PB_GZ = 0, PB_GG = 4096, PB_MG = 8192;
constexpr float NORM_EPS = 1e-6f;
constexpr int KB16 = 11008, KF8 = FF - KB16, ACT2_PITCH = 2 * KB16 + KF8;
static_assert(KB16 % 128 == 0 && KF8 % 256 == 0, "mixed K split");
constexpr int N_PHASES = 14;

constexpr size_t MiB = 1u << 20;
constexpr size_t WS_CTL = 0, CTL_ZERO_BYTES = 64 * 1024;
constexpr size_t WS_KMEAN = 1 * MiB, WS_ROPE = 2 * MiB, WS_AB = 4 * MiB, WS_G = 8 * MiB, WS_BETA = 10 * MiB;
constexpr size_t WS_WGU = 16 * MiB, WS_WD = 188 * MiB;
constexpr size_t WS_H = 274 * MiB;
constexpr size_t WS_WB = 402 * MiB;
constexpr size_t WS_BIG = 612 * MiB, WS_PB = 1060 * MiB;
constexpr size_t WS_OG = 1444 * MiB, WS_OM = 1572 * MiB, WS_WBG = 1636 * MiB, WS_WBM = 1668 * MiB, WS_WO = 1684 * MiB, WS_H8 = 1716 * MiB, WS_END = 1780 * MiB;
constexpr size_t WS_W8 = 548 * MiB;
constexpr size_t WS_QN = 16 * MiB, WS_KN = 80 * MiB, WS_VP = 144 * MiB, WS_KNT = 274 * MiB;
constexpr size_t WS_U = 612 * MiB, WS_W = 740 * MiB, WS_AT = 868 * MiB, WS_GC = 932 * MiB;
constexpr size_t WS_MQ = 402 * MiB, WS_MK = 466 * MiB, WS_MV = 530 * MiB;
constexpr size_t WS_Y1 = 16 * MiB;
static_assert(WS_WGU + (size_t)22016 * 4096 * 2 <= WS_WD && WS_WD + (size_t)4096 * 11008 * 2 <= WS_H && WS_H + (size_t)M * DM * 2 <= WS_WB, "ws map 1");
static_assert(WS_WB + (size_t)NPROJ * DM * 2 <= WS_BIG && WS_BIG + (size_t)M * PA_LD * 2 <= WS_PB && WS_PB + (size_t)M * PB_LD * 2 <= WS_OG && WS_MV + (size_t)M * 2048 * 2 <= WS_BIG && WS_Y1 + (size_t)M * DM * 4 <= WS_H && WS_GC + (size_t)8192 * 64 * 4 <= WS_PB, "ws map 2");
constexpr int CW_BAR = 4096, CW_Q = 64;

constexpr int RING_BYTES = 131072, TR_STRIDE = 16640, PREP_STRIDE = 17408, MISC_OFF = 159744, LDS_BYTES = 163840;
static_assert(8 * TR_STRIDE <= MISC_OFF, "LDS map");

#define GAS __attribute__((address_space(1)))
#define LAS __attribute__((address_space(3)))
typedef unsigned short bf16;
typedef unsigned v4u __attribute__((ext_vector_type(4)));
typedef unsigned v2u __attribute__((ext_vector_type(2)));
typedef float f32x4 __attribute__((ext_vector_type(4)));
typedef float f32x2 __attribute__((ext_vector_type(2)));
#define LDS_WAIT() asm volatile("s_waitcnt lgkmcnt(0)" ::: "memory")
#define VM_WAIT() asm volatile("s_waitcnt vmcnt(0)" ::: "memory")
__device__ __forceinline__ unsigned f2bf(float f) { unsigned u = __builtin_bit_cast(unsigned, f); return (u + 0x7fffu + ((u >> 16) & 1u)) >> 16; }
typedef __bf16 bf16x2_t __attribute__((ext_vector_type(2)));
__device__ __forceinline__ unsigned cvtpk(float lo, float hi) { f32x2 v = {lo, hi}; bf16x2_t b = __builtin_convertvector(v, bf16x2_t); return __builtin_bit_cast(unsigned, b); }
__device__ __forceinline__ unsigned pk2(float lo, float hi) { return cvtpk(lo, hi); }
__device__ __forceinline__ float bf2f(unsigned short b) { return __uint_as_float(((unsigned)b) << 16); }
__device__ __forceinline__ float blo(unsigned w) { return __uint_as_float(w << 16); }
__device__ __forceinline__ float bhi(unsigned w) { return __uint_as_float(w & 0xffff0000u); }
template <int CTRL, int RM> __device__ __forceinline__ float dpp_f(float v) { return __int_as_float(__builtin_amdgcn_update_dpp(0, __float_as_int(v), CTRL, RM, 0xf, true)); }
__device__ __forceinline__ float row_sum16(float v) { v += dpp_f<0xB1, 0xf>(v); v += dpp_f<0x4E, 0xf>(v); v += dpp_f<0x141, 0xf>(v); v += dpp_f<0x140, 0xf>(v); return v; }
__device__ __forceinline__ float half_sum32(float v) { v = row_sum16(v); v += dpp_f<0x142, 0xa>(v); return v; }
__device__ __forceinline__ float rd_lane(float v, int l) { return __int_as_float(__builtin_amdgcn_readlane(__float_as_int(v), l)); }
__device__ __forceinline__ float wave_sum(float v) { v = half_sum32(v); return rd_lane(v, 31) + rd_lane(v, 63); }
__device__ __forceinline__ float wave_max(float v) {
#pragma unroll
    for (int o = 1; o < 64; o <<= 1) v = fmaxf(v, __shfl_xor(v, o));
    return v;
}
__device__ __forceinline__ float xhalf_max(float v) { auto rr = __builtin_amdgcn_permlane32_swap(__float_as_uint(v), __float_as_uint(v), false, false); return fmaxf(__uint_as_float(rr[0]), __uint_as_float(rr[1])); }
__device__ __forceinline__ float xhalf_sum(float v) { auto rr = __builtin_amdgcn_permlane32_swap(__float_as_uint(v), __float_as_uint(v), false, false); return __uint_as_float(rr[0]) + __uint_as_float(rr[1]); }
#define XB_TMO      128
#define XB_XCNT(j)  (256  + 64 * (j))
#define XB_XSUB(j)  (1280 + 64 * (j))
#define XB_XGEN(j)  (2304 + 64 * (j))
#define XB_TOP      3328
#define XB_TOPGEN   3392
#define XCD_BAR_WORDS 3456
#define XB_SPIN_CAP (1u << 18)

__device__ __forceinline__ unsigned xb_ld(unsigned* p)              { return __hip_atomic_load(p, __ATOMIC_RELAXED, __HIP_MEMORY_SCOPE_AGENT); }
__device__ __forceinline__ unsigned xb_add(unsigned* p, unsigned v) { return __hip_atomic_fetch_add(p, v, __ATOMIC_RELAXED, __HIP_MEMORY_SCOPE_AGENT); }
__device__ __forceinline__ unsigned xb_xcc_id() { return (unsigned)__builtin_amdgcn_s_getreg((3 << 11) | 20) & 0xFu; }
#define XB_SPIN(cond, bar) do { unsigned _sp = 0; while (cond) { __builtin_amdgcn_s_sleep(1); \
    if ((++_sp & 255u) == 0u) { if (xb_ld(&(bar)[XB_TMO])) break; if (_sp > XB_SPIN_CAP) { atomicAdd(&(bar)[XB_TMO], 1u); break; } } } } while (0)

struct XcdBarrier {
    unsigned* bar; unsigned x;
    volatile LAS unsigned* st;
};

__device__ __forceinline__ XcdBarrier xcd_barrier_post(unsigned* bar, volatile LAS unsigned* st) {
    XcdBarrier b; b.bar = bar; b.x = xb_xcc_id(); b.st = st;
    if (threadIdx.x == 0) (void)xb_add(&bar[XB_XCNT(b.x)], 1u);
    return b;
}
__device__ __forceinline__ void xcd_barrier_complete(unsigned* bar, unsigned x, unsigned& nloc, unsigned& nx) {
    const unsigned G = gridDim.x * gridDim.y * gridDim.z;
    unsigned sum, cnt, mine, sp = 0u;
    for (;;) {
        sum = 0u; cnt = 0u; mine = 0u;
#pragma unroll
        for (unsigned j = 0; j < 16; ++j) { const unsigned c = xb_ld(&bar[XB_XCNT(j)]); sum += c; cnt += (c > 0u) ? 1u : 0u; mine = (j == x) ? c : mine; }
        if (sum == G) break;
        __builtin_amdgcn_s_sleep(1);
        if ((++sp & 255u) == 0u) { if (xb_ld(&bar[XB_TMO])) break; if (sp > XB_SPIN_CAP) { atomicAdd(&bar[XB_TMO], 1u); break; } }
    }
    nloc = mine > 0u ? mine : 1u; nx = cnt > 0u ? cnt : 1u;
}

__device__ __forceinline__ void xcd_barrier(const XcdBarrier& b) {
    asm volatile("s_waitcnt vmcnt(0)" ::: "memory");
    __syncthreads();
    if (threadIdx.x == 0) {
        unsigned* bar = b.bar;
        __builtin_amdgcn_s_waitcnt(0);
        unsigned nloc = b.st[0], nx = b.st[1];
        if (nloc == 0u) { xcd_barrier_complete(bar, b.x, nloc, nx); b.st[0] = nloc; b.st[1] = nx; }
        const unsigned old = xb_add(&bar[XB_XSUB(b.x)], 1u);
        const unsigned gen = old / nloc;
        if (old + 1u == (gen + 1u) * nloc) {
            __builtin_amdgcn_fence(__ATOMIC_RELEASE, "agent");
            asm volatile("s_waitcnt vmcnt(0)" ::: "memory");
            const unsigned og = xb_add(&bar[XB_TOP], 1u);
            const unsigned tg = og / nx;
            if (og + 1u == (tg + 1u) * nx) xb_add(&bar[XB_TOPGEN], 1u);
            else XB_SPIN(xb_ld(&bar[XB_TOPGEN]) == tg, bar);
            __builtin_amdgcn_fence(__ATOMIC_ACQUIRE, "agent");
            xb_add(&bar[XB_XGEN(b.x)], 1u);
            asm volatile("s_waitcnt vmcnt(0)" ::: "memory");
        } else {
            XB_SPIN(xb_ld(&bar[XB_XGEN(b.x)]) == gen, bar);
            __builtin_amdgcn_fence(__ATOMIC_ACQUIRE, "agent");
            asm volatile("s_waitcnt vmcnt(0)" ::: "memory");
        }
    }
    __syncthreads();
}
struct Frame {
    LAS unsigned char* lds;
    volatile LAS unsigned* MISC;
    unsigned* ctl;
    int tid, lane, wave, vcu, G; unsigned char* wsb;
    const float* in[20]; float* out;
    __device__ __forceinline__ bf16* WGU() const { return (bf16*)(wsb + WS_WGU); }
    __device__ __forceinline__ bf16* WD() const { return (bf16*)(wsb + WS_WD); }
    __device__ __forceinline__ bf16* H() const { return (bf16*)(wsb + WS_H); }
    __device__ __forceinline__ bf16* WB() const { return (bf16*)(wsb + WS_WB); }
    __device__ __forceinline__ bf16* PA() const { return (bf16*)(wsb + WS_BIG); }
    __device__ __forceinline__ bf16* PB() const { return (bf16*)(wsb + WS_PB); }
    __device__ __forceinline__ bf16* ACT() const { return (bf16*)(wsb + WS_BIG); }
    __device__ __forceinline__ bf16* OG() const { return (bf16*)(wsb + WS_OG); }
    __device__ __forceinline__ bf16* OM() const { return (bf16*)(wsb + WS_OM); }
    __device__ __forceinline__ bf16* WBG() const { return (bf16*)(wsb + WS_WBG); }
    __device__ __forceinline__ bf16* WBM() const { return (bf16*)(wsb + WS_WBM); }
    __device__ __forceinline__ bf16* WO() const { return (bf16*)(wsb + WS_WO); }
    __device__ __forceinline__ bf16* QN() const { return (bf16*)(wsb + WS_QN); }
    __device__ __forceinline__ bf16* KN() const { return (bf16*)(wsb + WS_KN); }
    __device__ __forceinline__ bf16* VP() const { return (bf16*)(wsb + WS_VP); }
    __device__ __forceinline__ bf16* KNT() const { return (bf16*)(wsb + WS_KNT); }
    __device__ __forceinline__ bf16* MQ() const { return (bf16*)(wsb + WS_MQ); }
    __device__ __forceinline__ bf16* MK() const { return (bf16*)(wsb + WS_MK); }
    __device__ __forceinline__ bf16* MV() const { return (bf16*)(wsb + WS_MV); }
    __device__ __forceinline__ bf16* U() const { return (bf16*)(wsb + WS_U); }
    __device__ __forceinline__ bf16* W() const { return (bf16*)(wsb + WS_W); }
    __device__ __forceinline__ bf16* AT() const { return (bf16*)(wsb + WS_AT); }
    __device__ __forceinline__ bf16* KMH() const { return (bf16*)(wsb + WS_KMEAN); }
    __device__ __forceinline__ bf16* KML() const { return (bf16*)(wsb + (WS_KMEAN + 262144)); }
    __device__ __forceinline__ float* AB() const { return (float*)(wsb + WS_AB); }
    __device__ __forceinline__ float* GG() const { return (float*)(wsb + WS_G); }
    __device__ __forceinline__ float* BETA() const { return (float*)(wsb + WS_BETA); }
    __device__ __forceinline__ float* Y1() const { return (float*)(wsb + WS_Y1); }
    __device__ __forceinline__ float* GC() const { return (float*)(wsb + WS_GC); }
    __device__ __forceinline__ f32x2* ROPE() const { return (f32x2*)(wsb + WS_ROPE); }
    __device__ __forceinline__ unsigned char* H8() const { return wsb + WS_H8; }
    __device__ __forceinline__ unsigned char* W8() const { return wsb + WS_W8; }
    __device__ __forceinline__ unsigned* CM(int f) const { return (unsigned*)(wsb + WS_CTL + (256 + 128 * f) * 1024); }
    __device__ __forceinline__ unsigned* CMW() const { return (unsigned*)(wsb + WS_CTL + 640 * 1024); }
    __device__ __forceinline__ unsigned* RM(int f) const { return (unsigned*)(wsb + WS_CTL + (768 + 64 * f) * 1024); }
    __device__ __forceinline__ unsigned* CMD(int f) const { return (unsigned*)(wsb + WS_CTL + (896 + 16 * f) * 1024); }
    __device__ __forceinline__ unsigned char* ACT8() const { return wsb + WS_PB; }
    __device__ __forceinline__ float* RS() const { return (float*)(wsb + WS_CTL + 512 * 1024); }
};

template <int MODE> __device__ __forceinline__ int rowmap(int n0) {
    if (MODE == 0) return n0;
    if (MODE == 1) return 256 * (n0 >> 7) + (n0 & 127);
    if (MODE == 2) return 256 * (n0 >> 7) + 128 + (n0 & 127);
    if (MODE == 3) return n0 < 8192 ? n0 : (n0 < 12288 ? n0 + 4096 : (n0 < 12352 ? 16384 + (n0 - 12288) : n0 - 4160));
    return n0 - 16448;
}
__device__ __forceinline__ bool win_i8(int n0) { return n0 >= 16448; }
__device__ __forceinline__ const float* tr_src(const float* W, int N, int item, int lane, int nblk_ = 0) { const int nblk = nblk_ ? nblk_ : (N >> 6), kb = item / nblk, nb = item - kb * nblk; return W + (size_t)(kb << 6) * N + (nb << 6) + lane; }
__device__ __forceinline__ void tr_load(const float* src, int N, float (&v)[64]) {
#pragma unroll
    for (int j = 0; j < 64; ++j) v[j] = __builtin_nontemporal_load(src + (size_t)j * N);
}
__device__ __forceinline__ void tr_put(LAS float* scr, const float (&v)[64], int lane) {
#pragma unroll
    for (int j = 0; j < 64; ++j) scr[j * 65 + lane] = v[j];
    LDS_WAIT();
}
template <int MODE> __device__ __forceinline__ void tr_out(int K, int N, bf16* WT, LAS float* scr, int item, int lane, int nblk_ = 0) {
    const int nblk = nblk_ ? nblk_ : (N >> 6), kb = item / nblk, nb = item - kb * nblk, k0 = kb << 6, n0 = nb << 6;
    const int c = lane & 7, r = lane >> 3, drow = rowmap<MODE>(n0);
#pragma unroll
    for (int j = 0; j < 8; ++j) { const int n = r + 8 * j; const LAS float* s = scr + (8 * c) * 65 + n;
        v4u o; o.x = pk2(s[0], s[65]); o.y = pk2(s[130], s[195]); o.z = pk2(s[260], s[325]); o.w = pk2(s[390], s[455]);
        *(v4u*)(WT + (size_t)(drow + n) * K + k0 + 8 * c) = o; }
    LDS_WAIT();
}
__device__ __forceinline__ unsigned pk4_fp8(float a, float b, float c, float d) { int w = 0; w = __builtin_amdgcn_cvt_pk_fp8_f32(a, b, w, false); w = __builtin_amdgcn_cvt_pk_fp8_f32(c, d, w, true); return (unsigned)w; }
__device__ __forceinline__ void tr_out8(int K, int N, unsigned char* WT, int drow, LAS float* scr, int item, int lane) {
    const int nblk = N >> 6, kb = item / nblk, nb = item - kb * nblk, k0 = kb << 6, n0 = nb << 6;
    const int c = lane & 7, r = lane >> 3;
#pragma unroll
    for (int j = 0; j < 8; ++j) { const int n = r + 8 * j; const LAS float* sp = scr + (8 * c) * 65 + n;
        v2u o; o.x = pk4_fp8(sp[0] * 64.f, sp[65] * 64.f, sp[130] * 64.f, sp[195] * 64.f); o.y = pk4_fp8(sp[260] * 64.f, sp[325] * 64.f, sp[390] * 64.f, sp[455] * 64.f);
        *(v2u*)(WT + (size_t)(drow + n0 + n) * K + k0 + 8 * c) = o; }
    LDS_WAIT();
}
__device__ __forceinline__ unsigned pk4_i8(float a, float b, float c, float d) {
    const int ia = (int)__builtin_rintf(a), ib = (int)__builtin_rintf(b), ic = (int)__builtin_rintf(c), id = (int)__builtin_rintf(d);
    return (unsigned)(ia & 0xff) | ((unsigned)(ib & 0xff) << 8) | ((unsigned)(ic & 0xff) << 16) | ((unsigned)id << 24); }
template <int MODE> __device__ __forceinline__ void tr_q_i8(int N, const unsigned* CM, int item, int lane, float (&q)[8]) {
    const int nblk = N >> 6, kb = item / nblk, nb = item - kb * nblk, n0 = nb << 6, r = lane >> 3, drow = rowmap<MODE>(n0);
#pragma unroll
    for (int j = 0; j < 8; ++j) q[j] = 127.0f / fmaxf(__uint_as_float(CM[drow + r + 8 * j]), 1e-30f);
}
template <int MODE> __device__ __forceinline__ void tr_out_i8(int K, int N, unsigned char* WT, const float (&q)[8], LAS float* scr, int item, int lane) {
    const int nblk = N >> 6, kb = item / nblk, nb = item - kb * nblk, k0 = kb << 6, n0 = nb << 6;
    const int c = lane & 7, r = lane >> 3, drow = rowmap<MODE>(n0);
#pragma unroll
    for (int j = 0; j < 8; ++j) { const int n = r + 8 * j; const LAS float* sp = scr + (8 * c) * 65 + n; const float qq = q[j];
        v2u o; o.x = pk4_i8(sp[0] * qq, sp[65] * qq, sp[130] * qq, sp[195] * qq); o.y = pk4_i8(sp[260] * qq, sp[325] * qq, sp[390] * qq, sp[455] * qq);
        *(v2u*)(WT + (size_t)(drow + n) * K + k0 + 8 * c) = o; }
    LDS_WAIT();
}
__device__ __forceinline__ void colmax_ffn(Frame& F, const float* wg, const float* wu, unsigned* CM) {
    const int gw = F.vcu * NWAVES + F.wave, NGW = F.G * NWAVES, lane = F.lane;
    constexpr int I1 = (DM / 64) * (FF / 64);
    for (int it = gw; it < 2 * I1; it += NGW) {
        const bool up = it >= I1; const int item = up ? it - I1 : it; const int nb = item % (FF / 64), n0 = nb << 6;
        const float* s = tr_src(up ? wu : wg, FF, item, lane);
        float v[64]; tr_load(s, FF, v);
        float mx = 0.f;
#pragma unroll
        for (int j = 0; j < 64; ++j) mx = fmaxf(mx, fabsf(v[j]));
        atomicMax(CM + (up ? rowmap<2>(n0) : rowmap<1>(n0)) + lane, __float_as_uint(mx));
    }
}
__device__ __forceinline__ void strip_quant_i8(Frame& F, const float* W, int N, int c0, int drow0, unsigned char* WT, float* CS) {
    LAS float* xch = (LAS float*)(F.lds + 150528);
    int lane_a = threadIdx.x & 63; asm volatile("" : "+v"(lane_a));
    const int r0 = F.wave * 512;
    const char* bu = (const char*)W + ((size_t)r0 * N + c0) * 4;
    const unsigned voff = (unsigned)(32 * (lane_a >> 5) * N + (lane_a & 31)) * 4u;
    unsigned v[128]; float mx = 0.f; float ta[32], tb[32];
#define SQ_LOAD(t, i) do { _Pragma("unroll") for (int j = 0; j < 32; ++j) t[j] = __builtin_nontemporal_load((const float*)(bu + (size_t)(64 * (i) + j) * N * 4 + voff)); } while (0)
#define SQ_PACK(t, i) do { _Pragma("unroll") for (int j = 0; j < 16; ++j) { unsigned w = pk2(t[2 * j], t[2 * j + 1]); mx = fmaxf(mx, fmaxf(fabsf(blo(w)), fabsf(bhi(w)))); asm volatile("" : "+v"(w)); v[16 * (i) + j] = w; }   \
        __builtin_amdgcn_sched_barrier(0); } while (0)
    SQ_LOAD(ta, 0);
#pragma unroll
    for (int i = 0; i < 8; i += 2) {
        SQ_LOAD(tb, i + 1); SQ_PACK(ta, i);
        if (i + 2 < 8) SQ_LOAD(ta, i + 2);
        SQ_PACK(tb, i + 1); }
#undef SQ_LOAD
#undef SQ_PACK
    int lane = threadIdx.x & 63; asm volatile("" : "+v"(lane));
    const int col = lane & 31, half = lane >> 5;
    mx = xhalf_max(mx);
    if (lane < 32) xch[F.wave * 32 + lane] = mx;
    __syncthreads();
    float cm = 0.f;
#pragma unroll
    for (int w = 0; w < 8; ++w) cm = fmaxf(cm, xch[w * 32 + col]);
    __syncthreads();
    if (F.wave == 0 && lane < 32) CS[drow0 + col] = cm;
    const float q = 127.0f / fmaxf(cm, 1e-30f);
    unsigned char* dst = WT + (size_t)(drow0 + col) * DM + r0 + 32 * half;
#pragma unroll
    for (int i = 0; i < 8; ++i) { v4u o0, o1;
        o0.x = pk4_i8(blo(v[16 * i + 0]) * q, bhi(v[16 * i + 0]) * q, blo(v[16 * i + 1]) * q, bhi(v[16 * i + 1]) * q); o0.y = pk4_i8(blo(v[16 * i + 2]) * q, bhi(v[16 * i + 2]) * q, blo(v[16 * i + 3]) * q, bhi(v[16 * i + 3]) * q);
        o0.z = pk4_i8(blo(v[16 * i + 4]) * q, bhi(v[16 * i + 4]) * q, blo(v[16 * i + 5]) * q, bhi(v[16 * i + 5]) * q); o0.w = pk4_i8(blo(v[16 * i + 6]) * q, bhi(v[16 * i + 6]) * q, blo(v[16 * i + 7]) * q, bhi(v[16 * i + 7]) * q);
        o1.x = pk4_i8(blo(v[16 * i + 8]) * q, bhi(v[16 * i + 8]) * q, blo(v[16 * i + 9]) * q, bhi(v[16 * i + 9]) * q); o1.y = pk4_i8(blo(v[16 * i + 10]) * q, bhi(v[16 * i + 10]) * q, blo(v[16 * i + 11]) * q, bhi(v[16 * i + 11]) * q);
        o1.z = pk4_i8(blo(v[16 * i + 12]) * q, bhi(v[16 * i + 12]) * q, blo(v[16 * i + 13]) * q, bhi(v[16 * i + 13]) * q); o1.w = pk4_i8(blo(v[16 * i + 14]) * q, bhi(v[16 * i + 14]) * q, blo(v[16 * i + 15]) * q, bhi(v[16 * i + 15]) * q);
        *(v4u*)(dst + 64 * i) = o0; *(v4u*)(dst + 64 * i + 16) = o1; }
}
__device__ __forceinline__ void strip_quant_wd(Frame& F, const float* W, int c0, unsigned char* WT, float* CS) {
    LAS float* xch = (LAS float*)(F.lds + 150528);
    int lane_a = threadIdx.x & 63; asm volatile("" : "+v"(lane_a));
    const int wave = F.wave, g0 = wave < 4 ? wave * 22 : 88 + (wave - 4) * 21, ng = wave < 4 ? 22 : 21;
    const char* bu = (const char*)W + ((size_t)(g0 * 64) * DM + c0) * 4;
    const int qa = lane_a >> 4; const unsigned voff = (unsigned)(16 * qa * DM + (lane_a & 15)) * 4u;
    unsigned v[176]; float mx = 0.f; float ta[16], tb[16];
#define WD_LOAD(t, i) do { _Pragma("unroll") for (int j = 0; j < 16; ++j) t[j] = *(const float*)(bu + (size_t)(64 * (i) + j) * DM * 4 + voff); } while (0)
#define WD_ROT(t, i) do { \
        _Pragma("unroll") for (int h = 1; h < 16; h <<= 1) _Pragma("unroll") for (int j = 0; j < 16; ++j) if (!(j & h)) { const float a = t[j], b = t[j + h]; t[j] = a + b; t[j + h] = a - b; } \
        _Pragma("unroll") for (int j = 0; j < 16; ++j) { auto a = __builtin_amdgcn_permlane16_swap(__float_as_uint(t[j]), __float_as_uint(t[j]), false, false); \
            const float lo = __uint_as_float(a[0]), hi = __uint_as_float(a[1]); t[j] = (qa & 1) ? lo - hi : lo + hi; } \
        _Pragma("unroll") for (int j = 0; j < 16; ++j) { auto b = __builtin_amdgcn_permlane32_swap(__float_as_uint(t[j]), __float_as_uint(t[j]), false, false); \
            const float lo = __uint_as_float(b[0]), hi = __uint_as_float(b[1]); t[j] = ((qa & 2) ? lo - hi : lo + hi) * 0.125f; } \
        _Pragma("unroll") for (int j = 0; j < 8; ++j) { unsigned w = pk2(t[2 * j], t[2 * j + 1]); mx = fmaxf(mx, fmaxf(fabsf(blo(w)), fabsf(bhi(w)))); asm volatile("" : "+v"(w)); v[8 * (i) + j] = w; } \
        __builtin_amdgcn_sched_barrier(0); } while (0)
    WD_LOAD(ta, 0);
#pragma unroll
    for (int i = 0; i < 16; i += 2) {
        WD_LOAD(tb, i + 1);
        WD_ROT(ta, i);
        if (i + 2 < 16) WD_LOAD(ta, i + 2);
        WD_ROT(tb, i + 1);
    }
#pragma unroll
    for (int i = 16; i < 22; ++i) {
        if (i < ng) { WD_LOAD(ta, i); WD_ROT(ta, i); } else {
#pragma unroll
            for (int j = 0; j < 8; ++j) v[8 * i + j] = 0u; }
    }
#undef WD_LOAD
#undef WD_ROT
    int lane = threadIdx.x & 63; asm volatile("" : "+v"(lane));
    const int col = lane & 15, q4 = lane >> 4;
    { auto a = __builtin_amdgcn_permlane16_swap(__float_as_uint(mx), __float_as_uint(mx), false, false); mx = fmaxf(__uint_as_float(a[0]), __uint_as_float(a[1]));
      auto b = __builtin_amdgcn_permlane32_swap(__float_as_uint(mx), __float_as_uint(mx), false, false); mx = fmaxf(__uint_as_float(b[0]), __uint_as_float(b[1])); }
    if (lane < 16) xch[wave * 16 + lane] = mx;
    __syncthreads();
    float cm = 0.f;
#pragma unroll
    for (int w = 0; w < 8; ++w) cm = fmaxf(cm, xch[w * 16 + col]);
    __syncthreads();
    if (wave == 0 && lane < 16) CS[c0 + col] = cm;
    const float qq = 127.0f / fmaxf(cm, 1e-30f);
    unsigned char* dst = WT + (size_t)(c0 + col) * FF + (size_t)g0 * 64 + 16 * q4;
#pragma unroll
    for (int i = 0; i < 22; ++i) if (i < ng) { v4u o;
        o.x = pk4_i8(blo(v[8 * i + 0]) * qq, bhi(v[8 * i + 0]) * qq, blo(v[8 * i + 1]) * qq, bhi(v[8 * i + 1]) * qq); o.y = pk4_i8(blo(v[8 * i + 2]) * qq, bhi(v[8 * i + 2]) * qq, blo(v[8 * i + 3]) * qq, bhi(v[8 * i + 3]) * qq);
        o.z = pk4_i8(blo(v[8 * i + 4]) * qq, bhi(v[8 * i + 4]) * qq, blo(v[8 * i + 5]) * qq, bhi(v[8 * i + 5]) * qq); o.w = pk4_i8(blo(v[8 * i + 6]) * qq, bhi(v[8 * i + 6]) * qq, blo(v[8 * i + 7]) * qq, bhi(v[8 * i + 7]) * qq);
        *(v4u*)(dst + 64 * i) = o; }
}
__device__ __forceinline__ void quant_wd(Frame& F, const float* wd, float* CS) { for (int s = F.vcu; s < DM / 16; s += F.G) strip_quant_wd(F, wd, 16 * s, (unsigned char*)F.WD(), CS); }
__device__ __forceinline__ void quant_ffn_gu(Frame& F, const float* wg, const float* wu, float* CS) {
    for (int s = blockIdx.x; s < 2 * (FF / 32); s += F.G) { const bool up = s >= FF / 32; const int c0 = (up ? s - FF / 32 : s) * 32;
        strip_quant_i8(F, up ? wu : wg, FF, c0, up ? rowmap<2>(c0) : rowmap<1>(c0), (unsigned char*)F.WGU(), CS); }
}
__device__ __forceinline__ void fwht32x2(float (&v)[64]) {
#pragma unroll
    for (int h = 1; h < 64; h <<= 1)
#pragma unroll
        for (int j = 0; j < 64; ++j) if (!(j & h)) { const float a = v[j], b = v[j + h]; v[j] = a + b; v[j + h] = a - b; }
#pragma unroll
    for (int j = 0; j < 64; ++j) v[j] *= 0.125f;
}
__device__ __forceinline__ void colmax_wd(Frame& F, const float* wd, unsigned* CMD) {
    const int gw = F.vcu * NWAVES + F.wave, NGW = F.G * NWAVES, lane = F.lane;
    constexpr int I2 = (FF / 64) * (DM / 64);
    for (int it = gw; it < I2; it += NGW) { const int n0 = (it % (DM / 64)) << 6;
        float v[64]; tr_load(tr_src(wd, DM, it, lane), DM, v);
        fwht32x2(v);
        float mx = 0.f;
#pragma unroll
        for (int j = 0; j < 64; ++j) mx = fmaxf(mx, fabsf(v[j]));
        atomicMax(CMD + n0 + lane, __float_as_uint(mx));
    }
}
__device__ __forceinline__ void requant_rows(Frame& F, const bf16* A, unsigned char* A8, float* RS) {
    const int gw = F.vcu * NWAVES + F.wave, NGW = F.G * NWAVES;
    constexpr int NV = FF / 8;
    const float s1 = (F.lane & 1) ? -1.0f : 1.0f, s2 = (F.lane & 2) ? -1.0f : 1.0f, s4 = (F.lane & 4) ? -1.0f : 1.0f;
    for (int m = gw; m < M; m += NGW) {
        const v4u* src = (const v4u*)(A + (size_t)m * FF); v2u* dst = (v2u*)(A8 + (size_t)m * FF);
        v4u w[22];
#pragma unroll
        for (int j = 0; j < 22; ++j) { const int idx = F.lane + 64 * j; w[j] = (v4u){0u, 0u, 0u, 0u}; if (idx < NV) w[j] = src[idx]; }
        float mx = 0.f;
#pragma unroll
        for (int j = 0; j < 22; ++j) {
            float x[8] = {blo(w[j].x), bhi(w[j].x), blo(w[j].y), bhi(w[j].y), blo(w[j].z), bhi(w[j].z), blo(w[j].w), bhi(w[j].w)};
#pragma unroll
            for (int h = 1; h < 8; h <<= 1)
#pragma unroll
                for (int i = 0; i < 8; ++i) if (!(i & h)) { const float a = x[i], b = x[i + h]; x[i] = a + b; x[i + h] = a - b; }
#pragma unroll
            for (int i = 0; i < 8; ++i) x[i] = __builtin_fmaf(s1, x[i], dpp_f<0xB1, 0xf>(x[i]));
#pragma unroll
            for (int i = 0; i < 8; ++i) x[i] = __builtin_fmaf(s2, x[i], dpp_f<0x4E, 0xf>(x[i]));
#pragma unroll
            for (int i = 0; i < 8; ++i) x[i] = __builtin_fmaf(s4, x[i], __int_as_float(__builtin_amdgcn_ds_swizzle(__float_as_int(x[i]), 0x101F))) * 0.125f;
            w[j].x = pk2(x[0], x[1]); w[j].y = pk2(x[2], x[3]); w[j].z = pk2(x[4], x[5]); w[j].w = pk2(x[6], x[7]);
            mx = fmaxf(mx, fmaxf(fmaxf(fmaxf(fabsf(blo(w[j].x)), fabsf(bhi(w[j].x))), fmaxf(fabsf(blo(w[j].y)), fabsf(bhi(w[j].y)))), fmaxf(fmaxf(fabsf(blo(w[j].z)), fabsf(bhi(w[j].z))), fmaxf(fabsf(blo(w[j].w)), fabsf(bhi(w[j].w))))));
        }
        mx = fmaxf(wave_max(mx), 1e-30f);
        const float q = 127.0f / mx;
#pragma unroll
        for (int j = 0; j < 22; ++j) { const int idx = F.lane + 64 * j;
            if (idx < NV) { v2u o; o.x = pk4_i8(blo(w[j].x) * q, bhi(w[j].x) * q, blo(w[j].y) * q, bhi(w[j].y) * q); o.y = pk4_i8(blo(w[j].z) * q, bhi(w[j].z) * q, blo(w[j].w) * q, bhi(w[j].w) * q); dst[idx] = o; } }
        if (F.lane == 0) RS[m] = mx * (1.0f / 127.0f);
    }
}
template <class SRC, class XF, class PRE, class OUT> __device__ __forceinline__ void tr_pipeline(int it0, int itEnd, int step, LAS float* scr, int lane, SRC srcf, XF xf, PRE pref, OUT outf) {
    if (it0 >= itEnd) return;
    float v[64]; const float* s; int N;
    srcf(it0, s, N); tr_load(s, N, v);
    for (int it = it0;;) {
        xf(it, v);
        tr_put(scr, v, lane);
        float q[8]; pref(it, q);
        const int nx = it + step;
        if (nx < itEnd) { srcf(nx, s, N); tr_load(s, N, v); }
        outf(it, q);
        if (nx >= itEnd) break;
        it = nx;
    }
}
__device__ __forceinline__ void convert_wd(Frame& F, const float* wd, const unsigned* CMD) {
    LAS float* scr = (LAS float*)(F.lds + F.wave * TR_STRIDE);
    const int gw = F.vcu * NWAVES + F.wave, NGW = F.G * NWAVES, lane = F.lane;
    constexpr int I2 = (FF / 64) * (DM / 64);
    unsigned char* wdt = (unsigned char*)F.WD();
    tr_pipeline(gw, I2, NGW, scr, lane,
        [&](int it, const float*& s, int& N) { s = tr_src(wd, DM, it, lane); N = DM; },
        [&](int, float (&v)[64]) { fwht32x2(v); },
        [&](int it, float (&q)[8]) { tr_q_i8<0>(DM, CMD, it, lane, q); },
        [&](int it, const float (&q)[8]) { tr_out_i8<0>(FF, DM, wdt, q, scr, it, lane); });
}
__device__ __forceinline__ void convert_win(Frame& F) {
    LAS float* scr = (LAS float*)(F.lds + F.wave * TR_STRIDE);
    const int gw = F.vcu * NWAVES + F.wave, NGW = F.G * NWAVES, lane = F.lane;
    constexpr int NB = 16448 / 64, I1 = (DM / 64) * NB;
    const float* win = F.in[6]; bf16* wb = F.WB();
    tr_pipeline(gw, I1, NGW, scr, lane,
        [&](int it, const float*& s, int& N) { s = tr_src(win, 26688, it, lane, NB); N = 26688; },
        [&](int, float (&)[64]) {},
        [&](int, float (&)[8]) {},
        [&](int it, const float (&)[8]) { tr_out<3>(DM, 26688, wb, scr, it, lane, NB); });
    __syncthreads();
    for (int s = blockIdx.x; s < (26688 - 16448) / 32; s += F.G) { const int c0 = 16448 + 32 * s; strip_quant_i8(F, win, 26688, c0, c0 - 16448, F.W8(), (float*)F.CMW()); }
}
__device__ __forceinline__ void colmax_win(Frame& F) {
    const int gw = F.vcu * NWAVES + F.wave, NGW = F.G * NWAVES, lane = F.lane;
    constexpr int NB = 26688 / 64, I1 = (DM / 64) * NB;
    unsigned* cm = F.CMW();
    for (int it = gw; it < I1; it += NGW) { const int n0 = (it % NB) << 6;
        if (!win_i8(n0)) continue;
        float v[64]; tr_load(tr_src(F.in[6], 26688, it, lane), 26688, v);
        float mx = 0.f;
#pragma unroll
        for (int j = 0; j < 64; ++j) mx = fmaxf(mx, fabsf(v[j]));
        atomicMax(cm + rowmap<4>(n0) + lane, __float_as_uint(mx));
    }
}
__device__ __forceinline__ void convert_branch(Frame& F) {
    LAS float* scr = (LAS float*)(F.lds + F.wave * TR_STRIDE);
    const int gw = F.vcu * NWAVES + F.wave, NGW = F.G * NWAVES, lane = F.lane;
    constexpr int IG = 64 * 64, IM = 32 * 64;
    const float* w13 = F.in[13]; const float* w14 = F.in[14]; const float* w15 = F.in[15]; bf16* wbg = F.WBG(); unsigned char* wbm = (unsigned char*)F.WBM(); bf16* wo = F.WO();
    tr_pipeline(gw, 2 * IG + IM, NGW, scr, lane,
        [&](int it, const float*& s, int& N) { N = 4096; if (it < IG) s = tr_src(w13, 4096, it, lane); else if (it < IG + IM) s = tr_src(w14, 4096, it - IG, lane); else s = tr_src(w15, 4096, it - IG - IM, lane); },
        [&](int, float (&)[64]) {},
        [&](int, float (&)[8]) {},
        [&](int it, const float (&)[8]) { if (it < IG) tr_out<0>(4096, 4096, wbg, scr, it, lane);
                      else if (it < IG + IM) tr_out8(2048, 4096, wbm, 0, scr, it - IG, lane);
                      else tr_out<0>(4096, 4096, wo, scr, it - IG - IM, lane); });
}
__device__ __forceinline__ void rms_rows(Frame& F, const float* X, const float* gain, bf16* O, unsigned char* O8 = nullptr) {
    LAS f32x4* gl = (LAS f32x4*)(F.lds + 8 * TR_STRIDE);
    for (int i = F.tid; i < DM / 4; i += NWAVES * 64) gl[i] = ((const f32x4*)gain)[i];
    __syncthreads();
    const int gw = F.vcu * NWAVES + F.wave, NGW = F.G * NWAVES;
    int m = gw; if (m >= M) return;
    f32x4 v[16], nv[16];
    { const f32x4* xr = (const f32x4*)(X + (size_t)m * DM) + F.lane;
#pragma unroll
      for (int j = 0; j < 16; ++j) v[j] = xr[64 * j]; }
    for (;;) {
        const int mn = m + NGW;
        if (mn < M) { const f32x4* xr = (const f32x4*)(X + (size_t)mn * DM) + F.lane;
#pragma unroll
            for (int j = 0; j < 16; ++j) nv[j] = xr[64 * j]; }
        float s = 0.f;
#pragma unroll
        for (int j = 0; j < 16; ++j) s += (v[j].x * v[j].x + v[j].y * v[j].y) + (v[j].z * v[j].z + v[j].w * v[j].w);
        const float r = 1.0f / sqrtf(wave_sum(s) * (1.0f / DM) + NORM_EPS);
        v2u* o8 = (v2u*)(O + (size_t)m * DM) + F.lane;
#pragma unroll
        for (int j = 0; j < 16; ++j) { const f32x4 g = gl[F.lane + 64 * j]; const float a = v[j].x * r * g.x, b = v[j].y * r * g.y, c = v[j].z * r * g.z, d = v[j].w * r * g.w;
            v2u w; w.x = pk2(a, b); w.y = pk2(c, d); o8[64 * j] = w;
            if (O8) ((unsigned*)(O8 + (size_t)m * DM))[F.lane + 64 * j] = pk4_fp8(a, b, c, d); }
        if (mn >= M) break;
#pragma unroll
        for (int j = 0; j < 16; ++j) v[j] = nv[j];
        m = mn;
    }
}
__device__ __forceinline__ void rms_rows_i8(Frame& F, const float* X, const float* gain, unsigned char* O, float* RS, bf16* Ob = nullptr) {
    LAS f32x4* gl = (LAS f32x4*)(F.lds + 8 * TR_STRIDE);
    for (int i = F.tid; i < DM / 4; i += NWAVES * 64) gl[i] = ((const f32x4*)gain)[i];
    __syncthreads();
    const int gw = F.vcu * NWAVES + F.wave, NGW = F.G * NWAVES;
    int m = gw; if (m >= M) return;
    f32x4 v[16], nv[16];
    { const f32x4* xr = (const f32x4*)(X + (size_t)m * DM) + F.lane;
#pragma unroll
      for (int j = 0; j < 16; ++j) v[j] = xr[64 * j]; }
    for (;;) {
        const int mn = m + NGW;
        if (mn < M) { const f32x4* xr = (const f32x4*)(X + (size_t)mn * DM) + F.lane;
#pragma unroll
            for (int j = 0; j < 16; ++j) nv[j] = xr[64 * j]; }
        float s = 0.f;
#pragma unroll
        for (int j = 0; j < 16; ++j) s += (v[j].x * v[j].x + v[j].y * v[j].y) + (v[j].z * v[j].z + v[j].w * v[j].w);
        const float r = 1.0f / sqrtf(wave_sum(s) * (1.0f / DM) + NORM_EPS);
        float mx = 0.f;
#pragma unroll
        for (int j = 0; j < 16; ++j) { const f32x4 g = gl[F.lane + 64 * j]; v[j].x *= r * g.x; v[j].y *= r * g.y; v[j].z *= r * g.z; v[j].w *= r * g.w;
            mx = fmaxf(fmaxf(mx, fmaxf(fabsf(v[j].x), fabsf(v[j].y))), fmaxf(fabsf(v[j].z), fabsf(v[j].w))); }
        if (Ob) { v2u* ob = (v2u*)(Ob + (size_t)m * DM) + F.lane;
#pragma unroll
            for (int j = 0; j < 16; ++j) { v2u w; w.x = pk2(v[j].x, v[j].y); w.y = pk2(v[j].z, v[j].w); ob[64 * j] = w; } }
        mx = fmaxf(wave_max(mx), 1e-30f);
        const float q = 127.0f / mx;
        unsigned* o = (unsigned*)(O + (size_t)m * DM) + F.lane;
#pragma unroll
        for (int j = 0; j < 16; ++j) o[64 * j] = pk4_i8(v[j].x * q, v[j].y * q, v[j].z * q, v[j].w * q);
        if (F.lane == 0) RS[m] = mx * (1.0f / 127.0f);
        if (mn >= M) break;
#pragma unroll
        for (int j = 0; j < 16; ++j) v[j] = nv[j];
        m = mn;
    }
}
__device__ __forceinline__ void rope_table(Frame& F) {
    const int gt = F.vcu * NWAVES * 64 + F.tid, NT = F.G * NWAVES * 64;
    for (int idx = gt; idx < SEQ * 64; idx += NT) {
        const int s = idx >> 6, i = idx & 63;
        double f = 1.0, bs = 0.8659643233600653; int e = i;
        while (e) { if (e & 1) f *= bs; bs *= bs; e >>= 1; }
        const float inv = (float)f; const float ang = (float)s * inv;
        const double a = (double)ang; const double k = __builtin_rint(a * 0.15915494309189535);
        double r = __builtin_fma(-k, 6.283185307179586, a); r = __builtin_fma(-k, 2.4492935982947064e-16, r);
        const double q = r * 0.25, q2 = q * q;
        const double sn = q * (1.0 + q2 * (-1.0 / 6 + q2 * (1.0 / 120 + q2 * (-1.0 / 5040 + q2 * (1.0 / 362880 + q2 * (-1.0 / 39916800 + q2 * (1.0 / 6227020800.0)))))));
        const double cs = 1.0 + q2 * (-0.5 + q2 * (1.0 / 24 + q2 * (-1.0 / 720 + q2 * (1.0 / 40320 + q2 * (-1.0 / 3628800 + q2 * (1.0 / 479001600 + q2 * (-1.0 / 87178291200.0)))))));
        const double s2 = 2.0 * sn * cs, c2 = 1.0 - 2.0 * sn * sn, s4 = 2.0 * s2 * c2, c4 = 1.0 - 2.0 * s2 * s2;
        F.ROPE()[idx] = (f32x2){(float)c4, (float)s4};
    }
}
__device__ __forceinline__ void prep_moba(Frame& F) {
    LAS float* red = (LAS float*)F.lds;
    const int w = F.wave, lane = F.lane, l = lane & 31, hh = lane >> 5;
    for (int item = blockIdx.x; item < BATCH * 16 * 16 * 3; item += F.G) {
        const int which = item % 3; int r = item / 3; const int h = r & 15; r >>= 4; const int j = r & 15; const int b = r >> 4;
        const int colbase = (which == 0 ? PA_MQ : which == 1 ? PA_MK : PA_MV) + h * 128;
        bf16* dst = (bf16*)(F.wsb + (which == 0 ? WS_MQ : which == 1 ? WS_MK : WS_MV)) + ((size_t)(b * 16 + h) * SEQ + j * 256) * 128;
        const bf16* src = F.PA() + (size_t)(b * SEQ + j * 256) * PA_LD + colbase;
        float k1a = 0.f, k1b = 0.f, k2a = 0.f, k2b = 0.f;
        if (which == 2) {
            LAS unsigned short* tl = (LAS unsigned short*)(F.lds + 4096);
#pragma unroll 8
            for (int i = 0; i < 32; ++i) { const int tt = w * 32 + i; const unsigned v = *(const unsigned*)(src + (size_t)tt * PA_LD + 2 * lane);
                tl[(2 * lane) * 258 + tt] = (unsigned short)(v & 0xffffu); tl[(2 * lane + 1) * 258 + tt] = (unsigned short)(v >> 16); }
            __syncthreads();
            bf16* vt = F.MV() + (size_t)(b * 16 + h) * 128 * SEQ + j * 256;
#pragma unroll 4
            for (int i = 0; i < 16; ++i) { const int d = w * 16 + i; const LAS unsigned* rp = (const LAS unsigned*)(tl + d * 258) + 2 * lane;
                *(v2u*)(vt + (size_t)d * SEQ + 4 * lane) = (v2u){rp[0], rp[1]}; }
        } else {
            const float* gq = F.in[11]; const float* gk = F.in[12];
            const f32x2 gqa = *(const f32x2*)(gq + 2 * l), gqb = *(const f32x2*)(gq + 64 + 2 * l), gka = *(const f32x2*)(gk + 2 * l), gkb = *(const f32x2*)(gk + 64 + 2 * l);
            const f32x2 g1 = which == 0 ? gqa : gka, g2 = which == 0 ? gqb : gkb;
#pragma unroll 4
            for (int it = 0; it < 16; ++it) { const int tt = w * 32 + 2 * it + hh, s = j * 256 + tt;
                const unsigned u1 = *(const unsigned*)(src + (size_t)tt * PA_LD + 2 * l), u2 = *(const unsigned*)(src + (size_t)tt * PA_LD + 64 + 2 * l);
                const f32x4 cs = *(const f32x4*)((const float*)F.ROPE() + (size_t)(s * 64 + 2 * l) * 2);
                const float x1a = blo(u1), x1b = bhi(u1), x2a = blo(u2), x2b = bhi(u2);
                const float hs = half_sum32((x1a * x1a + x1b * x1b) + (x2a * x2a + x2b * x2b));
                const float tot = hh ? rd_lane(hs, 63) : rd_lane(hs, 31);
                const float rr = 1.0f / sqrtf(tot * (1.0f / 128) + NORM_EPS);
                const float y1a = x1a * rr * g1.x, y1b = x1b * rr * g1.y, y2a = x2a * rr * g2.x, y2b = x2b * rr * g2.y;
                const float o1a = y1a * cs.x - y2a * cs.y, o2a = y2a * cs.x + y1a * cs.y, o1b = y1b * cs.z - y2b * cs.w, o2b = y2b * cs.z + y1b * cs.w;
                *(unsigned*)(dst + tt * 128 + 2 * l) = pk2(o1a, o1b); *(unsigned*)(dst + tt * 128 + 64 + 2 * l) = pk2(o2a, o2b);
                k1a += o1a; k1b += o1b; k2a += o2a; k2b += o2b; }
            k1a = xhalf_sum(k1a); k1b = xhalf_sum(k1b); k2a = xhalf_sum(k2a); k2b = xhalf_sum(k2b);
        }
        if (hh == 0) { *(LAS f32x2*)(red + w * 128 + 2 * l) = (f32x2){k1a, k1b}; *(LAS f32x2*)(red + w * 128 + 64 + 2 * l) = (f32x2){k2a, k2b}; }
        __syncthreads();
        if (which == 1 && F.tid < 128) { float s = 0.f;
#pragma unroll
            for (int ww = 0; ww < 8; ++ww) s += red[ww * 128 + F.tid];
            const float km = s * (1.0f / 256); const unsigned hi = f2bf(km); const float rem = km - __uint_as_float(hi << 16);
            F.KMH()[((size_t)(b * 16 + h) * 16 + j) * 128 + F.tid] = (bf16)hi; F.KML()[((size_t)(b * 16 + h) * 16 + j) * 128 + F.tid] = (bf16)f2bf(rem); }
        __syncthreads();
    }
}
__device__ __forceinline__ float bf_el(const v4u& x, int i) { const unsigned w = (i >> 1) == 0 ? x.x : (i >> 1) == 1 ? x.y : (i >> 1) == 2 ? x.z : x.w; return (i & 1) ? bhi(w) : blo(w); }
__device__ __forceinline__ void prep_gdn(Frame& F) {
    const int gw = F.vcu * NWAVES + F.wave, NGW = F.G * NWAVES, lane = F.lane, q = lane >> 4, li = lane & 15;
    const float* cw = F.in[7];
    LAS unsigned short* tl = (LAS unsigned short*)(F.lds + F.wave * PREP_STRIDE);
    for (int item = gw; item < BATCH * 64 * 64; item += NGW) {
        const int grp = item & 63, c = (item >> 6) & 63, b = item >> 12, t0 = b * SEQ + c * 64, ch = grp * 128 + 8 * li;
        float wt[4][8];
#pragma unroll
        for (int j = 0; j < 4; ++j) { const f32x4 wa = *(const f32x4*)(cw + j * 8192 + ch), wb = *(const f32x4*)(cw + j * 8192 + ch + 4);
            wt[j][0] = wa.x; wt[j][1] = wa.y; wt[j][2] = wa.z; wt[j][3] = wa.w; wt[j][4] = wb.x; wt[j][5] = wb.y; wt[j][6] = wb.z; wt[j][7] = wb.w; }
        const bf16* src = F.PA() + (size_t)(t0 + 16 * q) * PA_LD + ch;
        v4u xm3 = (v4u){0u, 0u, 0u, 0u}, xm2 = xm3, xm1 = xm3;
        if (c > 0 || q > 0) { xm3 = *(const v4u*)(src - 3 * (ptrdiff_t)PA_LD); xm2 = *(const v4u*)(src - 2 * (ptrdiff_t)PA_LD); xm1 = *(const v4u*)(src - (ptrdiff_t)PA_LD); }
#pragma unroll 4
        for (int s = 0; s < 16; ++s) { const int tt = 16 * q + s;
            const v4u x0 = *(const v4u*)(src + (size_t)s * PA_LD);
            float a[8]; float ss = 0.f;
#pragma unroll
            for (int i = 0; i < 8; ++i) { float v = wt[0][i] * bf_el(xm3, i) + wt[1][i] * bf_el(xm2, i) + wt[2][i] * bf_el(xm1, i) + wt[3][i] * bf_el(x0, i);
                v = v * __builtin_amdgcn_rcpf(1.0f + __expf(-v)); a[i] = v; ss += v * v; }
            xm3 = xm2; xm2 = xm1; xm1 = x0;
            if (grp < 32) { const float rr = __builtin_amdgcn_rsqf(row_sum16(ss) + NORM_EPS);
#pragma unroll
                for (int i = 0; i < 8; ++i) a[i] *= rr; }
            const v4u pk = (v4u){cvtpk(a[0], a[1]), cvtpk(a[2], a[3]), cvtpk(a[4], a[5]), cvtpk(a[6], a[7])};
            if (grp < 16) *(v4u*)(F.QN() + (size_t)(t0 + tt) * 2048 + grp * 128 + 8 * li) = pk;
            else { if (grp < 32) *(v4u*)(F.KN() + (size_t)(t0 + tt) * 2048 + (grp - 16) * 128 + 8 * li) = pk;
                   LAS unsigned short* tp = tl + (8 * li) * 68 + tt;
                   tp[0] = (unsigned short)(pk.x & 0xffffu); tp[68] = (unsigned short)(pk.x >> 16); tp[136] = (unsigned short)(pk.y & 0xffffu); tp[204] = (unsigned short)(pk.y >> 16);
                   tp[272] = (unsigned short)(pk.z & 0xffffu); tp[340] = (unsigned short)(pk.z >> 16); tp[408] = (unsigned short)(pk.w & 0xffffu); tp[476] = (unsigned short)(pk.w >> 16); }
        }
        if (grp >= 16) {
            LDS_WAIT();
            bf16* dst = (bf16*)(F.wsb + (grp < 32 ? WS_KNT : WS_VP)) + (grp < 32 ? ((size_t)(b * 16 + grp - 16) * 64 + c) : ((size_t)(b * 32 + grp - 32) * 64 + c)) * 8192;
#pragma unroll 4
            for (int i = 0; i < 16; ++i) { const int row = 8 * i + (lane >> 3), chk = lane & 7; const LAS v2u* rp = (const LAS v2u*)(tl + row * 68 + 8 * chk);
                const v2u lo = rp[0], hi = rp[1]; *(v4u*)(dst + row * 64 + 8 * chk) = (v4u){lo.x, lo.y, hi.x, hi.y}; }
            LDS_WAIT();
        }
    }
    const int gt = F.vcu * NWAVES * 64 + F.tid, NT = F.G * NWAVES * 64;
    for (int idx = gt; idx < M * 32; idx += NT) { const int hv = idx & 31, t = idx >> 5;
        const float a = F.AB()[(size_t)t * 64 + hv], bb = F.AB()[(size_t)t * 64 + 32 + hv];
        const float x = a + F.in[9][hv]; const float sp = fmaxf(x, 0.f) + log1pf(expf(-fabsf(x)));
        F.GG()[idx] = -expf(F.in[8][hv]) * sp; F.BETA()[idx] = 1.0f / (1.0f + expf(-bb)); }
}
typedef short bf16x8 __attribute__((ext_vector_type(8)));
typedef float f32x16 __attribute__((ext_vector_type(16)));
#define MFMA32(a, b, c) __builtin_amdgcn_mfma_f32_32x32x16_bf16((a), (b), (c), 0, 0, 0)
constexpr int MB_KT = 17408, MB_BUF = 34816;

__device__ __forceinline__ void moba_stage_load(const bf16* Kb, const bf16* Vb, int kpos0, int tid, v4u (&kr)[2], v4u (&vr)[2]) {
    const v4u* kp = (const v4u*)(Kb + (size_t)(kpos0 + (tid >> 3)) * 128 + (tid & 7) * 16); kr[0] = kp[0]; kr[1] = kp[1];
    const v4u* vp = (const v4u*)(Vb + (size_t)(tid >> 2) * SEQ + kpos0 + (tid & 3) * 16); vr[0] = vp[0]; vr[1] = vp[1];
}
__device__ __forceinline__ void moba_stage_store(LAS unsigned char* buf, int tid, const v4u (&kr)[2], const v4u (&vr)[2]) {
    LAS unsigned char* kd = buf + (tid >> 3) * 272 + (tid & 7) * 32; *(LAS v4u*)kd = kr[0]; *(LAS v4u*)(kd + 16) = kr[1];
    LAS unsigned char* vd = buf + MB_KT + (tid >> 2) * 136 + (tid & 3) * 32;
    *(LAS v2u*)vd = (v2u){vr[0].x, vr[0].y}; *(LAS v2u*)(vd + 8) = (v2u){vr[0].z, vr[0].w}; *(LAS v2u*)(vd + 16) = (v2u){vr[1].x, vr[1].y}; *(LAS v2u*)(vd + 24) = (v2u){vr[1].z, vr[1].w};
}
__device__ __forceinline__ void moba_unit(Frame& F, int bh, int j) {
    const int w = F.wave, lane = F.lane, r = lane & 31, h = lane >> 5, tid = F.tid;
    LAS unsigned char* L = F.lds;
    const bf16* Qb = F.MQ() + ((size_t)bh * SEQ + j * 256 + 32 * w) * 128;
    const bf16* Kb = F.MK() + (size_t)bh * SEQ * 128;
    const bf16* Vb = F.MV() + (size_t)bh * 128 * SEQ;
    bf16x8 qf[8];
#pragma unroll
    for (int ks = 0; ks < 8; ++ks) qf[ks] = *(const bf16x8*)(Qb + r * 128 + 16 * ks + 8 * h);
    unsigned selmask = 0u;
    if (j > 0) {
        f32x16 g;
#pragma unroll
        for (int i = 0; i < 16; ++i) g[i] = 0.f;
        const bf16* kmh = F.KMH() + ((size_t)bh * 16 + (r & 15)) * 128 + 8 * h; const bf16* kml = F.KML() + ((size_t)bh * 16 + (r & 15)) * 128 + 8 * h;
        bf16x8 ah[8], al[8];
#pragma unroll
        for (int ks = 0; ks < 8; ++ks) { ah[ks] = *(const bf16x8*)(kmh + 16 * ks); al[ks] = *(const bf16x8*)(kml + 16 * ks); }
#pragma unroll
        for (int ks = 0; ks < 8; ++ks) { g = MFMA32(ah[ks], qf[ks], g); g = MFMA32(al[ks], qf[ks], g); }
        unsigned key[16];
#pragma unroll
        for (int i = 0; i < 8; ++i) { const int base = (i & 3) + 8 * (i >> 2); const int n0 = base + 4 * h, n1 = base + 4 * (1 - h);
            auto rr = __builtin_amdgcn_permlane32_swap(__float_as_uint(g[i]), __float_as_uint(g[i]), false, false);
            const unsigned u0 = __float_as_uint(g[i]), u1 = h ? rr[0] : rr[1];
            const unsigned s0 = u0 ^ ((u0 >> 31) ? 0xffffffffu : 0x80000000u), s1 = u1 ^ ((u1 >> 31) ? 0xffffffffu : 0x80000000u);
            key[i] = n0 < j ? ((s0 & ~15u) | (unsigned)(15 - n0)) : 0u; key[8 + i] = n1 < j ? ((s1 & ~15u) | (unsigned)(15 - n1)) : 0u; }
#pragma unroll
        for (int rd = 0; rd < 3; ++rd) { unsigned best = key[0];
#pragma unroll
            for (int i = 1; i < 16; ++i) best = best > key[i] ? best : key[i];
            if (best != 0u) selmask |= 1u << (15u - (best & 15u));
#pragma unroll
            for (int i = 0; i < 16; ++i) key[i] = (key[i] == best) ? 0u : key[i]; }
    }
    f32x16 o[4];
#pragma unroll
    for (int b4 = 0; b4 < 4; ++b4)
#pragma unroll
        for (int i = 0; i < 16; ++i) o[b4][i] = 0.f;
    float m_run = -INFINITY, l_run = 0.f;
    const int nT = 4 * (j + 1), qpos = 32 * w + r;
    constexpr float C = 0.08838834764831845f * 1.4426950408889634f;
    v4u kr[2], vr[2];
    __syncthreads();
    moba_stage_load(Kb, Vb, j * 256, tid, kr, vr); moba_stage_store(L, tid, kr, vr);
    __syncthreads();
    for (int tt = 0; tt < nT; ++tt) {
        const bool own = tt < 4; const int blk = own ? j : ((tt - 4) >> 2), sub64 = own ? tt : ((tt - 4) & 3);
        if (tt + 1 < nT) { const int t1 = tt + 1; const int kp1 = (t1 < 4) ? j * 256 + 64 * t1 : ((t1 - 4) >> 2) * 256 + 64 * ((t1 - 4) & 3); moba_stage_load(Kb, Vb, kp1, tid, kr, vr); }
        {
        LAS unsigned char* Kt = L + (tt & 1) * MB_BUF; LAS unsigned char* Vt = Kt + MB_KT;
        const bool lane_sel = own ? true : (((selmask >> blk) & 1u) != 0u);
        const bool skip = own ? (64 * sub64 > 32 * w + 31) : (__ballot(lane_sel) == 0ull);
        if (!skip) {
            f32x16 x0, x1;
#pragma unroll
            for (int i = 0; i < 16; ++i) { x0[i] = 0.f; x1[i] = 0.f; }
#define MB_LDK(dst, g) do { dst[0] = *(const LAS bf16x8*)(Kt + r * 272 + 64 * (g) + 16 * h); dst[1] = *(const LAS bf16x8*)(Kt + (32 + r) * 272 + 64 * (g) + 16 * h); \
                            dst[2] = *(const LAS bf16x8*)(Kt + r * 272 + 64 * (g) + 32 + 16 * h); dst[3] = *(const LAS bf16x8*)(Kt + (32 + r) * 272 + 64 * (g) + 32 + 16 * h); } while (0)
#define MB_QK(src, g) do { x0 = MFMA32(src[0], qf[2 * (g)], x0); x1 = MFMA32(src[1], qf[2 * (g)], x1); x0 = MFMA32(src[2], qf[2 * (g) + 1], x0); x1 = MFMA32(src[3], qf[2 * (g) + 1], x1); } while (0)
            { bf16x8 fa[4], fb[4];
              MB_LDK(fa, 0); MB_LDK(fb, 1); __builtin_amdgcn_sched_barrier(0);
              MB_QK(fa, 0); MB_LDK(fa, 2); __builtin_amdgcn_sched_barrier(0);
              MB_QK(fb, 1); MB_LDK(fb, 3); __builtin_amdgcn_sched_barrier(0);
              MB_QK(fa, 2); __builtin_amdgcn_sched_barrier(0);
              MB_QK(fb, 3); }
#undef MB_LDK
#undef MB_QK
            if (own && (64 * sub64 + 63 > 32 * w)) {
#pragma unroll
                for (int i = 0; i < 16; ++i) { const int key0 = 64 * sub64 + (i & 3) + 8 * (i >> 2) + 4 * h;
                    x0[i] = (key0 <= qpos) ? x0[i] : -INFINITY; x1[i] = (key0 + 32 <= qpos) ? x1[i] : -INFINITY; }
            }
            float mx = fmaxf(x0[0], x1[0]);
#pragma unroll
            for (int i = 1; i < 16; ++i) mx = fmaxf(fmaxf(mx, x0[i]), x1[i]);
            mx = xhalf_max(mx);
            mx = lane_sel ? mx : -INFINITY;
            const float m_new = fmaxf(m_run, mx);
            if (__any(m_new != m_run)) {
                const float alpha = __builtin_amdgcn_exp2f((m_run - m_new) * C);
                l_run *= alpha;
#pragma unroll
                for (int b4 = 0; b4 < 4; ++b4)
#pragma unroll
                    for (int i = 0; i < 16; ++i) o[b4][i] *= alpha;
                m_run = m_new;
            }
            const float mC = -m_run * C;
            float rs = 0.f;
#pragma unroll
            for (int i = 0; i < 16; ++i) { x0[i] = __builtin_amdgcn_exp2f(fmaf(x0[i], C, mC)); x1[i] = __builtin_amdgcn_exp2f(fmaf(x1[i], C, mC)); rs += x0[i] + x1[i]; }
            rs = xhalf_sum(rs);
            l_run += lane_sel ? rs : 0.f;
            const unsigned pmask = lane_sel ? 0xffffffffu : 0u;
            bf16x8 pb[4];
#pragma unroll
            for (int st = 0; st < 4; ++st) { v4u pw; const int s8 = 8 * (st & 1);
                if (st < 2) { pw.x = cvtpk(x0[s8], x0[s8 + 1]); pw.y = cvtpk(x0[s8 + 2], x0[s8 + 3]); pw.z = cvtpk(x0[s8 + 4], x0[s8 + 5]); pw.w = cvtpk(x0[s8 + 6], x0[s8 + 7]); }
                else { pw.x = cvtpk(x1[s8], x1[s8 + 1]); pw.y = cvtpk(x1[s8 + 2], x1[s8 + 3]); pw.z = cvtpk(x1[s8 + 4], x1[s8 + 5]); pw.w = cvtpk(x1[s8 + 6], x1[s8 + 7]); }
                pw.x &= pmask; pw.y &= pmask; pw.z &= pmask; pw.w &= pmask; pb[st] = __builtin_bit_cast(bf16x8, pw); }
#define MB_LDV(dst, st) do { _Pragma("unroll") for (int b4 = 0; b4 < 4; ++b4) { const LAS unsigned char* vp = Vt + (32 * b4 + r) * 136 + (16 * (st) + 4 * h) * 2; \
                const v2u lo = *(const LAS v2u*)vp, hi = *(const LAS v2u*)(vp + 16); dst[b4] = __builtin_bit_cast(bf16x8, (v4u){lo.x, lo.y, hi.x, hi.y}); } } while (0)
#define MB_PV(src, st) do { _Pragma("unroll") for (int b4 = 0; b4 < 4; ++b4) o[b4] = MFMA32(src[b4], pb[st], o[b4]); } while (0)
            { bf16x8 va[4], vb[4];
              MB_LDV(va, 0); MB_LDV(vb, 1); __builtin_amdgcn_sched_barrier(0);
              MB_PV(va, 0); MB_LDV(va, 2); __builtin_amdgcn_sched_barrier(0);
              MB_PV(vb, 1); MB_LDV(vb, 3); __builtin_amdgcn_sched_barrier(0);
              MB_PV(va, 2); __builtin_amdgcn_sched_barrier(0);
              MB_PV(vb, 3); }
#undef MB_LDV
#undef MB_PV
        }
        }
        if (tt + 1 < nT) moba_stage_store(L + ((tt + 1) & 1) * MB_BUF, tid, kr, vr);
        __syncthreads();
    }
    const float inv = 16.0f / l_run; const int b = bh >> 4, hh = bh & 15;
    unsigned char* orow = (unsigned char*)F.OM() + (size_t)(b * SEQ + j * 256 + 32 * w + r) * 2048 + hh * 128;
#pragma unroll
    for (int b4 = 0; b4 < 4; ++b4)
#pragma unroll
        for (int gq = 0; gq < 4; ++gq) *(unsigned*)(orow + 32 * b4 + 8 * gq + 4 * h) = pk4_fp8(o[b4][4 * gq] * inv, o[b4][4 * gq + 1] * inv, o[b4][4 * gq + 2] * inv, o[b4][4 * gq + 3] * inv);
}
__device__ __forceinline__ void moba_phase(Frame& F) {
    for (int p = blockIdx.x; p < BATCH * 16 * 8; p += F.G) { const int bh = p >> 3, jj = p & 7; moba_unit(F, bh, 15 - jj); moba_unit(F, bh, jj); }
}
__device__ __forceinline__ int crow(int reg, int h) { return (reg & 3) + 8 * (reg >> 2) + 4 * h; }
__device__ __forceinline__ float rdlane(float v, int l) { return __int_as_float(__builtin_amdgcn_readlane(__float_as_int(v), l)); }
template <int TB, int CB> __device__ __forceinline__ float lsel(const f32x16& L00, const f32x16& L10, const f32x16& L11, int reg, int ln) {
    return TB == 0 ? rdlane(L00[reg], ln) : (CB == 0 ? rdlane(L10[reg], ln) : rdlane(L11[reg], ln)); }
__device__ __forceinline__ void sub_step(float& acc, float lv, int ln, float xk) { int tmp;
    asm volatile("s_nop 0\n\tv_readlane_b32 %1, %2, %3\n\ts_nop 1\n\tv_fma_f32 %0, -%1, %4, %0" : "+v"(acc), "=&s"(tmp) : "v"(lv), "s"(ln), "v"(xk)); }
__device__ __forceinline__ void sub_step4(float& a0, float& a1, float& a2, float& a3, float l0, float l1, float l2, float l3, int n0, int n1, int n2, int n3, float x0, float x1, float x2, float x3) {
    int t0, t1, t2, t3;
    asm volatile("s_nop 0\n\tv_readlane_b32 %4, %8, %12\n\tv_readlane_b32 %5, %9, %13\n\tv_readlane_b32 %6, %10, %14\n\tv_readlane_b32 %7, %11, %15\n\t"
                 "v_fma_f32 %0, -%4, %16, %0\n\tv_fma_f32 %1, -%5, %17, %1\n\tv_fma_f32 %2, -%6, %18, %2\n\tv_fma_f32 %3, -%7, %19, %3"
                 : "+v"(a0), "+v"(a1), "+v"(a2), "+v"(a3), "=&s"(t0), "=&s"(t1), "=&s"(t2), "=&s"(t3)
                 : "v"(l0), "v"(l1), "v"(l2), "v"(l3), "s"(n0), "s"(n1), "s"(n2), "s"(n3), "v"(x0), "v"(x1), "v"(x2), "v"(x3));
}
__device__ __forceinline__ v4u pack8(const float (&x)[8]) { v4u p; p.x = cvtpk(x[0], x[1]); p.y = cvtpk(x[2], x[3]); p.z = cvtpk(x[4], x[5]); p.w = cvtpk(x[6], x[7]); return p; }

__device__ __forceinline__ void t_frags(const float (&X)[64], float sv, bf16x8 (&F0)[4], bf16x8 (&F1)[4]) {
#pragma unroll
    for (int ks = 0; ks < 4; ++ks) {
        float lo[8], hi[8];
#pragma unroll
        for (int jj = 0; jj < 8; ++jj) { lo[jj] = X[16 * ks + jj] * rdlane(sv, 16 * ks + jj); hi[jj] = X[16 * ks + 8 + jj] * rdlane(sv, 16 * ks + 8 + jj); }
        const v4u pl = pack8(lo), ph = pack8(hi); v4u f0, f1;
        { auto rr = __builtin_amdgcn_permlane32_swap(pl.x, ph.x, false, false); f0.x = rr[0]; f1.x = rr[1]; }
        { auto rr = __builtin_amdgcn_permlane32_swap(pl.y, ph.y, false, false); f0.y = rr[0]; f1.y = rr[1]; }
        { auto rr = __builtin_amdgcn_permlane32_swap(pl.z, ph.z, false, false); f0.z = rr[0]; f1.z = rr[1]; }
        { auto rr = __builtin_amdgcn_permlane32_swap(pl.w, ph.w, false, false); f0.w = rr[0]; f1.w = rr[1]; }
        F0[ks] = __builtin_bit_cast(bf16x8, f0); F1[ks] = __builtin_bit_cast(bf16x8, f1);
    }
}
__device__ __forceinline__ void gdn_local_task(Frame& F, int task, LAS float* sm) {
    int lane_o = F.lane; asm volatile("" : "+v"(lane_o));
    const int lane = lane_o, r = lane & 31, h = lane >> 5;
    const int c = task & 63, bhv = task >> 6, hv = bhv & 31, b = bhv >> 5, hq = hv >> 1;
    const int t0 = b * SEQ + c * 64; const size_t tq = (size_t)(b * 16 + hq) * 64 + c;
    const float g = F.GG()[(size_t)(t0 + lane) * 32 + hv], bt = F.BETA()[(size_t)(t0 + lane) * 32 + hv];
    float gc = g;
#pragma unroll
    for (int o = 1; o < 64; o <<= 1) { const float t = __int_as_float(__builtin_amdgcn_ds_bpermute(4 * ((lane - o) & 63), __float_as_int(gc))); gc += (lane >= o) ? t : 0.f; }
    sm[lane] = gc; sm[64 + lane] = bt;
    F.GC()[(size_t)task * 64 + lane] = gc;
    LDS_WAIT();
    bf16x8 kf[2][8];
#pragma unroll
    for (int tb = 0; tb < 2; ++tb)
#pragma unroll
        for (int ks = 0; ks < 8; ++ks) kf[tb][ks] = *(const bf16x8*)(F.KN() + (size_t)(t0 + 32 * tb + r) * 2048 + hq * 128 + 16 * ks + 8 * h);
    f32x16 L00, L10, L11;
#pragma unroll
    for (int i = 0; i < 16; ++i) { L00[i] = 0.f; L10[i] = 0.f; L11[i] = 0.f; }
#pragma unroll
    for (int ks = 0; ks < 8; ++ks) { L00 = MFMA32(kf[0][ks], kf[0][ks], L00); L10 = MFMA32(kf[1][ks], kf[0][ks], L10); L11 = MFMA32(kf[1][ks], kf[1][ks], L11); }
    const float gci0 = sm[r], gci1 = sm[32 + r];
#pragma unroll
    for (int reg = 0; reg < 16; ++reg) { const int kr = crow(reg, h); const float gk0 = sm[kr], bk0 = sm[64 + kr], gk1 = sm[32 + kr], bk1 = sm[96 + kr];
        L00[reg] = (r < kr) ? L00[reg] * bk0 * __expf(gk0 - gci0) : 0.f;
        L10[reg] = L10[reg] * bk1 * __expf(gk1 - gci0);
        L11[reg] = (r < kr) ? L11[reg] * bk1 * __expf(gk1 - gci1) : 0.f; }
    { bf16* at = F.AT() + (size_t)task * 4096; const float sc = 0.08838834764831845f;
      { bf16x8 qf[8];
#pragma unroll
        for (int ks = 0; ks < 8; ++ks) qf[ks] = *(const bf16x8*)(F.QN() + (size_t)(t0 + r) * 2048 + hq * 128 + 16 * ks + 8 * h);
        f32x16 A00;
#pragma unroll
        for (int i = 0; i < 16; ++i) A00[i] = 0.f;
#pragma unroll
        for (int ks = 0; ks < 8; ++ks) A00 = MFMA32(kf[0][ks], qf[ks], A00);
#pragma unroll
        for (int g4 = 0; g4 < 4; ++g4) { float v[4];
#pragma unroll
            for (int t = 0; t < 4; ++t) { const int reg = 4 * g4 + t, jr = crow(reg, h); v[t] = (jr <= r) ? A00[reg] * sc * __expf(gci0 - sm[jr]) : 0.f; }
            *(v2u*)(at + r * 64 + 8 * g4 + 4 * h) = (v2u){cvtpk(v[0], v[1]), cvtpk(v[2], v[3])}; } }
      { bf16x8 qf[8];
#pragma unroll
        for (int ks = 0; ks < 8; ++ks) qf[ks] = *(const bf16x8*)(F.QN() + (size_t)(t0 + 32 + r) * 2048 + hq * 128 + 16 * ks + 8 * h);
        f32x16 A01, A11;
#pragma unroll
        for (int i = 0; i < 16; ++i) { A01[i] = 0.f; A11[i] = 0.f; }
#pragma unroll
        for (int ks = 0; ks < 8; ++ks) { A01 = MFMA32(kf[0][ks], qf[ks], A01); A11 = MFMA32(kf[1][ks], qf[ks], A11); }
#pragma unroll
        for (int g4 = 0; g4 < 4; ++g4) { float v[4], u[4];
#pragma unroll
            for (int t = 0; t < 4; ++t) { const int reg = 4 * g4 + t, jr = crow(reg, h); v[t] = A01[reg] * sc * __expf(gci1 - sm[jr]); u[t] = (jr <= r) ? A11[reg] * sc * __expf(gci1 - sm[32 + jr]) : 0.f; }
            *(v2u*)(at + (32 + r) * 64 + 8 * g4 + 4 * h) = (v2u){cvtpk(v[0], v[1]), cvtpk(v[2], v[3])};
            *(v2u*)(at + (32 + r) * 64 + 32 + 8 * g4 + 4 * h) = (v2u){cvtpk(u[0], u[1]), cvtpk(u[2], u[3])}; } } }
    asm volatile("" ::: "memory"); __builtin_amdgcn_sched_barrier(0);
    bf16x8 vfr[2][4];
    { const bf16* vt = F.VP() + (size_t)task * 8192;
#pragma unroll
      for (int db = 0; db < 2; ++db)
#pragma unroll
          for (int ks = 0; ks < 4; ++ks) vfr[db][ks] = *(const bf16x8*)(vt + (32 * db + r) * 64 + 16 * ks + 8 * h); }
    float X[64];
    asm volatile("s_nop 7" ::: "memory");
#define GL_LV(k, i) (((k) < 32) ? L00[(((k) & 31) & 3) + 4 * (((k) & 31) >> 3)] : (((i) < 32) ? L10[(((k) & 31) & 3) + 4 * (((k) & 31) >> 3)] : L11[(((k) & 31) & 3) + 4 * (((k) & 31) >> 3)]))
#define GL_LN(k, i) (((i) & 31) + 32 * ((((k) & 31) >> 2) & 1))
#pragma unroll
    for (int i = 63; i >= 0; --i) {
        float a0 = (lane == i) ? 1.f : 0.f, a1 = 0.f, a2 = 0.f, a3 = 0.f;
        const int n4 = (63 - i) >> 2;
#pragma unroll
        for (int g = 0; g < n4; ++g) { const int k = i + 1 + 4 * g;
            sub_step4(a0, a1, a2, a3, GL_LV(k, i), GL_LV(k + 1, i), GL_LV(k + 2, i), GL_LV(k + 3, i), GL_LN(k, i), GL_LN(k + 1, i), GL_LN(k + 2, i), GL_LN(k + 3, i), X[k], X[k + 1], X[k + 2], X[k + 3]); }
#pragma unroll
        for (int k = i + 1 + 4 * n4; k < 64; ++k) sub_step(a0, GL_LV(k, i), GL_LN(k, i), X[k]);
        X[i] = (a0 + a1) + (a2 + a3);
    }
#undef GL_LV
#undef GL_LN
    asm volatile("" ::: "memory"); __builtin_amdgcn_sched_barrier(0);
    bf16x8 F0[4], F1[4];
    t_frags(X, bt, F0, F1);
    { bf16* ub = F.U() + (size_t)task * 8192;
#pragma unroll
      for (int db = 0; db < 4; ++db) { f32x16 u0, u1;
#pragma unroll
          for (int i = 0; i < 16; ++i) { u0[i] = 0.f; u1[i] = 0.f; }
#pragma unroll
          for (int ks = 0; ks < 4; ++ks) { const bf16x8 vf = db < 2 ? vfr[db & 1][ks] : *(const bf16x8*)(F.VP() + (size_t)task * 8192 + (32 * db + r) * 64 + 16 * ks + 8 * h); if (ks < 2) u0 = MFMA32(F0[ks], vf, u0); u1 = MFMA32(F1[ks], vf, u1); }
          v4u* d0 = (v4u*)(ub + ((0 * 4 + db) * 64 + lane) * 16); v4u* d1 = (v4u*)(ub + ((1 * 4 + db) * 64 + lane) * 16);
          { float a[8], bb[8];
#pragma unroll
            for (int i = 0; i < 8; ++i) { a[i] = u0[i]; bb[i] = u0[8 + i]; }
            d0[0] = pack8(a); d0[1] = pack8(bb);
#pragma unroll
            for (int i = 0; i < 8; ++i) { a[i] = u1[i]; bb[i] = u1[8 + i]; }
            d1[0] = pack8(a); d1[1] = pack8(bb); } } }
    asm volatile("" ::: "memory"); __builtin_amdgcn_sched_barrier(0);
    t_frags(X, bt * __expf(gc), F0, F1);
    { const bf16* kt = F.KNT() + tq * 8192; bf16* wb = F.W() + (size_t)task * 8192;
#pragma unroll
      for (int a = 0; a < 4; ++a) { f32x16 w0, w1;
#pragma unroll
          for (int i = 0; i < 16; ++i) { w0[i] = 0.f; w1[i] = 0.f; }
#pragma unroll
          for (int ks = 0; ks < 4; ++ks) { const bf16x8 ktf = *(const bf16x8*)(kt + (32 * a + r) * 64 + 16 * ks + 8 * h); if (ks < 2) w0 = MFMA32(ktf, F0[ks], w0); w1 = MFMA32(ktf, F1[ks], w1); }
#pragma unroll
          for (int g4 = 0; g4 < 4; ++g4) {
              *(v2u*)(wb + r * 128 + 32 * a + 8 * g4 + 4 * h) = (v2u){cvtpk(w0[4 * g4], w0[4 * g4 + 1]), cvtpk(w0[4 * g4 + 2], w0[4 * g4 + 3])};
              *(v2u*)(wb + (32 + r) * 128 + 32 * a + 8 * g4 + 4 * h) = (v2u){cvtpk(w1[4 * g4], w1[4 * g4 + 1]), cvtpk(w1[4 * g4 + 2], w1[4 * g4 + 3])}; } } }
    LDS_WAIT();
}
__device__ __forceinline__ void gdn_local_phase(Frame& F) {
    LAS float* sm = (LAS float*)(F.lds + F.wave * 512);
    const int gw = F.vcu * NWAVES + F.wave, NGW = F.G * NWAVES;
    for (int task = gw; task < BATCH * 32 * 64; task += NGW) gdn_local_task(F, task, sm);
}

constexpr int SC_W = 0, SC_Q = 16896, SC_A = 33792, SC_KT = 42496, SC_E1 = 59904, SC_E2 = 60160, SC_BUF = 60416, SC_OT = 2 * SC_BUF, SC_OTB = 16896;
static_assert(SC_OT + 2 * SC_OTB <= MISC_OFF, "scan LDS map");
__device__ __forceinline__ bf16x8 frag8(const LAS unsigned char* p) { const v2u lo = *(const LAS v2u*)p, hi = *(const LAS v2u*)(p + 16); return __builtin_bit_cast(bf16x8, (v4u){lo.x, lo.y, hi.x, hi.y}); }
__device__ __forceinline__ void st16(LAS unsigned char* p, v4u v) { *(LAS v2u*)p = (v2u){v.x, v.y}; *(LAS v2u*)(p + 8) = (v2u){v.z, v.w}; }
struct ScanRegs { v4u rw[4], rq[4], ra[2], rk[4]; float gcv, glv; };
__device__ __forceinline__ void scan_issue(Frame& F, int lt, size_t task, size_t tq, int t0, int hq, ScanRegs& R) {
#pragma unroll
    for (int i = 0; i < 4; ++i) { const int idx = lt + 256 * i, row = idx >> 4, ch = idx & 15;
        R.rw[i] = *(const v4u*)(F.W() + task * 8192 + row * 128 + ch * 8); R.rq[i] = *(const v4u*)(F.QN() + (size_t)(t0 + row) * 2048 + hq * 128 + ch * 8); }
#pragma unroll
    for (int i = 0; i < 2; ++i) { const int idx = lt + 256 * i, row = idx >> 3, ch = idx & 7; R.ra[i] = *(const v4u*)(F.AT() + task * 4096 + row * 64 + ch * 8); }
#pragma unroll
    for (int i = 0; i < 4; ++i) { const int idx = lt + 256 * i, row = idx >> 3, ch = idx & 7; R.rk[i] = *(const v4u*)(F.KNT() + tq * 8192 + row * 64 + ch * 8); }
    R.gcv = 0.f; R.glv = 0.f;
    if (lt < 64) { R.gcv = F.GC()[task * 64 + lt]; R.glv = F.GC()[task * 64 + 63]; }
}
__device__ __forceinline__ void scan_store(int lt, const ScanRegs& R, LAS unsigned char* buf) {
#pragma unroll
    for (int i = 0; i < 4; ++i) { const int idx = lt + 256 * i, row = idx >> 4, ch = idx & 15; st16(buf + SC_W + row * 264 + ch * 16, R.rw[i]); st16(buf + SC_Q + row * 264 + ch * 16, R.rq[i]); }
#pragma unroll
    for (int i = 0; i < 2; ++i) { const int idx = lt + 256 * i, row = idx >> 3, ch = idx & 7; st16(buf + SC_A + row * 136 + ch * 16, R.ra[i]); }
#pragma unroll
    for (int i = 0; i < 4; ++i) { const int idx = lt + 256 * i, row = idx >> 3, ch = idx & 7; st16(buf + SC_KT + row * 136 + ch * 16, R.rk[i]); }
    if (lt < 64) { ((LAS float*)(buf + SC_E1))[lt] = __expf(R.gcv) * 0.08838834764831845f; ((LAS float*)(buf + SC_E2))[lt] = __expf(R.glv - R.gcv); }
}
__device__ __forceinline__ void scan_finalize(Frame& F, LAS unsigned char* L, int c, int t0, int lw, int lane, int hv, f32x2 gn, const unsigned (&zw)[16]) {
    const LAS unsigned char* ot = L + SC_OT + (c & 1) * SC_OTB;
#pragma unroll
    for (int hb = 0; hb < 2; ++hb) {
        float o0[8], o1[8], ss[8];
#pragma unroll
        for (int i = 0; i < 8; ++i) { const unsigned ow = *(const LAS unsigned*)(ot + (16 * lw + 8 * hb + i) * 264 + 4 * lane); o0[i] = blo(ow); o1[i] = bhi(ow); ss[i] = o0[i] * o0[i] + o1[i] * o1[i]; }
#pragma unroll
        for (int i = 0; i < 8; ++i) ss[i] = wave_sum(ss[i]);
#pragma unroll
        for (int i = 0; i < 8; ++i) { const float rr = __builtin_amdgcn_rsqf(ss[i] * (1.0f / 128) + NORM_EPS); const float z0 = blo(zw[8 * hb + i]), z1 = bhi(zw[8 * hb + i]);
            const float y0 = o0[i] * rr * gn.x * (z0 * __builtin_amdgcn_rcpf(1.0f + __expf(-z0))), y1 = o1[i] * rr * gn.y * (z1 * __builtin_amdgcn_rcpf(1.0f + __expf(-z1)));
            *(unsigned*)(F.OG() + (size_t)(t0 + 16 * lw + 8 * hb + i) * 4096 + hv * 128 + 2 * lane) = pk2(y0, y1); }
    }
}
__device__ __forceinline__ void gdn_scan_seq(Frame& F, int seq) {
    int tid_o = F.tid; asm volatile("" : "+v"(tid_o));
    const int tid = tid_o, w = __builtin_amdgcn_readfirstlane(tid >> 6), lane = tid & 63, r = lane & 31, h = lane >> 5;
    const int b = seq >> 5, hv = seq & 31, hq = hv >> 1;
    LAS unsigned char* L = F.lds;
    const size_t task0 = (size_t)seq * 64, tq0 = (size_t)(b * 16 + hq) * 64;
    __syncthreads();
    if (w >= 4) {
        const int lt = tid - 256, lw = w - 4;
        const float* onorm = F.in[10]; const f32x2 gn = *(const f32x2*)(onorm + 2 * lane);
        ScanRegs R0, R1;
        scan_issue(F, lt, task0, tq0, b * SEQ, hq, R0); scan_issue(F, lt, task0 + 1, tq0 + 1, b * SEQ + 64, hq, R1);
        scan_store(lt, R0, L);
        __syncthreads();
#define SCAN_LOADER_STEP(c, RA, RB) do { \
            const int t0 = b * SEQ + (c) * 64; \
            unsigned zw[16]; \
            _Pragma("unroll") for (int i = 0; i < 16; ++i) zw[i] = *(const unsigned*)(F.PB() + (size_t)(t0 + 16 * lw + i) * PB_LD + PB_GZ + hv * 128 + 2 * lane); \
            if ((c) + 2 < 64) scan_issue(F, lt, task0 + (c) + 2, tq0 + (c) + 2, b * SEQ + ((c) + 2) * 64, hq, RA); \
            if ((c) + 1 < 64) scan_store(lt, RB, L + (((c) + 1) & 1) * SC_BUF); \
            __syncthreads(); \
            scan_finalize(F, L, (c), t0, lw, lane, hv, gn, zw); } while (0)
        for (int c = 0; c < 64; c += 2) {
            SCAN_LOADER_STEP(c, R0, R1);
            SCAN_LOADER_STEP(c + 1, R1, R0);
        }
#undef SCAN_LOADER_STEP
    } else {
        f32x16 Sx[4];
#pragma unroll
        for (int a = 0; a < 4; ++a)
#pragma unroll
            for (int i = 0; i < 16; ++i) Sx[a][i] = 0.f;
        v4u ur[4];
        { const v4u* up = (const v4u*)(F.U() + task0 * 8192 + ((0 * 4 + w) * 64 + lane) * 16); ur[0] = up[0]; ur[1] = up[1];
          const v4u* up1 = (const v4u*)(F.U() + task0 * 8192 + ((1 * 4 + w) * 64 + lane) * 16); ur[2] = up1[0]; ur[3] = up1[1]; }
        __syncthreads();
        for (int c = 0; c < 64; ++c) {
            const LAS unsigned char* buf = L + (c & 1) * SC_BUF; const LAS float* e1 = (const LAS float*)(buf + SC_E1); const LAS float* e2 = (const LAS float*)(buf + SC_E2);
            bf16x8 Sb[4][2];
#pragma unroll
            for (int a = 0; a < 4; ++a)
#pragma unroll
                for (int s = 0; s < 2; ++s) { float t[8];
#pragma unroll
                    for (int jj = 0; jj < 8; ++jj) t[jj] = Sx[a][8 * s + jj];
                    Sb[a][s] = __builtin_bit_cast(bf16x8, pack8(t)); }
            f32x16 vn[2];
#define SC_LD4(dst, off, gi) do { _Pragma("unroll") for (int q_ = 0; q_ < 4; ++q_) dst[q_] = frag8(buf + (off) + (32 * ((gi) >> 1) + r) * 264 + (32 * (2 * ((gi) & 1) + (q_ >> 1)) + 16 * (q_ & 1) + 4 * h) * 2); } while (0)
#define SC_MM4(acc, src, gi) do { _Pragma("unroll") for (int q_ = 0; q_ < 4; ++q_) acc = MFMA32(src[q_], Sb[2 * ((gi) & 1) + (q_ >> 1)][q_ & 1], acc); } while (0)
            { f32x16 y0, y1;
#pragma unroll
              for (int i = 0; i < 16; ++i) { y0[i] = 0.f; y1[i] = 0.f; }
              bf16x8 fa[4], fb[4];
              SC_LD4(fa, SC_W, 0); SC_LD4(fb, SC_W, 1); __builtin_amdgcn_sched_barrier(0);
              SC_MM4(y0, fa, 0); SC_LD4(fa, SC_W, 2); __builtin_amdgcn_sched_barrier(0);
              SC_MM4(y0, fb, 1); SC_LD4(fb, SC_W, 3); __builtin_amdgcn_sched_barrier(0);
              SC_MM4(y1, fa, 2); __builtin_amdgcn_sched_barrier(0);
              SC_MM4(y1, fb, 3);
#pragma unroll
              for (int tb = 0; tb < 2; ++tb) { const v4u ua = ur[2 * tb], ub = ur[2 * tb + 1]; const f32x16& y = tb ? y1 : y0;
                vn[tb][0] = blo(ua.x) - y[0]; vn[tb][1] = bhi(ua.x) - y[1]; vn[tb][2] = blo(ua.y) - y[2]; vn[tb][3] = bhi(ua.y) - y[3];
                vn[tb][4] = blo(ua.z) - y[4]; vn[tb][5] = bhi(ua.z) - y[5]; vn[tb][6] = blo(ua.w) - y[6]; vn[tb][7] = bhi(ua.w) - y[7];
                vn[tb][8] = blo(ub.x) - y[8]; vn[tb][9] = bhi(ub.x) - y[9]; vn[tb][10] = blo(ub.y) - y[10]; vn[tb][11] = bhi(ub.y) - y[11];
                vn[tb][12] = blo(ub.z) - y[12]; vn[tb][13] = bhi(ub.z) - y[13]; vn[tb][14] = blo(ub.w) - y[14]; vn[tb][15] = bhi(ub.w) - y[15]; } }
            if (c + 1 < 64) { const v4u* up = (const v4u*)(F.U() + (task0 + c + 1) * 8192 + ((0 * 4 + w) * 64 + lane) * 16); ur[0] = up[0]; ur[1] = up[1];
                const v4u* up1 = (const v4u*)(F.U() + (task0 + c + 1) * 8192 + ((1 * 4 + w) * 64 + lane) * 16); ur[2] = up1[0]; ur[3] = up1[1]; }
            bf16x8 Vb[2][2], Vb2[2][2];
#pragma unroll
            for (int tb = 0; tb < 2; ++tb)
#pragma unroll
                for (int s = 0; s < 2; ++s) { float t[8], t2[8];
                    const f32x4 ea = *(const LAS f32x4*)(e2 + 32 * tb + 16 * s + 4 * h), eb = *(const LAS f32x4*)(e2 + 32 * tb + 16 * s + 8 + 4 * h);
#pragma unroll
                    for (int jj = 0; jj < 4; ++jj) { t[jj] = vn[tb][8 * s + jj]; t[4 + jj] = vn[tb][8 * s + 4 + jj]; t2[jj] = t[jj] * ea[jj]; t2[4 + jj] = t[4 + jj] * eb[jj]; }
                    Vb[tb][s] = __builtin_bit_cast(bf16x8, pack8(t)); Vb2[tb][s] = __builtin_bit_cast(bf16x8, pack8(t2)); }
            LAS unsigned char* ot = L + SC_OT + (c & 1) * SC_OTB;
            { f32x16 y0, y1;
#pragma unroll
              for (int i = 0; i < 16; ++i) { y0[i] = 0.f; y1[i] = 0.f; }
              bf16x8 fa[4], fb[4], at[6];
              SC_LD4(fa, SC_Q, 0); SC_LD4(fb, SC_Q, 1); __builtin_amdgcn_sched_barrier(0);
              SC_MM4(y0, fa, 0); SC_LD4(fa, SC_Q, 2); __builtin_amdgcn_sched_barrier(0);
              SC_MM4(y0, fb, 1); SC_LD4(fb, SC_Q, 3); __builtin_amdgcn_sched_barrier(0);
              SC_MM4(y1, fa, 2);
#pragma unroll
              for (int s2 = 0; s2 < 2; ++s2) { at[s2] = frag8(buf + SC_A + r * 136 + (16 * s2 + 4 * h) * 2); at[2 + s2] = frag8(buf + SC_A + (32 + r) * 136 + (16 * s2 + 4 * h) * 2); at[4 + s2] = frag8(buf + SC_A + (32 + r) * 136 + (32 + 16 * s2 + 4 * h) * 2); }
              __builtin_amdgcn_sched_barrier(0);
              SC_MM4(y1, fb, 3);
#pragma unroll
              for (int g4 = 0; g4 < 4; ++g4) { const f32x4 ea = *(const LAS f32x4*)(e1 + 8 * g4 + 4 * h), eb = *(const LAS f32x4*)(e1 + 32 + 8 * g4 + 4 * h);
#pragma unroll
                  for (int t = 0; t < 4; ++t) { y0[4 * g4 + t] *= ea[t]; y1[4 * g4 + t] *= eb[t]; } }
              y0 = MFMA32(at[0], Vb[0][0], y0); y0 = MFMA32(at[1], Vb[0][1], y0);
              y1 = MFMA32(at[2], Vb[0][0], y1); y1 = MFMA32(at[3], Vb[0][1], y1); y1 = MFMA32(at[4], Vb[1][0], y1); y1 = MFMA32(at[5], Vb[1][1], y1);
#pragma unroll
              for (int reg = 0; reg < 16; reg += 2) { const unsigned p0 = cvtpk(y0[reg], y0[reg + 1]), p1 = cvtpk(y1[reg], y1[reg + 1]);
                  *(LAS unsigned short*)(ot + crow(reg, h) * 264 + (32 * w + r) * 2) = (unsigned short)(p0 & 0xffffu); *(LAS unsigned short*)(ot + crow(reg + 1, h) * 264 + (32 * w + r) * 2) = (unsigned short)(p0 >> 16);
                  *(LAS unsigned short*)(ot + (32 + crow(reg, h)) * 264 + (32 * w + r) * 2) = (unsigned short)(p1 & 0xffffu); *(LAS unsigned short*)(ot + (32 + crow(reg + 1, h)) * 264 + (32 * w + r) * 2) = (unsigned short)(p1 >> 16); } }
            { const float eg0 = e1[63] * 11.313708498984761f;
#define SC_LDK(dst, a) do { _Pragma("unroll") for (int q_ = 0; q_ < 4; ++q_) dst[q_] = frag8(buf + SC_KT + (32 * (a) + r) * 136 + (32 * (q_ >> 1) + 16 * (q_ & 1) + 4 * h) * 2); } while (0)
#define SC_MMK(a, src) do { _Pragma("unroll") for (int q_ = 0; q_ < 4; ++q_) Sx[a] = MFMA32(src[q_], Vb2[q_ >> 1][q_ & 1], Sx[a]); } while (0)
              bf16x8 fa[4], fb[4];
              SC_LDK(fa, 0); SC_LDK(fb, 1);
#pragma unroll
              for (int a = 0; a < 4; ++a)
#pragma unroll
                  for (int i = 0; i < 16; ++i) Sx[a][i] *= eg0;
              __builtin_amdgcn_sched_barrier(0);
              SC_MMK(0, fa); SC_LDK(fa, 2); __builtin_amdgcn_sched_barrier(0);
              SC_MMK(1, fb); SC_LDK(fb, 3); __builtin_amdgcn_sched_barrier(0);
              SC_MMK(2, fa); __builtin_amdgcn_sched_barrier(0);
              SC_MMK(3, fb); }
#undef SC_LDK
#undef SC_MMK
#undef SC_LD4
#undef SC_MM4
            __syncthreads();
        }
    }
}
__device__ __forceinline__ void moba_queue(Frame& F) {
    const unsigned x0 = xb_xcc_id() & 7u;
    for (unsigned k = 0; k < 8u;) {
        const unsigned x = (x0 + k) & 7u;
        __syncthreads();
        if (F.tid == 0) F.MISC[0] = __hip_atomic_fetch_add(F.ctl + CW_Q + 64 * x, 1u, __ATOMIC_RELAXED, __HIP_MEMORY_SCOPE_AGENT);
        __syncthreads();
        const unsigned q = F.MISC[0];
        if (q >= 64u) { ++k; continue; }
        const int bh = (int)((q >> 3) * 8u + x), jj = (int)(q & 7u); moba_unit(F, bh, 15 - jj); moba_unit(F, bh, jj);
    }
}
struct Args { const float* in[20]; float* out; unsigned char* ws; int ph_lo, ph_hi, li, pad; };
__global__ void __launch_bounds__(NWAVES * 64, 2) fwd(Args args) {
    extern __shared__ __attribute__((aligned(16))) unsigned char lds[];
    Frame F;
    F.lds = (LAS unsigned char*)lds;
    F.MISC = (volatile LAS unsigned*)(F.lds + MISC_OFF);
    F.tid = threadIdx.x; F.lane = F.tid & 63; F.wave = __builtin_amdgcn_readfirstlane(F.tid >> 6);
    F.G = gridDim.x; { const int bx = blockIdx.x; F.vcu = (F.G % 8 == 0) ? (bx % 8) * (F.G / 8) + bx / 8 : bx; }
    unsigned char* ws = args.ws;
    F.ctl = (unsigned*)(ws + WS_CTL); F.wsb = ws;
#pragma unroll
    for (int i = 0; i < 20; ++i) F.in[i] = args.in[i];
    F.out = args.out;
    for (int u = F.tid; u < (LDS_BYTES - MISC_OFF) / 4; u += NWAVES * 64) ((LAS unsigned*)(F.lds + MISC_OFF))[u] = 0u;
    __syncthreads();
    XcdBarrier bar; bar.bar = (unsigned*)(F.ctl + CW_BAR); bar.x = 0; bar.st = nullptr;
#if MK_SINGLE
    bar = xcd_barrier_post((unsigned*)(F.ctl + CW_BAR), F.MISC + 8);
#define GRID_BAR() xcd_barrier(bar)
#else
#define GRID_BAR() do { } while (0)
#endif
    const int lo = args.ph_lo, hi = args.ph_hi;
#define IN(k) (lo <= (k) && (k) < hi)
#define BOTH(k) (IN(k) && IN((k) + 1))
#ifndef PROBE_REP
#define PROBE_REP -1
#endif
#define REFRESH() do { int t_ = threadIdx.x; asm volatile("" : "+v"(t_)); F.tid = t_; F.lane = t_ & 63; F.wave = __builtin_amdgcn_readfirstlane(t_ >> 6); } while (0)
#define REP(k) _Pragma("unroll") for (int rep_ = 0; rep_ < ((PROBE_REP == (k)) ? 2 : 1); ++rep_)
    typedef pg8::bf16_t pb;
    REP(0) if (IN(0)) { REFRESH(); quant_ffn_gu(F, F.in[2], F.in[3], (float*)F.CM(0)); quant_wd(F, F.in[4], (float*)F.CMD(0)); rope_table(F);
        rms_rows_i8(F, F.in[0], F.in[1], (unsigned char*)F.H(), F.RS()); if (BOTH(0)) GRID_BAR(); }
    REP(1) if (IN(1)) { pg8::Gemm g{(const pb*)F.H(), (const pb*)F.WGU(), M, 2 * FF, DM}; pg8::StaticOrder S; S.init(M, 2 * FF, F.G, (int)blockIdx.x);
        pg8::EpiSwiGLUT<true> E{(pb*)F.ACT(), FF, F.RS(), (const float*)F.CM(0), F.RM(0)}; pg8::gemm_phase<pg8::EpiSwiGLUT<true>, pg8::StaticOrder, true, true, 3>(F.lds, g, S, E); if (BOTH(1)) GRID_BAR(); }
    REP(2) if (IN(2)) { REFRESH(); requant_rows(F, F.ACT(), F.ACT8(), F.RS()); GRID_BAR();
        pg8::Gemm g{(const pb*)F.ACT8(), (const pb*)F.WD(), M, DM, FF}; pg8::StaticOrder S; S.init(M, DM, F.G, (int)blockIdx.x);
        pg8::EpiResid8 E{F.in[0], F.out, DM, 0.5f, nullptr, nullptr, nullptr, F.RS(), (const float*)F.CMD(0)}; pg8::gemm_phase<pg8::EpiResid8, pg8::StaticOrder, true, true, 3>(F.lds, g, S, E); if (BOTH(2)) GRID_BAR(); }
    REP(3) if (IN(3)) { REFRESH(); convert_win(F); rms_rows_i8(F, F.out, F.in[5], F.H8(), F.RS(), F.H()); if (BOTH(3)) GRID_BAR(); }
    REP(4) if (IN(4)) { { pg8::Gemm g{(const pb*)F.H(), (const pb*)F.WB(), M, NPROJ, DM, 0}; pg8::StaticOrder S; S.init(M, NPROJ, F.G, (int)blockIdx.x);
          typedef pg8::EpiProjT<false, 0, PA_LD, 48, (long)((WS_PB - WS_BIG) / 2), PB_LD, 16, 0, PB_LD, 0> EP; EP E{(pb*)F.PA(), F.AB(), nullptr, nullptr}; pg8::gemm_phase<EP, pg8::StaticOrder, true, true>(F.lds, g, S, E); }
        { pg8::Gemm g{(const pb*)F.H8(), (const pb*)F.W8(), M, NGATE, DM, 0}; pg8::StaggerOrder S;
          { const int nb = (M / 256) * (NPROJ / 256), n8 = (M / 256) * (NGATE / 256), G = F.G; int c0 = nb % G, R0 = (n8 - 2 * (G - c0)) / G; if ((G & 7) || (c0 & 7) || R0 < 0) { c0 = 0; R0 = 0; }
            S.init2(M, NGATE, G, (int)blockIdx.x, R0, c0); }
          typedef pg8::EpiProjT<true, PA_MV, PA_LD, 8, (long)((WS_PB - WS_BIG) / 2) + PB_GG, PB_LD, 32, 0, PB_LD, 0> EP8; EP8 E{(pb*)F.PA(), F.AB(), F.RS(), (const float*)F.CMW()};
          pg8::gemm_phase<EP8, pg8::StaggerOrder, true, true, 3>(F.lds, g, S, E); }
        if (BOTH(4)) GRID_BAR(); }
    REP(5) if (IN(5)) { REFRESH(); prep_moba(F); prep_gdn(F); __syncthreads(); convert_branch(F); if (BOTH(5)) GRID_BAR(); }
    REP(6) if (IN(6)) { REFRESH(); gdn_local_phase(F); if (BOTH(6)) GRID_BAR(); }
    REP(7) if (IN(7)) { REFRESH(); for (int seq = blockIdx.x; seq < BATCH * 32; seq += F.G) gdn_scan_seq(F, seq); moba_queue(F); if (BOTH(7)) GRID_BAR(); }
    REP(8) if (IN(8)) { pg8::Gemm g{(const pb*)F.OG(), (const pb*)F.WBG(), M, DM, 4096}; pg8::StaticOrder S; S.init(M, DM, F.G, (int)blockIdx.x);
        pg8::EpiGate<true> E{(pb*)F.H(), DM, (const pb*)F.PB() + PB_GG, PB_LD}; pg8::gemm_phase<pg8::EpiGate<true>, pg8::StaticOrder, true, true>(F.lds, g, S, E); }
    REP(9) if (IN(9)) { pg8::Gemm g{(const pb*)F.OM(), (const pb*)F.WBM(), M, DM, 2048, 0x7b7b7b7b}; pg8::StaticOrder S; S.init(M, DM, F.G, (int)blockIdx.x);
        pg8::EpiGate<false> E{(pb*)F.H(), DM, (const pb*)F.PB() + PB_MG, PB_LD}; pg8::gemm_phase<pg8::EpiGate<false>, pg8::StaticOrder, true, true, true>(F.lds, g, S, E); if (BOTH(9)) GRID_BAR(); }
    REP(10) if (IN(10)) { pg8::Gemm g{(const pb*)F.H(), (const pb*)F.WO(), M, DM, DM}; pg8::StaticOrder S; S.init(M, DM, F.G, (int)blockIdx.x);
        pg8::EpiResid E{F.out, F.out, DM, 1.0f, nullptr, nullptr, nullptr, nullptr, nullptr}; pg8::gemm_phase<pg8::EpiResid, pg8::StaticOrder, true, true>(F.lds, g, S, E); if (BOTH(10)) GRID_BAR(); }
    REP(11) if (IN(11)) { REFRESH(); quant_ffn_gu(F, F.in[17], F.in[18], (float*)F.CM(1)); quant_wd(F, F.in[19], (float*)F.CMD(1)); rms_rows_i8(F, F.out, F.in[16], (unsigned char*)F.H(), F.RS()); if (BOTH(11)) GRID_BAR(); }
    REP(12) if (IN(12)) { pg8::Gemm g{(const pb*)F.H(), (const pb*)F.WGU(), M, 2 * FF, DM}; pg8::StaticOrder S; S.init(M, 2 * FF, F.G, (int)blockIdx.x);
        pg8::EpiSwiGLUT<true> E{(pb*)F.ACT(), FF, F.RS(), (const float*)F.CM(1), F.RM(1)}; pg8::gemm_phase<pg8::EpiSwiGLUT<true>, pg8::StaticOrder, true, true, 3>(F.lds, g, S, E); if (BOTH(12)) GRID_BAR(); }
    REP(13) if (IN(13)) { REFRESH(); requant_rows(F, F.ACT(), F.ACT8(), F.RS()); GRID_BAR();
        pg8::Gemm g{(const pb*)F.ACT8(), (const pb*)F.WD(), M, DM, FF}; pg8::StaticOrder S; S.init(M, DM, F.G, (int)blockIdx.x);
        pg8::EpiResid8 E{F.out, F.out, DM, 0.5f, nullptr, nullptr, nullptr, F.RS(), (const float*)F.CMD(1)}; pg8::gemm_phase<pg8::EpiResid8, pg8::StaticOrder, true, true, 3>(F.lds, g, S, E); }
#undef IN
#undef BOTH
}

extern "C" void kernel_launch(void* const* d_in, const int* in_sizes, int n_in, void* d_out, int out_size, void* d_ws, size_t ws_size, hipStream_t stream) {
    static int grid = 0;
    if (grid == 0) {
        if (n_in != 20 || out_size != M * DM || ws_size < WS_END) { fprintf(stderr, "kernel_launch: unexpected shapes (n_in %d out %d ws %zu)\n", n_in, out_size, ws_size); grid = -1; return; }
        int dev = 0, cus = 0;
        if (hipGetDevice(&dev) != hipSuccess || hipDeviceGetAttribute(&cus, hipDeviceAttributeMultiprocessorCount, dev) != hipSuccess) { grid = -1; return; }
        if (hipFuncSetAttribute((const void*)fwd, hipFuncAttributeMaxDynamicSharedMemorySize, LDS_BYTES) != hipSuccess) { fprintf(stderr, "kernel_launch: hipFuncSetAttribute failed\n"); grid = -1; return; }
        (void)hipGetLastError();
        grid = cus;
    }
    if (grid < 0) return;
    (void)hipMemsetAsync((char*)d_ws + WS_CTL, 0, CTL_ZERO_BYTES, stream);
    Args a{};
    for (int i = 0; i < 20; ++i) a.in[i] = (const float*)d_in[i];
    a.out = (float*)d_out; a.ws = (unsigned char*)d_ws;
#if MK_SINGLE
    a.ph_lo = 0; a.ph_hi = N_PHASES; a.li = 0;
    hipLaunchKernelGGL(fwd, dim3(grid), dim3(NWAVES * 64), LDS_BYTES, stream, a);
#else
    for (int p = 0; p < N_PHASES; ++p) { a.ph_lo = p; a.ph_hi = p + 1; a.li = p;
        hipLaunchKernelGGL(fwd, dim3(grid), dim3(NWAVES * 64), LDS_BYTES, stream, a); }
#endif
}
```

```cpp
#include <hip/hip_runtime.h>
#include <cstdio>
#include <cstdint>
#include <cmath>
namespace pg8 {
#define PG8_LAS __attribute__((address_space(3)))
typedef unsigned short bf16_t;
typedef short bf16x8 __attribute__((ext_vector_type(8)));
typedef float f32x4 __attribute__((ext_vector_type(4)));
typedef unsigned u32x4 __attribute__((ext_vector_type(4)));
constexpr int BM = 256, BK = 64, HALF = 128, HTB = HALF * BK * 2  , STAGE_BYTES = 8 * HTB, NXCD = 8, WGM = 8;

__host__ __device__ __forceinline__ int lds_byte(int r, int c) { const int st = (r >> 4) * 2 + (c >> 5), rr = r & 15, cc = c & 31, ob = rr * 64 + cc * 2; return st * 1024 + (ob ^ (((ob >> 9) & 1) << 5)); }
__host__ __device__ __forceinline__ void stage_rc(int b, int& R, int& C) { const int st = b / 1024, sb = b % 1024, swz = sb ^ (((sb >> 9) & 1) << 5); R = (st >> 1) * 16 + swz / 64; C = (st & 1) * 32 + (swz % 64) / 2; }
__host__ __device__ __forceinline__ int perm32(int rho) { const int n = rho >> 4, i = rho & 15; return 8 * (i >> 2) + 4 * n + (i & 3); }

struct Unit { int pm, pn; };
struct Gemm { const bf16_t* A; const bf16_t* Bt; int M, N, K; int sA; int nb16; };

struct StaticOrder {
    int nM, nN, nwg, G, c;
    __host__ __device__ void init(int M, int N, int G_, int c_) { nM = M / BM; nN = N / BM; nwg = nM * nN; G = G_; c = c_; }
    __host__ __device__ bool next(int i, Unit& u) const {
        const long L = (long)i * G + c; if (L >= nwg) return false;
        int wgid = (int)L; { const int q = nwg / NXCD, r = nwg % NXCD, xcd = wgid % NXCD, off = wgid / NXCD; wgid = (xcd < r ? xcd * (q + 1) : r * (q + 1) + (xcd - r) * q) + off; }
        const int nig = WGM * nN, gid = wgid / nig, fm = gid * WGM, gsz = (nM - fm) < WGM ? (nM - fm) : WGM;
        u.pm = fm + ((wgid % nig) % gsz); u.pn = (wgid % nig) / gsz; return true;
    }
    __device__ __forceinline__ void a_ready(const Unit&) const {}
    __device__ __forceinline__ void done(const Unit&) const {}
};
struct StaggerOrder : StaticOrder {
    int R0, c0;
    __host__ __device__ void init2(int M, int N, int G_, int c_, int R0_, int c0_) { init(M, N, G_, c_); R0 = R0_; c0 = c0_; }
    __host__ __device__ bool next(int i, Unit& u) const {
        long L;
        if (i < R0) L = (long)i * G + c; else { if (c < c0) return false; L = (long)R0 * G + (long)(i - R0) * (G - c0) + (c - c0); }
        if (L >= nwg) return false;
        int wgid = (int)L; { const int q = nwg / NXCD, r = nwg % NXCD, xcd = wgid % NXCD, off = wgid / NXCD; wgid = (xcd < r ? xcd * (q + 1) : r * (q + 1) + (xcd - r) * q) + off; }
        const int nig = WGM * nN, gid = wgid / nig, fm = gid * WGM, gsz = (nM - fm) < WGM ? (nM - fm) : WGM;
        u.pm = fm + ((wgid % nig) % gsz); u.pn = (wgid % nig) / gsz; return true;
    }
};
__device__ __forceinline__ unsigned cvt_pk_bf16(float lo, float hi) { unsigned r; asm volatile("v_cvt_pk_bf16_f32 %0, %1, %2" : "=v"(r) : "v"(lo), "v"(hi)); return r; }
__device__ __forceinline__ float sigmoid_fast(float x) { return __builtin_amdgcn_rcpf(1.0f + __expf(-x)); }
__device__ __forceinline__ float bf_lo(unsigned w) { return __uint_as_float(w << 16); }
__device__ __forceinline__ float bf_hi(unsigned w) { return __uint_as_float(w & 0xffff0000u); }
__device__ __forceinline__ float row_rstd(const unsigned long long* SS, size_t row) { const float s = (float)SS[row] * (1.0f / 16777216.0f); return 1.0f / sqrtf(s * (1.0f / 4096.0f) + 1e-6f); }
__device__ __forceinline__ float fq_sum(float v) {
    auto a = __builtin_amdgcn_permlane16_swap(__float_as_uint(v), __float_as_uint(v), false, false); v = __uint_as_float(a[0]) + __uint_as_float(a[1]);
    auto b = __builtin_amdgcn_permlane32_swap(__float_as_uint(v), __float_as_uint(v), false, false); return __uint_as_float(b[0]) + __uint_as_float(b[1]); }
__device__ __forceinline__ unsigned pk4_e4m3(float a, float b, float c, float d) { int w = 0; w = __builtin_amdgcn_cvt_pk_fp8_f32(a, b, w, false); w = __builtin_amdgcn_cvt_pk_fp8_f32(c, d, w, true); return (unsigned)w; }
__device__ __forceinline__ void had32_lanes(float (&x)[8], int fq) {
#pragma unroll
    for (int h = 1; h < 8; h <<= 1)
#pragma unroll
        for (int i = 0; i < 8; ++i) if (!(i & h)) { const float a = x[i], b = x[i + h]; x[i] = a + b; x[i + h] = a - b; }
#pragma unroll
    for (int i = 0; i < 8; ++i) { auto a = __builtin_amdgcn_permlane16_swap(__float_as_uint(x[i]), __float_as_uint(x[i]), false, false);
        const float lo = __uint_as_float(a[0]), hi = __uint_as_float(a[1]); x[i] = (fq & 1) ? lo - hi : lo + hi; }
#pragma unroll
    for (int i = 0; i < 8; ++i) { auto b = __builtin_amdgcn_permlane32_swap(__float_as_uint(x[i]), __float_as_uint(x[i]), false, false);
        const float lo = __uint_as_float(b[0]), hi = __uint_as_float(b[1]); x[i] = ((fq & 2) ? lo - hi : lo + hi) * 0.17677669529663687f; }
}
__device__ __forceinline__ float fq_max(float v) {
    auto a = __builtin_amdgcn_permlane16_swap(__float_as_uint(v), __float_as_uint(v), false, false); v = fmaxf(__uint_as_float(a[0]), __uint_as_float(a[1]));
    auto b = __builtin_amdgcn_permlane32_swap(__float_as_uint(v), __float_as_uint(v), false, false); return fmaxf(__uint_as_float(b[0]), __uint_as_float(b[1])); }
template <bool I8, bool HAD = false> struct EpiSwiGLUT {
    static constexpr bool PERM = true, AFTER_DRAIN = false;
    bf16_t* O; int ldc; const float* RS; const float* CS; unsigned* RM;
    __device__ __forceinline__ void operator()(const f32x4 (&acc)[2][2][4][2], const Unit& u, int wr, int wc, int fr, int fq) const {
        const unsigned row0 = u.pm * BM + wr * 64 + fr; const int col0 = u.pn * HALF + wc * 32 + 8 * fq;
        float rs[8]; f32x4 cg0, cg1, cu0, cu1;
        if constexpr (I8) {
#pragma unroll
            for (int i = 0; i < 8; ++i) rs[i] = RS[row0 + (i >> 2) * HALF + (i & 3) * 16] * (1.0f / 127.0f);
            const float* cp = CS + u.pn * BM + wc * 32 + 8 * fq; cg0 = *(const f32x4*)cp; cg1 = *(const f32x4*)(cp + 4); cu0 = *(const f32x4*)(cp + HALF); cu1 = *(const f32x4*)(cp + HALF + 4);
        }
#pragma unroll
        for (int ai = 0; ai < 2; ++ai)
#pragma unroll
            for (int m = 0; m < 4; ++m) { const unsigned row = row0 + ai * HALF + m * 16; bf16_t* rowp = O + (size_t)row * ldc + col0;
                float x[8];
#pragma unroll
                for (int j = 0; j < 4; ++j) { float g0, g1, u0, u1;
                    if constexpr (I8) { const float r = rs[ai * 4 + m];
                        g0 = (float)__float_as_int(acc[ai][0][m][0][j]) * (r * cg0[j]); g1 = (float)__float_as_int(acc[ai][0][m][1][j]) * (r * cg1[j]);
                        u0 = (float)__float_as_int(acc[ai][1][m][0][j]) * (r * cu0[j]); u1 = (float)__float_as_int(acc[ai][1][m][1][j]) * (r * cu1[j]); }
                    else { g0 = acc[ai][0][m][0][j]; g1 = acc[ai][0][m][1][j]; u0 = acc[ai][1][m][0][j]; u1 = acc[ai][1][m][1][j]; }
                    x[j] = g0 * sigmoid_fast(g0) * u0; x[4 + j] = g1 * sigmoid_fast(g1) * u1; }
                if constexpr (HAD) had32_lanes(x, fq);
                u32x4 w; w.x = cvt_pk_bf16(x[0], x[1]); w.y = cvt_pk_bf16(x[2], x[3]); w.z = cvt_pk_bf16(x[4], x[5]); w.w = cvt_pk_bf16(x[6], x[7]); *(u32x4*)rowp = w;
                if constexpr (HAD) {
                    float mx = fmaxf(fmaxf(fmaxf(fabsf(x[0]), fabsf(x[1])), fmaxf(fabsf(x[2]), fabsf(x[3]))), fmaxf(fmaxf(fabsf(x[4]), fabsf(x[5])), fmaxf(fabsf(x[6]), fabsf(x[7]))));
                    mx = fq_max(mx);
                    if (fq == 0) atomicMax(RM + row, __float_as_uint(mx)); } }
    }
};
template <bool NORM, bool FP8COPY, bool I8 = false> struct EpiResidT {
    static constexpr bool PERM = true, AFTER_DRAIN = false;
    const float* base; float* out; int ldc; float scale; bf16_t* Hb; unsigned char* H8; unsigned long long* SS; const float* RS; const float* CS;
    __device__ __forceinline__ void operator()(const f32x4 (&acc)[2][2][4][2], const Unit& u, int wr, int wc, int fr, int fq) const {
        const unsigned row0 = u.pm * BM + wr * 64 + fr, col0 = u.pn * BM + wc * 32 + 8 * fq;
        const char* bp = (const char*)base; char* op = (char*)out; char* hp = (char*)Hb; char* h8 = (char*)H8; char* sp = (char*)SS;
        f32x4 cb[4], nb[4]; float rs[8]; f32x4 cs[2][2];
        if constexpr (I8) {
#pragma unroll
            for (int i = 0; i < 8; ++i) rs[i] = RS[row0 + (i >> 2) * HALF + (i & 3) * 16] * (scale / 127.0f);
            const float* cp = CS + col0; cs[0][0] = *(const f32x4*)cp; cs[0][1] = *(const f32x4*)(cp + 4); cs[1][0] = *(const f32x4*)(cp + HALF); cs[1][1] = *(const f32x4*)(cp + HALF + 4);
        }
#define EPI_LD(dst, i) do { const unsigned o_ = ((row0 + ((i) >> 2) * HALF + ((i) & 3) * 16) * (unsigned)ldc + col0) * 4u; \
            dst[0] = *(const f32x4*)(bp + o_); dst[1] = *(const f32x4*)(bp + (o_ + 16u)); dst[2] = *(const f32x4*)(bp + (o_ + 512u)); dst[3] = *(const f32x4*)(bp + (o_ + 528u)); } while (0)
        EPI_LD(cb, 0);
#pragma unroll
        for (int i = 0; i < 8; ++i) { const int ai = i >> 2, m = i & 3; const unsigned row = row0 + ai * HALF + m * 16, off = row * (unsigned)ldc + col0; float ss = 0.f;
            if (i + 1 < 8) EPI_LD(nb, i + 1);
#pragma unroll
            for (int bj = 0; bj < 2; ++bj) { const unsigned o = off + bj * HALF;
                f32x4 v0, v1;
                if constexpr (I8) { const float r = rs[i];
#pragma unroll
                    for (int j = 0; j < 4; ++j) { const float a0 = acc[ai][bj][m][0][j], a1 = acc[ai][bj][m][1][j];
                        v0[j] = cb[2 * bj][j] + (float)__float_as_int(a0) * (r * cs[bj][0][j]); v1[j] = cb[2 * bj + 1][j] + (float)__float_as_int(a1) * (r * cs[bj][1][j]); } }
                else { v0 = cb[2 * bj] + acc[ai][bj][m][0] * scale; v1 = cb[2 * bj + 1] + acc[ai][bj][m][1] * scale; }
                *(f32x4*)(op + o * 4u) = v0; *(f32x4*)(op + (o * 4u + 16u)) = v1;
                if constexpr (NORM) {
                    ss += (v0[0] * v0[0] + v0[1] * v0[1]) + (v0[2] * v0[2] + v0[3] * v0[3]) + (v1[0] * v1[0] + v1[1] * v1[1]) + (v1[2] * v1[2] + v1[3] * v1[3]);
                    u32x4 w; w.x = cvt_pk_bf16(v0[0], v0[1]); w.y = cvt_pk_bf16(v0[2], v0[3]); w.z = cvt_pk_bf16(v1[0], v1[1]); w.w = cvt_pk_bf16(v1[2], v1[3]);
                    *(u32x4*)(hp + o * 2u) = w;
                    if constexpr (FP8COPY) { typedef unsigned u32x2 __attribute__((ext_vector_type(2))); u32x2 w8; w8.x = pk4_e4m3(v0[0], v0[1], v0[2], v0[3]); w8.y = pk4_e4m3(v1[0], v1[1], v1[2], v1[3]); *(u32x2*)(h8 + o) = w8; } } }
            if constexpr (NORM) {
                ss = fq_sum(ss) * 16777216.0f;
                const unsigned hi = (unsigned)(ss * 2.3283064365386963e-10f), lo = (unsigned)(ss - (float)hi * 4294967296.0f);
                if (fq == 0) atomicAdd((unsigned long long*)(sp + row * 8u), ((unsigned long long)hi << 32) | lo); }
#pragma unroll
            for (int q = 0; q < 4; ++q) cb[q] = nb[q]; }
#undef EPI_LD
    }
};
typedef EpiResidT<false, false> EpiResid;
typedef EpiResidT<false, false, true> EpiResid8;
template <bool FP8COPY> using EpiResidN = EpiResidT<true, FP8COPY>;
template <bool I8, long oA, int ldA, int nA, long oB, int ldB, int nB, long oC, int ldC, int nC> struct EpiProjT {
    static constexpr bool PERM = true, AFTER_DRAIN = false;
    bf16_t* base; float* AB; const float* RS; const float* CS;
    __device__ __forceinline__ void operator()(const f32x4 (&acc)[2][2][4][2], const Unit& u, int wr, int wc, int fr, int fq) const {
        const int row0 = u.pm * BM + wr * 64 + fr;
        if (u.pn < nA + nB + nC) {
            const int sg = u.pn < nA ? 0 : (u.pn < nA + nB ? 1 : 2); bf16_t* O = base + (sg == 0 ? oA : (sg == 1 ? oB : oC)); const int ldc = sg == 0 ? ldA : (sg == 1 ? ldB : ldC);
            const int col0 = (sg == 0 ? u.pn : (sg == 1 ? u.pn - nA : u.pn - nA - nB)) * BM + wc * 32 + 8 * fq;
            float rs[8]; f32x4 cs[2][2];
            if constexpr (I8) {
#pragma unroll
                for (int i = 0; i < 8; ++i) rs[i] = RS[row0 + (i >> 2) * HALF + (i & 3) * 16] * (1.0f / 127.0f);
                const float* cp = CS + u.pn * BM + wc * 32 + 8 * fq; cs[0][0] = *(const f32x4*)cp; cs[0][1] = *(const f32x4*)(cp + 4); cs[1][0] = *(const f32x4*)(cp + HALF); cs[1][1] = *(const f32x4*)(cp + HALF + 4);
            }
#pragma unroll
            for (int ai = 0; ai < 2; ++ai)
#pragma unroll
                for (int m = 0; m < 4; ++m) { const size_t row = (size_t)(row0 + ai * HALF + m * 16); bf16_t* rowp = O + row * ldc + col0;
#pragma unroll
                    for (int bj = 0; bj < 2; ++bj) { f32x4 v0 = acc[ai][bj][m][0], v1 = acc[ai][bj][m][1];
                        if constexpr (I8) { const float r = rs[ai * 4 + m];
#pragma unroll
                            for (int j = 0; j < 4; ++j) { const float a0 = v0[j], a1 = v1[j]; v0[j] = (float)__float_as_int(a0) * (r * cs[bj][0][j]); v1[j] = (float)__float_as_int(a1) * (r * cs[bj][1][j]); } }
                        u32x4 w; w.x = cvt_pk_bf16(v0[0], v0[1]); w.y = cvt_pk_bf16(v0[2], v0[3]); w.z = cvt_pk_bf16(v1[0], v1[1]); w.w = cvt_pk_bf16(v1[2], v1[3]);
                        *(u32x4*)(rowp + bj * HALF) = w; } }
        } else if (wc < 2) {
#pragma unroll
            for (int ai = 0; ai < 2; ++ai)
#pragma unroll
                for (int m = 0; m < 4; ++m) { const size_t row = (size_t)(row0 + ai * HALF + m * 16); float* p = AB + row * 64 + wc * 32 + 8 * fq;
                    *(f32x4*)p = acc[ai][0][m][0]; *(f32x4*)(p + 4) = acc[ai][0][m][1]; }
        }
    }
};
template <bool FIRST> struct EpiGate {
    static constexpr bool PERM = true, AFTER_DRAIN = false;
    bf16_t* Y; int ldy; const bf16_t* gate; int ldg;
    __device__ __forceinline__ void operator()(const f32x4 (&acc)[2][2][4][2], const Unit& u, int wr, int wc, int fr, int fq) const {
        const unsigned row0 = u.pm * BM + wr * 64 + fr, col0 = u.pn * BM + wc * 32 + 8 * fq;
        const char* gp = (const char*)gate; char* yb = (char*)Y;
        u32x4 cg[2], ng[2], cy[2], ny[2];
#define EPI_LD(dg, dy, i) do { const unsigned r_ = row0 + ((i) >> 2) * HALF + ((i) & 3) * 16; const unsigned og_ = (r_ * (unsigned)ldg + col0) * 2u, oy_ = (r_ * (unsigned)ldy + col0) * 2u; \
            dg[0] = *(const u32x4*)(gp + og_); dg[1] = *(const u32x4*)(gp + (og_ + 256u)); if (!FIRST) { dy[0] = *(const u32x4*)(yb + oy_); dy[1] = *(const u32x4*)(yb + (oy_ + 256u)); } } while (0)
        EPI_LD(cg, cy, 0);
#pragma unroll
        for (int i = 0; i < 8; ++i) { const int ai = i >> 2, m = i & 3; const unsigned row = row0 + ai * HALF + m * 16;
            if (i + 1 < 8) EPI_LD(ng, ny, i + 1);
#pragma unroll
            for (int bj = 0; bj < 2; ++bj) { const u32x4 gw = cg[bj];
                f32x4 s0, s1; s0[0] = sigmoid_fast(bf_lo(gw.x)); s0[1] = sigmoid_fast(bf_hi(gw.x)); s0[2] = sigmoid_fast(bf_lo(gw.y)); s0[3] = sigmoid_fast(bf_hi(gw.y));
                s1[0] = sigmoid_fast(bf_lo(gw.z)); s1[1] = sigmoid_fast(bf_hi(gw.z)); s1[2] = sigmoid_fast(bf_lo(gw.w)); s1[3] = sigmoid_fast(bf_hi(gw.w));
                f32x4 v0 = acc[ai][bj][m][0] * s0, v1 = acc[ai][bj][m][1] * s1;
                if (!FIRST) { const u32x4 p = cy[bj]; v0[0] += bf_lo(p.x); v0[1] += bf_hi(p.x); v0[2] += bf_lo(p.y); v0[3] += bf_hi(p.y); v1[0] += bf_lo(p.z); v1[1] += bf_hi(p.z); v1[2] += bf_lo(p.w); v1[3] += bf_hi(p.w); }
                u32x4 w; w.x = cvt_pk_bf16(v0[0], v0[1]); w.y = cvt_pk_bf16(v0[2], v0[3]); w.z = cvt_pk_bf16(v1[0], v1[1]); w.w = cvt_pk_bf16(v1[2], v1[3]);
                *(u32x4*)(yb + ((row * (unsigned)ldy + col0) * 2u + bj * 256u)) = w; }
#pragma unroll
            for (int q = 0; q < 2; ++q) { cg[q] = ng[q]; if (!FIRST) cy[q] = ny[q]; } }
#undef EPI_LD
    }
};
template <class Epi, class Sched, bool ALIGN_EPI = false, bool SP2 = false, int FM = 0>
__device__ __forceinline__ void gemm_phase(PG8_LAS unsigned char* lds, const Gemm g, const Sched& S, const Epi& E) {
    int tid_o = threadIdx.x; asm volatile("" : "+v"(tid_o));
    const int tid = tid_o, wid = __builtin_amdgcn_readfirstlane(tid >> 6), lane = tid & 63, wr = wid >> 2, wc = wid & 3, fr = lane & 15, fq = lane >> 4;
    constexpr bool F8 = (FM == 1 || FM == 2); static_assert(FM != 2 || SP2, "mixed rows: SP2 only");
    constexpr int ES = (FM == 1 || FM == 3) ? 1 : 2;
    const int K = g.K, nt = K * ES / (BK * 2);
    const int f8_sw = 0x79797979, f8_sh = g.sA;
    unsigned voffA[2], voffB[2];
#pragma unroll
    for (int i = 0; i < 2; ++i) { int R, C; stage_rc(tid * 16 + i * 8192, R, C); const int Rb = Epi::PERM ? ((R & ~31) + perm32(R & 31)) : R;
        voffA[i] = (unsigned)(R * K) * ES + (unsigned)C * 2u; voffB[i] = (unsigned)(Rb * K) * ES + (unsigned)C * 2u; }
    const size_t kstep = (size_t)(BK * 2);
    const size_t hstep = (size_t)HALF * K * ES;
    const size_t tstep = 2 * hstep;
    const unsigned ldsw = (unsigned)wid * 1024u;
    const int aoff = lds_byte(wr * 64 + fr, fq * 8), boff = lds_byte(wc * 32 + fr, fq * 8);
#define PG8_SA(b, h) (((b) * 2 + (h)) * HTB)
#define PG8_SB(b, h) ((4 + (b) * 2 + (h)) * HTB)
#define PG8_STAGE(bufoff, gbase, voff) do { _Pragma("unroll") for (int _i = 0; _i < 2; ++_i) \
        __builtin_amdgcn_global_load_lds((const unsigned*)((const char*)(gbase) + (voff)[_i]), (PG8_LAS unsigned*)(lds + (bufoff) + ldsw + _i * 8192), 16, 0, 0); } while (0)
#define PG8_LDA(dst, b, h) do { _Pragma("unroll") for (int m = 0; m < 4; ++m) _Pragma("unroll") for (int k = 0; k < 2; ++k) dst[m][k] = *(const PG8_LAS bf16x8*)(lds + PG8_SA(b, h) + aoff + m * 2048 + k * 1024); } while (0)
#define PG8_LDB(dst, b, h) do { _Pragma("unroll") for (int n = 0; n < 2; ++n) _Pragma("unroll") for (int k = 0; k < 2; ++k) dst[n][k] = *(const PG8_LAS bf16x8*)(lds + PG8_SB(b, h) + boff + n * 2048 + k * 1024); } while (0)
#define PG8_MMA(ai, bj, At, Bt, F8X) do { __builtin_amdgcn_s_setprio(1); \
        if constexpr ((int)(F8X) == 1) { typedef int v4i_ __attribute__((ext_vector_type(4))); typedef int v8i_ __attribute__((ext_vector_type(8))); \
            const v8i_ b80 = __builtin_shufflevector(__builtin_bit_cast(v4i_, Bt[0][0]), __builtin_bit_cast(v4i_, Bt[0][1]), 0, 1, 2, 3, 4, 5, 6, 7); \
            const v8i_ b81 = __builtin_shufflevector(__builtin_bit_cast(v4i_, Bt[1][0]), __builtin_bit_cast(v4i_, Bt[1][1]), 0, 1, 2, 3, 4, 5, 6, 7); \
            const v8i_ a80 = __builtin_shufflevector(__builtin_bit_cast(v4i_, At[0][0]), __builtin_bit_cast(v4i_, At[0][1]), 0, 1, 2, 3, 4, 5, 6, 7); \
            const v8i_ a81 = __builtin_shufflevector(__builtin_bit_cast(v4i_, At[1][0]), __builtin_bit_cast(v4i_, At[1][1]), 0, 1, 2, 3, 4, 5, 6, 7); \
            const v8i_ a82 = __builtin_shufflevector(__builtin_bit_cast(v4i_, At[2][0]), __builtin_bit_cast(v4i_, At[2][1]), 0, 1, 2, 3, 4, 5, 6, 7); \
            const v8i_ a83 = __builtin_shufflevector(__builtin_bit_cast(v4i_, At[3][0]), __builtin_bit_cast(v4i_, At[3][1]), 0, 1, 2, 3, 4, 5, 6, 7); \
              \
            asm volatile("s_nop 1\n\t" \
                "v_mfma_scale_f32_16x16x128_f8f6f4 %0, %8, %10, %0, %14, %15 op_sel_hi:[0,0,0]\n\tv_mfma_scale_f32_16x16x128_f8f6f4 %1, %9, %10, %1, %14, %15 op_sel_hi:[0,0,0]\n\t" \
                "v_mfma_scale_f32_16x16x128_f8f6f4 %2, %8, %11, %2, %14, %15 op_sel_hi:[0,0,0]\n\tv_mfma_scale_f32_16x16x128_f8f6f4 %3, %9, %11, %3, %14, %15 op_sel_hi:[0,0,0]\n\t" \
                "v_mfma_scale_f32_16x16x128_f8f6f4 %4, %8, %12, %4, %14, %15 op_sel_hi:[0,0,0]\n\tv_mfma_scale_f32_16x16x128_f8f6f4 %5, %9, %12, %5, %14, %15 op_sel_hi:[0,0,0]\n\t" \
                "v_mfma_scale_f32_16x16x128_f8f6f4 %6, %8, %13, %6, %14, %15 op_sel_hi:[0,0,0]\n\tv_mfma_scale_f32_16x16x128_f8f6f4 %7, %9, %13, %7, %14, %15 op_sel_hi:[0,0,0]" \
                : "+v"(acc[ai][bj][0][0]), "+v"(acc[ai][bj][0][1]), "+v"(acc[ai][bj][1][0]), "+v"(acc[ai][bj][1][1]), "+v"(acc[ai][bj][2][0]), "+v"(acc[ai][bj][2][1]), "+v"(acc[ai][bj][3][0]), "+v"(acc[ai][bj][3][1]) \
                : "v"(b80), "v"(b81), "v"(a80), "v"(a81), "v"(a82), "v"(a83), "v"(f8_sw), "v"(f8_sh)); } \
        else if constexpr ((int)(F8X) == 3) { typedef int v4i_ __attribute__((ext_vector_type(4))); \
            _Pragma("unroll") for (int m = 0; m < 4; ++m) _Pragma("unroll") for (int n = 0; n < 2; ++n) _Pragma("unroll") for (int k = 0; k < 2; ++k) \
            acc[ai][bj][m][n] = __builtin_bit_cast(f32x4, __builtin_amdgcn_mfma_i32_16x16x64_i8(__builtin_bit_cast(v4i_, Bt[n][k]), __builtin_bit_cast(v4i_, At[m][k]), __builtin_bit_cast(v4i_, acc[ai][bj][m][n]), 0, 0, 0)); } \
        else { _Pragma("unroll") for (int m = 0; m < 4; ++m) _Pragma("unroll") for (int n = 0; n < 2; ++n) _Pragma("unroll") for (int k = 0; k < 2; ++k) \
            acc[ai][bj][m][n] = __builtin_amdgcn_mfma_f32_16x16x32_bf16(Bt[n][k], At[m][k], acc[ai][bj][m][n], 0, 0, 0); } \
        __builtin_amdgcn_s_setprio(0); } while (0)
#define PG8_WAIT_V(n) asm volatile("s_waitcnt vmcnt(" #n ")" ::: "memory")
#define PG8_WAIT_L(n) asm volatile("s_waitcnt lgkmcnt(" #n ")" ::: "memory")
#define PG8_BAR __builtin_amdgcn_s_barrier()
#define PG8_SCHED __builtin_amdgcn_sched_barrier(0)
#define PG8_KT2(F8X) do { \
            PG8_LDB(B0, 0, 0); PG8_LDB(B1, 0, 1); PG8_SCHED; PG8_LDA(At, 0, 0); PG8_STAGE(PG8_SA(1, 1), a1 + hstep, voffA); \
            PG8_WAIT_V(8); PG8_WAIT_L(0); PG8_BAR; PG8_MMA(0, 0, At, B0, F8X); PG8_MMA(0, 1, At, B1, F8X); PG8_BAR; PG8_SCHED; \
            PG8_LDA(At, 0, 1); PG8_STAGE(PG8_SB(0, 0), b2, voffB); PG8_STAGE(PG8_SB(0, 1), b2 + hstep, voffB); PG8_STAGE(PG8_SA(0, 0), a2, voffA); \
            PG8_WAIT_V(8); PG8_WAIT_L(0); PG8_BAR; PG8_MMA(1, 0, At, B0, F8X); PG8_MMA(1, 1, At, B1, F8X); PG8_BAR; PG8_SCHED; \
            PG8_LDB(B0, 1, 0); PG8_LDB(B1, 1, 1); PG8_SCHED; PG8_LDA(At, 1, 0); PG8_STAGE(PG8_SA(0, 1), a2 + hstep, voffA); \
            PG8_WAIT_V(8); PG8_WAIT_L(0); PG8_BAR; PG8_MMA(0, 0, At, B0, F8X); PG8_MMA(0, 1, At, B1, F8X); PG8_BAR; PG8_SCHED; \
            PG8_LDA(At, 1, 1); PG8_STAGE(PG8_SB(1, 0), b3, voffB); PG8_STAGE(PG8_SB(1, 1), b3 + hstep, voffB); PG8_STAGE(PG8_SA(1, 0), a3, voffA); \
            PG8_WAIT_V(8); PG8_WAIT_L(0); PG8_BAR; PG8_MMA(1, 0, At, B0, F8X); PG8_MMA(1, 1, At, B1, F8X); PG8_BAR; PG8_SCHED; } while (0)
    Unit cur, nxt; int ui = 0;
    if (!S.next(0, cur)) return;
    f32x4 acc[2][2][4][2];
#pragma unroll
    for (int a = 0; a < 2; ++a)
#pragma unroll
        for (int b = 0; b < 2; ++b)
#pragma unroll
            for (int m = 0; m < 4; ++m)
#pragma unroll
                for (int n = 0; n < 2; ++n) acc[a][b][m][n] = (f32x4){0.f, 0.f, 0.f, 0.f};
    bf16x8 At[4][2], B0[2][2], B1[2][2];
    const char* cA = (const char*)g.A + (size_t)cur.pm * tstep; const char* cB = (const char*)g.Bt + (size_t)cur.pn * tstep;
    S.a_ready(cur);
    if constexpr (SP2) {
        PG8_STAGE(PG8_SB(0, 0), cB, voffB); PG8_STAGE(PG8_SB(0, 1), cB + hstep, voffB); PG8_STAGE(PG8_SA(0, 0), cA, voffA); PG8_STAGE(PG8_SA(0, 1), cA + hstep, voffA);
        if (wr == 1) PG8_BAR;
        PG8_WAIT_V(2); PG8_BAR;
        PG8_STAGE(PG8_SB(1, 0), cB + kstep, voffB); PG8_STAGE(PG8_SA(1, 0), cA + kstep, voffA); PG8_STAGE(PG8_SB(1, 1), cB + hstep + kstep, voffB);
        PG8_WAIT_V(6); PG8_BAR;
    } else {
        PG8_STAGE(PG8_SB(0, 0), cB, voffB); PG8_STAGE(PG8_SA(0, 0), cA, voffA); PG8_STAGE(PG8_SB(0, 1), cB + hstep, voffB); PG8_STAGE(PG8_SA(0, 1), cA + hstep, voffA);
        if (wr == 1) PG8_BAR;
        PG8_WAIT_V(4); PG8_BAR;
        PG8_STAGE(PG8_SB(1, 0), cB + kstep, voffB); PG8_STAGE(PG8_SA(1, 0), cA + kstep, voffA); PG8_STAGE(PG8_SB(1, 1), cB + hstep + kstep, voffB);
        PG8_WAIT_V(6); PG8_BAR;
    }
    for (;;) {
        const bool has_next = S.next(ui + 1, nxt);
        const char* nA = has_next ? (const char*)g.A + (size_t)nxt.pm * tstep : cA; const char* nB = has_next ? (const char*)g.Bt + (size_t)nxt.pn * tstep : cB;
        int t = 0;
        if constexpr (FM == 2) {
            for (; t < g.nb16; t += 2) {
                const char* a1 = cA + (size_t)(t + 1) * kstep; const char* a2 = cA + (size_t)(t + 2) * kstep; const char* b2 = cB + (size_t)(t + 2) * kstep;
                const char* a3 = a2 + kstep; const char* b3 = b2 + kstep;
                PG8_KT2(false);
            }
        }
        for (; t < nt; t += 2) {
            const bool last = (t == nt - 2);
            const char* a1 = cA + (size_t)(t + 1) * kstep;
            const char* a2 = last ? nA : cA + (size_t)(t + 2) * kstep; const char* b2 = last ? nB : cB + (size_t)(t + 2) * kstep;
            const char* a3 = a2 + kstep; const char* b3 = b2 + kstep;
            if (last && has_next) S.a_ready(nxt);
            if constexpr (SP2) {
                PG8_KT2(FM == 2 ? 1 : FM);
            } else {
            PG8_LDB(B0, 0, 0); PG8_SCHED; PG8_LDA(At, 0, 0); PG8_STAGE(PG8_SA(1, 1), a1 + hstep, voffA);
            PG8_WAIT_L(8); PG8_BAR; PG8_WAIT_L(0); PG8_MMA(0, 0, At, B0, FM); PG8_BAR; PG8_SCHED;
            PG8_LDB(B1, 0, 1); PG8_STAGE(PG8_SB(0, 0), b2, voffB);
            PG8_BAR; PG8_WAIT_L(0); PG8_MMA(0, 1, At, B1, FM); PG8_BAR;
            PG8_LDA(At, 0, 1); PG8_STAGE(PG8_SA(0, 0), a2, voffA);
            PG8_BAR; PG8_WAIT_L(0); PG8_MMA(1, 0, At, B0, FM); PG8_BAR; PG8_SCHED;
            PG8_STAGE(PG8_SB(0, 1), b2 + hstep, voffB);
            PG8_WAIT_V(6); PG8_BAR; PG8_MMA(1, 1, At, B1, FM); PG8_BAR;
            PG8_LDB(B0, 1, 0); PG8_SCHED; PG8_LDA(At, 1, 0); PG8_STAGE(PG8_SA(0, 1), a2 + hstep, voffA);
            PG8_WAIT_L(8); PG8_BAR; PG8_WAIT_L(0); PG8_MMA(0, 0, At, B0, FM); PG8_BAR; PG8_SCHED;
            PG8_LDB(B1, 1, 1); PG8_STAGE(PG8_SB(1, 0), b3, voffB);
            PG8_BAR; PG8_WAIT_L(0); PG8_MMA(0, 1, At, B1, FM); PG8_BAR;
            PG8_LDA(At, 1, 1); PG8_STAGE(PG8_SA(1, 0), a3, voffA);
            PG8_BAR; PG8_WAIT_L(0); PG8_MMA(1, 0, At, B0, FM); PG8_BAR; PG8_SCHED;
            PG8_STAGE(PG8_SB(1, 1), b3 + hstep, voffB);
            PG8_WAIT_V(6); PG8_BAR; PG8_MMA(1, 1, At, B1, FM); PG8_BAR;
            }
        }
        if constexpr (F8) asm volatile("s_nop 15\n\ts_nop 15" ::: "memory");
        if constexpr (ALIGN_EPI) { if (wr == 0) PG8_BAR; }
        if constexpr (!Epi::AFTER_DRAIN) { E(acc, cur, wr, wc, fr, fq); S.done(cur); }
        if (!has_next) break;
#pragma unroll
        for (int a = 0; a < 2; ++a)
#pragma unroll
            for (int b = 0; b < 2; ++b)
#pragma unroll
                for (int m = 0; m < 4; ++m)
#pragma unroll
                    for (int n = 0; n < 2; ++n) acc[a][b][m][n] = (f32x4){0.f, 0.f, 0.f, 0.f};
        cur = nxt; cA = nA; cB = nB; ++ui;
        if constexpr (ALIGN_EPI) { if (wr == 1) PG8_BAR; }
    }
    PG8_WAIT_V(0);
    if constexpr (!ALIGN_EPI) { if (wr == 0) PG8_BAR; }
    PG8_BAR;
    if constexpr (Epi::AFTER_DRAIN) { E.fused(acc, cur, wr, wc, fr, fq, lds, wid, lane); S.done(cur); }
#undef PG8_SA
#undef PG8_SB
#undef PG8_STAGE
#undef PG8_LDA
#undef PG8_LDB
#undef PG8_MMA
#undef PG8_KT2
#undef PG8_WAIT_V
#undef PG8_WAIT_L
#undef PG8_BAR
#undef PG8_SCHED
}
}
#ifndef MK_SINGLE
#define MK_SINGLE 1
#endif
constexpr int NWAVES = 8;
constexpr int BATCH = 4, SEQ = 4096, DM = 4096, FF = 11008, M = BATCH * SEQ;
constexpr int NPROJ = 16640, NGATE = 10240, PA_LD = 14336, PB_LD = 12288;
constexpr int PA_GQ = 0, PA_GK = 2048, PA_GV = 4096, PA_MQ = 8192, PA_MK = 10240, PA_MV = 12288, PB_GZ = 0, PB_GG = 4096, PB_MG = 8192;
constexpr float NORM_EPS = 1e-6f;
constexpr int KB16 = 11008, KF8 = FF - KB16, ACT2_PITCH = 2 * KB16 + KF8;
static_assert(KB16 % 128 == 0 && KF8 % 256 == 0, "mixed K split");
constexpr int N_PHASES = 14;

constexpr size_t MiB = 1u << 20;
constexpr size_t WS_CTL = 0, CTL_ZERO_BYTES = 64 * 1024;
constexpr size_t WS_KMEAN = 1 * MiB, WS_ROPE = 2 * MiB, WS_AB = 4 * MiB, WS_G = 8 * MiB, WS_BETA = 10 * MiB;
constexpr size_t WS_WGU = 16 * MiB, WS_WD = 188 * MiB;
constexpr size_t WS_H = 274 * MiB;
constexpr size_t WS_WB = 402 * MiB;
constexpr size_t WS_BIG = 612 * MiB, WS_PB = 1060 * MiB;
constexpr size_t WS_OG = 1444 * MiB, WS_OM = 1572 * MiB, WS_WBG = 1636 * MiB, WS_WBM = 1668 * MiB, WS_WO = 1684 * MiB, WS_H8 = 1716 * MiB, WS_END = 1780 * MiB;
constexpr size_t WS_W8 = 548 * MiB;
constexpr size_t WS_QN = 16 * MiB, WS_KN = 80 * MiB, WS_VP = 144 * MiB, WS_KNT = 274 * MiB;
constexpr size_t WS_U = 612 * MiB, WS_W = 740 * MiB, WS_AT = 868 * MiB, WS_GC = 932 * MiB;
constexpr size_t WS_MQ = 402 * MiB, WS_MK = 466 * MiB, WS_MV = 530 * MiB;
constexpr size_t WS_Y1 = 16 * MiB;
static_assert(WS_WGU + (size_t)22016 * 4096 * 2 <= WS_WD && WS_WD + (size_t)4096 * 11008 * 2 <= WS_H && WS_H + (size_t)M * DM * 2 <= WS_WB, "ws map 1");
static_assert(WS_WB + (size_t)NPROJ * DM * 2 <= WS_BIG && WS_BIG + (size_t)M * PA_LD * 2 <= WS_PB && WS_PB + (size_t)M * PB_LD * 2 <= WS_OG && WS_MV + (size_t)M * 2048 * 2 <= WS_BIG && WS_Y1 + (size_t)M * DM * 4 <= WS_H && WS_GC + (size_t)8192 * 64 * 4 <= WS_PB, "ws map 2");
constexpr int CW_BAR = 4096, CW_Q = 64;

constexpr int RING_BYTES = 131072, TR_STRIDE = 16640, PREP_STRIDE = 17408, MISC_OFF = 159744, LDS_BYTES = 163840;
static_assert(8 * TR_STRIDE <= MISC_OFF, "LDS map");

#define GAS __attribute__((address_space(1)))
#define LAS __attribute__((address_space(3)))
typedef unsigned short bf16;
typedef unsigned v4u __attribute__((ext_vector_type(4)));
typedef unsigned v2u __attribute__((ext_vector_type(2)));
typedef float f32x4 __attribute__((ext_vector_type(4)));
typedef float f32x2 __attribute__((ext_vector_type(2)));
#define LDS_WAIT() asm volatile("s_waitcnt lgkmcnt(0)" ::: "memory")
#define VM_WAIT() asm volatile("s_waitcnt vmcnt(0)" ::: "memory")
__device__ __forceinline__ unsigned f2bf(float f) { unsigned u = __builtin_bit_cast(unsigned, f); return (u + 0x7fffu + ((u >> 16) & 1u)) >> 16; }
typedef __bf16 bf16x2_t __attribute__((ext_vector_type(2)));
__device__ __forceinline__ unsigned cvtpk(float lo, float hi) { f32x2 v = {lo, hi}; bf16x2_t b = __builtin_convertvector(v, bf16x2_t); return __builtin_bit_cast(unsigned, b); }
__device__ __forceinline__ unsigned pk2(float lo, float hi) { return cvtpk(lo, hi); }
__device__ __forceinline__ float bf2f(unsigned short b) { return __uint_as_float(((unsigned)b) << 16); }
__device__ __forceinline__ float blo(unsigned w) { return __uint_as_float(w << 16); }
__device__ __forceinline__ float bhi(unsigned w) { return __uint_as_float(w & 0xffff0000u); }
template <int CTRL, int RM> __device__ __forceinline__ float dpp_f(float v) { return __int_as_float(__builtin_amdgcn_update_dpp(0, __float_as_int(v), CTRL, RM, 0xf, true)); }
__device__ __forceinline__ float row_sum16(float v) { v += dpp_f<0xB1, 0xf>(v); v += dpp_f<0x4E, 0xf>(v); v += dpp_f<0x141, 0xf>(v); v += dpp_f<0x140, 0xf>(v); return v; }
__device__ __forceinline__ float half_sum32(float v) { v = row_sum16(v); v += dpp_f<0x142, 0xa>(v); return v; }
__device__ __forceinline__ float rd_lane(float v, int l) { return __int_as_float(__builtin_amdgcn_readlane(__float_as_int(v), l)); }
__device__ __forceinline__ float wave_sum(float v) { v = half_sum32(v); return rd_lane(v, 31) + rd_lane(v, 63); }
__device__ __forceinline__ float wave_max(float v) {
#pragma unroll
    for (int o = 1; o < 64; o <<= 1) v = fmaxf(v, __shfl_xor(v, o));
    return v;
}
__device__ __forceinline__ float xhalf_max(float v) { auto rr = __builtin_amdgcn_permlane32_swap(__float_as_uint(v), __float_as_uint(v), false, false); return fmaxf(__uint_as_float(rr[0]), __uint_as_float(rr[1])); }
__device__ __forceinline__ float xhalf_sum(float v) { auto rr = __builtin_amdgcn_permlane32_swap(__float_as_uint(v), __float_as_uint(v), false, false); return __uint_as_float(rr[0]) + __uint_as_float(rr[1]); }
#define XB_TMO      128
#define XB_XCNT(j)  (256  + 64 * (j))
#define XB_XSUB(j)  (1280 + 64 * (j))
#define XB_XGEN(j)  (2304 + 64 * (j))
#define XB_TOP      3328
#define XB_TOPGEN   3392
#define XCD_BAR_WORDS 3456
#define XB_SPIN_CAP (1u << 18)

__device__ __forceinline__ unsigned xb_ld(unsigned* p)              { return __hip_atomic_load(p, __ATOMIC_RELAXED, __HIP_MEMORY_SCOPE_AGENT); }
__device__ __forceinline__ unsigned xb_add(unsigned* p, unsigned v) { return __hip_atomic_fetch_add(p, v, __ATOMIC_RELAXED, __HIP_MEMORY_SCOPE_AGENT); }
__device__ __forceinline__ unsigned xb_xcc_id() { return (unsigned)__builtin_amdgcn_s_getreg((3 << 11) | 20) & 0xFu; }
#define XB_SPIN(cond, bar) do { unsigned _sp = 0; while (cond) { __builtin_amdgcn_s_sleep(1); \
    if ((++_sp & 255u) == 0u) { if (xb_ld(&(bar)[XB_TMO])) break; if (_sp > XB_SPIN_CAP) { atomicAdd(&(bar)[XB_TMO], 1u); break; } } } } while (0)

struct XcdBarrier {
    unsigned* bar; unsigned x;
    volatile LAS unsigned* st;
};

__device__ __forceinline__ XcdBarrier xcd_barrier_post(unsigned* bar, volatile LAS unsigned* st) {
    XcdBarrier b; b.bar = bar; b.x = xb_xcc_id(); b.st = st;
    if (threadIdx.x == 0) (void)xb_add(&bar[XB_XCNT(b.x)], 1u);
    return b;
}
__device__ __forceinline__ void xcd_barrier_complete(unsigned* bar, unsigned x, unsigned& nloc, unsigned& nx) {
    const unsigned G = gridDim.x * gridDim.y * gridDim.z;
    unsigned sum, cnt, mine, sp = 0u;
    for (;;) {
        sum = 0u; cnt = 0u; mine = 0u;
#pragma unroll
        for (unsigned j = 0; j < 16; ++j) { const unsigned c = xb_ld(&bar[XB_XCNT(j)]); sum += c; cnt += (c > 0u) ? 1u : 0u; mine = (j == x) ? c : mine; }
        if (sum == G) break;
        __builtin_amdgcn_s_sleep(1);
        if ((++sp & 255u) == 0u) { if (xb_ld(&bar[XB_TMO])) break; if (sp > XB_SPIN_CAP) { atomicAdd(&bar[XB_TMO], 1u); break; } }
    }
    nloc = mine > 0u ? mine : 1u; nx = cnt > 0u ? cnt : 1u;
}

__device__ __forceinline__ void xcd_barrier(const XcdBarrier& b) {
    asm volatile("s_waitcnt vmcnt(0)" ::: "memory");
    __syncthreads();
    if (threadIdx.x == 0) {
        unsigned* bar = b.bar;
        __builtin_amdgcn_s_waitcnt(0);
        unsigned nloc = b.st[0], nx = b.st[1];
        if (nloc == 0u) { xcd_barrier_complete(bar, b.x, nloc, nx); b.st[0] = nloc; b.st[1] = nx; }
        const unsigned old = xb_add(&bar[XB_XSUB(b.x)], 1u);
        const unsigned gen = old / nloc;
        if (old + 1u == (gen + 1u) * nloc) {
            __builtin_amdgcn_fence(__ATOMIC_RELEASE, "agent");
            asm volatile("s_waitcnt vmcnt(0)" ::: "memory");
            const unsigned og = xb_add(&bar[XB_TOP], 1u);
            const unsigned tg = og / nx;
            if (og + 1u == (tg + 1u) * nx) xb_add(&bar[XB_TOPGEN], 1u);
            else XB_SPIN(xb_ld(&bar[XB_TOPGEN]) == tg, bar);
            __builtin_amdgcn_fence(__ATOMIC_ACQUIRE, "agent");
            xb_add(&bar[XB_XGEN(b.x)], 1u);
            asm volatile("s_waitcnt vmcnt(0)" ::: "memory");
        } else {
            XB_SPIN(xb_ld(&bar[XB_XGEN(b.x)]) == gen, bar);
            __builtin_amdgcn_fence(__ATOMIC_ACQUIRE, "agent");
            asm volatile("s_waitcnt vmcnt(0)" ::: "memory");
        }
    }
    __syncthreads();
}
struct Frame {
    LAS unsigned char* lds;
    volatile LAS unsigned* MISC;
    unsigned* ctl;
    int tid, lane, wave, vcu, G; unsigned char* wsb;
    const float* in[20]; float* out;
    __device__ __forceinline__ bf16* WGU() const { return (bf16*)(wsb + WS_WGU); }
    __device__ __forceinline__ bf16* WD() const { return (bf16*)(wsb + WS_WD); }
    __device__ __forceinline__ bf16* H() const { return (bf16*)(wsb + WS_H); }
    __device__ __forceinline__ bf16* WB() const { return (bf16*)(wsb + WS_WB); }
    __device__ __forceinline__ bf16* PA() const { return (bf16*)(wsb + WS_BIG); }
    __device__ __forceinline__ bf16* PB() const { return (bf16*)(wsb + WS_PB); }
    __device__ __forceinline__ bf16* ACT() const { return (bf16*)(wsb + WS_BIG); }
    __device__ __forceinline__ bf16* OG() const { return (bf16*)(wsb + WS_OG); }
    __device__ __forceinline__ bf16* OM() const { return (bf16*)(wsb + WS_OM); }
    __device__ __forceinline__ bf16* WBG() const { return (bf16*)(wsb + WS_WBG); }
    __device__ __forceinline__ bf16* WBM() const { return (bf16*)(wsb + WS_WBM); }
    __device__ __forceinline__ bf16* WO() const { return (bf16*)(wsb + WS_WO); }
    __device__ __forceinline__ bf16* QN() const { return (bf16*)(wsb + WS_QN); }
    __device__ __forceinline__ bf16* KN() const { return (bf16*)(wsb + WS_KN); }
    __device__ __forceinline__ bf16* VP() const { return (bf16*)(wsb + WS_VP); }
    __device__ __forceinline__ bf16* KNT() const { return (bf16*)(wsb + WS_KNT); }
    __device__ __forceinline__ bf16* MQ() const { return (bf16*)(wsb + WS_MQ); }
    __device__ __forceinline__ bf16* MK() const { return (bf16*)(wsb + WS_MK); }
    __device__ __forceinline__ bf16* MV() const { return (bf16*)(wsb + WS_MV); }
    __device__ __forceinline__ bf16* U() const { return (bf16*)(wsb + WS_U); }
    __device__ __forceinline__ bf16* W() const { return (bf16*)(wsb + WS_W); }
    __device__ __forceinline__ bf16* AT() const { return (bf16*)(wsb + WS_AT); }
    __device__ __forceinline__ bf16* KMH() const { return (bf16*)(wsb + WS_KMEAN); }
    __device__ __forceinline__ bf16* KML() const { return (bf16*)(wsb + (WS_KMEAN + 262144)); }
    __device__ __forceinline__ float* AB() const { return (float*)(wsb + WS_AB); }
    __device__ __forceinline__ float* GG() const { return (float*)(wsb + WS_G); }
    __device__ __forceinline__ float* BETA() const { return (float*)(wsb + WS_BETA); }
    __device__ __forceinline__ float* Y1() const { return (float*)(wsb + WS_Y1); }
    __device__ __forceinline__ float* GC() const { return (float*)(wsb + WS_GC); }
    __device__ __forceinline__ f32x2* ROPE() const { return (f32x2*)(wsb + WS_ROPE); }
    __device__ __forceinline__ unsigned char* H8() const { return wsb + WS_H8; }
    __device__ __forceinline__ unsigned char* W8() const { return wsb + WS_W8; }
    __device__ __forceinline__ unsigned* CM(int f) const { return (unsigned*)(wsb + WS_CTL + (256 + 128 * f) * 1024); }
    __device__ __forceinline__ unsigned* CMW() const { return (unsigned*)(wsb + WS_CTL + 640 * 1024); }
    __device__ __forceinline__ unsigned* RM(int f) const { return (unsigned*)(wsb + WS_CTL + (768 + 64 * f) * 1024); }
    __device__ __forceinline__ unsigned* CMD(int f) const { return (unsigned*)(wsb + WS_CTL + (896 + 16 * f) * 1024); }
    __device__ __forceinline__ unsigned char* ACT8() const { return wsb + WS_PB; }
    __device__ __forceinline__ float* RS() const { return (float*)(wsb + WS_CTL + 512 * 1024); }
};

template <int MODE> __device__ __forceinline__ int rowmap(int n0) {
    if (MODE == 0) return n0;
    if (MODE == 1) return 256 * (n0 >> 7) + (n0 & 127);
    if (MODE == 2) return 256 * (n0 >> 7) + 128 + (n0 & 127);
    if (MODE == 3) return n0 < 8192 ? n0 : (n0 < 12288 ? n0 + 4096 : (n0 < 12352 ? 16384 + (n0 - 12288) : n0 - 4160));
    return n0 - 16448;
}
__device__ __forceinline__ bool win_i8(int n0) { return n0 >= 16448; }
__device__ __forceinline__ const float* tr_src(const float* W, int N, int item, int lane, int nblk_ = 0) { const int nblk = nblk_ ? nblk_ : (N >> 6), kb = item / nblk, nb = item - kb * nblk; return W + (size_t)(kb << 6) * N + (nb << 6) + lane; }
__device__ __forceinline__ void tr_load(const float* src, int N, float (&v)[64]) {
#pragma unroll
    for (int j = 0; j < 64; ++j) v[j] = __builtin_nontemporal_load(src + (size_t)j * N);
}
__device__ __forceinline__ void tr_put(LAS float* scr, const float (&v)[64], int lane) {
#pragma unroll
    for (int j = 0; j < 64; ++j) scr[j * 65 + lane] = v[j];
    LDS_WAIT();
}
template <int MODE> __device__ __forceinline__ void tr_out(int K, int N, bf16* WT, LAS float* scr, int item, int lane, int nblk_ = 0) {
    const int nblk = nblk_ ? nblk_ : (N >> 6), kb = item / nblk, nb = item - kb * nblk, k0 = kb << 6, n0 = nb << 6;
    const int c = lane & 7, r = lane >> 3, drow = rowmap<MODE>(n0);
#pragma unroll
    for (int j = 0; j < 8; ++j) { const int n = r + 8 * j; const LAS float* s = scr + (8 * c) * 65 + n;
        v4u o; o.x = pk2(s[0], s[65]); o.y = pk2(s[130], s[195]); o.z = pk2(s[260], s[325]); o.w = pk2(s[390], s[455]);
        *(v4u*)(WT + (size_t)(drow + n) * K + k0 + 8 * c) = o; }
    LDS_WAIT();
}
__device__ __forceinline__ unsigned pk4_fp8(float a, float b, float c, float d) { int w = 0; w = __builtin_amdgcn_cvt_pk_fp8_f32(a, b, w, false); w = __builtin_amdgcn_cvt_pk_fp8_f32(c, d, w, true); return (unsigned)w; }
__device__ __forceinline__ void tr_out8(int K, int N, unsigned char* WT, int drow, LAS float* scr, int item, int lane) {
    const int nblk = N >> 6, kb = item / nblk, nb = item - kb * nblk, k0 = kb << 6, n0 = nb << 6;
    const int c = lane & 7, r = lane >> 3;
#pragma unroll
    for (int j = 0; j < 8; ++j) { const int n = r + 8 * j; const LAS float* sp = scr + (8 * c) * 65 + n;
        v2u o; o.x = pk4_fp8(sp[0] * 64.f, sp[65] * 64.f, sp[130] * 64.f, sp[195] * 64.f); o.y = pk4_fp8(sp[260] * 64.f, sp[325] * 64.f, sp[390] * 64.f, sp[455] * 64.f);
        *(v2u*)(WT + (size_t)(drow + n0 + n) * K + k0 + 8 * c) = o; }
    LDS_WAIT();
}
__device__ __forceinline__ unsigned pk4_i8(float a, float b, float c, float d) {
    const int ia = (int)__builtin_rintf(a), ib = (int)__builtin_rintf(b), ic = (int)__builtin_rintf(c), id = (int)__builtin_rintf(d);
    return (unsigned)(ia & 0xff) | ((unsigned)(ib & 0xff) << 8) | ((unsigned)(ic & 0xff) << 16) | ((unsigned)id << 24); }
template <int MODE> __device__ __forceinline__ void tr_q_i8(int N, const unsigned* CM, int item, int lane, float (&q)[8]) {
    const int nblk = N >> 6, kb = item / nblk, nb = item - kb * nblk, n0 = nb << 6, r = lane >> 3, drow = rowmap<MODE>(n0);
#pragma unroll
    for (int j = 0; j < 8; ++j) q[j] = 127.0f / fmaxf(__uint_as_float(CM[drow + r + 8 * j]), 1e-30f);
}
template <int MODE> __device__ __forceinline__ void tr_out_i8(int K, int N, unsigned char* WT, const float (&q)[8], LAS float* scr, int item, int lane) {
    const int nblk = N >> 6, kb = item / nblk, nb = item - kb * nblk, k0 = kb << 6, n0 = nb << 6;
    const int c = lane & 7, r = lane >> 3, drow = rowmap<MODE>(n0);
#pragma unroll
    for (int j = 0; j < 8; ++j) { const int n = r + 8 * j; const LAS float* sp = scr + (8 * c) * 65 + n; const float qq = q[j];
        v2u o; o.x = pk4_i8(sp[0] * qq, sp[65] * qq, sp[130] * qq, sp[195] * qq); o.y = pk4_i8(sp[260] * qq, sp[325] * qq, sp[390] * qq, sp[455] * qq);
        *(v2u*)(WT + (size_t)(drow + n) * K + k0 + 8 * c) = o; }
    LDS_WAIT();
}
__device__ __forceinline__ void colmax_ffn(Frame& F, const float* wg, const float* wu, unsigned* CM) {
    const int gw = F.vcu * NWAVES + F.wave, NGW = F.G * NWAVES, lane = F.lane;
    constexpr int I1 = (DM / 64) * (FF / 64);
    for (int it = gw; it < 2 * I1; it += NGW) {
        const bool up = it >= I1; const int item = up ? it - I1 : it; const int nb = item % (FF / 64), n0 = nb << 6;
        const float* s = tr_src(up ? wu : wg, FF, item, lane);
        float v[64]; tr_load(s, FF, v);
        float mx = 0.f;
#pragma unroll
        for (int j = 0; j < 64; ++j) mx = fmaxf(mx, fabsf(v[j]));
        atomicMax(CM + (up ? rowmap<2>(n0) : rowmap<1>(n0)) + lane, __float_as_uint(mx));
    }
}
__device__ __forceinline__ void strip_quant_i8(Frame& F, const float* W, int N, int c0, int drow0, unsigned char* WT, float* CS) {
    LAS float* xch = (LAS float*)(F.lds + 150528);
    int lane_a = threadIdx.x & 63; asm volatile("" : "+v"(lane_a));
    const int r0 = F.wave * 512;
    const char* bu = (const char*)W + ((size_t)r0 * N + c0) * 4;
    const unsigned voff = (unsigned)(32 * (lane_a >> 5) * N + (lane_a & 31)) * 4u;
    unsigned v[128]; float mx = 0.f; float ta[32], tb[32];
#define SQ_LOAD(t, i) do { _Pragma("unroll") for (int j = 0; j < 32; ++j) t[j] = __builtin_nontemporal_load((const float*)(bu + (size_t)(64 * (i) + j) * N * 4 + voff)); } while (0)
#define SQ_PACK(t, i) do { _Pragma("unroll") for (int j = 0; j < 16; ++j) { unsigned w = pk2(t[2 * j], t[2 * j + 1]); mx = fmaxf(mx, fmaxf(fabsf(blo(w)), fabsf(bhi(w)))); asm volatile("" : "+v"(w)); v[16 * (i) + j] = w; }   \
        __builtin_amdgcn_sched_barrier(0); } while (0)
    SQ_LOAD(ta, 0);
#pragma unroll
    for (int i = 0; i < 8; i += 2) {
        SQ_LOAD(tb, i + 1); SQ_PACK(ta, i);
        if (i + 2 < 8) SQ_LOAD(ta, i + 2);
        SQ_PACK(tb, i + 1); }
#undef SQ_LOAD
#undef SQ_PACK
    int lane = threadIdx.x & 63; asm volatile("" : "+v"(lane));
    const int col = lane & 31, half = lane >> 5;
    mx = xhalf_max(mx);
    if (lane < 32) xch[F.wave * 32 + lane] = mx;
    __syncthreads();
    float cm = 0.f;
#pragma unroll
    for (int w = 0; w < 8; ++w) cm = fmaxf(cm, xch[w * 32 + col]);
    __syncthreads();
    if (F.wave == 0 && lane < 32) CS[drow0 + col] = cm;
    const float q = 127.0f / fmaxf(cm, 1e-30f);
    unsigned char* dst = WT + (size_t)(drow0 + col) * DM + r0 + 32 * half;
#pragma unroll
    for (int i = 0; i < 8; ++i) { v4u o0, o1;
        o0.x = pk4_i8(blo(v[16 * i + 0]) * q, bhi(v[16 * i + 0]) * q, blo(v[16 * i + 1]) * q, bhi(v[16 * i + 1]) * q); o0.y = pk4_i8(blo(v[16 * i + 2]) * q, bhi(v[16 * i + 2]) * q, blo(v[16 * i + 3]) * q, bhi(v[16 * i + 3]) * q);
        o0.z = pk4_i8(blo(v[16 * i + 4]) * q, bhi(v[16 * i + 4]) * q, blo(v[16 * i + 5]) * q, bhi(v[16 * i + 5]) * q); o0.w = pk4_i8(blo(v[16 * i + 6]) * q, bhi(v[16 * i + 6]) * q, blo(v[16 * i + 7]) * q, bhi(v[16 * i + 7]) * q);
        o1.x = pk4_i8(blo(v[16 * i + 8]) * q, bhi(v[16 * i + 8]) * q, blo(v[16 * i + 9]) * q, bhi(v[16 * i + 9]) * q); o1.y = pk4_i8(blo(v[16 * i + 10]) * q, bhi(v[16 * i + 10]) * q, blo(v[16 * i + 11]) * q, bhi(v[16 * i + 11]) * q);
        o1.z = pk4_i8(blo(v[16 * i + 12]) * q, bhi(v[16 * i + 12]) * q, blo(v[16 * i + 13]) * q, bhi(v[16 * i + 13]) * q); o1.w = pk4_i8(blo(v[16 * i + 14]) * q, bhi(v[16 * i + 14]) * q, blo(v[16 * i + 15]) * q, bhi(v[16 * i + 15]) * q);
        *(v4u*)(dst + 64 * i) = o0; *(v4u*)(dst + 64 * i + 16) = o1; }
}
__device__ __forceinline__ void strip_quant_wd(Frame& F, const float* W, int c0, unsigned char* WT, float* CS) {
    LAS float* xch = (LAS float*)(F.lds + 150528);
    int lane_a = threadIdx.x & 63; asm volatile("" : "+v"(lane_a));
    const int wave = F.wave, g0 = wave < 4 ? wave * 22 : 88 + (wave - 4) * 21, ng = wave < 4 ? 22 : 21;
    const char* bu = (const char*)W + ((size_t)(g0 * 64) * DM + c0) * 4;
    const int qa = lane_a >> 4; const unsigned voff = (unsigned)(16 * qa * DM + (lane_a & 15)) * 4u;
    unsigned v[176]; float mx = 0.f; float ta[16], tb[16];
#define WD_LOAD(t, i) do { _Pragma("unroll") for (int j = 0; j < 16; ++j) t[j] = *(const float*)(bu + (size_t)(64 * (i) + j) * DM * 4 + voff); } while (0)
#define WD_ROT(t, i) do { \
        _Pragma("unroll") for (int h = 1; h < 16; h <<= 1) _Pragma("unroll") for (int j = 0; j < 16; ++j) if (!(j & h)) { const float a = t[j], b = t[j + h]; t[j] = a + b; t[j + h] = a - b; } \
        _Pragma("unroll") for (int j = 0; j < 16; ++j) { auto a = __builtin_amdgcn_permlane16_swap(__float_as_uint(t[j]), __float_as_uint(t[j]), false, false); \
            const float lo = __uint_as_float(a[0]), hi = __uint_as_float(a[1]); t[j] = (qa & 1) ? lo - hi : lo + hi; } \
        _Pragma("unroll") for (int j = 0; j < 16; ++j) { auto b = __builtin_amdgcn_permlane32_swap(__float_as_uint(t[j]), __float_as_uint(t[j]), false, false); \
            const float lo = __uint_as_float(b[0]), hi = __uint_as_float(b[1]); t[j] = ((qa & 2) ? lo - hi : lo + hi) * 0.125f; } \
        _Pragma("unroll") for (int j = 0; j < 8; ++j) { unsigned w = pk2(t[2 * j], t[2 * j + 1]); mx = fmaxf(mx, fmaxf(fabsf(blo(w)), fabsf(bhi(w)))); asm volatile("" : "+v"(w)); v[8 * (i) + j] = w; } \
        __builtin_amdgcn_sched_barrier(0); } while (0)
    WD_LOAD(ta, 0);
#pragma unroll
    for (int i = 0; i < 16; i += 2) {
        WD_LOAD(tb, i + 1);
        WD_ROT(ta, i);
        if (i + 2 < 16) WD_LOAD(ta, i + 2);
        WD_ROT(tb, i + 1);
    }
#pragma unroll
    for (int i = 16; i < 22; ++i) {
        if (i < ng) { WD_LOAD(ta, i); WD_ROT(ta, i); } else {
#pragma unroll
            for (int j = 0; j < 8; ++j) v[8 * i + j] = 0u; }
    }
#undef WD_LOAD
#undef WD_ROT
    int lane = threadIdx.x & 63; asm volatile("" : "+v"(lane));
    const int col = lane & 15, q4 = lane >> 4;
    { auto a = __builtin_amdgcn_permlane16_swap(__float_as_uint(mx), __float_as_uint(mx), false, false); mx = fmaxf(__uint_as_float(a[0]), __uint_as_float(a[1]));
      auto b = __builtin_amdgcn_permlane32_swap(__float_as_uint(mx), __float_as_uint(mx), false, false); mx = fmaxf(__uint_as_float(b[0]), __uint_as_float(b[1])); }
    if (lane < 16) xch[wave * 16 + lane] = mx;
    __syncthreads();
    float cm = 0.f;
#pragma unroll
    for (int w = 0; w < 8; ++w) cm = fmaxf(cm, xch[w * 16 + col]);
    __syncthreads();
    if (wave == 0 && lane < 16) CS[c0 + col] = cm;
    const float qq = 127.0f / fmaxf(cm, 1e-30f);
    unsigned char* dst = WT + (size_t)(c0 + col) * FF + (size_t)g0 * 64 + 16 * q4;
#pragma unroll
    for (int i = 0; i < 22; ++i) if (i < ng) { v4u o;
        o.x = pk4_i8(blo(v[8 * i + 0]) * qq, bhi(v[8 * i + 0]) * qq, blo(v[8 * i + 1]) * qq, bhi(v[8 * i + 1]) * qq); o.y = pk4_i8(blo(v[8 * i + 2]) * qq, bhi(v[8 * i + 2]) * qq, blo(v[8 * i + 3]) * qq, bhi(v[8 * i + 3]) * qq);
        o.z = pk4_i8(blo(v[8 * i + 4]) * qq, bhi(v[8 * i + 4]) * qq, blo(v[8 * i + 5]) * qq, bhi(v[8 * i + 5]) * qq); o.w = pk4_i8(blo(v[8 * i + 6]) * qq, bhi(v[8 * i + 6]) * qq, blo(v[8 * i + 7]) * qq, bhi(v[8 * i + 7]) * qq);
        *(v4u*)(dst + 64 * i) = o; }
}
__device__ __forceinline__ void quant_wd(Frame& F, const float* wd, float* CS) { for (int s = F.vcu; s < DM / 16; s += F.G) strip_quant_wd(F, wd, 16 * s, (unsigned char*)F.WD(), CS); }
__device__ __forceinline__ void quant_ffn_gu(Frame& F, const float* wg, const float* wu, float* CS) {
    for (int s = blockIdx.x; s < 2 * (FF / 32); s += F.G) { const bool up = s >= FF / 32; const int c0 = (up ? s - FF / 32 : s) * 32;
        strip_quant_i8(F, up ? wu : wg, FF, c0, up ? rowmap<2>(c0) : rowmap<1>(c0), (unsigned char*)F.WGU(), CS); }
}
__device__ __forceinline__ void fwht32x2(float (&v)[64]) {
#pragma unroll
    for (int h = 1; h < 64; h <<= 1)
#pragma unroll
        for (int j = 0; j < 64; ++j) if (!(j & h)) { const float a = v[j], b = v[j + h]; v[j] = a + b; v[j + h] = a - b; }
#pragma unroll
    for (int j = 0; j < 64; ++j) v[j] *= 0.125f;
}
__device__ __forceinline__ void colmax_wd(Frame& F, const float* wd, unsigned* CMD) {
    const int gw = F.vcu * NWAVES + F.wave, NGW = F.G * NWAVES, lane = F.lane;
    constexpr int I2 = (FF / 64) * (DM / 64);
    for (int it = gw; it < I2; it += NGW) { const int n0 = (it % (DM / 64)) << 6;
        float v[64]; tr_load(tr_src(wd, DM, it, lane), DM, v);
        fwht32x2(v);
        float mx = 0.f;
#pragma unroll
        for (int j = 0; j < 64; ++j) mx = fmaxf(mx, fabsf(v[j]));
        atomicMax(CMD + n0 + lane, __float_as_uint(mx));
    }
}
__device__ __forceinline__ void requant_rows(Frame& F, const bf16* A, unsigned char* A8, float* RS) {
    const int gw = F.vcu * NWAVES + F.wave, NGW = F.G * NWAVES;
    constexpr int NV = FF / 8;
    const float s1 = (F.lane & 1) ? -1.0f : 1.0f, s2 = (F.lane & 2) ? -1.0f : 1.0f, s4 = (F.lane & 4) ? -1.0f : 1.0f;
    for (int m = gw; m < M; m += NGW) {
        const v4u* src = (const v4u*)(A + (size_t)m * FF); v2u* dst = (v2u*)(A8 + (size_t)m * FF);
        v4u w[22];
#pragma unroll
        for (int j = 0; j < 22; ++j) { const int idx = F.lane + 64 * j; w[j] = (v4u){0u, 0u, 0u, 0u}; if (idx < NV) w[j] = __builtin_nontemporal_load(src + idx); }
        float mx = 0.f;
#pragma unroll
        for (int j = 0; j < 22; ++j) {
            float x[8] = {blo(w[j].x), bhi(w[j].x), blo(w[j].y), bhi(w[j].y), blo(w[j].z), bhi(w[j].z), blo(w[j].w), bhi(w[j].w)};
#pragma unroll
            for (int h = 1; h < 8; h <<= 1)
#pragma unroll
                for (int i = 0; i < 8; ++i) if (!(i & h)) { const float a = x[i], b = x[i + h]; x[i] = a + b; x[i + h] = a - b; }
#pragma unroll
            for (int i = 0; i < 8; ++i) x[i] = __builtin_fmaf(s1, x[i], dpp_f<0xB1, 0xf>(x[i]));
#pragma unroll
            for (int i = 0; i < 8; ++i) x[i] = __builtin_fmaf(s2, x[i], dpp_f<0x4E, 0xf>(x[i]));
#pragma unroll
            for (int i = 0; i < 8; ++i) x[i] = __builtin_fmaf(s4, x[i], __int_as_float(__builtin_amdgcn_ds_swizzle(__float_as_int(x[i]), 0x101F))) * 0.125f;
            w[j].x = pk2(x[0], x[1]); w[j].y = pk2(x[2], x[3]); w[j].z = pk2(x[4], x[5]); w[j].w = pk2(x[6], x[7]);
            mx = fmaxf(mx, fmaxf(fmaxf(fmaxf(fabsf(blo(w[j].x)), fabsf(bhi(w[j].x))), fmaxf(fabsf(blo(w[j].y)), fabsf(bhi(w[j].y)))), fmaxf(fmaxf(fabsf(blo(w[j].z)), fabsf(bhi(w[j].z))), fmaxf(fabsf(blo(w[j].w)), fabsf(bhi(w[j].w))))));
        }
        mx = fmaxf(wave_max(mx), 1e-30f);
        const float q = 127.0f / mx;
#pragma unroll
        for (int j = 0; j < 22; ++j) { const int idx = F.lane + 64 * j;
            if (idx < NV) { v2u o; o.x = pk4_i8(blo(w[j].x) * q, bhi(w[j].x) * q, blo(w[j].y) * q, bhi(w[j].y) * q); o.y = pk4_i8(blo(w[j].z) * q, bhi(w[j].z) * q, blo(w[j].w) * q, bhi(w[j].w) * q); dst[idx] = o; } }
        if (F.lane == 0) RS[m] = mx * (1.0f / 127.0f);
    }
}
template <class SRC, class XF, class PRE, class OUT> __device__ __forceinline__ void tr_pipeline(int it0, int itEnd, int step, LAS float* scr, int lane, SRC srcf, XF xf, PRE pref, OUT outf) {
    if (it0 >= itEnd) return;
    float v[64]; const float* s; int N;
    srcf(it0, s, N); tr_load(s, N, v);
    for (int it = it0;;) {
        xf(it, v);
        tr_put(scr, v, lane);
        float q[8]; pref(it, q);
        const int nx = it + step;
        if (nx < itEnd) { srcf(nx, s, N); tr_load(s, N, v); }
        outf(it, q);
        if (nx >= itEnd) break;
        it = nx;
    }
}
__device__ __forceinline__ void convert_wd(Frame& F, const float* wd, const unsigned* CMD) {
    LAS float* scr = (LAS float*)(F.lds + F.wave * TR_STRIDE);
    const int gw = F.vcu * NWAVES + F.wave, NGW = F.G * NWAVES, lane = F.lane;
    constexpr int I2 = (FF / 64) * (DM / 64);
    unsigned char* wdt = (unsigned char*)F.WD();
    tr_pipeline(gw, I2, NGW, scr, lane,
        [&](int it, const float*& s, int& N) { s = tr_src(wd, DM, it, lane); N = DM; },
        [&](int, float (&v)[64]) { fwht32x2(v); },
        [&](int it, float (&q)[8]) { tr_q_i8<0>(DM, CMD, it, lane, q); },
        [&](int it, const float (&q)[8]) { tr_out_i8<0>(FF, DM, wdt, q, scr, it, lane); });
}
__device__ __forceinline__ void convert_win(Frame& F) {
    LAS float* scr = (LAS float*)(F.lds + F.wave * TR_STRIDE);
    const int gw = F.vcu * NWAVES + F.wave, NGW = F.G * NWAVES, lane = F.lane;
    constexpr int NB = 16448 / 64, I1 = (DM / 64) * NB;
    const float* win = F.in[6]; bf16* wb = F.WB();
    tr_pipeline(gw, I1, NGW, scr, lane,
        [&](int it, const float*& s, int& N) { s = tr_src(win, 26688, it, lane, NB); N = 26688; },
        [&](int, float (&)[64]) {},
        [&](int, float (&)[8]) {},
        [&](int it, const float (&)[8]) { tr_out<3>(DM, 26688, wb, scr, it, lane, NB); });
    __syncthreads();
    for (int s = blockIdx.x; s < (26688 - 16448) / 32; s += F.G) { const int c0 = 16448 + 32 * s; strip_quant_i8(F, win, 26688, c0, c0 - 16448, F.W8(), (float*)F.CMW()); }
}
__device__ __forceinline__ void colmax_win(Frame& F) {
    const int gw = F.vcu * NWAVES + F.wave, NGW = F.G * NWAVES, lane = F.lane;
    constexpr int NB = 26688 / 64, I1 = (DM / 64) * NB;
    unsigned* cm = F.CMW();
    for (int it = gw; it < I1; it += NGW) { const int n0 = (it % NB) << 6;
        if (!win_i8(n0)) continue;
        float v[64]; tr_load(tr_src(F.in[6], 26688, it, lane), 26688, v);
        float mx = 0.f;
#pragma unroll
        for (int j = 0; j < 64; ++j) mx = fmaxf(mx, fabsf(v[j]));
        atomicMax(cm + rowmap<4>(n0) + lane, __float_as_uint(mx));
    }
}
__device__ __forceinline__ void convert_branch(Frame& F) {
    LAS float* scr = (LAS float*)(F.lds + F.wave * TR_STRIDE);
    const int gw = F.vcu * NWAVES + F.wave, NGW = F.G * NWAVES, lane = F.lane;
    constexpr int IG = 64 * 64, IM = 32 * 64;
    const float* w13 = F.in[13]; const float* w14 = F.in[14]; const float* w15 = F.in[15]; bf16* wbg = F.WBG(); unsigned char* wbm = (unsigned char*)F.WBM(); bf16* wo = F.WO();
    tr_pipeline(gw, 2 * IG + IM, NGW, scr, lane,
        [&](int it, const float*& s, int& N) { N = 4096; if (it < IG) s = tr_src(w13, 4096, it, lane); else if (it < IG + IM) s = tr_src(w14, 4096, it - IG, lane); else s = tr_src(w15, 4096, it - IG - IM, lane); },
        [&](int, float (&)[64]) {},
        [&](int, float (&)[8]) {},
        [&](int it, const float (&)[8]) { if (it < IG) tr_out<0>(4096, 4096, wbg, scr, it, lane);
                      else if (it < IG + IM) tr_out8(2048, 4096, wbm, 0, scr, it - IG, lane);
                      else tr_out<0>(4096, 4096, wo, scr, it - IG - IM, lane); });
}
__device__ __forceinline__ void rms_rows(Frame& F, const float* X, const float* gain, bf16* O, unsigned char* O8 = nullptr) {
    LAS f32x4* gl = (LAS f32x4*)(F.lds + 8 * TR_STRIDE);
    for (int i = F.tid; i < DM / 4; i += NWAVES * 64) gl[i] = ((const f32x4*)gain)[i];
    __syncthreads();
    const int gw = F.vcu * NWAVES + F.wave, NGW = F.G * NWAVES;
    int m = gw; if (m >= M) return;
    f32x4 v[16], nv[16];
    { const f32x4* xr = (const f32x4*)(X + (size_t)m * DM) + F.lane;
#pragma unroll
      for (int j = 0; j < 16; ++j) v[j] = xr[64 * j]; }
    for (;;) {
        const int mn = m + NGW;
        if (mn < M) { const f32x4* xr = (const f32x4*)(X + (size_t)mn * DM) + F.lane;
#pragma unroll
            for (int j = 0; j < 16; ++j) nv[j] = xr[64 * j]; }
        float s = 0.f;
#pragma unroll
        for (int j = 0; j < 16; ++j) s += (v[j].x * v[j].x + v[j].y * v[j].y) + (v[j].z * v[j].z + v[j].w * v[j].w);
        const float r = 1.0f / sqrtf(wave_sum(s) * (1.0f / DM) + NORM_EPS);
        v2u* o8 = (v2u*)(O + (size_t)m * DM) + F.lane;
#pragma unroll
        for (int j = 0; j < 16; ++j) { const f32x4 g = gl[F.lane + 64 * j]; const float a = v[j].x * r * g.x, b = v[j].y * r * g.y, c = v[j].z * r * g.z, d = v[j].w * r * g.w;
            v2u w; w.x = pk2(a, b); w.y = pk2(c, d); o8[64 * j] = w;
            if (O8) ((unsigned*)(O8 + (size_t)m * DM))[F.lane + 64 * j] = pk4_fp8(a, b, c, d); }
        if (mn >= M) break;
#pragma unroll
        for (int j = 0; j < 16; ++j) v[j] = nv[j];
        m = mn;
    }
}
__device__ __forceinline__ void rms_rows_i8(Frame& F, const float* X, const float* gain, unsigned char* O, float* RS, bf16* Ob = nullptr) {
    LAS f32x4* gl = (LAS f32x4*)(F.lds + 8 * TR_STRIDE);
    for (int i = F.tid; i < DM / 4; i += NWAVES * 64) gl[i] = ((const f32x4*)gain)[i];
    __syncthreads();
    const int gw = F.vcu * NWAVES + F.wave, NGW = F.G * NWAVES;
    int m = gw; if (m >= M) return;
    f32x4 v[16], nv[16];
    { const f32x4* xr = (const f32x4*)(X + (size_t)m * DM) + F.lane;
#pragma unroll
      for (int j = 0; j < 16; ++j) v[j] = xr[64 * j]; }
    for (;;) {
        const int mn = m + NGW;
        if (mn < M) { const f32x4* xr = (const f32x4*)(X + (size_t)mn * DM) + F.lane;
#pragma unroll
            for (int j = 0; j < 16; ++j) nv[j] = xr[64 * j]; }
        float s = 0.f;
#pragma unroll
        for (int j = 0; j < 16; ++j) s += (v[j].x * v[j].x + v[j].y * v[j].y) + (v[j].z * v[j].z + v[j].w * v[j].w);
        const float r = 1.0f / sqrtf(wave_sum(s) * (1.0f / DM) + NORM_EPS);
        float mx = 0.f;
#pragma unroll
        for (int j = 0; j < 16; ++j) { const f32x4 g = gl[F.lane + 64 * j]; v[j].x *= r * g.x; v[j].y *= r * g.y; v[j].z *= r * g.z; v[j].w *= r * g.w;
            mx = fmaxf(fmaxf(mx, fmaxf(fabsf(v[j].x), fabsf(v[j].y))), fmaxf(fabsf(v[j].z), fabsf(v[j].w))); }
        if (Ob) { v2u* ob = (v2u*)(Ob + (size_t)m * DM) + F.lane;
#pragma unroll
            for (int j = 0; j < 16; ++j) { v2u w; w.x = pk2(v[j].x, v[j].y); w.y = pk2(v[j].z, v[j].w); ob[64 * j] = w; } }
        mx = fmaxf(wave_max(mx), 1e-30f);
        const float q = 127.0f / mx;
        unsigned* o = (unsigned*)(O + (size_t)m * DM) + F.lane;
#pragma unroll
        for (int j = 0; j < 16; ++j) o[64 * j] = pk4_i8(v[j].x * q, v[j].y * q, v[j].z * q, v[j].w * q);
        if (F.lane == 0) RS[m] = mx * (1.0f / 127.0f);
        if (mn >= M) break;
#pragma unroll
        for (int j = 0; j < 16; ++j) v[j] = nv[j];
        m = mn;
    }
}
__device__ __forceinline__ void rope_table(Frame& F) {
    const int gt = F.vcu * NWAVES * 64 + F.tid, NT = F.G * NWAVES * 64;
    for (int idx = gt; idx < SEQ * 64; idx += NT) {
        const int s = idx >> 6, i = idx & 63;
        double f = 1.0, bs = 0.8659643233600653; int e = i;
        while (e) { if (e & 1) f *= bs; bs *= bs; e >>= 1; }
        const float inv = (float)f; const float ang = (float)s * inv;
        const double a = (double)ang; const double k = __builtin_rint(a * 0.15915494309189535);
        double r = __builtin_fma(-k, 6.283185307179586, a); r = __builtin_fma(-k, 2.4492935982947064e-16, r);
        const double q = r * 0.25, q2 = q * q;
        const double sn = q * (1.0 + q2 * (-1.0 / 6 + q2 * (1.0 / 120 + q2 * (-1.0 / 5040 + q2 * (1.0 / 362880 + q2 * (-1.0 / 39916800 + q2 * (1.0 / 6227020800.0)))))));
        const double cs = 1.0 + q2 * (-0.5 + q2 * (1.0 / 24 + q2 * (-1.0 / 720 + q2 * (1.0 / 40320 + q2 * (-1.0 / 3628800 + q2 * (1.0 / 479001600 + q2 * (-1.0 / 87178291200.0)))))));
        const double s2 = 2.0 * sn * cs, c2 = 1.0 - 2.0 * sn * sn, s4 = 2.0 * s2 * c2, c4 = 1.0 - 2.0 * s2 * s2;
        F.ROPE()[idx] = (f32x2){(float)c4, (float)s4};
    }
}
__device__ __forceinline__ void prep_moba(Frame& F) {
    LAS float* red = (LAS float*)F.lds;
    const int w = F.wave, lane = F.lane, l = lane & 31, hh = lane >> 5;
    for (int item = blockIdx.x; item < BATCH * 16 * 16 * 3; item += F.G) {
        const int which = item % 3; int r = item / 3; const int h = r & 15; r >>= 4; const int j = r & 15; const int b = r >> 4;
        const int colbase = (which == 0 ? PA_MQ : which == 1 ? PA_MK : PA_MV) + h * 128;
        bf16* dst = (bf16*)(F.wsb + (which == 0 ? WS_MQ : which == 1 ? WS_MK : WS_MV)) + ((size_t)(b * 16 + h) * SEQ + j * 256) * 128;
        const bf16* src = F.PA() + (size_t)(b * SEQ + j * 256) * PA_LD + colbase;
        float k1a = 0.f, k1b = 0.f, k2a = 0.f, k2b = 0.f;
        if (which == 2) {
            LAS unsigned short* tl = (LAS unsigned short*)(F.lds + 4096);
#pragma unroll 8
            for (int i = 0; i < 32; ++i) { const int tt = w * 32 + i; const unsigned v = *(const unsigned*)(src + (size_t)tt * PA_LD + 2 * lane);
                tl[(2 * lane) * 258 + tt] = (unsigned short)(v & 0xffffu); tl[(2 * lane + 1) * 258 + tt] = (unsigned short)(v >> 16); }
            __syncthreads();
            bf16* vt = F.MV() + (size_t)(b * 16 + h) * 128 * SEQ + j * 256;
#pragma unroll 4
            for (int i = 0; i < 16; ++i) { const int d = w * 16 + i; const LAS unsigned* rp = (const LAS unsigned*)(tl + d * 258) + 2 * lane;
                *(v2u*)(vt + (size_t)d * SEQ + 4 * lane) = (v2u){rp[0], rp[1]}; }
        } else {
            const float* gq = F.in[11]; const float* gk = F.in[12];
            const f32x2 gqa = *(const f32x2*)(gq + 2 * l), gqb = *(const f32x2*)(gq + 64 + 2 * l), gka = *(const f32x2*)(gk + 2 * l), gkb = *(const f32x2*)(gk + 64 + 2 * l);
            const f32x2 g1 = which == 0 ? gqa : gka, g2 = which == 0 ? gqb : gkb;
#pragma unroll 4
            for (int it = 0; it < 16; ++it) { const int tt = w * 32 + 2 * it + hh, s = j * 256 + tt;
                const unsigned u1 = *(const unsigned*)(src + (size_t)tt * PA_LD + 2 * l), u2 = *(const unsigned*)(src + (size_t)tt * PA_LD + 64 + 2 * l);
                const f32x4 cs = *(const f32x4*)((const float*)F.ROPE() + (size_t)(s * 64 + 2 * l) * 2);
                const float x1a = blo(u1), x1b = bhi(u1), x2a = blo(u2), x2b = bhi(u2);
                const float hs = half_sum32((x1a * x1a + x1b * x1b) + (x2a * x2a + x2b * x2b));
                const float tot = hh ? rd_lane(hs, 63) : rd_lane(hs, 31);
                const float rr = 1.0f / sqrtf(tot * (1.0f / 128) + NORM_EPS);
                const float y1a = x1a * rr * g1.x, y1b = x1b * rr * g1.y, y2a = x2a * rr * g2.x, y2b = x2b * rr * g2.y;
                const float o1a = y1a * cs.x - y2a * cs.y, o2a = y2a * cs.x + y1a * cs.y, o1b = y1b * cs.z - y2b * cs.w, o2b = y2b * cs.z + y1b * cs.w;
                *(unsigned*)(dst + tt * 128 + 2 * l) = pk2(o1a, o1b); *(unsigned*)(dst + tt * 128 + 64 + 2 * l) = pk2(o2a, o2b);
                k1a += o1a; k1b += o1b; k2a += o2a; k2b += o2b; }
            k1a = xhalf_sum(k1a); k1b = xhalf_sum(k1b); k2a = xhalf_sum(k2a); k2b = xhalf_sum(k2b);
        }
        if (hh == 0) { *(LAS f32x2*)(red + w * 128 + 2 * l) = (f32x2){k1a, k1b}; *(LAS f32x2*)(red + w * 128 + 64 + 2 * l) = (f32x2){k2a, k2b}; }
        __syncthreads();
        if (which == 1 && F.tid < 128) { float s = 0.f;
#pragma unroll
            for (int ww = 0; ww < 8; ++ww) s += red[ww * 128 + F.tid];
            const float km = s * (1.0f / 256); const unsigned hi = f2bf(km); const float rem = km - __uint_as_float(hi << 16);
            F.KMH()[((size_t)(b * 16 + h) * 16 + j) * 128 + F.tid] = (bf16)hi; F.KML()[((size_t)(b * 16 + h) * 16 + j) * 128 + F.tid] = (bf16)f2bf(rem); }
        __syncthreads();
    }
}
__device__ __forceinline__ float bf_el(const v4u& x, int i) { const unsigned w = (i >> 1) == 0 ? x.x : (i >> 1) == 1 ? x.y : (i >> 1) == 2 ? x.z : x.w; return (i & 1) ? bhi(w) : blo(w); }
__device__ __forceinline__ void prep_gdn(Frame& F) {
    const int gw = F.vcu * NWAVES + F.wave, NGW = F.G * NWAVES, lane = F.lane, q = lane >> 4, li = lane & 15;
    const float* cw = F.in[7];
    LAS unsigned short* tl = (LAS unsigned short*)(F.lds + F.wave * PREP_STRIDE);
    for (int item = gw; item < BATCH * 64 * 64; item += NGW) {
        const int grp = item & 63, c = (item >> 6) & 63, b = item >> 12, t0 = b * SEQ + c * 64, ch = grp * 128 + 8 * li;
        float wt[4][8];
#pragma unroll
        for (int j = 0; j < 4; ++j) { const f32x4 wa = *(const f32x4*)(cw + j * 8192 + ch), wb = *(const f32x4*)(cw + j * 8192 + ch + 4);
            wt[j][0] = wa.x; wt[j][1] = wa.y; wt[j][2] = wa.z; wt[j][3] = wa.w; wt[j][4] = wb.x; wt[j][5] = wb.y; wt[j][6] = wb.z; wt[j][7] = wb.w; }
        const bf16* src = F.PA() + (size_t)(t0 + 16 * q) * PA_LD + ch;
        v4u xm3 = (v4u){0u, 0u, 0u, 0u}, xm2 = xm3, xm1 = xm3;
        if (c > 0 || q > 0) { xm3 = *(const v4u*)(src - 3 * (ptrdiff_t)PA_LD); xm2 = *(const v4u*)(src - 2 * (ptrdiff_t)PA_LD); xm1 = *(const v4u*)(src - (ptrdiff_t)PA_LD); }
#pragma unroll 4
        for (int s = 0; s < 16; ++s) { const int tt = 16 * q + s;
            const v4u x0 = *(const v4u*)(src + (size_t)s * PA_LD);
            float a[8]; float ss = 0.f;
#pragma unroll
            for (int i = 0; i < 8; ++i) { float v = wt[0][i] * bf_el(xm3, i) + wt[1][i] * bf_el(xm2, i) + wt[2][i] * bf_el(xm1, i) + wt[3][i] * bf_el(x0, i);
                v = v * __builtin_amdgcn_rcpf(1.0f + __expf(-v)); a[i] = v; ss += v * v; }
            xm3 = xm2; xm2 = xm1; xm1 = x0;
            if (grp < 32) { const float rr = __builtin_amdgcn_rsqf(row_sum16(ss) + NORM_EPS);
#pragma unroll
                for (int i = 0; i < 8; ++i) a[i] *= rr; }
            const v4u pk = (v4u){cvtpk(a[0], a[1]), cvtpk(a[2], a[3]), cvtpk(a[4], a[5]), cvtpk(a[6], a[7])};
            if (grp < 16) *(v4u*)(F.QN() + (size_t)(t0 + tt) * 2048 + grp * 128 + 8 * li) = pk;
            else { if (grp < 32) *(v4u*)(F.KN() + (size_t)(t0 + tt) * 2048 + (grp - 16) * 128 + 8 * li) = pk;
                   LAS unsigned short* tp = tl + (8 * li) * 68 + tt;
                   tp[0] = (unsigned short)(pk.x & 0xffffu); tp[68] = (unsigned short)(pk.x >> 16); tp[136] = (unsigned short)(pk.y & 0xffffu); tp[204] = (unsigned short)(pk.y >> 16);
                   tp[272] = (unsigned short)(pk.z & 0xffffu); tp[340] = (unsigned short)(pk.z >> 16); tp[408] = (unsigned short)(pk.w & 0xffffu); tp[476] = (unsigned short)(pk.w >> 16); }
        }
        if (grp >= 16) {
            LDS_WAIT();
            bf16* dst = (bf16*)(F.wsb + (grp < 32 ? WS_KNT : WS_VP)) + (grp < 32 ? ((size_t)(b * 16 + grp - 16) * 64 + c) : ((size_t)(b * 32 + grp - 32) * 64 + c)) * 8192;
#pragma unroll 4
            for (int i = 0; i < 16; ++i) { const int row = 8 * i + (lane >> 3), chk = lane & 7; const LAS v2u* rp = (const LAS v2u*)(tl + row * 68 + 8 * chk);
                const v2u lo = rp[0], hi = rp[1]; *(v4u*)(dst + row * 64 + 8 * chk) = (v4u){lo.x, lo.y, hi.x, hi.y}; }
            LDS_WAIT();
        }
    }
    const int gt = F.vcu * NWAVES * 64 + F.tid, NT = F.G * NWAVES * 64;
    for (int idx = gt; idx < M * 32; idx += NT) { const int hv = idx & 31, t = idx >> 5;
        const float a = F.AB()[(size_t)t * 64 + hv], bb = F.AB()[(size_t)t * 64 + 32 + hv];
        const float x = a + F.in[9][hv]; const float sp = fmaxf(x, 0.f) + log1pf(expf(-fabsf(x)));
        F.GG()[idx] = -expf(F.in[8][hv]) * sp; F.BETA()[idx] = 1.0f / (1.0f + expf(-bb)); }
}
typedef short bf16x8 __attribute__((ext_vector_type(8)));
typedef float f32x16 __attribute__((ext_vector_type(16)));
#define MFMA32(a, b, c) __builtin_amdgcn_mfma_f32_32x32x16_bf16((a), (b), (c), 0, 0, 0)
constexpr int MB_KT = 17408, MB_BUF = 34816;

__device__ __forceinline__ void moba_stage_load(const bf16* Kb, const bf16* Vb, int kpos0, int tid, v4u (&kr)[2], v4u (&vr)[2]) {
    const v4u* kp = (const v4u*)(Kb + (size_t)(kpos0 + (tid >> 3)) * 128 + (tid & 7) * 16); kr[0] = kp[0]; kr[1] = kp[1];
    const v4u* vp = (const v4u*)(Vb + (size_t)(tid >> 2) * SEQ + kpos0 + (tid & 3) * 16); vr[0] = vp[0]; vr[1] = vp[1];
}
__device__ __forceinline__ void moba_stage_store(LAS unsigned char* buf, int tid, const v4u (&kr)[2], const v4u (&vr)[2]) {
    LAS unsigned char* kd = buf + (tid >> 3) * 272 + (tid & 7) * 32; *(LAS v4u*)kd = kr[0]; *(LAS v4u*)(kd + 16) = kr[1];
    LAS unsigned char* vd = buf + MB_KT + (tid >> 2) * 136 + (tid & 3) * 32;
    *(LAS v2u*)vd = (v2u){vr[0].x, vr[0].y}; *(LAS v2u*)(vd + 8) = (v2u){vr[0].z, vr[0].w}; *(LAS v2u*)(vd + 16) = (v2u){vr[1].x, vr[1].y}; *(LAS v2u*)(vd + 24) = (v2u){vr[1].z, vr[1].w};
}
__device__ __forceinline__ void moba_unit(Frame& F, int bh, int j) {
    const int w = F.wave, lane = F.lane, r = lane & 31, h = lane >> 5, tid = F.tid;
    LAS unsigned char* L = F.lds;
    const bf16* Qb = F.MQ() + ((size_t)bh * SEQ + j * 256 + 32 * w) * 128;
    const bf16* Kb = F.MK() + (size_t)bh * SEQ * 128;
    const bf16* Vb = F.MV() + (size_t)bh * 128 * SEQ;
    bf16x8 qf[8];
#pragma unroll
    for (int ks = 0; ks < 8; ++ks) qf[ks] = *(const bf16x8*)(Qb + r * 128 + 16 * ks + 8 * h);
    unsigned selmask = 0u;
    if (j > 0) {
        f32x16 g;
#pragma unroll
        for (int i = 0; i < 16; ++i) g[i] = 0.f;
        const bf16* kmh = F.KMH() + ((size_t)bh * 16 + (r & 15)) * 128 + 8 * h; const bf16* kml = F.KML() + ((size_t)bh * 16 + (r & 15)) * 128 + 8 * h;
        bf16x8 ah[8], al[8];
#pragma unroll
        for (int ks = 0; ks < 8; ++ks) { ah[ks] = *(const bf16x8*)(kmh + 16 * ks); al[ks] = *(const bf16x8*)(kml + 16 * ks); }
#pragma unroll
        for (int ks = 0; ks < 8; ++ks) { g = MFMA32(ah[ks], qf[ks], g); g = MFMA32(al[ks], qf[ks], g); }
        unsigned key[16];
#pragma unroll
        for (int i = 0; i < 8; ++i) { const int base = (i & 3) + 8 * (i >> 2); const int n0 = base + 4 * h, n1 = base + 4 * (1 - h);
            auto rr = __builtin_amdgcn_permlane32_swap(__float_as_uint(g[i]), __float_as_uint(g[i]), false, false);
            const unsigned u0 = __float_as_uint(g[i]), u1 = h ? rr[0] : rr[1];
            const unsigned s0 = u0 ^ ((u0 >> 31) ? 0xffffffffu : 0x80000000u), s1 = u1 ^ ((u1 >> 31) ? 0xffffffffu : 0x80000000u);
            key[i] = n0 < j ? ((s0 & ~15u) | (unsigned)(15 - n0)) : 0u; key[8 + i] = n1 < j ? ((s1 & ~15u) | (unsigned)(15 - n1)) : 0u; }
#pragma unroll
        for (int rd = 0; rd < 3; ++rd) { unsigned best = key[0];
#pragma unroll
            for (int i = 1; i < 16; ++i) best = best > key[i] ? best : key[i];
            if (best != 0u) selmask |= 1u << (15u - (best & 15u));
#pragma unroll
            for (int i = 0; i < 16; ++i) key[i] = (key[i] == best) ? 0u : key[i]; }
    }
    f32x16 o[4];
#pragma unroll
    for (int b4 = 0; b4 < 4; ++b4)
#pragma unroll
        for (int i = 0; i < 16; ++i) o[b4][i] = 0.f;
    float m_run = -INFINITY, l_run = 0.f;
    const int nT = 4 * (j + 1), qpos = 32 * w + r;
    constexpr float C = 0.08838834764831845f * 1.4426950408889634f;
    v4u kr[2], vr[2];
    __syncthreads();
    moba_stage_load(Kb, Vb, j * 256, tid, kr, vr); moba_stage_store(L, tid, kr, vr);
    __syncthreads();
    for (int tt = 0; tt < nT; ++tt) {
        const bool own = tt < 4; const int blk = own ? j : ((tt - 4) >> 2), sub64 = own ? tt : ((tt - 4) & 3);
        if (tt + 1 < nT) { const int t1 = tt + 1; const int kp1 = (t1 < 4) ? j * 256 + 64 * t1 : ((t1 - 4) >> 2) * 256 + 64 * ((t1 - 4) & 3); moba_stage_load(Kb, Vb, kp1, tid, kr, vr); }
        {
        LAS unsigned char* Kt = L + (tt & 1) * MB_BUF; LAS unsigned char* Vt = Kt + MB_KT;
        const bool lane_sel = own ? true : (((selmask >> blk) & 1u) != 0u);
        const bool skip = own ? (64 * sub64 > 32 * w + 31) : (__ballot(lane_sel) == 0ull);
        if (!skip) {
            f32x16 x0, x1;
#pragma unroll
            for (int i = 0; i < 16; ++i) { x0[i] = 0.f; x1[i] = 0.f; }
#define MB_LDK(dst, g) do { dst[0] = *(const LAS bf16x8*)(Kt + r * 272 + 64 * (g) + 16 * h); dst[1] = *(const LAS bf16x8*)(Kt + (32 + r) * 272 + 64 * (g) + 16 * h); \
                            dst[2] = *(const LAS bf16x8*)(Kt + r * 272 + 64 * (g) + 32 + 16 * h); dst[3] = *(const LAS bf16x8*)(Kt + (32 + r) * 272 + 64 * (g) + 32 + 16 * h); } while (0)
#define MB_QK(src, g) do { x0 = MFMA32(src[0], qf[2 * (g)], x0); x1 = MFMA32(src[1], qf[2 * (g)], x1); x0 = MFMA32(src[2], qf[2 * (g) + 1], x0); x1 = MFMA32(src[3], qf[2 * (g) + 1], x1); } while (0)
            { bf16x8 fa[4], fb[4];
              MB_LDK(fa, 0); MB_LDK(fb, 1); __builtin_amdgcn_sched_barrier(0);
              MB_QK(fa, 0); MB_LDK(fa, 2); __builtin_amdgcn_sched_barrier(0);
              MB_QK(fb, 1); MB_LDK(fb, 3); __builtin_amdgcn_sched_barrier(0);
              MB_QK(fa, 2); __builtin_amdgcn_sched_barrier(0);
              MB_QK(fb, 3); }
#undef MB_LDK
#undef MB_QK
            if (own && (64 * sub64 + 63 > 32 * w)) {
#pragma unroll
                for (int i = 0; i < 16; ++i) { const int key0 = 64 * sub64 + (i & 3) + 8 * (i >> 2) + 4 * h;
                    x0[i] = (key0 <= qpos) ? x0[i] : -INFINITY; x1[i] = (key0 + 32 <= qpos) ? x1[i] : -INFINITY; }
            }
            float mx = fmaxf(x0[0], x1[0]);
#pragma unroll
            for (int i = 1; i < 16; ++i) mx = fmaxf(fmaxf(mx, x0[i]), x1[i]);
            mx = xhalf_max(mx);
            mx = lane_sel ? mx : -INFINITY;
            const float m_new = fmaxf(m_run, mx);
            if (__any(m_new != m_run)) {
                const float alpha = __builtin_amdgcn_exp2f((m_run - m_new) * C);
                l_run *= alpha;
#pragma unroll
                for (int b4 = 0; b4 < 4; ++b4)
#pragma unroll
                    for (int i = 0; i < 16; ++i) o[b4][i] *= alpha;
                m_run = m_new;
            }
            const float mC = -m_run * C;
            float rs = 0.f;
#pragma unroll
            for (int i = 0; i < 16; ++i) { x0[i] = __builtin_amdgcn_exp2f(fmaf(x0[i], C, mC)); x1[i] = __builtin_amdgcn_exp2f(fmaf(x1[i], C, mC)); rs += x0[i] + x1[i]; }
            rs = xhalf_sum(rs);
            l_run += lane_sel ? rs : 0.f;
            const unsigned pmask = lane_sel ? 0xffffffffu : 0u;
            bf16x8 pb[4];
#pragma unroll
            for (int st = 0; st < 4; ++st) { v4u pw; const int s8 = 8 * (st & 1);
                if (st < 2) { pw.x = cvtpk(x0[s8], x0[s8 + 1]); pw.y = cvtpk(x0[s8 + 2], x0[s8 + 3]); pw.z = cvtpk(x0[s8 + 4], x0[s8 + 5]); pw.w = cvtpk(x0[s8 + 6], x0[s8 + 7]); }
                else { pw.x = cvtpk(x1[s8], x1[s8 + 1]); pw.y = cvtpk(x1[s8 + 2], x1[s8 + 3]); pw.z = cvtpk(x1[s8 + 4], x1[s8 + 5]); pw.w = cvtpk(x1[s8 + 6], x1[s8 + 7]); }
                pw.x &= pmask; pw.y &= pmask; pw.z &= pmask; pw.w &= pmask; pb[st] = __builtin_bit_cast(bf16x8, pw); }
#define MB_LDV(dst, st) do { _Pragma("unroll") for (int b4 = 0; b4 < 4; ++b4) { const LAS unsigned char* vp = Vt + (32 * b4 + r) * 136 + (16 * (st) + 4 * h) * 2; \
                const v2u lo = *(const LAS v2u*)vp, hi = *(const LAS v2u*)(vp + 16); dst[b4] = __builtin_bit_cast(bf16x8, (v4u){lo.x, lo.y, hi.x, hi.y}); } } while (0)
#define MB_PV(src, st) do { _Pragma("unroll") for (int b4 = 0; b4 < 4; ++b4) o[b4] = MFMA32(src[b4], pb[st], o[b4]); } while (0)
            { bf16x8 va[4], vb[4];
              MB_LDV(va, 0); MB_LDV(vb, 1); __builtin_amdgcn_sched_barrier(0);
              MB_PV(va, 0); MB_LDV(va, 2); __builtin_amdgcn_sched_barrier(0);
              MB_PV(vb, 1); MB_LDV(vb, 3); __builtin_amdgcn_sched_barrier(0);
              MB_PV(va, 2); __builtin_amdgcn_sched_barrier(0);
              MB_PV(vb, 3); }
#undef MB_LDV
#undef MB_PV
        }
        }
        if (tt + 1 < nT) moba_stage_store(L + ((tt + 1) & 1) * MB_BUF, tid, kr, vr);
        __syncthreads();
    }
    const float inv = 16.0f / l_run; const int b = bh >> 4, hh = bh & 15;
    unsigned char* orow = (unsigned char*)F.OM() + (size_t)(b * SEQ + j * 256 + 32 * w + r) * 2048 + hh * 128;
#pragma unroll
    for (int b4 = 0; b4 < 4; ++b4)
#pragma unroll
        for (int gq = 0; gq < 4; ++gq) *(unsigned*)(orow + 32 * b4 + 8 * gq + 4 * h) = pk4_fp8(o[b4][4 * gq] * inv, o[b4][4 * gq + 1] * inv, o[b4][4 * gq + 2] * inv, o[b4][4 * gq + 3] * inv);
}
__device__ __forceinline__ void moba_phase(Frame& F) {
    for (int p = blockIdx.x; p < BATCH * 16 * 8; p += F.G) { const int bh = p >> 3, jj = p & 7; moba_unit(F, bh, 15 - jj); moba_unit(F, bh, jj); }
}
__device__ __forceinline__ int crow(int reg, int h) { return (reg & 3) + 8 * (reg >> 2) + 4 * h; }
__device__ __forceinline__ float rdlane(float v, int l) { return __int_as_float(__builtin_amdgcn_readlane(__float_as_int(v), l)); }
template <int TB, int CB> __device__ __forceinline__ float lsel(const f32x16& L00, const f32x16& L10, const f32x16& L11, int reg, int ln) {
    return TB == 0 ? rdlane(L00[reg], ln) : (CB == 0 ? rdlane(L10[reg], ln) : rdlane(L11[reg], ln)); }
__device__ __forceinline__ void sub_step(float& acc, float lv, int ln, float xk) { int tmp;
    asm volatile("s_nop 0\n\tv_readlane_b32 %1, %2, %3\n\ts_nop 1\n\tv_fma_f32 %0, -%1, %4, %0" : "+v"(acc), "=&s"(tmp) : "v"(lv), "s"(ln), "v"(xk)); }
__device__ __forceinline__ void sub_step4(float& a0, float& a1, float& a2, float& a3, float l0, float l1, float l2, float l3, int n0, int n1, int n2, int n3, float x0, float x1, float x2, float x3) {
    int t0, t1, t2, t3;
    asm volatile("s_nop 0\n\tv_readlane_b32 %4, %8, %12\n\tv_readlane_b32 %5, %9, %13\n\tv_readlane_b32 %6, %10, %14\n\tv_readlane_b32 %7, %11, %15\n\t"
                 "v_fma_f32 %0, -%4, %16, %0\n\tv_fma_f32 %1, -%5, %17, %1\n\tv_fma_f32 %2, -%6, %18, %2\n\tv_fma_f32 %3, -%7, %19, %3"
                 : "+v"(a0), "+v"(a1), "+v"(a2), "+v"(a3), "=&s"(t0), "=&s"(t1), "=&s"(t2), "=&s"(t3)
                 : "v"(l0), "v"(l1), "v"(l2), "v"(l3), "s"(n0), "s"(n1), "s"(n2), "s"(n3), "v"(x0), "v"(x1), "v"(x2), "v"(x3));
}
__device__ __forceinline__ v4u pack8(const float (&x)[8]) { v4u p; p.x = cvtpk(x[0], x[1]); p.y = cvtpk(x[2], x[3]); p.z = cvtpk(x[4], x[5]); p.w = cvtpk(x[6], x[7]); return p; }

__device__ __forceinline__ void t_frags(const float (&X)[64], float sv, bf16x8 (&F0)[4], bf16x8 (&F1)[4]) {
#pragma unroll
    for (int ks = 0; ks < 4; ++ks) {
        float lo[8], hi[8];
#pragma unroll
        for (int jj = 0; jj < 8; ++jj) { lo[jj] = X[16 * ks + jj] * rdlane(sv, 16 * ks + jj); hi[jj] = X[16 * ks + 8 + jj] * rdlane(sv, 16 * ks + 8 + jj); }
        const v4u pl = pack8(lo), ph = pack8(hi); v4u f0, f1;
        { auto rr = __builtin_amdgcn_permlane32_swap(pl.x, ph.x, false, false); f0.x = rr[0]; f1.x = rr[1]; }
        { auto rr = __builtin_amdgcn_permlane32_swap(pl.y, ph.y, false, false); f0.y = rr[0]; f1.y = rr[1]; }
        { auto rr = __builtin_amdgcn_permlane32_swap(pl.z, ph.z, false, false); f0.z = rr[0]; f1.z = rr[1]; }
        { auto rr = __builtin_amdgcn_permlane32_swap(pl.w, ph.w, false, false); f0.w = rr[0]; f1.w = rr[1]; }
        F0[ks] = __builtin_bit_cast(bf16x8, f0); F1[ks] = __builtin_bit_cast(bf16x8, f1);
    }
}
__device__ __forceinline__ void gdn_local_task(Frame& F, int task, LAS float* sm) {
    int lane_o = F.lane; asm volatile("" : "+v"(lane_o));
    const int lane = lane_o, r = lane & 31, h = lane >> 5;
    const int c = task & 63, bhv = task >> 6, hv = bhv & 31, b = bhv >> 5, hq = hv >> 1;
    const int t0 = b * SEQ + c * 64; const size_t tq = (size_t)(b * 16 + hq) * 64 + c;
    const float g = F.GG()[(size_t)(t0 + lane) * 32 + hv], bt = F.BETA()[(size_t)(t0 + lane) * 32 + hv];
    float gc = g;
#pragma unroll
    for (int o = 1; o < 64; o <<= 1) { const float t = __int_as_float(__builtin_amdgcn_ds_bpermute(4 * ((lane - o) & 63), __float_as_int(gc))); gc += (lane >= o) ? t : 0.f; }
    sm[lane] = gc; sm[64 + lane] = bt;
    F.GC()[(size_t)task * 64 + lane] = gc;
    LDS_WAIT();
    bf16x8 kf[2][8];
#pragma unroll
    for (int tb = 0; tb < 2; ++tb)
#pragma unroll
        for (int ks = 0; ks < 8; ++ks) kf[tb][ks] = *(const bf16x8*)(F.KN() + (size_t)(t0 + 32 * tb + r) * 2048 + hq * 128 + 16 * ks + 8 * h);
    f32x16 L00, L10, L11;
#pragma unroll
    for (int i = 0; i < 16; ++i) { L00[i] = 0.f; L10[i] = 0.f; L11[i] = 0.f; }
#pragma unroll
    for (int ks = 0; ks < 8; ++ks) { L00 = MFMA32(kf[0][ks], kf[0][ks], L00); L10 = MFMA32(kf[1][ks], kf[0][ks], L10); L11 = MFMA32(kf[1][ks], kf[1][ks], L11); }
    const float gci0 = sm[r], gci1 = sm[32 + r];
#pragma unroll
    for (int reg = 0; reg < 16; ++reg) { const int kr = crow(reg, h); const float gk0 = sm[kr], bk0 = sm[64 + kr], gk1 = sm[32 + kr], bk1 = sm[96 + kr];
        L00[reg] = (r < kr) ? L00[reg] * bk0 * __expf(gk0 - gci0) : 0.f;
        L10[reg] = L10[reg] * bk1 * __expf(gk1 - gci0);
        L11[reg] = (r < kr) ? L11[reg] * bk1 * __expf(gk1 - gci1) : 0.f; }
    { bf16* at = F.AT() + (size_t)task * 4096; const float sc = 0.08838834764831845f;
      { bf16x8 qf[8];
#pragma unroll
        for (int ks = 0; ks < 8; ++ks) qf[ks] = *(const bf16x8*)(F.QN() + (size_t)(t0 + r) * 2048 + hq * 128 + 16 * ks + 8 * h);
        f32x16 A00;
#pragma unroll
        for (int i = 0; i < 16; ++i) A00[i] = 0.f;
#pragma unroll
        for (int ks = 0; ks < 8; ++ks) A00 = MFMA32(kf[0][ks], qf[ks], A00);
#pragma unroll
        for (int g4 = 0; g4 < 4; ++g4) { float v[4];
#pragma unroll
            for (int t = 0; t < 4; ++t) { const int reg = 4 * g4 + t, jr = crow(reg, h); v[t] = (jr <= r) ? A00[reg] * sc * __expf(gci0 - sm[jr]) : 0.f; }
            *(v2u*)(at + r * 64 + 8 * g4 + 4 * h) = (v2u){cvtpk(v[0], v[1]), cvtpk(v[2], v[3])}; } }
      { bf16x8 qf[8];
#pragma unroll
        for (int ks = 0; ks < 8; ++ks) qf[ks] = *(const bf16x8*)(F.QN() + (size_t)(t0 + 32 + r) * 2048 + hq * 128 + 16 * ks + 8 * h);
        f32x16 A01, A11;
#pragma unroll
        for (int i = 0; i < 16; ++i) { A01[i] = 0.f; A11[i] = 0.f; }
#pragma unroll
        for (int ks = 0; ks < 8; ++ks) { A01 = MFMA32(kf[0][ks], qf[ks], A01); A11 = MFMA32(kf[1][ks], qf[ks], A11); }
#pragma unroll
        for (int g4 = 0; g4 < 4; ++g4) { float v[4], u[4];
#pragma unroll
            for (int t = 0; t < 4; ++t) { const int reg = 4 * g4 + t, jr = crow(reg, h); v[t] = A01[reg] * sc * __expf(gci1 - sm[jr]); u[t] = (jr <= r) ? A11[reg] * sc * __expf(gci1 - sm[32 + jr]) : 0.f; }
            *(v2u*)(at + (32 + r) * 64 + 8 * g4 + 4 * h) = (v2u){cvtpk(v[0], v[1]), cvtpk(v[2], v[3])};
            *(v2u*)(at + (32 + r) * 64 + 32 + 8 * g4 + 4 * h) = (v2u){cvtpk(u[0], u[1]), cvtpk(u[2], u[3])}; } } }
    asm volatile("" ::: "memory"); __builtin_amdgcn_sched_barrier(0);
    bf16x8 vfr[2][4];
    { const bf16* vt = F.VP() + (size_t)task * 8192;
#pragma unroll
      for (int db = 0; db < 2; ++db)
#pragma unroll
          for (int ks = 0; ks < 4; ++ks) vfr[db][ks] = *(const bf16x8*)(vt + (32 * db + r) * 64 + 16 * ks + 8 * h); }
    float X[64];
    asm volatile("s_nop 7" ::: "memory");
#define GL_LV(k, i) (((k) < 32) ? L00[(((k) & 31) & 3) + 4 * (((k) & 31) >> 3)] : (((i) < 32) ? L10[(((k) & 31) & 3) + 4 * (((k) & 31) >> 3)] : L11[(((k) & 31) & 3) + 4 * (((k) & 31) >> 3)]))
#define GL_LN(k, i) (((i) & 31) + 32 * ((((k) & 31) >> 2) & 1))
#pragma unroll
    for (int i = 63; i >= 0; --i) {
        float a0 = (lane == i) ? 1.f : 0.f, a1 = 0.f, a2 = 0.f, a3 = 0.f;
        const int n4 = (63 - i) >> 2;
#pragma unroll
        for (int g = 0; g < n4; ++g) { const int k = i + 1 + 4 * g;
            sub_step4(a0, a1, a2, a3, GL_LV(k, i), GL_LV(k + 1, i), GL_LV(k + 2, i), GL_LV(k + 3, i), GL_LN(k, i), GL_LN(k + 1, i), GL_LN(k + 2, i), GL_LN(k + 3, i), X[k], X[k + 1], X[k + 2], X[k + 3]); }
#pragma unroll
        for (int k = i + 1 + 4 * n4; k < 64; ++k) sub_step(a0, GL_LV(k, i), GL_LN(k, i), X[k]);
        X[i] = (a0 + a1) + (a2 + a3);
    }
#undef GL_LV
#undef GL_LN
    asm volatile("" ::: "memory"); __builtin_amdgcn_sched_barrier(0);
    bf16x8 F0[4], F1[4];
    t_frags(X, bt, F0, F1);
    { bf16* ub = F.U() + (size_t)task * 8192;
#pragma unroll
      for (int db = 0; db < 4; ++db) { f32x16 u0, u1;
#pragma unroll
          for (int i = 0; i < 16; ++i) { u0[i] = 0.f; u1[i] = 0.f; }
#pragma unroll
          for (int ks = 0; ks < 4; ++ks) { const bf16x8 vf = db < 2 ? vfr[db & 1][ks] : *(const bf16x8*)(F.VP() + (size_t)task * 8192 + (32 * db + r) * 64 + 16 * ks + 8 * h); if (ks < 2) u0 = MFMA32(F0[ks], vf, u0); u1 = MFMA32(F1[ks], vf, u1); }
          v4u* d0 = (v4u*)(ub + ((0 * 4 + db) * 64 + lane) * 16); v4u* d1 = (v4u*)(ub + ((1 * 4 + db) * 64 + lane) * 16);
          { float a[8], bb[8];
#pragma unroll
            for (int i = 0; i < 8; ++i) { a[i] = u0[i]; bb[i] = u0[8 + i]; }
            d0[0] = pack8(a); d0[1] = pack8(bb);
#pragma unroll
            for (int i = 0; i < 8; ++i) { a[i] = u1[i]; bb[i] = u1[8 + i]; }
            d1[0] = pack8(a); d1[1] = pack8(bb); } } }
    asm volatile("" ::: "memory"); __builtin_amdgcn_sched_barrier(0);
    t_frags(X, bt * __expf(gc), F0, F1);
    { const bf16* kt = F.KNT() + tq * 8192; bf16* wb = F.W() + (size_t)task * 8192;
#pragma unroll
      for (int a = 0; a < 4; ++a) { f32x16 w0, w1;
#pragma unroll
          for (int i = 0; i < 16; ++i) { w0[i] = 0.f; w1[i] = 0.f; }
#pragma unroll
          for (int ks = 0; ks < 4; ++ks) { const bf16x8 ktf = *(const bf16x8*)(kt + (32 * a + r) * 64 + 16 * ks + 8 * h); if (ks < 2) w0 = MFMA32(ktf, F0[ks], w0); w1 = MFMA32(ktf, F1[ks], w1); }
#pragma unroll
          for (int g4 = 0; g4 < 4; ++g4) {
              *(v2u*)(wb + r * 128 + 32 * a + 8 * g4 + 4 * h) = (v2u){cvtpk(w0[4 * g4], w0[4 * g4 + 1]), cvtpk(w0[4 * g4 + 2], w0[4 * g4 + 3])};
              *(v2u*)(wb + (32 + r) * 128 + 32 * a + 8 * g4 + 4 * h) = (v2u){cvtpk(w1[4 * g4], w1[4 * g4 + 1]), cvtpk(w1[4 * g4 + 2], w1[4 * g4 + 3])}; } } }
    LDS_WAIT();
}
__device__ __forceinline__ void gdn_local_phase(Frame& F) {
    LAS float* sm = (LAS float*)(F.lds + F.wave * 512);
    const int gw = F.vcu * NWAVES + F.wave, NGW = F.G * NWAVES;
    for (int task = gw; task < BATCH * 32 * 64; task += NGW) gdn_local_task(F, task, sm);
}

constexpr int SC_W = 0, SC_Q = 16896, SC_A = 33792, SC_KT = 42496, SC_E1 = 59904, SC_E2 = 60160, SC_BUF = 60416, SC_OT = 2 * SC_BUF, SC_OTB = 16896;
static_assert(SC_OT + 2 * SC_OTB <= MISC_OFF, "scan LDS map");
__device__ __forceinline__ bf16x8 frag8(const LAS unsigned char* p) { const v2u lo = *(const LAS v2u*)p, hi = *(const LAS v2u*)(p + 16); return __builtin_bit_cast(bf16x8, (v4u){lo.x, lo.y, hi.x, hi.y}); }
__device__ __forceinline__ void st16(LAS unsigned char* p, v4u v) { *(LAS v2u*)p = (v2u){v.x, v.y}; *(LAS v2u*)(p + 8) = (v2u){v.z, v.w}; }
struct ScanRegs { v4u rw[4], rq[4], ra[2], rk[4]; float gcv, glv; };
__device__ __forceinline__ void scan_issue(Frame& F, int lt, size_t task, size_t tq, int t0, int hq, ScanRegs& R) {
#pragma unroll
    for (int i = 0; i < 4; ++i) { const int idx = lt + 256 * i, row = idx >> 4, ch = idx & 15;
        R.rw[i] = *(const v4u*)(F.W() + task * 8192 + row * 128 + ch * 8); R.rq[i] = *(const v4u*)(F.QN() + (size_t)(t0 + row) * 2048 + hq * 128 + ch * 8); }
#pragma unroll
    for (int i = 0; i < 2; ++i) { const int idx = lt + 256 * i, row = idx >> 3, ch = idx & 7; R.ra[i] = *(const v4u*)(F.AT() + task * 4096 + row * 64 + ch * 8); }
#pragma unroll
    for (int i = 0; i < 4; ++i) { const int idx = lt + 256 * i, row = idx >> 3, ch = idx & 7; R.rk[i] = *(const v4u*)(F.KNT() + tq * 8192 + row * 64 + ch * 8); }
    R.gcv = 0.f; R.glv = 0.f;
    if (lt < 64) { R.gcv = F.GC()[task * 64 + lt]; R.glv = F.GC()[task * 64 + 63]; }
}
__device__ __forceinline__ void scan_store(int lt, const ScanRegs& R, LAS unsigned char* buf) {
#pragma unroll
    for (int i = 0; i < 4; ++i) { const int idx = lt + 256 * i, row = idx >> 4, ch = idx & 15; st16(buf + SC_W + row * 264 + ch * 16, R.rw[i]); st16(buf + SC_Q + row * 264 + ch * 16, R.rq[i]); }
#pragma unroll
    for (int i = 0; i < 2; ++i) { const int idx = lt + 256 * i, row = idx >> 3, ch = idx & 7; st16(buf + SC_A + row * 136 + ch * 16, R.ra[i]); }
#pragma unroll
    for (int i = 0; i < 4; ++i) { const int idx = lt + 256 * i, row = idx >> 3, ch = idx & 7; st16(buf + SC_KT + row * 136 + ch * 16, R.rk[i]); }
    if (lt < 64) { ((LAS float*)(buf + SC_E1))[lt] = __expf(R.gcv) * 0.08838834764831845f; ((LAS float*)(buf + SC_E2))[lt] = __expf(R.glv - R.gcv); }
}
__device__ __forceinline__ void scan_finalize(Frame& F, LAS unsigned char* L, int c, int t0, int lw, int lane, int hv, f32x2 gn, const unsigned (&zw)[16]) {
    const LAS unsigned char* ot = L + SC_OT + (c & 1) * SC_OTB;
#pragma unroll
    for (int hb = 0; hb < 2; ++hb) {
        float o0[8], o1[8], ss[8];
#pragma unroll
        for (int i = 0; i < 8; ++i) { const unsigned ow = *(const LAS unsigned*)(ot + (16 * lw + 8 * hb + i) * 264 + 4 * lane); o0[i] = blo(ow); o1[i] = bhi(ow); ss[i] = o0[i] * o0[i] + o1[i] * o1[i]; }
#pragma unroll
        for (int i = 0; i < 8; ++i) ss[i] = wave_sum(ss[i]);
#pragma unroll
        for (int i = 0; i < 8; ++i) { const float rr = __builtin_amdgcn_rsqf(ss[i] * (1.0f / 128) + NORM_EPS); const float z0 = blo(zw[8 * hb + i]), z1 = bhi(zw[8 * hb + i]);
            const float y0 = o0[i] * rr * gn.x * (z0 * __builtin_amdgcn_rcpf(1.0f + __expf(-z0))), y1 = o1[i] * rr * gn.y * (z1 * __builtin_amdgcn_rcpf(1.0f + __expf(-z1)));
            *(unsigned*)(F.OG() + (size_t)(t0 + 16 * lw + 8 * hb + i) * 4096 + hv * 128 + 2 * lane) = pk2(y0, y1); }
    }
}
__device__ __forceinline__ void gdn_scan_seq(Frame& F, int seq) {
    int tid_o = F.tid; asm volatile("" : "+v"(tid_o));
    const int tid = tid_o, w = __builtin_amdgcn_readfirstlane(tid >> 6), lane = tid & 63, r = lane & 31, h = lane >> 5;
    const int b = seq >> 5, hv = seq & 31, hq = hv >> 1;
    LAS unsigned char* L = F.lds;
    const size_t task0 = (size_t)seq * 64, tq0 = (size_t)(b * 16 + hq) * 64;
    __syncthreads();
    if (w >= 4) {
        const int lt = tid - 256, lw = w - 4;
        const float* onorm = F.in[10]; const f32x2 gn = *(const f32x2*)(onorm + 2 * lane);
        ScanRegs R0, R1;
        scan_issue(F, lt, task0, tq0, b * SEQ, hq, R0); scan_issue(F, lt, task0 + 1, tq0 + 1, b * SEQ + 64, hq, R1);
        scan_store(lt, R0, L);
        __syncthreads();
#define SCAN_LOADER_STEP(c, RA, RB) do { \
            const int t0 = b * SEQ + (c) * 64; \
            unsigned zw[16]; \
            _Pragma("unroll") for (int i = 0; i < 16; ++i) zw[i] = *(const unsigned*)(F.PB() + (size_t)(t0 + 16 * lw + i) * PB_LD + PB_GZ + hv * 128 + 2 * lane); \
            if ((c) + 2 < 64) scan_issue(F, lt, task0 + (c) + 2, tq0 + (c) + 2, b * SEQ + ((c) + 2) * 64, hq, RA); \
            if ((c) + 1 < 64) scan_store(lt, RB, L + (((c) + 1) & 1) * SC_BUF); \
            __syncthreads(); \
            scan_finalize(F, L, (c), t0, lw, lane, hv, gn, zw); } while (0)
        for (int c = 0; c < 64; c += 2) {
            SCAN_LOADER_STEP(c, R0, R1);
            SCAN_LOADER_STEP(c + 1, R1, R0);
        }
#undef SCAN_LOADER_STEP
    } else {
        f32x16 Sx[4];
#pragma unroll
        for (int a = 0; a < 4; ++a)
#pragma unroll
            for (int i = 0; i < 16; ++i) Sx[a][i] = 0.f;
        v4u ur[4];
        { const v4u* up = (const v4u*)(F.U() + task0 * 8192 + ((0 * 4 + w) * 64 + lane) * 16); ur[0] = up[0]; ur[1] = up[1];
          const v4u* up1 = (const v4u*)(F.U() + task0 * 8192 + ((1 * 4 + w) * 64 + lane) * 16); ur[2] = up1[0]; ur[3] = up1[1]; }
        __syncthreads();
        for (int c = 0; c < 64; ++c) {
            const LAS unsigned char* buf = L + (c & 1) * SC_BUF; const LAS float* e1 = (const LAS float*)(buf + SC_E1); const LAS float* e2 = (const LAS float*)(buf + SC_E2);
            bf16x8 Sb[4][2];
#pragma unroll
            for (int a = 0; a < 4; ++a)
#pragma unroll
                for (int s = 0; s < 2; ++s) { float t[8];
#pragma unroll
                    for (int jj = 0; jj < 8; ++jj) t[jj] = Sx[a][8 * s + jj];
                    Sb[a][s] = __builtin_bit_cast(bf16x8, pack8(t)); }
            f32x16 vn[2];
#define SC_LD4(dst, off, gi) do { _Pragma("unroll") for (int q_ = 0; q_ < 4; ++q_) dst[q_] = frag8(buf + (off) + (32 * ((gi) >> 1) + r) * 264 + (32 * (2 * ((gi) & 1) + (q_ >> 1)) + 16 * (q_ & 1) + 4 * h) * 2); } while (0)
#define SC_MM4(acc, src, gi) do { _Pragma("unroll") for (int q_ = 0; q_ < 4; ++q_) acc = MFMA32(src[q_], Sb[2 * ((gi) & 1) + (q_ >> 1)][q_ & 1], acc); } while (0)
            { f32x16 y0, y1;
#pragma unroll
              for (int i = 0; i < 16; ++i) { y0[i] = 0.f; y1[i] = 0.f; }
              bf16x8 fa[4], fb[4];
              SC_LD4(fa, SC_W, 0); SC_LD4(fb, SC_W, 1); __builtin_amdgcn_sched_barrier(0);
              SC_MM4(y0, fa, 0); SC_LD4(fa, SC_W, 2); __builtin_amdgcn_sched_barrier(0);
              SC_MM4(y0, fb, 1); SC_LD4(fb, SC_W, 3); __builtin_amdgcn_sched_barrier(0);
              SC_MM4(y1, fa, 2); __builtin_amdgcn_sched_barrier(0);
              SC_MM4(y1, fb, 3);
#pragma unroll
              for (int tb = 0; tb < 2; ++tb) { const v4u ua = ur[2 * tb], ub = ur[2 * tb + 1]; const f32x16& y = tb ? y1 : y0;
                vn[tb][0] = blo(ua.x) - y[0]; vn[tb][1] = bhi(ua.x) - y[1]; vn[tb][2] = blo(ua.y) - y[2]; vn[tb][3] = bhi(ua.y) - y[3];
                vn[tb][4] = blo(ua.z) - y[4]; vn[tb][5] = bhi(ua.z) - y[5]; vn[tb][6] = blo(ua.w) - y[6]; vn[tb][7] = bhi(ua.w) - y[7];
                vn[tb][8] = blo(ub.x) - y[8]; vn[tb][9] = bhi(ub.x) - y[9]; vn[tb][10] = blo(ub.y) - y[10]; vn[tb][11] = bhi(ub.y) - y[11];
                vn[tb][12] = blo(ub.z) - y[12]; vn[tb][13] = bhi(ub.z) - y[13]; vn[tb][14] = blo(ub.w) - y[14]; vn[tb][15] = bhi(ub.w) - y[15]; } }
            if (c + 1 < 64) { const v4u* up = (const v4u*)(F.U() + (task0 + c + 1) * 8192 + ((0 * 4 + w) * 64 + lane) * 16); ur[0] = up[0]; ur[1] = up[1];
                const v4u* up1 = (const v4u*)(F.U() + (task0 + c + 1) * 8192 + ((1 * 4 + w) * 64 + lane) * 16); ur[2] = up1[0]; ur[3] = up1[1]; }
            bf16x8 Vb[2][2], Vb2[2][2];
#pragma unroll
            for (int tb = 0; tb < 2; ++tb)
#pragma unroll
                for (int s = 0; s < 2; ++s) { float t[8], t2[8];
                    const f32x4 ea = *(const LAS f32x4*)(e2 + 32 * tb + 16 * s + 4 * h), eb = *(const LAS f32x4*)(e2 + 32 * tb + 16 * s + 8 + 4 * h);
#pragma unroll
                    for (int jj = 0; jj < 4; ++jj) { t[jj] = vn[tb][8 * s + jj]; t[4 + jj] = vn[tb][8 * s + 4 + jj]; t2[jj] = t[jj] * ea[jj]; t2[4 + jj] = t[4 + jj] * eb[jj]; }
                    Vb[tb][s] = __builtin_bit_cast(bf16x8, pack8(t)); Vb2[tb][s] = __builtin_bit_cast(bf16x8, pack8(t2)); }
            LAS unsigned char* ot = L + SC_OT + (c & 1) * SC_OTB;
            { f32x16 y0, y1;
#pragma unroll
              for (int i = 0; i < 16; ++i) { y0[i] = 0.f; y1[i] = 0.f; }
              bf16x8 fa[4], fb[4], at[6];
              SC_LD4(fa, SC_Q, 0); SC_LD4(fb, SC_Q, 1); __builtin_amdgcn_sched_barrier(0);
              SC_MM4(y0, fa, 0); SC_LD4(fa, SC_Q, 2); __builtin_amdgcn_sched_barrier(0);
              SC_MM4(y0, fb, 1); SC_LD4(fb, SC_Q, 3); __builtin_amdgcn_sched_barrier(0);
              SC_MM4(y1, fa, 2);
#pragma unroll
              for (int s2 = 0; s2 < 2; ++s2) { at[s2] = frag8(buf + SC_A + r * 136 + (16 * s2 + 4 * h) * 2); at[2 + s2] = frag8(buf + SC_A + (32 + r) * 136 + (16 * s2 + 4 * h) * 2); at[4 + s2] = frag8(buf + SC_A + (32 + r) * 136 + (32 + 16 * s2 + 4 * h) * 2); }
              __builtin_amdgcn_sched_barrier(0);
              SC_MM4(y1, fb, 3);
#pragma unroll
              for (int g4 = 0; g4 < 4; ++g4) { const f32x4 ea = *(const LAS f32x4*)(e1 + 8 * g4 + 4 * h), eb = *(const LAS f32x4*)(e1 + 32 + 8 * g4 + 4 * h);
#pragma unroll
                  for (int t = 0; t < 4; ++t) { y0[4 * g4 + t] *= ea[t]; y1[4 * g4 + t] *= eb[t]; } }
              y0 = MFMA32(at[0], Vb[0][0], y0); y0 = MFMA32(at[1], Vb[0][1], y0);
              y1 = MFMA32(at[2], Vb[0][0], y1); y1 = MFMA32(at[3], Vb[0][1], y1); y1 = MFMA32(at[4], Vb[1][0], y1); y1 = MFMA32(at[5], Vb[1][1], y1);
#pragma unroll
              for (int reg = 0; reg < 16; reg += 2) { const unsigned p0 = cvtpk(y0[reg], y0[reg + 1]), p1 = cvtpk(y1[reg], y1[reg + 1]);
                  *(LAS unsigned short*)(ot + crow(reg, h) * 264 + (32 * w + r) * 2) = (unsigned short)(p0 & 0xffffu); *(LAS unsigned short*)(ot + crow(reg + 1, h) * 264 + (32 * w + r) * 2) = (unsigned short)(p0 >> 16);
                  *(LAS unsigned short*)(ot + (32 + crow(reg, h)) * 264 + (32 * w + r) * 2) = (unsigned short)(p1 & 0xffffu); *(LAS unsigned short*)(ot + (32 + crow(reg + 1, h)) * 264 + (32 * w + r) * 2) = (unsigned short)(p1 >> 16); } }
            { const float eg0 = e1[63] * 11.313708498984761f;
#define SC_LDK(dst, a) do { _Pragma("unroll") for (int q_ = 0; q_ < 4; ++q_) dst[q_] = frag8(buf + SC_KT + (32 * (a) + r) * 136 + (32 * (q_ >> 1) + 16 * (q_ & 1) + 4 * h) * 2); } while (0)
#define SC_MMK(a, src) do { _Pragma("unroll") for (int q_ = 0; q_ < 4; ++q_) Sx[a] = MFMA32(src[q_], Vb2[q_ >> 1][q_ & 1], Sx[a]); } while (0)
              bf16x8 fa[4], fb[4];
              SC_LDK(fa, 0); SC_LDK(fb, 1);
#pragma unroll
              for (int a = 0; a < 4; ++a)
#pragma unroll
                  for (int i = 0; i < 16; ++i) Sx[a][i] *= eg0;
              __builtin_amdgcn_sched_barrier(0);
              SC_MMK(0, fa); SC_LDK(fa, 2); __builtin_amdgcn_sched_barrier(0);
              SC_MMK(1, fb); SC_LDK(fb, 3); __builtin_amdgcn_sched_barrier(0);
              SC_MMK(2, fa); __builtin_amdgcn_sched_barrier(0);
              SC_MMK(3, fb); }
#undef SC_LDK
#undef SC_MMK
#undef SC_LD4
#undef SC_MM4
            __syncthreads();
        }
    }
}
__device__ __forceinline__ void moba_queue(Frame& F) {
    const unsigned x0 = xb_xcc_id() & 7u;
    for (unsigned k = 0; k < 8u;) {
        const unsigned x = (x0 + k) & 7u;
        __syncthreads();
        if (F.tid == 0) F.MISC[0] = __hip_atomic_fetch_add(F.ctl + CW_Q + 64 * x, 1u, __ATOMIC_RELAXED, __HIP_MEMORY_SCOPE_AGENT);
        __syncthreads();
        const unsigned q = F.MISC[0];
        if (q >= 64u) { ++k; continue; }
        const int bh = (int)((q >> 3) * 8u + x), jj = (int)(q & 7u); moba_unit(F, bh, 15 - jj); moba_unit(F, bh, jj);
    }
}
struct Args { const float* in[20]; float* out; unsigned char* ws; int ph_lo, ph_hi, li, pad; };
__global__ void __launch_bounds__(NWAVES * 64, 2) fwd(Args args) {
    extern __shared__ __attribute__((aligned(16))) unsigned char lds[];
    Frame F;
    F.lds = (LAS unsigned char*)lds;
    F.MISC = (volatile LAS unsigned*)(F.lds + MISC_OFF);
    F.tid = threadIdx.x; F.lane = F.tid & 63; F.wave = __builtin_amdgcn_readfirstlane(F.tid >> 6);
    F.G = gridDim.x; { const int bx = blockIdx.x; F.vcu = (F.G % 8 == 0) ? (bx % 8) * (F.G / 8) + bx / 8 : bx; }
    unsigned char* ws = args.ws;
    F.ctl = (unsigned*)(ws + WS_CTL); F.wsb = ws;
#pragma unroll
    for (int i = 0; i < 20; ++i) F.in[i] = args.in[i];
    F.out = args.out;
    for (int u = F.tid; u < (LDS_BYTES - MISC_OFF) / 4; u += NWAVES * 64) ((LAS unsigned*)(F.lds + MISC_OFF))[u] = 0u;
    __syncthreads();
    XcdBarrier bar; bar.bar = (unsigned*)(F.ctl + CW_BAR); bar.x = 0; bar.st = nullptr;
#if MK_SINGLE
    bar = xcd_barrier_post((unsigned*)(F.ctl + CW_BAR), F.MISC + 8);
#define GRID_BAR() xcd_barrier(bar)
#else
#define GRID_BAR() do { } while (0)
#endif
    const int lo = args.ph_lo, hi = args.ph_hi;
#define IN(k) (lo <= (k) && (k) < hi)
#define BOTH(k) (IN(k) && IN((k) + 1))
#ifndef PROBE_REP
#define PROBE_REP -1
#endif
#define REFRESH() do { int t_ = threadIdx.x; asm volatile("" : "+v"(t_)); F.tid = t_; F.lane = t_ & 63; F.wave = __builtin_amdgcn_readfirstlane(t_ >> 6); } while (0)
#define REP(k) _Pragma("unroll") for (int rep_ = 0; rep_ < ((PROBE_REP == (k)) ? 2 : 1); ++rep_)
    typedef pg8::bf16_t pb;
    REP(0) if (IN(0)) { REFRESH(); quant_ffn_gu(F, F.in[2], F.in[3], (float*)F.CM(0)); quant_wd(F, F.in[4], (float*)F.CMD(0)); rope_table(F);
        rms_rows_i8(F, F.in[0], F.in[1], (unsigned char*)F.H(), F.RS()); if (BOTH(0)) GRID_BAR(); }
    REP(1) if (IN(1)) { pg8::Gemm g{(const pb*)F.H(), (const pb*)F.WGU(), M, 2 * FF, DM}; pg8::StaticOrder S; S.init(M, 2 * FF, F.G, (int)blockIdx.x);
        pg8::EpiSwiGLUT<true> E{(pb*)F.ACT(), FF, F.RS(), (const float*)F.CM(0), F.RM(0)}; pg8::gemm_phase<pg8::EpiSwiGLUT<true>, pg8::StaticOrder, true, true, 3>(F.lds, g, S, E); if (BOTH(1)) GRID_BAR(); }
    REP(2) if (IN(2)) { REFRESH(); requant_rows(F, F.ACT(), F.ACT8(), F.RS()); GRID_BAR();
        pg8::Gemm g{(const pb*)F.ACT8(), (const pb*)F.WD(), M, DM, FF}; pg8::StaticOrder S; S.init(M, DM, F.G, (int)blockIdx.x);
        pg8::EpiResid8 E{F.in[0], F.out, DM, 0.5f, nullptr, nullptr, nullptr, F.RS(), (const float*)F.CMD(0)}; pg8::gemm_phase<pg8::EpiResid8, pg8::StaticOrder, true, true, 3>(F.lds, g, S, E); if (BOTH(2)) GRID_BAR(); }
    REP(3) if (IN(3)) { REFRESH(); convert_win(F); rms_rows_i8(F, F.out, F.in[5], F.H8(), F.RS(), F.H()); if (BOTH(3)) GRID_BAR(); }
    REP(4) if (IN(4)) { { pg8::Gemm g{(const pb*)F.H(), (const pb*)F.WB(), M, NPROJ, DM, 0}; pg8::StaticOrder S; S.init(M, NPROJ, F.G, (int)blockIdx.x);
          typedef pg8::EpiProjT<false, 0, PA_LD, 48, (long)((WS_PB - WS_BIG) / 2), PB_LD, 16, 0, PB_LD, 0> EP; EP E{(pb*)F.PA(), F.AB(), nullptr, nullptr}; pg8::gemm_phase<EP, pg8::StaticOrder, true, true>(F.lds, g, S, E); }
        { pg8::Gemm g{(const pb*)F.H8(), (const pb*)F.W8(), M, NGATE, DM, 0}; pg8::StaggerOrder S;
          { const int nb = (M / 256) * (NPROJ / 256), n8 = (M / 256) * (NGATE / 256), G = F.G; int c0 = nb % G, R0 = (n8 - 2 * (G - c0)) / G; if ((G & 7) || (c0 & 7) || R0 < 0) { c0 = 0; R0 = 0; }
            S.init2(M, NGATE, G, (int)blockIdx.x, R0, c0); }
          typedef pg8::EpiProjT<true, PA_MV, PA_LD, 8, (long)((WS_PB - WS_BIG) / 2) + PB_GG, PB_LD, 32, 0, PB_LD, 0> EP8; EP8 E{(pb*)F.PA(), F.AB(), F.RS(), (const float*)F.CMW()};
          pg8::gemm_phase<EP8, pg8::StaggerOrder, true, true, 3>(F.lds, g, S, E); }
        if (BOTH(4)) GRID_BAR(); }
    REP(5) if (IN(5)) { REFRESH(); prep_moba(F); prep_gdn(F); __syncthreads(); convert_branch(F); if (BOTH(5)) GRID_BAR(); }
    REP(6) if (IN(6)) { REFRESH(); gdn_local_phase(F); if (BOTH(6)) GRID_BAR(); }
    REP(7) if (IN(7)) { REFRESH(); for (int seq = blockIdx.x; seq < BATCH * 32; seq += F.G) gdn_scan_seq(F, seq); moba_queue(F); if (BOTH(7)) GRID_BAR(); }
    REP(8) if (IN(8)) { pg8::Gemm g{(const pb*)F.OG(), (const pb*)F.WBG(), M, DM, 4096}; pg8::StaticOrder S; S.init(M, DM, F.G, (int)blockIdx.x);
        pg8::EpiGate<true> E{(pb*)F.H(), DM, (const pb*)F.PB() + PB_GG, PB_LD}; pg8::gemm_phase<pg8::EpiGate<true>, pg8::StaticOrder, true, true>(F.lds, g, S, E); }
    REP(9) if (IN(9)) { pg8::Gemm g{(const pb*)F.OM(), (const pb*)F.WBM(), M, DM, 2048, 0x7b7b7b7b}; pg8::StaticOrder S; S.init(M, DM, F.G, (int)blockIdx.x);
        pg8::EpiGate<false> E{(pb*)F.H(), DM, (const pb*)F.PB() + PB_MG, PB_LD}; pg8::gemm_phase<pg8::EpiGate<false>, pg8::StaticOrder, true, true, true>(F.lds, g, S, E); if (BOTH(9)) GRID_BAR(); }
    REP(10) if (IN(10)) { pg8::Gemm g{(const pb*)F.H(), (const pb*)F.WO(), M, DM, DM}; pg8::StaticOrder S; S.init(M, DM, F.G, (int)blockIdx.x);
        pg8::EpiResid E{F.out, F.out, DM, 1.0f, nullptr, nullptr, nullptr, nullptr, nullptr}; pg8::gemm_phase<pg8::EpiResid, pg8::StaticOrder, true, true>(F.lds, g, S, E); if (BOTH(10)) GRID_BAR(); }
    REP(11) if (IN(11)) { REFRESH(); quant_ffn_gu(F, F.in[17], F.in[18], (float*)F.CM(1)); quant_wd(F, F.in[19], (float*)F.CMD(1)); rms_rows_i8(F, F.out, F.in[16], (unsigned char*)F.H(), F.RS()); if (BOTH(11)) GRID_BAR(); }
    REP(12) if (IN(12)) { pg8::Gemm g{(const pb*)F.H(), (const pb*)F.WGU(), M, 2 * FF, DM}; pg8::StaticOrder S; S.init(M, 2 * FF, F.G, (int)blockIdx.x);
        pg8::EpiSwiGLUT<true> E{(pb*)F.ACT(), FF, F.RS(), (const float*)F.CM(1), F.RM(1)}; pg8::gemm_phase<pg8::EpiSwiGLUT<true>, pg8::StaticOrder, true, true, 3>(F.lds, g, S, E); if (BOTH(12)) GRID_BAR(); }
    REP(13) if (IN(13)) { REFRESH(); requant_rows(F, F.ACT(), F.ACT8(), F.RS()); GRID_BAR();
        pg8::Gemm g{(const pb*)F.ACT8(), (const pb*)F.WD(), M, DM, FF}; pg8::StaticOrder S; S.init(M, DM, F.G, (int)blockIdx.x);
        pg8::EpiResid8 E{F.out, F.out, DM, 0.5f, nullptr, nullptr, nullptr, F.RS(), (const float*)F.CMD(1)}; pg8::gemm_phase<pg8::EpiResid8, pg8::StaticOrder, true, true, 3>(F.lds, g, S, E); }
#undef IN
#undef BOTH
}

extern "C" void kernel_launch(void* const* d_in, const int* in_sizes, int n_in, void* d_out, int out_size, void* d_ws, size_t ws_size, hipStream_t stream) {
    static int grid = 0;
    if (grid == 0) {
        if (n_in != 20 || out_size != M * DM || ws_size < WS_END) { fprintf(stderr, "kernel_launch: unexpected shapes (n_in %d out %d ws %zu)\n", n_in, out_size, ws_size); grid = -1; return; }
        int dev = 0, cus = 0;
        if (hipGetDevice(&dev) != hipSuccess || hipDeviceGetAttribute(&cus, hipDeviceAttributeMultiprocessorCount, dev) != hipSuccess) { grid = -1; return; }
        if (hipFuncSetAttribute((const void*)fwd, hipFuncAttributeMaxDynamicSharedMemorySize, LDS_BYTES) != hipSuccess) { fprintf(stderr, "kernel_launch: hipFuncSetAttribute failed\n"); grid = -1; return; }
        (void)hipGetLastError();
        grid = cus;
    }
    if (grid < 0) return;
    (void)hipMemsetAsync((char*)d_ws + WS_CTL, 0, CTL_ZERO_BYTES, stream);
    Args a{};
    for (int i = 0; i < 20; ++i) a.in[i] = (const float*)d_in[i];
    a.out = (float*)d_out; a.ws = (unsigned char*)d_ws;
#if MK_SINGLE
    a.ph_lo = 0; a.ph_hi = N_PHASES; a.li = 0;
    hipLaunchKernelGGL(fwd, dim3(grid), dim3(NWAVES * 64), LDS_BYTES, stream, a);
#else
    for (int p = 0; p < N_PHASES; ++p) { a.ph_lo = p; a.ph_hi = p + 1; a.li = p;
        hipLaunchKernelGGL(fwd, dim3(grid), dim3(NWAVES * 64), LDS_BYTES, stream, a); }
#endif
}
```

```cpp
#include <hip/hip_runtime.h>
#include <cstdio>
#include <cstdint>
#include <cmath>
namespace pg8 {
#define PG8_LAS __attribute__((address_space(3)))
typedef unsigned short bf16_t;
typedef short bf16x8 __attribute__((ext_vector_type(8)));
typedef float f32x4 __attribute__((ext_vector_type(4)));
typedef unsigned u32x4 __attribute__((ext_vector_type(4)));
constexpr int BM = 256, BK = 64, HALF = 128, HTB = HALF * BK * 2  , STAGE_BYTES = 8 * HTB, NXCD = 8, WGM = 8;

__host__ __device__ __forceinline__ int lds_byte(int r, int c) { const int st = (r >> 4) * 2 + (c >> 5), rr = r & 15, cc = c & 31, ob = rr * 64 + cc * 2; return st * 1024 + (ob ^ (((ob >> 9) & 1) << 5)); }
__host__ __device__ __forceinline__ void stage_rc(int b, int& R, int& C) { const int st = b / 1024, sb = b % 1024, swz = sb ^ (((sb >> 9) & 1) << 5); R = (st >> 1) * 16 + swz / 64; C = (st & 1) * 32 + (swz % 64) / 2; }
__host__ __device__ __forceinline__ int perm32(int rho) { const int n = rho >> 4, i = rho & 15; return 8 * (i >> 2) + 4 * n + (i & 3); }

struct Unit { int pm, pn; };
struct Gemm { const bf16_t* A; const bf16_t* Bt; int M, N, K; int sA; int nb16; };

struct StaticOrder {
    int nM, nN, nwg, G, c;
    __host__ __device__ void init(int M, int N, int G_, int c_) { nM = M / BM; nN = N / BM; nwg = nM * nN; G = G_; c = c_; }
    __host__ __device__ bool next(int i, Unit& u) const {
        const long L = (long)i * G + c; if (L >= nwg) return false;
        int wgid = (int)L; { const int q = nwg / NXCD, r = nwg % NXCD, xcd = wgid % NXCD, off = wgid / NXCD; wgid = (xcd < r ? xcd * (q + 1) : r * (q + 1) + (xcd - r) * q) + off; }
        const int nig = WGM * nN, gid = wgid / nig, fm = gid * WGM, gsz = (nM - fm) < WGM ? (nM - fm) : WGM;
        u.pm = fm + ((wgid % nig) % gsz); u.pn = (wgid % nig) / gsz; return true;
    }
    __device__ __forceinline__ void a_ready(const Unit&) const {}
    __device__ __forceinline__ void done(const Unit&) const {}
};
struct StaggerOrder : StaticOrder {
    int R0, c0;
    __host__ __device__ void init2(int M, int N, int G_, int c_, int R0_, int c0_) { init(M, N, G_, c_); R0 = R0_; c0 = c0_; }
    __host__ __device__ bool next(int i, Unit& u) const {
        long L;
        if (i < R0) L = (long)i * G + c; else { if (c < c0) return false; L = (long)R0 * G + (long)(i - R0) * (G - c0) + (c - c0); }
        if (L >= nwg) return false;
        int wgid = (int)L; { const int q = nwg / NXCD, r = nwg % NXCD, xcd = wgid % NXCD, off = wgid / NXCD; wgid = (xcd < r ? xcd * (q + 1) : r * (q + 1) + (xcd - r) * q) + off; }
        const int nig = WGM * nN, gid = wgid / nig, fm = gid * WGM, gsz = (nM - fm) < WGM ? (nM - fm) : WGM;
        u.pm = fm + ((wgid % nig) % gsz); u.pn = (wgid % nig) / gsz; return true;
    }
};
__device__ __forceinline__ unsigned cvt_pk_bf16(float lo, float hi) { unsigned r; asm volatile("v_cvt_pk_bf16_f32 %0, %1, %2" : "=v"(r) : "v"(lo), "v"(hi)); return r; }
__device__ __forceinline__ float sigmoid_fast(float x) { return __builtin_amdgcn_rcpf(1.0f + __expf(-x)); }
__device__ __forceinline__ float bf_lo(unsigned w) { return __uint_as_float(w << 16); }
__device__ __forceinline__ float bf_hi(unsigned w) { return __uint_as_float(w & 0xffff0000u); }
__device__ __forceinline__ float row_rstd(const unsigned long long* SS, size_t row) { const float s = (float)SS[row] * (1.0f / 16777216.0f); return 1.0f / sqrtf(s * (1.0f / 4096.0f) + 1e-6f); }
__device__ __forceinline__ float fq_sum(float v) {
    auto a = __builtin_amdgcn_permlane16_swap(__float_as_uint(v), __float_as_uint(v), false, false); v = __uint_as_float(a[0]) + __uint_as_float(a[1]);
    auto b = __builtin_amdgcn_permlane32_swap(__float_as_uint(v), __float_as_uint(v), false, false); return __uint_as_float(b[0]) + __uint_as_float(b[1]); }
__device__ __forceinline__ unsigned pk4_e4m3(float a, float b, float c, float d) { int w = 0; w = __builtin_amdgcn_cvt_pk_fp8_f32(a, b, w, false); w = __builtin_amdgcn_cvt_pk_fp8_f32(c, d, w, true); return (unsigned)w; }
__device__ __forceinline__ void had32_lanes(float (&x)[8], int fq) {
#pragma unroll
    for (int h = 1; h < 8; h <<= 1)
#pragma unroll
        for (int i = 0; i < 8; ++i) if (!(i & h)) { const float a = x[i], b = x[i + h]; x[i] = a + b; x[i + h] = a - b; }
#pragma unroll
    for (int i = 0; i < 8; ++i) { auto a = __builtin_amdgcn_permlane16_swap(__float_as_uint(x[i]), __float_as_uint(x[i]), false, false);
        const float lo = __uint_as_float(a[0]), hi = __uint_as_float(a[1]); x[i] = (fq & 1) ? lo - hi : lo + hi; }
#pragma unroll
    for (int i = 0; i < 8; ++i) { auto b = __builtin_amdgcn_permlane32_swap(__float_as_uint(x[i]), __float_as_uint(x[i]), false, false);
        const float lo = __uint_as_float(b[0]), hi = __uint_as_float(b[1]); x[i] = ((fq & 2) ? lo - hi : lo + hi) * 0.17677669529663687f; }
}
__device__ __forceinline__ float fq_max(float v) {
    auto a = __builtin_amdgcn_permlane16_swap(__float_as_uint(v), __float_as_uint(v), false, false); v = fmaxf(__uint_as_float(a[0]), __uint_as_float(a[1]));
    auto b = __builtin_amdgcn_permlane32_swap(__float_as_uint(v), __float_as_uint(v), false, false); return fmaxf(__uint_as_float(b[0]), __uint_as_float(b[1])); }
template <bool I8, bool HAD = false> struct EpiSwiGLUT {
    static constexpr bool PERM = true, AFTER_DRAIN = false;
    bf16_t* O; int ldc; const float* RS; const float* CS; unsigned* RM;
    __device__ __forceinline__ void operator()(const f32x4 (&acc)[2][2][4][2], const Unit& u, int wr, int wc, int fr, int fq) const {
        const unsigned row0 = u.pm * BM + wr * 64 + fr; const int col0 = u.pn * HALF + wc * 32 + 8 * fq;
        float rs[8]; f32x4 cg0, cg1, cu0, cu1;
        if constexpr (I8) {
#pragma unroll
            for (int i = 0; i < 8; ++i) rs[i] = RS[row0 + (i >> 2) * HALF + (i & 3) * 16] * (1.0f / 127.0f);
            const float* cp = CS + u.pn * BM + wc * 32 + 8 * fq; cg0 = *(const f32x4*)cp; cg1 = *(const f32x4*)(cp + 4); cu0 = *(const f32x4*)(cp + HALF); cu1 = *(const f32x4*)(cp + HALF + 4);
        }
#pragma unroll
        for (int ai = 0; ai < 2; ++ai)
#pragma unroll
            for (int m = 0; m < 4; ++m) { const unsigned row = row0 + ai * HALF + m * 16; bf16_t* rowp = O + (size_t)row * ldc + col0;
                float x[8];
#pragma unroll
                for (int j = 0; j < 4; ++j) { float g0, g1, u0, u1;
                    if constexpr (I8) { const float r = rs[ai * 4 + m];
                        g0 = (float)__float_as_int(acc[ai][0][m][0][j]) * (r * cg0[j]); g1 = (float)__float_as_int(acc[ai][0][m][1][j]) * (r * cg1[j]);
                        u0 = (float)__float_as_int(acc[ai][1][m][0][j]) * (r * cu0[j]); u1 = (float)__float_as_int(acc[ai][1][m][1][j]) * (r * cu1[j]); }
                    else { g0 = acc[ai][0][m][0][j]; g1 = acc[ai][0][m][1][j]; u0 = acc[ai][1][m][0][j]; u1 = acc[ai][1][m][1][j]; }
                    x[j] = g0 * sigmoid_fast(g0) * u0; x[4 + j] = g1 * sigmoid_fast(g1) * u1; }
                if constexpr (HAD) had32_lanes(x, fq);
                u32x4 w; w.x = cvt_pk_bf16(x[0], x[1]); w.y = cvt_pk_bf16(x[2], x[3]); w.z = cvt_pk_bf16(x[4], x[5]); w.w = cvt_pk_bf16(x[6], x[7]); *(u32x4*)rowp = w;
                if constexpr (HAD) {
                    float mx = fmaxf(fmaxf(fmaxf(fabsf(x[0]), fabsf(x[1])), fmaxf(fabsf(x[2]), fabsf(x[3]))), fmaxf(fmaxf(fabsf(x[4]), fabsf(x[5])), fmaxf(fabsf(x[6]), fabsf(x[7]))));
                    mx = fq_max(mx);
                    if (fq == 0) atomicMax(RM + row, __float_as_uint(mx)); } }
    }
};
template <bool NORM, bool FP8COPY, bool I8 = false> struct EpiResidT {
    static constexpr bool PERM = true, AFTER_DRAIN = false;
    const float* base; float* out; int ldc; float scale; bf16_t* Hb; unsigned char* H8; unsigned long long* SS; const float* RS; const float* CS;
    __device__ __forceinline__ void operator()(const f32x4 (&acc)[2][2][4][2], const Unit& u, int wr, int wc, int fr, int fq) const {
        const unsigned row0 = u.pm * BM + wr * 64 + fr, col0 = u.pn * BM + wc * 32 + 8 * fq;
        const char* bp = (const char*)base; char* op = (char*)out; char* hp = (char*)Hb; char* h8 = (char*)H8; char* sp = (char*)SS;
        f32x4 cb[4], nb[4]; float rs[8]; f32x4 cs[2][2];
        if constexpr (I8) {
#pragma unroll
            for (int i = 0; i < 8; ++i) rs[i] = RS[row0 + (i >> 2) * HALF + (i & 3) * 16] * (scale / 127.0f);
            const float* cp = CS + col0; cs[0][0] = *(const f32x4*)cp; cs[0][1] = *(const f32x4*)(cp + 4); cs[1][0] = *(const f32x4*)(cp + HALF); cs[1][1] = *(const f32x4*)(cp + HALF + 4);
        }
#define EPI_LD(dst, i) do { const unsigned o_ = ((row0 + ((i) >> 2) * HALF + ((i) & 3) * 16) * (unsigned)ldc + col0) * 4u; \
            dst[0] = *(const f32x4*)(bp + o_); dst[1] = *(const f32x4*)(bp + (o_ + 16u)); dst[2] = *(const f32x4*)(bp + (o_ + 512u)); dst[3] = *(const f32x4*)(bp + (o_ + 528u)); } while (0)
        EPI_LD(cb, 0);
#pragma unroll
        for (int i = 0; i < 8; ++i) { const int ai = i >> 2, m = i & 3; const unsigned row = row0 + ai * HALF + m * 16, off = row * (unsigned)ldc + col0; float ss = 0.f;
            if (i + 1 < 8) EPI_LD(nb, i + 1);
#pragma unroll
            for (int bj = 0; bj < 2; ++bj) { const unsigned o = off + bj * HALF;
                f32x4 v0, v1;
                if constexpr (I8) { const float r = rs[i];
#pragma unroll
                    for (int j = 0; j < 4; ++j) { const float a0 = acc[ai][bj][m][0][j], a1 = acc[ai][bj][m][1][j];
                        v0[j] = cb[2 * bj][j] + (float)__float_as_int(a0) * (r * cs[bj][0][j]); v1[j] = cb[2 * bj + 1][j] + (float)__float_as_int(a1) * (r * cs[bj][1][j]); } }
                else { v0 = cb[2 * bj] + acc[ai][bj][m][0] * scale; v1 = cb[2 * bj + 1] + acc[ai][bj][m][1] * scale; }
                *(f32x4*)(op + o * 4u) = v0; *(f32x4*)(op + (o * 4u + 16u)) = v1;
                if constexpr (NORM) {
                    ss += (v0[0] * v0[0] + v0[1] * v0[1]) + (v0[2] * v0[2] + v0[3] * v0[3]) + (v1[0] * v1[0] + v1[1] * v1[1]) + (v1[2] * v1[2] + v1[3] * v1[3]);
                    u32x4 w; w.x = cvt_pk_bf16(v0[0], v0[1]); w.y = cvt_pk_bf16(v0[2], v0[3]); w.z = cvt_pk_bf16(v1[0], v1[1]); w.w = cvt_pk_bf16(v1[2], v1[3]);
                    *(u32x4*)(hp + o * 2u) = w;
                    if constexpr (FP8COPY) { typedef unsigned u32x2 __attribute__((ext_vector_type(2))); u32x2 w8; w8.x = pk4_e4m3(v0[0], v0[1], v0[2], v0[3]); w8.y = pk4_e4m3(v1[0], v1[1], v1[2], v1[3]); *(u32x2*)(h8 + o) = w8; } } }
            if constexpr (NORM) {
                ss = fq_sum(ss) * 16777216.0f;
                const unsigned hi = (unsigned)(ss * 2.3283064365386963e-10f), lo = (unsigned)(ss - (float)hi * 4294967296.0f);
                if (fq == 0) atomicAdd((unsigned long long*)(sp + row * 8u), ((unsigned long long)hi << 32) | lo); }
#pragma unroll
            for (int q = 0; q < 4; ++q) cb[q] = nb[q]; }
#undef EPI_LD
    }
};
typedef EpiResidT<false, false> EpiResid;
typedef EpiResidT<false, false, true> EpiResid8;
template <bool FP8COPY> using EpiResidN = EpiResidT<true, FP8COPY>;
template <bool I8, long oA, int ldA, int nA, long oB, int ldB, int nB, long oC, int ldC, int nC> struct EpiProjT {
    static constexpr bool PERM = true, AFTER_DRAIN = false;
    bf16_t* base; float* AB; const float* RS; const float* CS;
    __device__ __forceinline__ void operator()(const f32x4 (&acc)[2][2][4][2], const Unit& u, int wr, int wc, int fr, int fq) const {
        const int row0 = u.pm * BM + wr * 64 + fr;
        if (u.pn < nA + nB + nC) {
            const int sg = u.pn < nA ? 0 : (u.pn < nA + nB ? 1 : 2); bf16_t* O = base + (sg == 0 ? oA : (sg == 1 ? oB : oC)); const int ldc = sg == 0 ? ldA : (sg == 1 ? ldB : ldC);
            const int col0 = (sg == 0 ? u.pn : (sg == 1 ? u.pn - nA : u.pn - nA - nB)) * BM + wc * 32 + 8 * fq;
            float rs[8]; f32x4 cs[2][2];
            if constexpr (I8) {
#pragma unroll
                for (int i = 0; i < 8; ++i) rs[i] = RS[row0 + (i >> 2) * HALF + (i & 3) * 16] * (1.0f / 127.0f);
                const float* cp = CS + u.pn * BM + wc * 32 + 8 * fq; cs[0][0] = *(const f32x4*)cp; cs[0][1] = *(const f32x4*)(cp + 4); cs[1][0] = *(const f32x4*)(cp + HALF); cs[1][1] = *(const f32x4*)(cp + HALF + 4);
            }
#pragma unroll
            for (int ai = 0; ai < 2; ++ai)
#pragma unroll
                for (int m = 0; m < 4; ++m) { const size_t row = (size_t)(row0 + ai * HALF + m * 16); bf16_t* rowp = O + row * ldc + col0;
#pragma unroll
                    for (int bj = 0; bj < 2; ++bj) { f32x4 v0 = acc[ai][bj][m][0], v1 = acc[ai][bj][m][1];
                        if constexpr (I8) { const float r = rs[ai * 4 + m];
#pragma unroll
                            for (int j = 0; j < 4; ++j) { const float a0 = v0[j], a1 = v1[j]; v0[j] = (float)__float_as_int(a0) * (r * cs[bj][0][j]); v1[j] = (float)__float_as_int(a1) * (r * cs[bj][1][j]); } }
                        u32x4 w; w.x = cvt_pk_bf16(v0[0], v0[1]); w.y = cvt_pk_bf16(v0[2], v0[3]); w.z = cvt_pk_bf16(v1[0], v1[1]); w.w = cvt_pk_bf16(v1[2], v1[3]);
                        *(u32x4*)(rowp + bj * HALF) = w; } }
        } else if (wc < 2) {
#pragma unroll
            for (int ai = 0; ai < 2; ++ai)
#pragma unroll
                for (int m = 0; m < 4; ++m) { const size_t row = (size_t)(row0 + ai * HALF + m * 16); float* p = AB + row * 64 + wc * 32 + 8 * fq;
                    *(f32x4*)p = acc[ai][0][m][0]; *(f32x4*)(p + 4) = acc[ai][0][m][1]; }
        }
    }
};
template <bool FIRST> struct EpiGate {
    static constexpr bool PERM = true, AFTER_DRAIN = false;
    bf16_t* Y; int ldy; const bf16_t* gate; int ldg;
    __device__ __forceinline__ void operator()(const f32x4 (&acc)[2][2][4][2], const Unit& u, int wr, int wc, int fr, int fq) const {
        const unsigned row0 = u.pm * BM + wr * 64 + fr, col0 = u.pn * BM + wc * 32 + 8 * fq;
        const char* gp = (const char*)gate; char* yb = (char*)Y;
        u32x4 cg[2], ng[2], cy[2], ny[2];
#define EPI_LD(dg, dy, i) do { const unsigned r_ = row0 + ((i) >> 2) * HALF + ((i) & 3) * 16; const unsigned og_ = (r_ * (unsigned)ldg + col0) * 2u, oy_ = (r_ * (unsigned)ldy + col0) * 2u; \
            dg[0] = *(const u32x4*)(gp + og_); dg[1] = *(const u32x4*)(gp + (og_ + 256u)); if (!FIRST) { dy[0] = *(const u32x4*)(yb + oy_); dy[1] = *(const u32x4*)(yb + (oy_ + 256u)); } } while (0)
        EPI_LD(cg, cy, 0);
#pragma unroll
        for (int i = 0; i < 8; ++i) { const int ai = i >> 2, m = i & 3; const unsigned row = row0 + ai * HALF + m * 16;
            if (i + 1 < 8) EPI_LD(ng, ny, i + 1);
#pragma unroll
            for (int bj = 0; bj < 2; ++bj) { const u32x4 gw = cg[bj];
                f32x4 s0, s1; s0[0] = sigmoid_fast(bf_lo(gw.x)); s0[1] = sigmoid_fast(bf_hi(gw.x)); s0[2] = sigmoid_fast(bf_lo(gw.y)); s0[3] = sigmoid_fast(bf_hi(gw.y));
                s1[0] = sigmoid_fast(bf_lo(gw.z)); s1[1] = sigmoid_fast(bf_hi(gw.z)); s1[2] = sigmoid_fast(bf_lo(gw.w)); s1[3] = sigmoid_fast(bf_hi(gw.w));
                f32x4 v0 = acc[ai][bj][m][0] * s0, v1 = acc[ai][bj][m][1] * s1;
                if (!FIRST) { const u32x4 p = cy[bj]; v0[0] += bf_lo(p.x); v0[1] += bf_hi(p.x); v0[2] += bf_lo(p.y); v0[3] += bf_hi(p.y); v1[0] += bf_lo(p.z); v1[1] += bf_hi(p.z); v1[2] += bf_lo(p.w); v1[3] += bf_hi(p.w); }
                u32x4 w; w.x = cvt_pk_bf16(v0[0], v0[1]); w.y = cvt_pk_bf16(v0[2], v0[3]); w.z = cvt_pk_bf16(v1[0], v1[1]); w.w = cvt_pk_bf16(v1[2], v1[3]);
                *(u32x4*)(yb + ((row * (unsigned)ldy + col0) * 2u + bj * 256u)) = w; }
#pragma unroll
            for (int q = 0; q < 2; ++q) { cg[q] = ng[q]; if (!FIRST) cy[q] = ny[q]; } }
#undef EPI_LD
    }
};
template <class Epi, class Sched, bool ALIGN_EPI = false, bool SP2 = false, int FM = 0>
__device__ __forceinline__ void gemm_phase(PG8_LAS unsigned char* lds, const Gemm g, const Sched& S, const Epi& E) {
    int tid_o = threadIdx.x; asm volatile("" : "+v"(tid_o));
    const int tid = tid_o, wid = __builtin_amdgcn_readfirstlane(tid >> 6), lane = tid & 63, wr = wid >> 2, wc = wid & 3, fr = lane & 15, fq = lane >> 4;
    constexpr bool F8 = (FM == 1 || FM == 2); static_assert(FM != 2 || SP2, "mixed rows: SP2 only");
    constexpr int ES = (FM == 1 || FM == 3) ? 1 : 2;
    const int K = g.K, nt = K * ES / (BK * 2);
    const int f8_sw = 0x79797979, f8_sh = g.sA;
    unsigned voffA[2], voffB[2];
#pragma unroll
    for (int i = 0; i < 2; ++i) { int R, C; stage_rc(tid * 16 + i * 8192, R, C); const int Rb = Epi::PERM ? ((R & ~31) + perm32(R & 31)) : R;
        voffA[i] = (unsigned)(R * K) * ES + (unsigned)C * 2u; voffB[i] = (unsigned)(Rb * K) * ES + (unsigned)C * 2u; }
    const size_t kstep = (size_t)(BK * 2);
    const size_t hstep = (size_t)HALF * K * ES;
    const size_t tstep = 2 * hstep;
    const unsigned ldsw = (unsigned)wid * 1024u;
    const int aoff = lds_byte(wr * 64 + fr, fq * 8), boff = lds_byte(wc * 32 + fr, fq * 8);
#define PG8_SA(b, h) (((b) * 2 + (h)) * HTB)
#define PG8_SB(b, h) ((4 + (b) * 2 + (h)) * HTB)
#define PG8_STAGE(bufoff, gbase, voff) do { _Pragma("unroll") for (int _i = 0; _i < 2; ++_i) \
        __builtin_amdgcn_global_load_lds((const unsigned*)((const char*)(gbase) + (voff)[_i]), (PG8_LAS unsigned*)(lds + (bufoff) + ldsw + _i * 8192), 16, 0, 0); } while (0)
#define PG8_LDA(dst, b, h) do { _Pragma("unroll") for (int m = 0; m < 4; ++m) _Pragma("unroll") for (int k = 0; k < 2; ++k) dst[m][k] = *(const PG8_LAS bf16x8*)(lds + PG8_SA(b, h) + aoff + m * 2048 + k * 1024); } while (0)
#define PG8_LDB(dst, b, h) do { _Pragma("unroll") for (int n = 0; n < 2; ++n) _Pragma("unroll") for (int k = 0; k < 2; ++k) dst[n][k] = *(const PG8_LAS bf16x8*)(lds + PG8_SB(b, h) + boff + n * 2048 + k * 1024); } while (0)
#define PG8_MMA(ai, bj, At, Bt, F8X) do { __builtin_amdgcn_s_setprio(1); \
        if constexpr ((int)(F8X) == 1) { typedef int v4i_ __attribute__((ext_vector_type(4))); typedef int v8i_ __attribute__((ext_vector_type(8))); \
            const v8i_ b80 = __builtin_shufflevector(__builtin_bit_cast(v4i_, Bt[0][0]), __builtin_bit_cast(v4i_, Bt[0][1]), 0, 1, 2, 3, 4, 5, 6, 7); \
            const v8i_ b81 = __builtin_shufflevector(__builtin_bit_cast(v4i_, Bt[1][0]), __builtin_bit_cast(v4i_, Bt[1][1]), 0, 1, 2, 3, 4, 5, 6, 7); \
            const v8i_ a80 = __builtin_shufflevector(__builtin_bit_cast(v4i_, At[0][0]), __builtin_bit_cast(v4i_, At[0][1]), 0, 1, 2, 3, 4, 5, 6, 7); \
            const v8i_ a81 = __builtin_shufflevector(__builtin_bit_cast(v4i_, At[1][0]), __builtin_bit_cast(v4i_, At[1][1]), 0, 1, 2, 3, 4, 5, 6, 7); \
            const v8i_ a82 = __builtin_shufflevector(__builtin_bit_cast(v4i_, At[2][0]), __builtin_bit_cast(v4i_, At[2][1]), 0, 1, 2, 3, 4, 5, 6, 7); \
            const v8i_ a83 = __builtin_shufflevector(__builtin_bit_cast(v4i_, At[3][0]), __builtin_bit_cast(v4i_, At[3][1]), 0, 1, 2, 3, 4, 5, 6, 7); \
              \
            asm volatile("s_nop 1\n\t" \
                "v_mfma_scale_f32_16x16x128_f8f6f4 %0, %8, %10, %0, %14, %15 op_sel_hi:[0,0,0]\n\tv_mfma_scale_f32_16x16x128_f8f6f4 %1, %9, %10, %1, %14, %15 op_sel_hi:[0,0,0]\n\t" \
                "v_mfma_scale_f32_16x16x128_f8f6f4 %2, %8, %11, %2, %14, %15 op_sel_hi:[0,0,0]\n\tv_mfma_scale_f32_16x16x128_f8f6f4 %3, %9, %11, %3, %14, %15 op_sel_hi:[0,0,0]\n\t" \
                "v_mfma_scale_f32_16x16x128_f8f6f4 %4, %8, %12, %4, %14, %15 op_sel_hi:[0,0,0]\n\tv_mfma_scale_f32_16x16x128_f8f6f4 %5, %9, %12, %5, %14, %15 op_sel_hi:[0,0,0]\n\t" \
                "v_mfma_scale_f32_16x16x128_f8f6f4 %6, %8, %13, %6, %14, %15 op_sel_hi:[0,0,0]\n\tv_mfma_scale_f32_16x16x128_f8f6f4 %7, %9, %13, %7, %14, %15 op_sel_hi:[0,0,0]" \
                : "+v"(acc[ai][bj][0][0]), "+v"(acc[ai][bj][0][1]), "+v"(acc[ai][bj][1][0]), "+v"(acc[ai][bj][1][1]), "+v"(acc[ai][bj][2][0]), "+v"(acc[ai][bj][2][1]), "+v"(acc[ai][bj][3][0]), "+v"(acc[ai][bj][3][1]) \
                : "v"(b80), "v"(b81), "v"(a80), "v"(a81), "v"(a82), "v"(a83), "v"(f8_sw), "v"(f8_sh)); } \
        else if constexpr ((int)(F8X) == 3) { typedef int v4i_ __attribute__((ext_vector_type(4))); \
            _Pragma("unroll") for (int m = 0; m < 4; ++m) _Pragma("unroll") for (int n = 0; n < 2; ++n) _Pragma("unroll") for (int k = 0; k < 2; ++k) \
            acc[ai][bj][m][n] = __builtin_bit_cast(f32x4, __builtin_amdgcn_mfma_i32_16x16x64_i8(__builtin_bit_cast(v4i_, Bt[n][k]), __builtin_bit_cast(v4i_, At[m][k]), __builtin_bit_cast(v4i_, acc[ai][bj][m][n]), 0, 0, 0)); } \
        else { _Pragma("unroll") for (int m = 0; m < 4; ++m) _Pragma("unroll") for (int n = 0; n < 2; ++n) _Pragma("unroll") for (int k = 0; k < 2; ++k) \
            acc[ai][bj][m][n] = __builtin_amdgcn_mfma_f32_16x16x32_bf16(Bt[n][k], At[m][k], acc[ai][bj][m][n], 0, 0, 0); } \
        __builtin_amdgcn_s_setprio(0); } while (0)
#define PG8_WAIT_V(n) asm volatile("s_waitcnt vmcnt(" #n ")" ::: "memory")
#define PG8_WAIT_L(n) asm volatile("s_waitcnt lgkmcnt(" #n ")" ::: "memory")
#define PG8_BAR __builtin_amdgcn_s_barrier()
#define PG8_SCHED __builtin_amdgcn_sched_barrier(0)
#define PG8_KT2(F8X) do { \
            PG8_LDB(B0, 0, 0); PG8_LDB(B1, 0, 1); PG8_SCHED; PG8_LDA(At, 0, 0); PG8_STAGE(PG8_SA(1, 1), a1 + hstep, voffA); \
            PG8_WAIT_V(8); PG8_WAIT_L(0); PG8_BAR; PG8_MMA(0, 0, At, B0, F8X); PG8_MMA(0, 1, At, B1, F8X); PG8_BAR; PG8_SCHED; \
            PG8_LDA(At, 0, 1); PG8_STAGE(PG8_SB(0, 0), b2, voffB); PG8_STAGE(PG8_SB(0, 1), b2 + hstep, voffB); PG8_STAGE(PG8_SA(0, 0), a2, voffA); \
            PG8_WAIT_V(8); PG8_WAIT_L(0); PG8_BAR; PG8_MMA(1, 0, At, B0, F8X); PG8_MMA(1, 1, At, B1, F8X); PG8_BAR; PG8_SCHED; \
            PG8_LDB(B0, 1, 0); PG8_LDB(B1, 1, 1); PG8_SCHED; PG8_LDA(At, 1, 0); PG8_STAGE(PG8_SA(0, 1), a2 + hstep, voffA); \
            PG8_WAIT_V(8); PG8_WAIT_L(0); PG8_BAR; PG8_MMA(0, 0, At, B0, F8X); PG8_MMA(0, 1, At, B1, F8X); PG8_BAR; PG8_SCHED; \
            PG8_LDA(At, 1, 1); PG8_STAGE(PG8_SB(1, 0), b3, voffB); PG8_STAGE(PG8_SB(1, 1), b3 + hstep, voffB); PG8_STAGE(PG8_SA(1, 0), a3, voffA); \
            PG8_WAIT_V(8); PG8_WAIT_L(0); PG8_BAR; PG8_MMA(1, 0, At, B0, F8X); PG8_MMA(1, 1, At, B1, F8X); PG8_BAR; PG8_SCHED; } while (0)
    Unit cur, nxt; int ui = 0;
    if (!S.next(0, cur)) return;
    f32x4 acc[2][2][4][2];
#pragma unroll
    for (int a = 0; a < 2; ++a)
#pragma unroll
        for (int b = 0; b < 2; ++b)
#pragma unroll
            for (int m = 0; m < 4; ++m)
#pragma unroll
                for (int n = 0; n < 2; ++n) acc[a][b][m][n] = (f32x4){0.f, 0.f, 0.f, 0.f};
    bf16x8 At[4][2], B0[2][2], B1[2][2];
    const char* cA = (const char*)g.A + (size_t)cur.pm * tstep; const char* cB = (const char*)g.Bt + (size_t)cur.pn * tstep;
    S.a_ready(cur);
    if constexpr (SP2) {
        PG8_STAGE(PG8_SB(0, 0), cB, voffB); PG8_STAGE(PG8_SB(0, 1), cB + hstep, voffB); PG8_STAGE(PG8_SA(0, 0), cA, voffA); PG8_STAGE(PG8_SA(0, 1), cA + hstep, voffA);
        if (wr == 1) PG8_BAR;
        PG8_WAIT_V(2); PG8_BAR;
        PG8_STAGE(PG8_SB(1, 0), cB + kstep, voffB); PG8_STAGE(PG8_SA(1, 0), cA + kstep, voffA); PG8_STAGE(PG8_SB(1, 1), cB + hstep + kstep, voffB);
        PG8_WAIT_V(6); PG8_BAR;
    } else {
        PG8_STAGE(PG8_SB(0, 0), cB, voffB); PG8_STAGE(PG8_SA(0, 0), cA, voffA); PG8_STAGE(PG8_SB(0, 1), cB + hstep, voffB); PG8_STAGE(PG8_SA(0, 1), cA + hstep, voffA);
        if (wr == 1) PG8_BAR;
        PG8_WAIT_V(4); PG8_BAR;
        PG8_STAGE(PG8_SB(1, 0), cB + kstep, voffB); PG8_STAGE(PG8_SA(1, 0), cA + kstep, voffA); PG8_STAGE(PG8_SB(1, 1), cB + hstep + kstep, voffB);
        PG8_WAIT_V(6); PG8_BAR;
    }
    for (;;) {
        const bool has_next = S.next(ui + 1, nxt);
        const char* nA = has_next ? (const char*)g.A + (size_t)nxt.pm * tstep : cA; const char* nB = has_next ? (const char*)g.Bt + (size_t)nxt.pn * tstep : cB;
        int t = 0;
        if constexpr (FM == 2) {
            for (; t < g.nb16; t += 2) {
                const char* a1 = cA + (size_t)(t + 1) * kstep; const char* a2 = cA + (size_t)(t + 2) * kstep; const char* b2 = cB + (size_t)(t + 2) * kstep;
                const char* a3 = a2 + kstep; const char* b3 = b2 + kstep;
                PG8_KT2(false);
            }
        }
        for (; t < nt; t += 2) {
            const bool last = (t == nt - 2);
            const char* a1 = cA + (size_t)(t + 1) * kstep;
            const char* a2 = last ? nA : cA + (size_t)(t + 2) * kstep; const char* b2 = last ? nB : cB + (size_t)(t + 2) * kstep;
            const char* a3 = a2 + kstep; const char* b3 = b2 + kstep;
            if (last && has_next) S.a_ready(nxt);
            if constexpr (SP2) {
                PG8_KT2(FM == 2 ? 1 : FM);
            } else {
            PG8_LDB(B0, 0, 0); PG8_SCHED; PG8_LDA(At, 0, 0); PG8_STAGE(PG8_SA(1, 1), a1 + hstep, voffA);
            PG8_WAIT_L(8); PG8_BAR; PG8_WAIT_L(0); PG8_MMA(0, 0, At, B0, FM); PG8_BAR; PG8_SCHED;
            PG8_LDB(B1, 0, 1); PG8_STAGE(PG8_SB(0, 0), b2, voffB);
            PG8_BAR; PG8_WAIT_L(0); PG8_MMA(0, 1, At, B1, FM); PG8_BAR;
            PG8_LDA(At, 0, 1); PG8_STAGE(PG8_SA(0, 0), a2, voffA);
            PG8_BAR; PG8_WAIT_L(0); PG8_MMA(1, 0, At, B0, FM); PG8_BAR; PG8_SCHED;
            PG8_STAGE(PG8_SB(0, 1), b2 + hstep, voffB);
            PG8_WAIT_V(6); PG8_BAR; PG8_MMA(1, 1, At, B1, FM); PG8_BAR;
            PG8_LDB(B0, 1, 0); PG8_SCHED; PG8_LDA(At, 1, 0); PG8_STAGE(PG8_SA(0, 1), a2 + hstep, voffA);
            PG8_WAIT_L(8); PG8_BAR; PG8_WAIT_L(0); PG8_MMA(0, 0, At, B0, FM); PG8_BAR; PG8_SCHED;
            PG8_LDB(B1, 1, 1); PG8_STAGE(PG8_SB(1, 0), b3, voffB);
            PG8_BAR; PG8_WAIT_L(0); PG8_MMA(0, 1, At, B1, FM); PG8_BAR;
            PG8_LDA(At, 1, 1); PG8_STAGE(PG8_SA(1, 0), a3, voffA);
            PG8_BAR; PG8_WAIT_L(0); PG8_MMA(1, 0, At, B0, FM); PG8_BAR; PG8_SCHED;
            PG8_STAGE(PG8_SB(1, 1), b3 + hstep, voffB);
            PG8_WAIT_V(6); PG8_BAR; PG8_MMA(1, 1, At, B1, FM); PG8_BAR;
            }
        }
        if constexpr (F8) asm volatile("s_nop 15\n\ts_nop 15" ::: "memory");
        if constexpr (ALIGN_EPI) { if (wr == 0) PG8_BAR; }
        if constexpr (!Epi::AFTER_DRAIN) { E(acc, cur, wr, wc, fr, fq); S.done(cur); }
        if (!has_next) break;
#pragma unroll
        for (int a = 0; a < 2; ++a)
#pragma unroll
            for (int b = 0; b < 2; ++b)
#pragma unroll
                for (int m = 0; m < 4; ++m)
#pragma unroll
                    for (int n = 0; n < 2; ++n) acc[a][b][m][n] = (f32x4){0.f, 0.f, 0.f, 0.f};
        cur = nxt; cA = nA; cB = nB; ++ui;
        if constexpr (ALIGN_EPI) { if (wr == 1) PG8_BAR; }
    }
    PG8_WAIT_V(0);
    if constexpr (!ALIGN_EPI) { if (wr == 0) PG8_BAR; }
    PG8_BAR;
    if constexpr (Epi::AFTER_DRAIN) { E.fused(acc, cur, wr, wc, fr, fq, lds, wid, lane); S.done(cur); }
#undef PG8_SA
#undef PG8_SB
#undef PG8_STAGE
#undef PG8_LDA
#undef PG8_LDB
#undef PG8_MMA
#undef PG8_KT2
#undef PG8_WAIT_V
#undef PG8_WAIT_L
#undef PG8_BAR
#undef PG8_SCHED
}
}
#ifndef MK_SINGLE
#define MK_SINGLE 1
#endif
constexpr int NWAVES = 8;
constexpr int BATCH = 4, SEQ = 4096, DM = 4096, FF = 11008, M = BATCH * SEQ;
constexpr int NPROJ = 16640, NGATE = 10240, PA_LD = 14336, PB_LD = 12288;
constexpr int PA_GQ = 0, PA_GK = 2048, PA_GV = 4096, PA_MQ = 8192, PA_MK = 10240, PA_MV = 12288, PB_GZ = 0, PB_GG = 4096, PB_MG = 8192;
constexpr float NORM_EPS = 1e-6f;
constexpr int KB16 = 11008, KF8 = FF - KB16, ACT2_PITCH = 2 * KB16 + KF8;
static_assert(KB16 % 128 == 0 && KF8 % 256 == 0, "mixed K split");
constexpr int N_PHASES = 14;

constexpr size_t MiB = 1u << 20;
constexpr size_t WS_CTL = 0, CTL_ZERO_BYTES = 64 * 1024;
constexpr size_t WS_KMEAN = 1 * MiB, WS_ROPE = 2 * MiB, WS_AB = 4 * MiB, WS_G = 8 * MiB, WS_BETA = 10 * MiB;
constexpr size_t WS_WGU = 16 * MiB, WS_WD = 188 * MiB;
constexpr size_t WS_H = 274 * MiB;
constexpr size_t WS_WB = 402 * MiB;
constexpr size_t WS_BIG = 612 * MiB, WS_PB = 1060 * MiB;
constexpr size_t WS_OG = 1444 * MiB, WS_OM = 1572 * MiB, WS_WBG = 1636 * MiB, WS_WBM = 1668 * MiB, WS_WO = 1684 * MiB, WS_H8 = 1716 * MiB, WS_END = 1780 * MiB;
constexpr size_t WS_W8 = 548 * MiB;
constexpr size_t WS_QN = 16 * MiB, WS_KN = 80 * MiB, WS_VP = 144 * MiB, WS_KNT = 274 * MiB;
constexpr size_t WS_U = 612 * MiB, WS_W = 740 * MiB, WS_AT = 868 * MiB, WS_GC = 932 * MiB;
constexpr size_t WS_MQ = 402 * MiB, WS_MK = 466 * MiB, WS_MV = 530 * MiB;
constexpr size_t WS_Y1 = 16 * MiB;
static_assert(WS_WGU + (size_t)22016 * 4096 * 2 <= WS_WD && WS_WD + (size_t)4096 * 11008 * 2 <= WS_H && WS_H + (size_t)M * DM * 2 <= WS_WB, "ws map 1");
static_assert(WS_WB + (size_t)NPROJ * DM * 2 <= WS_BIG && WS_BIG + (size_t)M * PA_LD * 2 <= WS_PB && WS_PB + (size_t)M * PB_LD * 2 <= WS_OG && WS_MV + (size_t)M * 2048 * 2 <= WS_BIG && WS_Y1 + (size_t)M * DM * 4 <= WS_H && WS_GC + (size_t)8192 * 64 * 4 <= WS_PB, "ws map 2");
constexpr int CW_BAR = 4096, CW_Q = 64;

constexpr int RING_BYTES = 131072, TR_STRIDE = 16640, PREP_STRIDE = 17408, MISC_OFF = 159744, LDS_BYTES = 163840;
static_assert(8 * TR_STRIDE <= MISC_OFF, "LDS map");

#define GAS __attribute__((address_space(1)))
#define LAS __attribute__((address_space(3)))
typedef unsigned short bf16;
typedef unsigned v4u __attribute__((ext_vector_type(4)));
typedef unsigned v2u __attribute__((ext_vector_type(2)));
typedef float f32x4 __attribute__((ext_vector_type(4)));
typedef float f32x2 __attribute__((ext_vector_type(2)));
#define LDS_WAIT() asm volatile("s_waitcnt lgkmcnt(0)" ::: "memory")
#define VM_WAIT() asm volatile("s_waitcnt vmcnt(0)" ::: "memory")
__device__ __forceinline__ unsigned f2bf(float f) { unsigned u = __builtin_bit_cast(unsigned, f); return (u + 0x7fffu + ((u >> 16) & 1u)) >> 16; }
typedef __bf16 bf16x2_t __attribute__((ext_vector_type(2)));
__device__ __forceinline__ unsigned cvtpk(float lo, float hi) { f32x2 v = {lo, hi}; bf16x2_t b = __builtin_convertvector(v, bf16x2_t); return __builtin_bit_cast(unsigned, b); }
__device__ __forceinline__ unsigned pk2(float lo, float hi) { return cvtpk(lo, hi); }
__device__ __forceinline__ float bf2f(unsigned short b) { return __uint_as_float(((unsigned)b) << 16); }
__device__ __forceinline__ float blo(unsigned w) { return __uint_as_float(w << 16); }
__device__ __forceinline__ float bhi(unsigned w) { return __uint_as_float(w & 0xffff0000u); }
template <int CTRL, int RM> __device__ __forceinline__ float dpp_f(float v) { return __int_as_float(__builtin_amdgcn_update_dpp(0, __float_as_int(v), CTRL, RM, 0xf, true)); }
__device__ __forceinline__ float row_sum16(float v) { v += dpp_f<0xB1, 0xf>(v); v += dpp_f<0x4E, 0xf>(v); v += dpp_f<0x141, 0xf>(v); v += dpp_f<0x140, 0xf>(v); return v; }
__device__ __forceinline__ float half_sum32(float v) { v = row_sum16(v); v += dpp_f<0x142, 0xa>(v); return v; }
__device__ __forceinline__ float rd_lane(float v, int l) { return __int_as_float(__builtin_amdgcn_readlane(__float_as_int(v), l)); }
__device__ __forceinline__ float wave_sum(float v) { v = half_sum32(v); return rd_lane(v, 31) + rd_lane(v, 63); }
__device__ __forceinline__ float wave_max(float v) {
#pragma unroll
    for (int o = 1; o < 64; o <<= 1) v = fmaxf(v, __shfl_xor(v, o));
    return v;
}
__device__ __forceinline__ float xhalf_max(float v) { auto rr = __builtin_amdgcn_permlane32_swap(__float_as_uint(v), __float_as_uint(v), false, false); return fmaxf(__uint_as_float(rr[0]), __uint_as_float(rr[1])); }
__device__ __forceinline__ float xhalf_sum(float v) { auto rr = __builtin_amdgcn_permlane32_swap(__float_as_uint(v), __float_as_uint(v), false, false); return __uint_as_float(rr[0]) + __uint_as_float(rr[1]); }
#define XB_TMO      128
#define XB_XCNT(j)  (256  + 64 * (j))
#define XB_XSUB(j)  (1280 + 64 * (j))
#define XB_XGEN(j)  (2304 + 64 * (j))
#define XB_TOP      3328
#define XB_TOPGEN   3392
#define XCD_BAR_WORDS 3456
#define XB_SPIN_CAP (1u << 18)

__device__ __forceinline__ unsigned xb_ld(unsigned* p)              { return __hip_atomic_load(p, __ATOMIC_RELAXED, __HIP_MEMORY_SCOPE_AGENT); }
__device__ __forceinline__ unsigned xb_add(unsigned* p, unsigned v) { return __hip_atomic_fetch_add(p, v, __ATOMIC_RELAXED, __HIP_MEMORY_SCOPE_AGENT); }
__device__ __forceinline__ unsigned xb_xcc_id() { return (unsigned)__builtin_amdgcn_s_getreg((3 << 11) | 20) & 0xFu; }
#define XB_SPIN(cond, bar) do { unsigned _sp = 0; while (cond) { __builtin_amdgcn_s_sleep(1); \
    if ((++_sp & 255u) == 0u) { if (xb_ld(&(bar)[XB_TMO])) break; if (_sp > XB_SPIN_CAP) { atomicAdd(&(bar)[XB_TMO], 1u); break; } } } } while (0)

struct XcdBarrier {
    unsigned* bar; unsigned x;
    volatile LAS unsigned* st;
};

__device__ __forceinline__ XcdBarrier xcd_barrier_post(unsigned* bar, volatile LAS unsigned* st) {
    XcdBarrier b; b.bar = bar; b.x = xb_xcc_id(); b.st = st;
    if (threadIdx.x == 0) (void)xb_add(&bar[XB_XCNT(b.x)], 1u);
    return b;
}
__device__ __forceinline__ void xcd_barrier_complete(unsigned* bar, unsigned x, unsigned& nloc, unsigned& nx) {
    const unsigned G = gridDim.x * gridDim.y * gridDim.z;
    unsigned sum, cnt, mine, sp = 0u;
    for (;;) {
        sum = 0u; cnt = 0u; mine = 0u;
#pragma unroll
        for (unsigned j = 0; j < 16; ++j) { const unsigned c = xb_ld(&bar[XB_XCNT(j)]); sum += c; cnt += (c > 0u) ? 1u : 0u; mine = (j == x) ? c : mine; }
        if (sum == G) break;
        __builtin_amdgcn_s_sleep(1);
        if ((++sp & 255u) == 0u) { if (xb_ld(&bar[XB_TMO])) break; if (sp > XB_SPIN_CAP) { atomicAdd(&bar[XB_TMO], 1u); break; } }
    }
    nloc = mine > 0u ? mine : 1u; nx = cnt > 0u ? cnt : 1u;
}

__device__ __forceinline__ void xcd_barrier(const XcdBarrier& b) {
    asm volatile("s_waitcnt vmcnt(0)" ::: "memory");
    __syncthreads();
    if (threadIdx.x == 0) {
        unsigned* bar = b.bar;
        __builtin_amdgcn_s_waitcnt(0);
        unsigned nloc = b.st[0], nx = b.st[1];
        if (nloc == 0u) { xcd_barrier_complete(bar, b.x, nloc, nx); b.st[0] = nloc; b.st[1] = nx; }
        const unsigned old = xb_add(&bar[XB_XSUB(b.x)], 1u);
        const unsigned gen = old / nloc;
        if (old + 1u == (gen + 1u) * nloc) {
            __builtin_amdgcn_fence(__ATOMIC_RELEASE, "agent");
            asm volatile("s_waitcnt vmcnt(0)" ::: "memory");
            const unsigned og = xb_add(&bar[XB_TOP], 1u);
            const unsigned tg = og / nx;
            if (og + 1u == (tg + 1u) * nx) xb_add(&bar[XB_TOPGEN], 1u);
            else XB_SPIN(xb_ld(&bar[XB_TOPGEN]) == tg, bar);
            __builtin_amdgcn_fence(__ATOMIC_ACQUIRE, "agent");
            xb_add(&bar[XB_XGEN(b.x)], 1u);
            asm volatile("s_waitcnt vmcnt(0)" ::: "memory");
        } else {
            XB_SPIN(xb_ld(&bar[XB_XGEN(b.x)]) == gen, bar);
            __builtin_amdgcn_fence(__ATOMIC_ACQUIRE, "agent");
            asm volatile("s_waitcnt vmcnt(0)" ::: "memory");
        }
    }
    __syncthreads();
}
struct Frame {
    LAS unsigned char* lds;
    volatile LAS unsigned* MISC;
    unsigned* ctl;
    int tid, lane, wave, vcu, G; unsigned char* wsb;
    const float* in[20]; float* out;
    __device__ __forceinline__ bf16* WGU() const { return (bf16*)(wsb + WS_WGU); }
    __device__ __forceinline__ bf16* WD() const { return (bf16*)(wsb + WS_WD); }
    __device__ __forceinline__ bf16* H() const { return (bf16*)(wsb + WS_H); }
    __device__ __forceinline__ bf16* WB() const { return (bf16*)(wsb + WS_WB); }
    __device__ __forceinline__ bf16* PA() const { return (bf16*)(wsb + WS_BIG); }
    __device__ __forceinline__ bf16* PB() const { return (bf16*)(wsb + WS_PB); }
    __device__ __forceinline__ bf16* ACT() const { return (bf16*)(wsb + WS_BIG); }
    __device__ __forceinline__ bf16* OG() const { return (bf16*)(wsb + WS_OG); }
    __device__ __forceinline__ bf16* OM() const { return (bf16*)(wsb + WS_OM); }
    __device__ __forceinline__ bf16* WBG() const { return (bf16*)(wsb + WS_WBG); }
    __device__ __forceinline__ bf16* WBM() const { return (bf16*)(wsb + WS_WBM); }
    __device__ __forceinline__ bf16* WO() const { return (bf16*)(wsb + WS_WO); }
    __device__ __forceinline__ bf16* QN() const { return (bf16*)(wsb + WS_QN); }
    __device__ __forceinline__ bf16* KN() const { return (bf16*)(wsb + WS_KN); }
    __device__ __forceinline__ bf16* VP() const { return (bf16*)(wsb + WS_VP); }
    __device__ __forceinline__ bf16* KNT() const { return (bf16*)(wsb + WS_KNT); }
    __device__ __forceinline__ bf16* MQ() const { return (bf16*)(wsb + WS_MQ); }
    __device__ __forceinline__ bf16* MK() const { return (bf16*)(wsb + WS_MK); }
    __device__ __forceinline__ bf16* MV() const { return (bf16*)(wsb + WS_MV); }
    __device__ __forceinline__ bf16* U() const { return (bf16*)(wsb + WS_U); }
    __device__ __forceinline__ bf16* W() const { return (bf16*)(wsb + WS_W); }
    __device__ __forceinline__ bf16* AT() const { return (bf16*)(wsb + WS_AT); }
    __device__ __forceinline__ bf16* KMH() const { return (bf16*)(wsb + WS_KMEAN); }
    __device__ __forceinline__ bf16* KML() const { return (bf16*)(wsb + (WS_KMEAN + 262144)); }
    __device__ __forceinline__ float* AB() const { return (float*)(wsb + WS_AB); }
    __device__ __forceinline__ float* GG() const { return (float*)(wsb + WS_G); }
    __device__ __forceinline__ float* BETA() const { return (float*)(wsb + WS_BETA); }
    __device__ __forceinline__ float* Y1() const { return (float*)(wsb + WS_Y1); }
    __device__ __forceinline__ float* GC() const { return (float*)(wsb + WS_GC); }
    __device__ __forceinline__ f32x2* ROPE() const { return (f32x2*)(wsb + WS_ROPE); }
    __device__ __forceinline__ unsigned char* H8() const { return wsb + WS_H8; }
    __device__ __forceinline__ unsigned char* W8() const { return wsb + WS_W8; }
    __device__ __forceinline__ unsigned* CM(int f) const { return (unsigned*)(wsb + WS_CTL + (256 + 128 * f) * 1024); }
    __device__ __forceinline__ unsigned* CMW() const { return (unsigned*)(wsb + WS_CTL + 640 * 1024); }
    __device__ __forceinline__ unsigned* RM(int f) const { return (unsigned*)(wsb + WS_CTL + (768 + 64 * f) * 1024); }
    __device__ __forceinline__ unsigned* CMD(int f) const { return (unsigned*)(wsb + WS_CTL + (896 + 16 * f) * 1024); }
    __device__ __forceinline__ unsigned char* ACT8() const { return wsb + WS_PB; }
    __device__ __forceinline__ float* RS() const { return (float*)(wsb + WS_CTL + 512 * 1024); }
};

template <int MODE> __device__ __forceinline__ int rowmap(int n0) {
    if (MODE == 0) return n0;
    if (MODE == 1) return 256 * (n0 >> 7) + (n0 & 127);
    if (MODE == 2) return 256 * (n0 >> 7) + 128 + (n0 & 127);
    if (MODE == 3) return n0 < 8192 ? n0 : (n0 < 12288 ? n0 + 4096 : (n0 < 12352 ? 16384 + (n0 - 12288) : n0 - 4160));
    return n0 - 16448;
}
__device__ __forceinline__ bool win_i8(int n0) { return n0 >= 16448; }
__device__ __forceinline__ const float* tr_src(const float* W, int N, int item, int lane, int nblk_ = 0) { const int nblk = nblk_ ? nblk_ : (N >> 6), kb = item / nblk, nb = item - kb * nblk; return W + (size_t)(kb << 6) * N + (nb << 6) + lane; }
__device__ __forceinline__ void tr_load(const float* src, int N, float (&v)[64]) {
#pragma unroll
    for (int j = 0; j < 64; ++j) v[j] = __builtin_nontemporal_load(src + (size_t)j * N);
}
__device__ __forceinline__ void tr_put(LAS float* scr, const float (&v)[64], int lane) {
#pragma unroll
    for (int j = 0; j < 64; ++j) scr[j * 65 + lane] = v[j];
    LDS_WAIT();
}
template <int MODE> __device__ __forceinline__ void tr_out(int K, int N, bf16* WT, LAS float* scr, int item, int lane, int nblk_ = 0) {
    const int nblk = nblk_ ? nblk_ : (N >> 6), kb = item / nblk, nb = item - kb * nblk, k0 = kb << 6, n0 = nb << 6;
    const int c = lane & 7, r = lane >> 3, drow = rowmap<MODE>(n0);
#pragma unroll
    for (int j = 0; j < 8; ++j) { const int n = r + 8 * j; const LAS float* s = scr + (8 * c) * 65 + n;
        v4u o; o.x = pk2(s[0], s[65]); o.y = pk2(s[130], s[195]); o.z = pk2(s[260], s[325]); o.w = pk2(s[390], s[455]);
        *(v4u*)(WT + (size_t)(drow + n) * K + k0 + 8 * c) = o; }
    LDS_WAIT();
}
__device__ __forceinline__ unsigned pk4_fp8(float a, float b, float c, float d) { int w = 0; w = __builtin_amdgcn_cvt_pk_fp8_f32(a, b, w, false); w = __builtin_amdgcn_cvt_pk_fp8_f32(c, d, w, true); return (unsigned)w; }
__device__ __forceinline__ void tr_out8(int K, int N, unsigned char* WT, int drow, LAS float* scr, int item, int lane) {
    const int nblk = N >> 6, kb = item / nblk, nb = item - kb * nblk, k0 = kb << 6, n0 = nb << 6;
    const int c = lane & 7, r = lane >> 3;
#pragma unroll
    for (int j = 0; j < 8; ++j) { const int n = r + 8 * j; const LAS float* sp = scr + (8 * c) * 65 + n;
        v2u o; o.x = pk4_fp8(sp[0] * 64.f, sp[65] * 64.f, sp[130] * 64.f, sp[195] * 64.f); o.y = pk4_fp8(sp[260] * 64.f, sp[325] * 64.f, sp[390] * 64.f, sp[455] * 64.f);
        *(v2u*)(WT + (size_t)(drow + n0 + n) * K + k0 + 8 * c) = o; }
    LDS_WAIT();
}
__device__ __forceinline__ unsigned pk4_i8(float a, float b, float c, float d) {
    const int ia = (int)__builtin_rintf(a), ib = (int)__builtin_rintf(b), ic = (int)__builtin_rintf(c), id = (int)__builtin_rintf(d);
    return (unsigned)(ia & 0xff) | ((unsigned)(ib & 0xff) << 8) | ((unsigned)(ic & 0xff) << 16) | ((unsigned)id << 24); }
template <int MODE> __device__ __forceinline__ void tr_q_i8(int N, const unsigned* CM, int item, int lane, float (&q)[8]) {
    const int nblk = N >> 6, kb = item / nblk, nb = item - kb * nblk, n0 = nb << 6, r = lane >> 3, drow = rowmap<MODE>(n0);
#pragma unroll
    for (int j = 0; j < 8; ++j) q[j] = 127.0f / fmaxf(__uint_as_float(CM[drow + r + 8 * j]), 1e-30f);
}
template <int MODE> __device__ __forceinline__ void tr_out_i8(int K, int N, unsigned char* WT, const float (&q)[8], LAS float* scr, int item, int lane) {
    const int nblk = N >> 6, kb = item / nblk, nb = item - kb * nblk, k0 = kb << 6, n0 = nb << 6;
    const int c = lane & 7, r = lane >> 3, drow = rowmap<MODE>(n0);
#pragma unroll
    for (int j = 0; j < 8; ++j) { const int n = r + 8 * j; const LAS float* sp = scr + (8 * c) * 65 + n; const float qq = q[j];
        v2u o; o.x = pk4_i8(sp[0] * qq, sp[65] * qq, sp[130] * qq, sp[195] * qq); o.y = pk4_i8(sp[260] * qq, sp[325] * qq, sp[390] * qq, sp[455] * qq);
        *(v2u*)(WT + (size_t)(drow + n) * K + k0 + 8 * c) = o; }
    LDS_WAIT();
}
__device__ __forceinline__ void colmax_ffn(Frame& F, const float* wg, const float* wu, unsigned* CM) {
    const int gw = F.vcu * NWAVES + F.wave, NGW = F.G * NWAVES, lane = F.lane;
    constexpr int I1 = (DM / 64) * (FF / 64);
    for (int it = gw; it < 2 * I1; it += NGW) {
        const bool up = it >= I1; const int item = up ? it - I1 : it; const int nb = item % (FF / 64), n0 = nb << 6;
        const float* s = tr_src(up ? wu : wg, FF, item, lane);
        float v[64]; tr_load(s, FF, v);
        float mx = 0.f;
#pragma unroll
        for (int j = 0; j < 64; ++j) mx = fmaxf(mx, fabsf(v[j]));
        atomicMax(CM + (up ? rowmap<2>(n0) : rowmap<1>(n0)) + lane, __float_as_uint(mx));
    }
}
__device__ __forceinline__ void strip_quant_i8(Frame& F, const float* W, int N, int c0, int drow0, unsigned char* WT, float* CS) {
    LAS float* xch = (LAS float*)(F.lds + 150528);
    int lane_a = threadIdx.x & 63; asm volatile("" : "+v"(lane_a));
    const int r0 = F.wave * 512;
    const char* bu = (const char*)W + ((size_t)r0 * N + c0) * 4;
    const unsigned voff = (unsigned)(32 * (lane_a >> 5) * N + (lane_a & 31)) * 4u;
    unsigned v[128]; float mx = 0.f; float ta[32], tb[32];
#define SQ_LOAD(t, i) do { _Pragma("unroll") for (int j = 0; j < 32; ++j) t[j] = __builtin_nontemporal_load((const float*)(bu + (size_t)(64 * (i) + j) * N * 4 + voff)); } while (0)
#define SQ_PACK(t, i) do { _Pragma("unroll") for (int j = 0; j < 16; ++j) { unsigned w = pk2(t[2 * j], t[2 * j + 1]); mx = fmaxf(mx, fmaxf(fabsf(blo(w)), fabsf(bhi(w)))); asm volatile("" : "+v"(w)); v[16 * (i) + j] = w; }   \
        __builtin_amdgcn_sched_barrier(0); } while (0)
    SQ_LOAD(ta, 0);
#pragma unroll
    for (int i = 0; i < 8; i += 2) {
        SQ_LOAD(tb, i + 1); SQ_PACK(ta, i);
        if (i + 2 < 8) SQ_LOAD(ta, i + 2);
        SQ_PACK(tb, i + 1); }
#undef SQ_LOAD
#undef SQ_PACK
    int lane = threadIdx.x & 63; asm volatile("" : "+v"(lane));
    const int col = lane & 31, half = lane >> 5;
    mx = xhalf_max(mx);
    if (lane < 32) xch[F.wave * 32 + lane] = mx;
    __syncthreads();
    float cm = 0.f;
#pragma unroll
    for (int w = 0; w < 8; ++w) cm = fmaxf(cm, xch[w * 32 + col]);
    __syncthreads();
    if (F.wave == 0 && lane < 32) CS[drow0 + col] = cm;
    const float q = 127.0f / fmaxf(cm, 1e-30f);
    unsigned char* dst = WT + (size_t)(drow0 + col) * DM + r0 + 32 * half;
#pragma unroll
    for (int i = 0; i < 8; ++i) { v4u o0, o1;
        o0.x = pk4_i8(blo(v[16 * i + 0]) * q, bhi(v[16 * i + 0]) * q, blo(v[16 * i + 1]) * q, bhi(v[16 * i + 1]) * q); o0.y = pk4_i8(blo(v[16 * i + 2]) * q, bhi(v[16 * i + 2]) * q, blo(v[16 * i + 3]) * q, bhi(v[16 * i + 3]) * q);
        o0.z = pk4_i8(blo(v[16 * i + 4]) * q, bhi(v[16 * i + 4]) * q, blo(v[16 * i + 5]) * q, bhi(v[16 * i + 5]) * q); o0.w = pk4_i8(blo(v[16 * i + 6]) * q, bhi(v[16 * i + 6]) * q, blo(v[16 * i + 7]) * q, bhi(v[16 * i + 7]) * q);
        o1.x = pk4_i8(blo(v[16 * i + 8]) * q, bhi(v[16 * i + 8]) * q, blo(v[16 * i + 9]) * q, bhi(v[16 * i + 9]) * q); o1.y = pk4_i8(blo(v[16 * i + 10]) * q, bhi(v[16 * i + 10]) * q, blo(v[16 * i + 11]) * q, bhi(v[16 * i + 11]) * q);
        o1.z = pk4_i8(blo(v[16 * i + 12]) * q, bhi(v[16 * i + 12]) * q, blo(v[16 * i + 13]) * q, bhi(v[16 * i + 13]) * q); o1.w = pk4_i8(blo(v[16 * i + 14]) * q, bhi(v[16 * i + 14]) * q, blo(v[16 * i + 15]) * q, bhi(v[16 * i + 15]) * q);
        *(v4u*)(dst + 64 * i) = o0; *(v4u*)(dst + 64 * i + 16) = o1; }
}
__device__ __forceinline__ void strip_quant_wd(Frame& F, const float* W, int c0, unsigned char* WT, float* CS) {
    LAS float* xch = (LAS float*)(F.lds + 150528);
    int lane_a = threadIdx.x & 63; asm volatile("" : "+v"(lane_a));
    const int wave = F.wave, g0 = wave < 4 ? wave * 22 : 88 + (wave - 4) * 21, ng = wave < 4 ? 22 : 21;
    const char* bu = (const char*)W + ((size_t)(g0 * 64) * DM + c0) * 4;
    const int qa = lane_a >> 4; const unsigned voff = (unsigned)(16 * qa * DM + (lane_a & 15)) * 4u;
    unsigned v[176]; float mx = 0.f; float ta[16], tb[16];
#define WD_LOAD(t, i) do { _Pragma("unroll") for (int j = 0; j < 16; ++j) t[j] = *(const float*)(bu + (size_t)(64 * (i) + j) * DM * 4 + voff); } while (0)
#define WD_ROT(t, i) do { \
        _Pragma("unroll") for (int h = 1; h < 16; h <<= 1) _Pragma("unroll") for (int j = 0; j < 16; ++j) if (!(j & h)) { const float a = t[j], b = t[j + h]; t[j] = a + b; t[j + h] = a - b; } \
        _Pragma("unroll") for (int j = 0; j < 16; ++j) { auto a = __builtin_amdgcn_permlane16_swap(__float_as_uint(t[j]), __float_as_uint(t[j]), false, false); \
            const float lo = __uint_as_float(a[0]), hi = __uint_as_float(a[1]); t[j] = (qa & 1) ? lo - hi : lo + hi; } \
        _Pragma("unroll") for (int j = 0; j < 16; ++j) { auto b = __builtin_amdgcn_permlane32_swap(__float_as_uint(t[j]), __float_as_uint(t[j]), false, false); \
            const float lo = __uint_as_float(b[0]), hi = __uint_as_float(b[1]); t[j] = ((qa & 2) ? lo - hi : lo + hi) * 0.125f; } \
        _Pragma("unroll") for (int j = 0; j < 8; ++j) { unsigned w = pk2(t[2 * j], t[2 * j + 1]); mx = fmaxf(mx, fmaxf(fabsf(blo(w)), fabsf(bhi(w)))); asm volatile("" : "+v"(w)); v[8 * (i) + j] = w; } \
        __builtin_amdgcn_sched_barrier(0); } while (0)
    WD_LOAD(ta, 0);
#pragma unroll
    for (int i = 0; i < 16; i += 2) {
        WD_LOAD(tb, i + 1);
        WD_ROT(ta, i);
        if (i + 2 < 16) WD_LOAD(ta, i + 2);
        WD_ROT(tb, i + 1);
    }
#pragma unroll
    for (int i = 16; i < 22; ++i) {
        if (i < ng) { WD_LOAD(ta, i); WD_ROT(ta, i); } else {
#pragma unroll
            for (int j = 0; j < 8; ++j) v[8 * i + j] = 0u; }
    }
#undef WD_LOAD
#undef WD_ROT
    int lane = threadIdx.x & 63; asm volatile("" : "+v"(lane));
    const int col = lane & 15, q4 = lane >> 4;
    { auto a = __builtin_amdgcn_permlane16_swap(__float_as_uint(mx), __float_as_uint(mx), false, false); mx = fmaxf(__uint_as_float(a[0]), __uint_as_float(a[1]));
      auto b = __builtin_amdgcn_permlane32_swap(__float_as_uint(mx), __float_as_uint(mx), false, false); mx = fmaxf(__uint_as_float(b[0]), __uint_as_float(b[1])); }
    if (lane < 16) xch[wave * 16 + lane] = mx;
    __syncthreads();
    float cm = 0.f;
#pragma unroll
    for (int w = 0; w < 8; ++w) cm = fmaxf(cm, xch[w * 16 + col]);
    __syncthreads();
    if (wave == 0 && lane < 16) CS[c0 + col] = cm;
    const float qq = 127.0f / fmaxf(cm, 1e-30f);
    unsigned char* dst = WT + (size_t)(c0 + col) * FF + (size_t)g0 * 64 + 16 * q4;
#pragma unroll
    for (int i = 0; i < 22; ++i) if (i < ng) { v4u o;
        o.x = pk4_i8(blo(v[8 * i + 0]) * qq, bhi(v[8 * i + 0]) * qq, blo(v[8 * i + 1]) * qq, bhi(v[8 * i + 1]) * qq); o.y = pk4_i8(blo(v[8 * i + 2]) * qq, bhi(v[8 * i + 2]) * qq, blo(v[8 * i + 3]) * qq, bhi(v[8 * i + 3]) * qq);
        o.z = pk4_i8(blo(v[8 * i + 4]) * qq, bhi(v[8 * i + 4]) * qq, blo(v[8 * i + 5]) * qq, bhi(v[8 * i + 5]) * qq); o.w = pk4_i8(blo(v[8 * i + 6]) * qq, bhi(v[8 * i + 6]) * qq, blo(v[8 * i + 7]) * qq, bhi(v[8 * i + 7]) * qq);
        *(v4u*)(dst + 64 * i) = o; }
}
__device__ __forceinline__ void quant_wd(Frame& F, const float* wd, float* CS) { for (int s = F.vcu; s < DM / 16; s += F.G) strip_quant_wd(F, wd, 16 * s, (unsigned char*)F.WD(), CS); }
__device__ __forceinline__ void quant_ffn_gu(Frame& F, const float* wg, const float* wu, float* CS) {
    for (int s = blockIdx.x; s < 2 * (FF / 32); s += F.G) { const bool up = s >= FF / 32; const int c0 = (up ? s - FF / 32 : s) * 32;
        strip_quant_i8(F, up ? wu : wg, FF, c0, up ? rowmap<2>(c0) : rowmap<1>(c0), (unsigned char*)F.WGU(), CS); }
}
__device__ __forceinline__ void fwht32x2(float (&v)[64]) {
#pragma unroll
    for (int h = 1; h < 64; h <<= 1)
#pragma unroll
        for (int j = 0; j < 64; ++j) if (!(j & h)) { const float a = v[j], b = v[j + h]; v[j] = a + b; v[j + h] = a - b; }
#pragma unroll
    for (int j = 0; j < 64; ++j) v[j] *= 0.125f;
}
__device__ __forceinline__ void colmax_wd(Frame& F, const float* wd, unsigned* CMD) {
    const int gw = F.vcu * NWAVES + F.wave, NGW = F.G * NWAVES, lane = F.lane;
    constexpr int I2 = (FF / 64) * (DM / 64);
    for (int it = gw; it < I2; it += NGW) { const int n0 = (it % (DM / 64)) << 6;
        float v[64]; tr_load(tr_src(wd, DM, it, lane), DM, v);
        fwht32x2(v);
        float mx = 0.f;
#pragma unroll
        for (int j = 0; j < 64; ++j) mx = fmaxf(mx, fabsf(v[j]));
        atomicMax(CMD + n0 + lane, __float_as_uint(mx));
    }
}
__device__ __forceinline__ void requant_rows(Frame& F, const bf16* A, unsigned char* A8, float* RS) {
    const int gw = F.vcu * NWAVES + F.wave, NGW = F.G * NWAVES;
    constexpr int NV = FF / 8;
    const float s1 = (F.lane & 1) ? -1.0f : 1.0f, s2 = (F.lane & 2) ? -1.0f : 1.0f, s4 = (F.lane & 4) ? -1.0f : 1.0f;
    for (int m = gw; m < M; m += NGW) {
        const v4u* src = (const v4u*)(A + (size_t)m * FF); v2u* dst = (v2u*)(A8 + (size_t)m * FF);
        v4u w[22];
#pragma unroll
        for (int j = 0; j < 22; ++j) { const int idx = F.lane + 64 * j; w[j] = (v4u){0u, 0u, 0u, 0u}; if (idx < NV) w[j] = __builtin_nontemporal_load(src + idx); }
        float mx = 0.f;
#pragma unroll
        for (int j = 0; j < 22; ++j) {
            float x[8] = {blo(w[j].x), bhi(w[j].x), blo(w[j].y), bhi(w[j].y), blo(w[j].z), bhi(w[j].z), blo(w[j].w), bhi(w[j].w)};
#pragma unroll
            for (int h = 1; h < 8; h <<= 1)
#pragma unroll
                for (int i = 0; i < 8; ++i) if (!(i & h)) { const float a = x[i], b = x[i + h]; x[i] = a + b; x[i + h] = a - b; }
#pragma unroll
            for (int i = 0; i < 8; ++i) x[i] = __builtin_fmaf(s1, x[i], dpp_f<0xB1, 0xf>(x[i]));
#pragma unroll
            for (int i = 0; i < 8; ++i) x[i] = __builtin_fmaf(s2, x[i], dpp_f<0x4E, 0xf>(x[i]));
#pragma unroll
            for (int i = 0; i < 8; ++i) x[i] = __builtin_fmaf(s4, x[i], __int_as_float(__builtin_amdgcn_ds_swizzle(__float_as_int(x[i]), 0x101F))) * 0.125f;
            w[j].x = pk2(x[0], x[1]); w[j].y = pk2(x[2], x[3]); w[j].z = pk2(x[4], x[5]); w[j].w = pk2(x[6], x[7]);
            mx = fmaxf(mx, fmaxf(fmaxf(fmaxf(fabsf(blo(w[j].x)), fabsf(bhi(w[j].x))), fmaxf(fabsf(blo(w[j].y)), fabsf(bhi(w[j].y)))), fmaxf(fmaxf(fabsf(blo(w[j].z)), fabsf(bhi(w[j].z))), fmaxf(fabsf(blo(w[j].w)), fabsf(bhi(w[j].w))))));
        }
        mx = fmaxf(wave_max(mx), 1e-30f);
        const float q = 127.0f / mx;
#pragma unroll
        for (int j = 0; j < 22; ++j) { const int idx = F.lane + 64 * j;
            if (idx < NV) { v2u o; o.x = pk4_i8(blo(w[j].x) * q, bhi(w[j].x) * q, blo(w[j].y) * q, bhi(w[j].y) * q); o.y = pk4_i8(blo(w[j].z) * q, bhi(w[j].z) * q, blo(w[j].w) * q, bhi(w[j].w) * q); dst[idx] = o; } }
        if (F.lane == 0) RS[m] = mx * (1.0f / 127.0f);
    }
}
template <class SRC, class XF, class PRE, class OUT> __device__ __forceinline__ void tr_pipeline(int it0, int itEnd, int step, LAS float* scr, int lane, SRC srcf, XF xf, PRE pref, OUT outf) {
    if (it0 >= itEnd) return;
    float v[64]; const float* s; int N;
    srcf(it0, s, N); tr_load(s, N, v);
    for (int it = it0;;) {
        xf(it, v);
        tr_put(scr, v, lane);
        float q[8]; pref(it, q);
        const int nx = it + step;
        if (nx < itEnd) { srcf(nx, s, N); tr_load(s, N, v); }
        outf(it, q);
        if (nx >= itEnd) break;
        it = nx;
    }
}
__device__ __forceinline__ void convert_wd(Frame& F, const float* wd, const unsigned* CMD) {
    LAS float* scr = (LAS float*)(F.lds + F.wave * TR_STRIDE);
    const int gw = F.vcu * NWAVES + F.wave, NGW = F.G * NWAVES, lane = F.lane;
    constexpr int I2 = (FF / 64) * (DM / 64);
    unsigned char* wdt = (unsigned char*)F.WD();
    tr_pipeline(gw, I2, NGW, scr, lane,
        [&](int it, const float*& s, int& N) { s = tr_src(wd, DM, it, lane); N = DM; },
        [&](int, float (&v)[64]) { fwht32x2(v); },
        [&](int it, float (&q)[8]) { tr_q_i8<0>(DM, CMD, it, lane, q); },
        [&](int it, const float (&q)[8]) { tr_out_i8<0>(FF, DM, wdt, q, scr, it, lane); });
}
__device__ __forceinline__ void convert_win(Frame& F) {
    LAS float* scr = (LAS float*)(F.lds + F.wave * TR_STRIDE);
    const int gw = F.vcu * NWAVES + F.wave, NGW = F.G * NWAVES, lane = F.lane;
    constexpr int NB = 16448 / 64, I1 = (DM / 64) * NB;
    const float* win = F.in[6]; bf16* wb = F.WB();
    tr_pipeline(gw, I1, NGW, scr, lane,
        [&](int it, const float*& s, int& N) { s = tr_src(win, 26688, it, lane, NB); N = 26688; },
        [&](int, float (&)[64]) {},
        [&](int, float (&)[8]) {},
        [&](int it, const float (&)[8]) { tr_out<3>(DM, 26688, wb, scr, it, lane, NB); });
    __syncthreads();
    for (int s = blockIdx.x; s < (26688 - 16448) / 32; s += F.G) { const int c0 = 16448 + 32 * s; strip_quant_i8(F, win, 26688, c0, c0 - 16448, F.W8(), (float*)F.CMW()); }
}
__device__ __forceinline__ void colmax_win(Frame& F) {
    const int gw = F.vcu * NWAVES + F.wave, NGW = F.G * NWAVES, lane = F.lane;
    constexpr int NB = 26688 / 64, I1 = (DM / 64) * NB;
    unsigned* cm = F.CMW();
    for (int it = gw; it < I1; it += NGW) { const int n0 = (it % NB) << 6;
        if (!win_i8(n0)) continue;
        float v[64]; tr_load(tr_src(F.in[6], 26688, it, lane), 26688, v);
        float mx = 0.f;
#pragma unroll
        for (int j = 0; j < 64; ++j) mx = fmaxf(mx, fabsf(v[j]));
        atomicMax(cm + rowmap<4>(n0) + lane, __float_as_uint(mx));
    }
}
__device__ __forceinline__ void convert_branch(Frame& F) {
    LAS float* scr = (LAS float*)(F.lds + F.wave * TR_STRIDE);
    const int gw = F.vcu * NWAVES + F.wave, NGW = F.G * NWAVES, lane = F.lane;
    constexpr int IG = 64 * 64, IM = 32 * 64;
    const float* w13 = F.in[13]; const float* w14 = F.in[14]; const float* w15 = F.in[15]; bf16* wbg = F.WBG(); unsigned char* wbm = (unsigned char*)F.WBM(); bf16* wo = F.WO();
    tr_pipeline(gw, 2 * IG + IM, NGW, scr, lane,
        [&](int it, const float*& s, int& N) { N = 4096; if (it < IG) s = tr_src(w13, 4096, it, lane); else if (it < IG + IM) s = tr_src(w14, 4096, it - IG, lane); else s = tr_src(w15, 4096, it - IG - IM, lane); },
        [&](int, float (&)[64]) {},
        [&](int, float (&)[8]) {},
        [&](int it, const float (&)[8]) { if (it < IG) tr_out<0>(4096, 4096, wbg, scr, it, lane);
                      else if (it < IG + IM) tr_out8(2048, 4096, wbm, 0, scr, it - IG, lane);
                      else tr_out<0>(4096, 4096, wo, scr, it - IG - IM, lane); });
}
__device__ __forceinline__ void rms_rows(Frame& F, const float* X, const float* gain, bf16* O, unsigned char* O8 = nullptr) {
    LAS f32x4* gl = (LAS f32x4*)(F.lds + 8 * TR_STRIDE);
    for (int i = F.tid; i < DM / 4; i += NWAVES * 64) gl[i] = ((const f32x4*)gain)[i];
    __syncthreads();
    const int gw = F.vcu * NWAVES + F.wave, NGW = F.G * NWAVES;
    int m = gw; if (m >= M) return;
    f32x4 v[16], nv[16];
    { const f32x4* xr = (const f32x4*)(X + (size_t)m * DM) + F.lane;
#pragma unroll
      for (int j = 0; j < 16; ++j) v[j] = xr[64 * j]; }
    for (;;) {
        const int mn = m + NGW;
        if (mn < M) { const f32x4* xr = (const f32x4*)(X + (size_t)mn * DM) + F.lane;
#pragma unroll
            for (int j = 0; j < 16; ++j) nv[j] = xr[64 * j]; }
        float s = 0.f;
#pragma unroll
        for (int j = 0; j < 16; ++j) s += (v[j].x * v[j].x + v[j].y * v[j].y) + (v[j].z * v[j].z + v[j].w * v[j].w);
        const float r = 1.0f / sqrtf(wave_sum(s) * (1.0f / DM) + NORM_EPS);
        v2u* o8 = (v2u*)(O + (size_t)m * DM) + F.lane;
#pragma unroll
        for (int j = 0; j < 16; ++j) { const f32x4 g = gl[F.lane + 64 * j]; const float a = v[j].x * r * g.x, b = v[j].y * r * g.y, c = v[j].z * r * g.z, d = v[j].w * r * g.w;
            v2u w; w.x = pk2(a, b); w.y = pk2(c, d); o8[64 * j] = w;
            if (O8) ((unsigned*)(O8 + (size_t)m * DM))[F.lane + 64 * j] = pk4_fp8(a, b, c, d); }
        if (mn >= M) break;
#pragma unroll
        for (int j = 0; j < 16; ++j) v[j] = nv[j];
        m = mn;
    }
}
__device__ __forceinline__ void rms_rows_i8(Frame& F, const float* X, const float* gain, unsigned char* O, float* RS, bf16* Ob = nullptr) {
    LAS f32x4* gl = (LAS f32x4*)(F.lds + 8 * TR_STRIDE);
    for (int i = F.tid; i < DM / 4; i += NWAVES * 64) gl[i] = ((const f32x4*)gain)[i];
    __syncthreads();
    const int gw = F.vcu * NWAVES + F.wave, NGW = F.G * NWAVES;
    int m = gw; if (m >= M) return;
    f32x4 v[16], nv[16];
    { const f32x4* xr = (const f32x4*)(X + (size_t)m * DM) + F.lane;
#pragma unroll
      for (int j = 0; j < 16; ++j) v[j] = __builtin_nontemporal_load(xr + 64 * j); }
    for (;;) {
        const int mn = m + NGW;
        if (mn < M) { const f32x4* xr = (const f32x4*)(X + (size_t)mn * DM) + F.lane;
#pragma unroll
            for (int j = 0; j < 16; ++j) nv[j] = __builtin_nontemporal_load(xr + 64 * j); }
        float s = 0.f;
#pragma unroll
        for (int j = 0; j < 16; ++j) s += (v[j].x * v[j].x + v[j].y * v[j].y) + (v[j].z * v[j].z + v[j].w * v[j].w);
        const float r = 1.0f / sqrtf(wave_sum(s) * (1.0f / DM) + NORM_EPS);
        float mx = 0.f;
#pragma unroll
        for (int j = 0; j < 16; ++j) { const f32x4 g = gl[F.lane + 64 * j]; v[j].x *= r * g.x; v[j].y *= r * g.y; v[j].z *= r * g.z; v[j].w *= r * g.w;
            mx = fmaxf(fmaxf(mx, fmaxf(fabsf(v[j].x), fabsf(v[j].y))), fmaxf(fabsf(v[j].z), fabsf(v[j].w))); }
        if (Ob) { v2u* ob = (v2u*)(Ob + (size_t)m * DM) + F.lane;
#pragma unroll
            for (int j = 0; j < 16; ++j) { v2u w; w.x = pk2(v[j].x, v[j].y); w.y = pk2(v[j].z, v[j].w); ob[64 * j] = w; } }
        mx = fmaxf(wave_max(mx), 1e-30f);
        const float q = 127.0f / mx;
        unsigned* o = (unsigned*)(O + (size_t)m * DM) + F.lane;
#pragma unroll
        for (int j = 0; j < 16; ++j) o[64 * j] = pk4_i8(v[j].x * q, v[j].y * q, v[j].z * q, v[j].w * q);
        if (F.lane == 0) RS[m] = mx * (1.0f / 127.0f);
        if (mn >= M) break;
#pragma unroll
        for (int j = 0; j < 16; ++j) v[j] = nv[j];
        m = mn;
    }
}
__device__ __forceinline__ void rope_table(Frame& F) {
    const int gt = F.vcu * NWAVES * 64 + F.tid, NT = F.G * NWAVES * 64;
    for (int idx = gt; idx < SEQ * 64; idx += NT) {
        const int s = idx >> 6, i = idx & 63;
        double f = 1.0, bs = 0.8659643233600653; int e = i;
        while (e) { if (e & 1) f *= bs; bs *= bs; e >>= 1; }
        const float inv = (float)f; const float ang = (float)s * inv;
        const double a = (double)ang; const double k = __builtin_rint(a * 0.15915494309189535);
        double r = __builtin_fma(-k, 6.283185307179586, a); r = __builtin_fma(-k, 2.4492935982947064e-16, r);
        const double q = r * 0.25, q2 = q * q;
        const double sn = q * (1.0 + q2 * (-1.0 / 6 + q2 * (1.0 / 120 + q2 * (-1.0 / 5040 + q2 * (1.0 / 362880 + q2 * (-1.0 / 39916800 + q2 * (1.0 / 6227020800.0)))))));
        const double cs = 1.0 + q2 * (-0.5 + q2 * (1.0 / 24 + q2 * (-1.0 / 720 + q2 * (1.0 / 40320 + q2 * (-1.0 / 3628800 + q2 * (1.0 / 479001600 + q2 * (-1.0 / 87178291200.0)))))));
        const double s2 = 2.0 * sn * cs, c2 = 1.0 - 2.0 * sn * sn, s4 = 2.0 * s2 * c2, c4 = 1.0 - 2.0 * s2 * s2;
        F.ROPE()[idx] = (f32x2){(float)c4, (float)s4};
    }
}
__device__ __forceinline__ void prep_moba(Frame& F) {
    LAS float* red = (LAS float*)F.lds;
    const int w = F.wave, lane = F.lane, l = lane & 31, hh = lane >> 5;
    for (int item = blockIdx.x; item < BATCH * 16 * 16 * 3; item += F.G) {
        const int which = item % 3; int r = item / 3; const int h = r & 15; r >>= 4; const int j = r & 15; const int b = r >> 4;
        const int colbase = (which == 0 ? PA_MQ : which == 1 ? PA_MK : PA_MV) + h * 128;
        bf16* dst = (bf16*)(F.wsb + (which == 0 ? WS_MQ : which == 1 ? WS_MK : WS_MV)) + ((size_t)(b * 16 + h) * SEQ + j * 256) * 128;
        const bf16* src = F.PA() + (size_t)(b * SEQ + j * 256) * PA_LD + colbase;
        float k1a = 0.f, k1b = 0.f, k2a = 0.f, k2b = 0.f;
        if (which == 2) {
            LAS unsigned short* tl = (LAS unsigned short*)(F.lds + 4096);
#pragma unroll 8
            for (int i = 0; i < 32; ++i) { const int tt = w * 32 + i; const unsigned v = *(const unsigned*)(src + (size_t)tt * PA_LD + 2 * lane);
                tl[(2 * lane) * 258 + tt] = (unsigned short)(v & 0xffffu); tl[(2 * lane + 1) * 258 + tt] = (unsigned short)(v >> 16); }
            __syncthreads();
            bf16* vt = F.MV() + (size_t)(b * 16 + h) * 128 * SEQ + j * 256;
#pragma unroll 4
            for (int i = 0; i < 16; ++i) { const int d = w * 16 + i; const LAS unsigned* rp = (const LAS unsigned*)(tl + d * 258) + 2 * lane;
                *(v2u*)(vt + (size_t)d * SEQ + 4 * lane) = (v2u){rp[0], rp[1]}; }
        } else {
            const float* gq = F.in[11]; const float* gk = F.in[12];
            const f32x2 gqa = *(const f32x2*)(gq + 2 * l), gqb = *(const f32x2*)(gq + 64 + 2 * l), gka = *(const f32x2*)(gk + 2 * l), gkb = *(const f32x2*)(gk + 64 + 2 * l);
            const f32x2 g1 = which == 0 ? gqa : gka, g2 = which == 0 ? gqb : gkb;
#pragma unroll 4
            for (int it = 0; it < 16; ++it) { const int tt = w * 32 + 2 * it + hh, s = j * 256 + tt;
                const unsigned u1 = *(const unsigned*)(src + (size_t)tt * PA_LD + 2 * l), u2 = *(const unsigned*)(src + (size_t)tt * PA_LD + 64 + 2 * l);
                const f32x4 cs = *(const f32x4*)((const float*)F.ROPE() + (size_t)(s * 64 + 2 * l) * 2);
                const float x1a = blo(u1), x1b = bhi(u1), x2a = blo(u2), x2b = bhi(u2);
                const float hs = half_sum32((x1a * x1a + x1b * x1b) + (x2a * x2a + x2b * x2b));
                const float tot = hh ? rd_lane(hs, 63) : rd_lane(hs, 31);
                const float rr = 1.0f / sqrtf(tot * (1.0f / 128) + NORM_EPS);
                const float y1a = x1a * rr * g1.x, y1b = x1b * rr * g1.y, y2a = x2a * rr * g2.x, y2b = x2b * rr * g2.y;
                const float o1a = y1a * cs.x - y2a * cs.y, o2a = y2a * cs.x + y1a * cs.y, o1b = y1b * cs.z - y2b * cs.w, o2b = y2b * cs.z + y1b * cs.w;
                *(unsigned*)(dst + tt * 128 + 2 * l) = pk2(o1a, o1b); *(unsigned*)(dst + tt * 128 + 64 + 2 * l) = pk2(o2a, o2b);
                k1a += o1a; k1b += o1b; k2a += o2a; k2b += o2b; }
            k1a = xhalf_sum(k1a); k1b = xhalf_sum(k1b); k2a = xhalf_sum(k2a); k2b = xhalf_sum(k2b);
        }
        if (hh == 0) { *(LAS f32x2*)(red + w * 128 + 2 * l) = (f32x2){k1a, k1b}; *(LAS f32x2*)(red + w * 128 + 64 + 2 * l) = (f32x2){k2a, k2b}; }
        __syncthreads();
        if (which == 1 && F.tid < 128) { float s = 0.f;
#pragma unroll
            for (int ww = 0; ww < 8; ++ww) s += red[ww * 128 + F.tid];
            const float km = s * (1.0f / 256); const unsigned hi = f2bf(km); const float rem = km - __uint_as_float(hi << 16);
            F.KMH()[((size_t)(b * 16 + h) * 16 + j) * 128 + F.tid] = (bf16)hi; F.KML()[((size_t)(b * 16 + h) * 16 + j) * 128 + F.tid] = (bf16)f2bf(rem); }
        __syncthreads();
    }
}
__device__ __forceinline__ float bf_el(const v4u& x, int i) { const unsigned w = (i >> 1) == 0 ? x.x : (i >> 1) == 1 ? x.y : (i >> 1) == 2 ? x.z : x.w; return (i & 1) ? bhi(w) : blo(w); }
__device__ __forceinline__ void prep_gdn(Frame& F) {
    const int gw = F.vcu * NWAVES + F.wave, NGW = F.G * NWAVES, lane = F.lane, q = lane >> 4, li = lane & 15;
    const float* cw = F.in[7];
    LAS unsigned short* tl = (LAS unsigned short*)(F.lds + F.wave * PREP_STRIDE);
    for (int item = gw; item < BATCH * 64 * 64; item += NGW) {
        const int grp = item & 63, c = (item >> 6) & 63, b = item >> 12, t0 = b * SEQ + c * 64, ch = grp * 128 + 8 * li;
        float wt[4][8];
#pragma unroll
        for (int j = 0; j < 4; ++j) { const f32x4 wa = *(const f32x4*)(cw + j * 8192 + ch), wb = *(const f32x4*)(cw + j * 8192 + ch + 4);
            wt[j][0] = wa.x; wt[j][1] = wa.y; wt[j][2] = wa.z; wt[j][3] = wa.w; wt[j][4] = wb.x; wt[j][5] = wb.y; wt[j][6] = wb.z; wt[j][7] = wb.w; }
        const bf16* src = F.PA() + (size_t)(t0 + 16 * q) * PA_LD + ch;
        v4u xm3 = (v4u){0u, 0u, 0u, 0u}, xm2 = xm3, xm1 = xm3;
        if (c > 0 || q > 0) { xm3 = *(const v4u*)(src - 3 * (ptrdiff_t)PA_LD); xm2 = *(const v4u*)(src - 2 * (ptrdiff_t)PA_LD); xm1 = *(const v4u*)(src - (ptrdiff_t)PA_LD); }
#pragma unroll 4
        for (int s = 0; s < 16; ++s) { const int tt = 16 * q + s;
            const v4u x0 = *(const v4u*)(src + (size_t)s * PA_LD);
            float a[8]; float ss = 0.f;
#pragma unroll
            for (int i = 0; i < 8; ++i) { float v = wt[0][i] * bf_el(xm3, i) + wt[1][i] * bf_el(xm2, i) + wt[2][i] * bf_el(xm1, i) + wt[3][i] * bf_el(x0, i);
                v = v * __builtin_amdgcn_rcpf(1.0f + __expf(-v)); a[i] = v; ss += v * v; }
            xm3 = xm2; xm2 = xm1; xm1 = x0;
            if (grp < 32) { const float rr = __builtin_amdgcn_rsqf(row_sum16(ss) + NORM_EPS);
#pragma unroll
                for (int i = 0; i < 8; ++i) a[i] *= rr; }
            const v4u pk = (v4u){cvtpk(a[0], a[1]), cvtpk(a[2], a[3]), cvtpk(a[4], a[5]), cvtpk(a[6], a[7])};
            if (grp < 16) *(v4u*)(F.QN() + (size_t)(t0 + tt) * 2048 + grp * 128 + 8 * li) = pk;
            else { if (grp < 32) *(v4u*)(F.KN() + (size_t)(t0 + tt) * 2048 + (grp - 16) * 128 + 8 * li) = pk;
                   LAS unsigned short* tp = tl + (8 * li) * 68 + tt;
                   tp[0] = (unsigned short)(pk.x & 0xffffu); tp[68] = (unsigned short)(pk.x >> 16); tp[136] = (unsigned short)(pk.y & 0xffffu); tp[204] = (unsigned short)(pk.y >> 16);
                   tp[272] = (unsigned short)(pk.z & 0xffffu); tp[340] = (unsigned short)(pk.z >> 16); tp[408] = (unsigned short)(pk.w & 0xffffu); tp[476] = (unsigned short)(pk.w >> 16); }
        }
        if (grp >= 16) {
            LDS_WAIT();
            bf16* dst = (bf16*)(F.wsb + (grp < 32 ? WS_KNT : WS_VP)) + (grp < 32 ? ((size_t)(b * 16 + grp - 16) * 64 + c) : ((size_t)(b * 32 + grp - 32) * 64 + c)) * 8192;
#pragma unroll 4
            for (int i = 0; i < 16; ++i) { const int row = 8 * i + (lane >> 3), chk = lane & 7; const LAS v2u* rp = (const LAS v2u*)(tl + row * 68 + 8 * chk);
                const v2u lo = rp[0], hi = rp[1]; *(v4u*)(dst + row * 64 + 8 * chk) = (v4u){lo.x, lo.y, hi.x, hi.y}; }
            LDS_WAIT();
        }
    }
    const int gt = F.vcu * NWAVES * 64 + F.tid, NT = F.G * NWAVES * 64;
    for (int idx = gt; idx < M * 32; idx += NT) { const int hv = idx & 31, t = idx >> 5;
        const float a = F.AB()[(size_t)t * 64 + hv], bb = F.AB()[(size_t)t * 64 + 32 + hv];
        const float x = a + F.in[9][hv]; const float sp = fmaxf(x, 0.f) + log1pf(expf(-fabsf(x)));
        F.GG()[idx] = -expf(F.in[8][hv]) * sp; F.BETA()[idx] = 1.0f / (1.0f + expf(-bb)); }
}
typedef short bf16x8 __attribute__((ext_vector_type(8)));
typedef float f32x16 __attribute__((ext_vector_type(16)));
#define MFMA32(a, b, c) __builtin_amdgcn_mfma_f32_32x32x16_bf16((a), (b), (c), 0, 0, 0)
constexpr int MB_KT = 17408, MB_BUF = 34816;

__device__ __forceinline__ void moba_stage_load(const bf16* Kb, const bf16* Vb, int kpos0, int tid, v4u (&kr)[2], v4u (&vr)[2]) {
    const v4u* kp = (const v4u*)(Kb + (size_t)(kpos0 + (tid >> 3)) * 128 + (tid & 7) * 16); kr[0] = kp[0]; kr[1] = kp[1];
    const v4u* vp = (const v4u*)(Vb + (size_t)(tid >> 2) * SEQ + kpos0 + (tid & 3) * 16); vr[0] = vp[0]; vr[1] = vp[1];
}
__device__ __forceinline__ void moba_stage_store(LAS unsigned char* buf, int tid, const v4u (&kr)[2], const v4u (&vr)[2]) {
    LAS unsigned char* kd = buf + (tid >> 3) * 272 + (tid & 7) * 32; *(LAS v4u*)kd = kr[0]; *(LAS v4u*)(kd + 16) = kr[1];
    LAS unsigned char* vd = buf + MB_KT + (tid >> 2) * 136 + (tid & 3) * 32;
    *(LAS v2u*)vd = (v2u){vr[0].x, vr[0].y}; *(LAS v2u*)(vd + 8) = (v2u){vr[0].z, vr[0].w}; *(LAS v2u*)(vd + 16) = (v2u){vr[1].x, vr[1].y}; *(LAS v2u*)(vd + 24) = (v2u){vr[1].z, vr[1].w};
}
__device__ __forceinline__ void moba_unit(Frame& F, int bh, int j) {
    const int w = F.wave, lane = F.lane, r = lane & 31, h = lane >> 5, tid = F.tid;
    LAS unsigned char* L = F.lds;
    const bf16* Qb = F.MQ() + ((size_t)bh * SEQ + j * 256 + 32 * w) * 128;
    const bf16* Kb = F.MK() + (size_t)bh * SEQ * 128;
    const bf16* Vb = F.MV() + (size_t)bh * 128 * SEQ;
    bf16x8 qf[8];
#pragma unroll
    for (int ks = 0; ks < 8; ++ks) qf[ks] = *(const bf16x8*)(Qb + r * 128 + 16 * ks + 8 * h);
    unsigned selmask = 0u;
    if (j > 0) {
        f32x16 g;
#pragma unroll
        for (int i = 0; i < 16; ++i) g[i] = 0.f;
        const bf16* kmh = F.KMH() + ((size_t)bh * 16 + (r & 15)) * 128 + 8 * h; const bf16* kml = F.KML() + ((size_t)bh * 16 + (r & 15)) * 128 + 8 * h;
        bf16x8 ah[8], al[8];
#pragma unroll
        for (int ks = 0; ks < 8; ++ks) { ah[ks] = *(const bf16x8*)(kmh + 16 * ks); al[ks] = *(const bf16x8*)(kml + 16 * ks); }
#pragma unroll
        for (int ks = 0; ks < 8; ++ks) { g = MFMA32(ah[ks], qf[ks], g); g = MFMA32(al[ks], qf[ks], g); }
        unsigned key[16];
#pragma unroll
        for (int i = 0; i < 8; ++i) { const int base = (i & 3) + 8 * (i >> 2); const int n0 = base + 4 * h, n1 = base + 4 * (1 - h);
            auto rr = __builtin_amdgcn_permlane32_swap(__float_as_uint(g[i]), __float_as_uint(g[i]), false, false);
            const unsigned u0 = __float_as_uint(g[i]), u1 = h ? rr[0] : rr[1];
            const unsigned s0 = u0 ^ ((u0 >> 31) ? 0xffffffffu : 0x80000000u), s1 = u1 ^ ((u1 >> 31) ? 0xffffffffu : 0x80000000u);
            key[i] = n0 < j ? ((s0 & ~15u) | (unsigned)(15 - n0)) : 0u; key[8 + i] = n1 < j ? ((s1 & ~15u) | (unsigned)(15 - n1)) : 0u; }
#pragma unroll
        for (int rd = 0; rd < 3; ++rd) { unsigned best = key[0];
#pragma unroll
            for (int i = 1; i < 16; ++i) best = best > key[i] ? best : key[i];
            if (best != 0u) selmask |= 1u << (15u - (best & 15u));
#pragma unroll
            for (int i = 0; i < 16; ++i) key[i] = (key[i] == best) ? 0u : key[i]; }
    }
    f32x16 o[4];
#pragma unroll
    for (int b4 = 0; b4 < 4; ++b4)
#pragma unroll
        for (int i = 0; i < 16; ++i) o[b4][i] = 0.f;
    float m_run = -INFINITY, l_run = 0.f;
    const int nT = 4 * (j + 1), qpos = 32 * w + r;
    constexpr float C = 0.08838834764831845f * 1.4426950408889634f;
    v4u kr[2], vr[2];
    __syncthreads();
    moba_stage_load(Kb, Vb, j * 256, tid, kr, vr); moba_stage_store(L, tid, kr, vr);
    __syncthreads();
    for (int tt = 0; tt < nT; ++tt) {
        const bool own = tt < 4; const int blk = own ? j : ((tt - 4) >> 2), sub64 = own ? tt : ((tt - 4) & 3);
        if (tt + 1 < nT) { const int t1 = tt + 1; const int kp1 = (t1 < 4) ? j * 256 + 64 * t1 : ((t1 - 4) >> 2) * 256 + 64 * ((t1 - 4) & 3); moba_stage_load(Kb, Vb, kp1, tid, kr, vr); }
        {
        LAS unsigned char* Kt = L + (tt & 1) * MB_BUF; LAS unsigned char* Vt = Kt + MB_KT;
        const bool lane_sel = own ? true : (((selmask >> blk) & 1u) != 0u);
        const bool skip = own ? (64 * sub64 > 32 * w + 31) : (__ballot(lane_sel) == 0ull);
        if (!skip) {
            f32x16 x0, x1;
#pragma unroll
            for (int i = 0; i < 16; ++i) { x0[i] = 0.f; x1[i] = 0.f; }
#define MB_LDK(dst, g) do { dst[0] = *(const LAS bf16x8*)(Kt + r * 272 + 64 * (g) + 16 * h); dst[1] = *(const LAS bf16x8*)(Kt + (32 + r) * 272 + 64 * (g) + 16 * h); \
                            dst[2] = *(const LAS bf16x8*)(Kt + r * 272 + 64 * (g) + 32 + 16 * h); dst[3] = *(const LAS bf16x8*)(Kt + (32 + r) * 272 + 64 * (g) + 32 + 16 * h); } while (0)
#define MB_QK(src, g) do { x0 = MFMA32(src[0], qf[2 * (g)], x0); x1 = MFMA32(src[1], qf[2 * (g)], x1); x0 = MFMA32(src[2], qf[2 * (g) + 1], x0); x1 = MFMA32(src[3], qf[2 * (g) + 1], x1); } while (0)
            { bf16x8 fa[4], fb[4];
              MB_LDK(fa, 0); MB_LDK(fb, 1); __builtin_amdgcn_sched_barrier(0);
              MB_QK(fa, 0); MB_LDK(fa, 2); __builtin_amdgcn_sched_barrier(0);
              MB_QK(fb, 1); MB_LDK(fb, 3); __builtin_amdgcn_sched_barrier(0);
              MB_QK(fa, 2); __builtin_amdgcn_sched_barrier(0);
              MB_QK(fb, 3); }
#undef MB_LDK
#undef MB_QK
            if (own && (64 * sub64 + 63 > 32 * w)) {
#pragma unroll
                for (int i = 0; i < 16; ++i) { const int key0 = 64 * sub64 + (i & 3) + 8 * (i >> 2) + 4 * h;
                    x0[i] = (key0 <= qpos) ? x0[i] : -INFINITY; x1[i] = (key0 + 32 <= qpos) ? x1[i] : -INFINITY; }
            }
            float mx = fmaxf(x0[0], x1[0]);
#pragma unroll
            for (int i = 1; i < 16; ++i) mx = fmaxf(fmaxf(mx, x0[i]), x1[i]);
            mx = xhalf_max(mx);
            mx = lane_sel ? mx : -INFINITY;
            const float m_new = fmaxf(m_run, mx);
            if (__any(m_new != m_run)) {
                const float alpha = __builtin_amdgcn_exp2f((m_run - m_new) * C);
                l_run *= alpha;
#pragma unroll
                for (int b4 = 0; b4 < 4; ++b4)
#pragma unroll
                    for (int i = 0; i < 16; ++i) o[b4][i] *= alpha;
                m_run = m_new;
            }
            const float mC = -m_run * C;
            float rs = 0.f;
#pragma unroll
            for (int i = 0; i < 16; ++i) { x0[i] = __builtin_amdgcn_exp2f(fmaf(x0[i], C, mC)); x1[i] = __builtin_amdgcn_exp2f(fmaf(x1[i], C, mC)); rs += x0[i] + x1[i]; }
            rs = xhalf_sum(rs);
            l_run += lane_sel ? rs : 0.f;
            const unsigned pmask = lane_sel ? 0xffffffffu : 0u;
            bf16x8 pb[4];
#pragma unroll
            for (int st = 0; st < 4; ++st) { v4u pw; const int s8 = 8 * (st & 1);
                if (st < 2) { pw.x = cvtpk(x0[s8], x0[s8 + 1]); pw.y = cvtpk(x0[s8 + 2], x0[s8 + 3]); pw.z = cvtpk(x0[s8 + 4], x0[s8 + 5]); pw.w = cvtpk(x0[s8 + 6], x0[s8 + 7]); }
                else { pw.x = cvtpk(x1[s8], x1[s8 + 1]); pw.y = cvtpk(x1[s8 + 2], x1[s8 + 3]); pw.z = cvtpk(x1[s8 + 4], x1[s8 + 5]); pw.w = cvtpk(x1[s8 + 6], x1[s8 + 7]); }
                pw.x &= pmask; pw.y &= pmask; pw.z &= pmask; pw.w &= pmask; pb[st] = __builtin_bit_cast(bf16x8, pw); }
#define MB_LDV(dst, st) do { _Pragma("unroll") for (int b4 = 0; b4 < 4; ++b4) { const LAS unsigned char* vp = Vt + (32 * b4 + r) * 136 + (16 * (st) + 4 * h) * 2; \
                const v2u lo = *(const LAS v2u*)vp, hi = *(const LAS v2u*)(vp + 16); dst[b4] = __builtin_bit_cast(bf16x8, (v4u){lo.x, lo.y, hi.x, hi.y}); } } while (0)
#define MB_PV(src, st) do { _Pragma("unroll") for (int b4 = 0; b4 < 4; ++b4) o[b4] = MFMA32(src[b4], pb[st], o[b4]); } while (0)
            { bf16x8 va[4], vb[4];
              MB_LDV(va, 0); MB_LDV(vb, 1); __builtin_amdgcn_sched_barrier(0);
              MB_PV(va, 0); MB_LDV(va, 2); __builtin_amdgcn_sched_barrier(0);
              MB_PV(vb, 1); MB_LDV(vb, 3); __builtin_amdgcn_sched_barrier(0);
              MB_PV(va, 2); __builtin_amdgcn_sched_barrier(0);
              MB_PV(vb, 3); }
#undef MB_LDV
#undef MB_PV
        }
        }
        if (tt + 1 < nT) moba_stage_store(L + ((tt + 1) & 1) * MB_BUF, tid, kr, vr);
        __syncthreads();
    }
    const float inv = 16.0f / l_run; const int b = bh >> 4, hh = bh & 15;
    unsigned char* orow = (unsigned char*)F.OM() + (size_t)(b * SEQ + j * 256 + 32 * w + r) * 2048 + hh * 128;
#pragma unroll
    for (int b4 = 0; b4 < 4; ++b4)
#pragma unroll
        for (int gq = 0; gq < 4; ++gq) *(unsigned*)(orow + 32 * b4 + 8 * gq + 4 * h) = pk4_fp8(o[b4][4 * gq] * inv, o[b4][4 * gq + 1] * inv, o[b4][4 * gq + 2] * inv, o[b4][4 * gq + 3] * inv);
}
__device__ __forceinline__ void moba_phase(Frame& F) {
    for (int p = blockIdx.x; p < BATCH * 16 * 8; p += F.G) { const int bh = p >> 3, jj = p & 7; moba_unit(F, bh, 15 - jj); moba_unit(F, bh, jj); }
}
__device__ __forceinline__ int crow(int reg, int h) { return (reg & 3) + 8 * (reg >> 2) + 4 * h; }
__device__ __forceinline__ float rdlane(float v, int l) { return __int_as_float(__builtin_amdgcn_readlane(__float_as_int(v), l)); }
template <int TB, int CB> __device__ __forceinline__ float lsel(const f32x16& L00, const f32x16& L10, const f32x16& L11, int reg, int ln) {
    return TB == 0 ? rdlane(L00[reg], ln) : (CB == 0 ? rdlane(L10[reg], ln) : rdlane(L11[reg], ln)); }
__device__ __forceinline__ void sub_step(float& acc, float lv, int ln, float xk) { int tmp;
    asm volatile("s_nop 0\n\tv_readlane_b32 %1, %2, %3\n\ts_nop 1\n\tv_fma_f32 %0, -%1, %4, %0" : "+v"(acc), "=&s"(tmp) : "v"(lv), "s"(ln), "v"(xk)); }
__device__ __forceinline__ void sub_step4(float& a0, float& a1, float& a2, float& a3, float l0, float l1, float l2, float l3, int n0, int n1, int n2, int n3, float x0, float x1, float x2, float x3) {
    int t0, t1, t2, t3;
    asm volatile("s_nop 0\n\tv_readlane_b32 %4, %8, %12\n\tv_readlane_b32 %5, %9, %13\n\tv_readlane_b32 %6, %10, %14\n\tv_readlane_b32 %7, %11, %15\n\t"
                 "v_fma_f32 %0, -%4, %16, %0\n\tv_fma_f32 %1, -%5, %17, %1\n\tv_fma_f32 %2, -%6, %18, %2\n\tv_fma_f32 %3, -%7, %19, %3"
                 : "+v"(a0), "+v"(a1), "+v"(a2), "+v"(a3), "=&s"(t0), "=&s"(t1), "=&s"(t2), "=&s"(t3)
                 : "v"(l0), "v"(l1), "v"(l2), "v"(l3), "s"(n0), "s"(n1), "s"(n2), "s"(n3), "v"(x0), "v"(x1), "v"(x2), "v"(x3));
}
__device__ __forceinline__ v4u pack8(const float (&x)[8]) { v4u p; p.x = cvtpk(x[0], x[1]); p.y = cvtpk(x[2], x[3]); p.z = cvtpk(x[4], x[5]); p.w = cvtpk(x[6], x[7]); return p; }

__device__ __forceinline__ void t_frags(const float (&X)[64], float sv, bf16x8 (&F0)[4], bf16x8 (&F1)[4]) {
#pragma unroll
    for (int ks = 0; ks < 4; ++ks) {
        float lo[8], hi[8];
#pragma unroll
        for (int jj = 0; jj < 8; ++jj) { lo[jj] = X[16 * ks + jj] * rdlane(sv, 16 * ks + jj); hi[jj] = X[16 * ks + 8 + jj] * rdlane(sv, 16 * ks + 8 + jj); }
        const v4u pl = pack8(lo), ph = pack8(hi); v4u f0, f1;
        { auto rr = __builtin_amdgcn_permlane32_swap(pl.x, ph.x, false, false); f0.x = rr[0]; f1.x = rr[1]; }
        { auto rr = __builtin_amdgcn_permlane32_swap(pl.y, ph.y, false, false); f0.y = rr[0]; f1.y = rr[1]; }
        { auto rr = __builtin_amdgcn_permlane32_swap(pl.z, ph.z, false, false); f0.z = rr[0]; f1.z = rr[1]; }
        { auto rr = __builtin_amdgcn_permlane32_swap(pl.w, ph.w, false, false); f0.w = rr[0]; f1.w = rr[1]; }
        F0[ks] = __builtin_bit_cast(bf16x8, f0); F1[ks] = __builtin_bit_cast(bf16x8, f1);
    }
}
__device__ __forceinline__ void gdn_local_task(Frame& F, int task, LAS float* sm) {
    int lane_o = F.lane; asm volatile("" : "+v"(lane_o));
    const int lane = lane_o, r = lane & 31, h = lane >> 5;
    const int c = task & 63, bhv = task >> 6, hv = bhv & 31, b = bhv >> 5, hq = hv >> 1;
    const int t0 = b * SEQ + c * 64; const size_t tq = (size_t)(b * 16 + hq) * 64 + c;
    const float g = F.GG()[(size_t)(t0 + lane) * 32 + hv], bt = F.BETA()[(size_t)(t0 + lane) * 32 + hv];
    float gc = g;
#pragma unroll
    for (int o = 1; o < 64; o <<= 1) { const float t = __int_as_float(__builtin_amdgcn_ds_bpermute(4 * ((lane - o) & 63), __float_as_int(gc))); gc += (lane >= o) ? t : 0.f; }
    sm[lane] = gc; sm[64 + lane] = bt;
    F.GC()[(size_t)task * 64 + lane] = gc;
    LDS_WAIT();
    bf16x8 kf[2][8];
#pragma unroll
    for (int tb = 0; tb < 2; ++tb)
#pragma unroll
        for (int ks = 0; ks < 8; ++ks) kf[tb][ks] = *(const bf16x8*)(F.KN() + (size_t)(t0 + 32 * tb + r) * 2048 + hq * 128 + 16 * ks + 8 * h);
    f32x16 L00, L10, L11;
#pragma unroll
    for (int i = 0; i < 16; ++i) { L00[i] = 0.f; L10[i] = 0.f; L11[i] = 0.f; }
#pragma unroll
    for (int ks = 0; ks < 8; ++ks) { L00 = MFMA32(kf[0][ks], kf[0][ks], L00); L10 = MFMA32(kf[1][ks], kf[0][ks], L10); L11 = MFMA32(kf[1][ks], kf[1][ks], L11); }
    const float gci0 = sm[r], gci1 = sm[32 + r];
#pragma unroll
    for (int reg = 0; reg < 16; ++reg) { const int kr = crow(reg, h); const float gk0 = sm[kr], bk0 = sm[64 + kr], gk1 = sm[32 + kr], bk1 = sm[96 + kr];
        L00[reg] = (r < kr) ? L00[reg] * bk0 * __expf(gk0 - gci0) : 0.f;
        L10[reg] = L10[reg] * bk1 * __expf(gk1 - gci0);
        L11[reg] = (r < kr) ? L11[reg] * bk1 * __expf(gk1 - gci1) : 0.f; }
    { bf16* at = F.AT() + (size_t)task * 4096; const float sc = 0.08838834764831845f;
      { bf16x8 qf[8];
#pragma unroll
        for (int ks = 0; ks < 8; ++ks) qf[ks] = *(const bf16x8*)(F.QN() + (size_t)(t0 + r) * 2048 + hq * 128 + 16 * ks + 8 * h);
        f32x16 A00;
#pragma unroll
        for (int i = 0; i < 16; ++i) A00[i] = 0.f;
#pragma unroll
        for (int ks = 0; ks < 8; ++ks) A00 = MFMA32(kf[0][ks], qf[ks], A00);
#pragma unroll
        for (int g4 = 0; g4 < 4; ++g4) { float v[4];
#pragma unroll
            for (int t = 0; t < 4; ++t) { const int reg = 4 * g4 + t, jr = crow(reg, h); v[t] = (jr <= r) ? A00[reg] * sc * __expf(gci0 - sm[jr]) : 0.f; }
            *(v2u*)(at + r * 64 + 8 * g4 + 4 * h) = (v2u){cvtpk(v[0], v[1]), cvtpk(v[2], v[3])}; } }
      { bf16x8 qf[8];
#pragma unroll
        for (int ks = 0; ks < 8; ++ks) qf[ks] = *(const bf16x8*)(F.QN() + (size_t)(t0 + 32 + r) * 2048 + hq * 128 + 16 * ks + 8 * h);
        f32x16 A01, A11;
#pragma unroll
        for (int i = 0; i < 16; ++i) { A01[i] = 0.f; A11[i] = 0.f; }
#pragma unroll
        for (int ks = 0; ks < 8; ++ks) { A01 = MFMA32(kf[0][ks], qf[ks], A01); A11 = MFMA32(kf[1][ks], qf[ks], A11); }
#pragma unroll
        for (int g4 = 0; g4 < 4; ++g4) { float v[4], u[4];
#pragma unroll
            for (int t = 0; t < 4; ++t) { const int reg = 4 * g4 + t, jr = crow(reg, h); v[t] = A01[reg] * sc * __expf(gci1 - sm[jr]); u[t] = (jr <= r) ? A11[reg] * sc * __expf(gci1 - sm[32 + jr]) : 0.f; }
            *(v2u*)(at + (32 + r) * 64 + 8 * g4 + 4 * h) = (v2u){cvtpk(v[0], v[1]), cvtpk(v[2], v[3])};
            *(v2u*)(at + (32 + r) * 64 + 32 + 8 * g4 + 4 * h) = (v2u){cvtpk(u[0], u[1]), cvtpk(u[2], u[3])}; } } }
    asm volatile("" ::: "memory"); __builtin_amdgcn_sched_barrier(0);
    bf16x8 vfr[2][4];
    { const bf16* vt = F.VP() + (size_t)task * 8192;
#pragma unroll
      for (int db = 0; db < 2; ++db)
#pragma unroll
          for (int ks = 0; ks < 4; ++ks) vfr[db][ks] = *(const bf16x8*)(vt + (32 * db + r) * 64 + 16 * ks + 8 * h); }
    float X[64];
    asm volatile("s_nop 7" ::: "memory");
#define GL_LV(k, i) (((k) < 32) ? L00[(((k) & 31) & 3) + 4 * (((k) & 31) >> 3)] : (((i) < 32) ? L10[(((k) & 31) & 3) + 4 * (((k) & 31) >> 3)] : L11[(((k) & 31) & 3) + 4 * (((k) & 31) >> 3)]))
#define GL_LN(k, i) (((i) & 31) + 32 * ((((k) & 31) >> 2) & 1))
#pragma unroll
    for (int i = 63; i >= 0; --i) {
        float a0 = (lane == i) ? 1.f : 0.f, a1 = 0.f, a2 = 0.f, a3 = 0.f;
        const int n4 = (63 - i) >> 2;
#pragma unroll
        for (int g = 0; g < n4; ++g) { const int k = i + 1 + 4 * g;
            sub_step4(a0, a1, a2, a3, GL_LV(k, i), GL_LV(k + 1, i), GL_LV(k + 2, i), GL_LV(k + 3, i), GL_LN(k, i), GL_LN(k + 1, i), GL_LN(k + 2, i), GL_LN(k + 3, i), X[k], X[k + 1], X[k + 2], X[k + 3]); }
#pragma unroll
        for (int k = i + 1 + 4 * n4; k < 64; ++k) sub_step(a0, GL_LV(k, i), GL_LN(k, i), X[k]);
        X[i] = (a0 + a1) + (a2 + a3);
    }
#undef GL_LV
#undef GL_LN
    asm volatile("" ::: "memory"); __builtin_amdgcn_sched_barrier(0);
    bf16x8 F0[4], F1[4];
    t_frags(X, bt, F0, F1);
    { bf16* ub = F.U() + (size_t)task * 8192;
#pragma unroll
      for (int db = 0; db < 4; ++db) { f32x16 u0, u1;
#pragma unroll
          for (int i = 0; i < 16; ++i) { u0[i] = 0.f; u1[i] = 0.f; }
#pragma unroll
          for (int ks = 0; ks < 4; ++ks) { const bf16x8 vf = db < 2 ? vfr[db & 1][ks] : *(const bf16x8*)(F.VP() + (size_t)task * 8192 + (32 * db + r) * 64 + 16 * ks + 8 * h); if (ks < 2) u0 = MFMA32(F0[ks], vf, u0); u1 = MFMA32(F1[ks], vf, u1); }
          v4u* d0 = (v4u*)(ub + ((0 * 4 + db) * 64 + lane) * 16); v4u* d1 = (v4u*)(ub + ((1 * 4 + db) * 64 + lane) * 16);
          { float a[8], bb[8];
#pragma unroll
            for (int i = 0; i < 8; ++i) { a[i] = u0[i]; bb[i] = u0[8 + i]; }
            d0[0] = pack8(a); d0[1] = pack8(bb);
#pragma unroll
            for (int i = 0; i < 8; ++i) { a[i] = u1[i]; bb[i] = u1[8 + i]; }
            d1[0] = pack8(a); d1[1] = pack8(bb); } } }
    asm volatile("" ::: "memory"); __builtin_amdgcn_sched_barrier(0);
    t_frags(X, bt * __expf(gc), F0, F1);
    { const bf16* kt = F.KNT() + tq * 8192; bf16* wb = F.W() + (size_t)task * 8192;
#pragma unroll
      for (int a = 0; a < 4; ++a) { f32x16 w0, w1;
#pragma unroll
          for (int i = 0; i < 16; ++i) { w0[i] = 0.f; w1[i] = 0.f; }
#pragma unroll
          for (int ks = 0; ks < 4; ++ks) { const bf16x8 ktf = *(const bf16x8*)(kt + (32 * a + r) * 64 + 16 * ks + 8 * h); if (ks < 2) w0 = MFMA32(ktf, F0[ks], w0); w1 = MFMA32(ktf, F1[ks], w1); }
#pragma unroll
          for (int g4 = 0; g4 < 4; ++g4) {
              *(v2u*)(wb + r * 128 + 32 * a + 8 * g4 + 4 * h) = (v2u){cvtpk(w0[4 * g4], w0[4 * g4 + 1]), cvtpk(w0[4 * g4 + 2], w0[4 * g4 + 3])};
              *(v2u*)(wb + (32 + r) * 128 + 32 * a + 8 * g4 + 4 * h) = (v2u){cvtpk(w1[4 * g4], w1[4 * g4 + 1]), cvtpk(w1[4 * g4 + 2], w1[4 * g4 + 3])}; } } }
    LDS_WAIT();
}
__device__ __forceinline__ void gdn_local_phase(Frame& F) {
    LAS float* sm = (LAS float*)(F.lds + F.wave * 512);
    const int gw = F.vcu * NWAVES + F.wave, NGW = F.G * NWAVES;
    for (int task = gw; task < BATCH * 32 * 64; task += NGW) gdn_local_task(F, task, sm);
}

constexpr int SC_W = 0, SC_Q = 16896, SC_A = 33792, SC_KT = 42496, SC_E1 = 59904, SC_E2 = 60160, SC_BUF = 60416, SC_OT = 2 * SC_BUF, SC_OTB = 16896;
static_assert(SC_OT + 2 * SC_OTB <= MISC_OFF, "scan LDS map");
__device__ __forceinline__ bf16x8 frag8(const LAS unsigned char* p) { const v2u lo = *(const LAS v2u*)p, hi = *(const LAS v2u*)(p + 16); return __builtin_bit_cast(bf16x8, (v4u){lo.x, lo.y, hi.x, hi.y}); }
__device__ __forceinline__ void st16(LAS unsigned char* p, v4u v) { *(LAS v2u*)p = (v2u){v.x, v.y}; *(LAS v2u*)(p + 8) = (v2u){v.z, v.w}; }
struct ScanRegs { v4u rw[4], rq[4], ra[2], rk[4]; float gcv, glv; };
__device__ __forceinline__ void scan_issue(Frame& F, int lt, size_t task, size_t tq, int t0, int hq, ScanRegs& R) {
#pragma unroll
    for (int i = 0; i < 4; ++i) { const int idx = lt + 256 * i, row = idx >> 4, ch = idx & 15;
        R.rw[i] = *(const v4u*)(F.W() + task * 8192 + row * 128 + ch * 8); R.rq[i] = *(const v4u*)(F.QN() + (size_t)(t0 + row) * 2048 + hq * 128 + ch * 8); }
#pragma unroll
    for (int i = 0; i < 2; ++i) { const int idx = lt + 256 * i, row = idx >> 3, ch = idx & 7; R.ra[i] = *(const v4u*)(F.AT() + task * 4096 + row * 64 + ch * 8); }
#pragma unroll
    for (int i = 0; i < 4; ++i) { const int idx = lt + 256 * i, row = idx >> 3, ch = idx & 7; R.rk[i] = *(const v4u*)(F.KNT() + tq * 8192 + row * 64 + ch * 8); }
    R.gcv = 0.f; R.glv = 0.f;
    if (lt < 64) { R.gcv = F.GC()[task * 64 + lt]; R.glv = F.GC()[task * 64 + 63]; }
}
__device__ __forceinline__ void scan_store(int lt, const ScanRegs& R, LAS unsigned char* buf) {
#pragma unroll
    for (int i = 0; i < 4; ++i) { const int idx = lt + 256 * i, row = idx >> 4, ch = idx & 15; st16(buf + SC_W + row * 264 + ch * 16, R.rw[i]); st16(buf + SC_Q + row * 264 + ch * 16, R.rq[i]); }
#pragma unroll
    for (int i = 0; i < 2; ++i) { const int idx = lt + 256 * i, row = idx >> 3, ch = idx & 7; st16(buf + SC_A + row * 136 + ch * 16, R.ra[i]); }
#pragma unroll
    for (int i = 0; i < 4; ++i) { const int idx = lt + 256 * i, row = idx >> 3, ch = idx & 7; st16(buf + SC_KT + row * 136 + ch * 16, R.rk[i]); }
    if (lt < 64) { ((LAS float*)(buf + SC_E1))[lt] = __expf(R.gcv) * 0.08838834764831845f; ((LAS float*)(buf + SC_E2))[lt] = __expf(R.glv - R.gcv); }
}
__device__ __forceinline__ void scan_finalize(Frame& F, LAS unsigned char* L, int c, int t0, int lw, int lane, int hv, f32x2 gn, const unsigned (&zw)[16]) {
    const LAS unsigned char* ot = L + SC_OT + (c & 1) * SC_OTB;
#pragma unroll
    for (int hb = 0; hb < 2; ++hb) {
        float o0[8], o1[8], ss[8];
#pragma unroll
        for (int i = 0; i < 8; ++i) { const unsigned ow = *(const LAS unsigned*)(ot + (16 * lw + 8 * hb + i) * 264 + 4 * lane); o0[i] = blo(ow); o1[i] = bhi(ow); ss[i] = o0[i] * o0[i] + o1[i] * o1[i]; }
#pragma unroll
        for (int i = 0; i < 8; ++i) ss[i] = wave_sum(ss[i]);
#pragma unroll
        for (int i = 0; i < 8; ++i) { const float rr = __builtin_amdgcn_rsqf(ss[i] * (1.0f / 128) + NORM_EPS); const float z0 = blo(zw[8 * hb + i]), z1 = bhi(zw[8 * hb + i]);
            const float y0 = o0[i] * rr * gn.x * (z0 * __builtin_amdgcn_rcpf(1.0f + __expf(-z0))), y1 = o1[i] * rr * gn.y * (z1 * __builtin_amdgcn_rcpf(1.0f + __expf(-z1)));
            *(unsigned*)(F.OG() + (size_t)(t0 + 16 * lw + 8 * hb + i) * 4096 + hv * 128 + 2 * lane) = pk2(y0, y1); }
    }
}
__device__ __forceinline__ void gdn_scan_seq(Frame& F, int seq) {
    int tid_o = F.tid; asm volatile("" : "+v"(tid_o));
    const int tid = tid_o, w = __builtin_amdgcn_readfirstlane(tid >> 6), lane = tid & 63, r = lane & 31, h = lane >> 5;
    const int b = seq >> 5, hv = seq & 31, hq = hv >> 1;
    LAS unsigned char* L = F.lds;
    const size_t task0 = (size_t)seq * 64, tq0 = (size_t)(b * 16 + hq) * 64;
    __syncthreads();
    if (w >= 4) {
        const int lt = tid - 256, lw = w - 4;
        const float* onorm = F.in[10]; const f32x2 gn = *(const f32x2*)(onorm + 2 * lane);
        ScanRegs R0, R1;
        scan_issue(F, lt, task0, tq0, b * SEQ, hq, R0); scan_issue(F, lt, task0 + 1, tq0 + 1, b * SEQ + 64, hq, R1);
        scan_store(lt, R0, L);
        __syncthreads();
#define SCAN_LOADER_STEP(c, RA, RB) do { \
            const int t0 = b * SEQ + (c) * 64; \
            unsigned zw[16]; \
            _Pragma("unroll") for (int i = 0; i < 16; ++i) zw[i] = *(const unsigned*)(F.PB() + (size_t)(t0 + 16 * lw + i) * PB_LD + PB_GZ + hv * 128 + 2 * lane); \
            if ((c) + 2 < 64) scan_issue(F, lt, task0 + (c) + 2, tq0 + (c) + 2, b * SEQ + ((c) + 2) * 64, hq, RA); \
            if ((c) + 1 < 64) scan_store(lt, RB, L + (((c) + 1) & 1) * SC_BUF); \
            __syncthreads(); \
            scan_finalize(F, L, (c), t0, lw, lane, hv, gn, zw); } while (0)
        for (int c = 0; c < 64; c += 2) {
            SCAN_LOADER_STEP(c, R0, R1);
            SCAN_LOADER_STEP(c + 1, R1, R0);
        }
#undef SCAN_LOADER_STEP
    } else {
        f32x16 Sx[4];
#pragma unroll
        for (int a = 0; a < 4; ++a)
#pragma unroll
            for (int i = 0; i < 16; ++i) Sx[a][i] = 0.f;
        v4u ur[4];
        { const v4u* up = (const v4u*)(F.U() + task0 * 8192 + ((0 * 4 + w) * 64 + lane) * 16); ur[0] = up[0]; ur[1] = up[1];
          const v4u* up1 = (const v4u*)(F.U() + task0 * 8192 + ((1 * 4 + w) * 64 + lane) * 16); ur[2] = up1[0]; ur[3] = up1[1]; }
        __syncthreads();
        for (int c = 0; c < 64; ++c) {
            const LAS unsigned char* buf = L + (c & 1) * SC_BUF; const LAS float* e1 = (const LAS float*)(buf + SC_E1); const LAS float* e2 = (const LAS float*)(buf + SC_E2);
            bf16x8 Sb[4][2];
#pragma unroll
            for (int a = 0; a < 4; ++a)
#pragma unroll
                for (int s = 0; s < 2; ++s) { float t[8];
#pragma unroll
                    for (int jj = 0; jj < 8; ++jj) t[jj] = Sx[a][8 * s + jj];
                    Sb[a][s] = __builtin_bit_cast(bf16x8, pack8(t)); }
            f32x16 vn[2];
#define SC_LD4(dst, off, gi) do { _Pragma("unroll") for (int q_ = 0; q_ < 4; ++q_) dst[q_] = frag8(buf + (off) + (32 * ((gi) >> 1) + r) * 264 + (32 * (2 * ((gi) & 1) + (q_ >> 1)) + 16 * (q_ & 1) + 4 * h) * 2); } while (0)
#define SC_MM4(acc, src, gi) do { _Pragma("unroll") for (int q_ = 0; q_ < 4; ++q_) acc = MFMA32(src[q_], Sb[2 * ((gi) & 1) + (q_ >> 1)][q_ & 1], acc); } while (0)
            { f32x16 y0, y1;
#pragma unroll
              for (int i = 0; i < 16; ++i) { y0[i] = 0.f; y1[i] = 0.f; }
              bf16x8 fa[4], fb[4];
              SC_LD4(fa, SC_W, 0); SC_LD4(fb, SC_W, 1); __builtin_amdgcn_sched_barrier(0);
              SC_MM4(y0, fa, 0); SC_LD4(fa, SC_W, 2); __builtin_amdgcn_sched_barrier(0);
              SC_MM4(y0, fb, 1); SC_LD4(fb, SC_W, 3); __builtin_amdgcn_sched_barrier(0);
              SC_MM4(y1, fa, 2); __builtin_amdgcn_sched_barrier(0);
              SC_MM4(y1, fb, 3);
#pragma unroll
              for (int tb = 0; tb < 2; ++tb) { const v4u ua = ur[2 * tb], ub = ur[2 * tb + 1]; const f32x16& y = tb ? y1 : y0;
                vn[tb][0] = blo(ua.x) - y[0]; vn[tb][1] = bhi(ua.x) - y[1]; vn[tb][2] = blo(ua.y) - y[2]; vn[tb][3] = bhi(ua.y) - y[3];
                vn[tb][4] = blo(ua.z) - y[4]; vn[tb][5] = bhi(ua.z) - y[5]; vn[tb][6] = blo(ua.w) - y[6]; vn[tb][7] = bhi(ua.w) - y[7];
                vn[tb][8] = blo(ub.x) - y[8]; vn[tb][9] = bhi(ub.x) - y[9]; vn[tb][10] = blo(ub.y) - y[10]; vn[tb][11] = bhi(ub.y) - y[11];
                vn[tb][12] = blo(ub.z) - y[12]; vn[tb][13] = bhi(ub.z) - y[13]; vn[tb][14] = blo(ub.w) - y[14]; vn[tb][15] = bhi(ub.w) - y[15]; } }
            if (c + 1 < 64) { const v4u* up = (const v4u*)(F.U() + (task0 + c + 1) * 8192 + ((0 * 4 + w) * 64 + lane) * 16); ur[0] = up[0]; ur[1] = up[1];
                const v4u* up1 = (const v4u*)(F.U() + (task0 + c + 1) * 8192 + ((1 * 4 + w) * 64 + lane) * 16); ur[2] = up1[0]; ur[3] = up1[1]; }
            bf16x8 Vb[2][2], Vb2[2][2];
#pragma unroll
            for (int tb = 0; tb < 2; ++tb)
#pragma unroll
                for (int s = 0; s < 2; ++s) { float t[8], t2[8];
                    const f32x4 ea = *(const LAS f32x4*)(e2 + 32 * tb + 16 * s + 4 * h), eb = *(const LAS f32x4*)(e2 + 32 * tb + 16 * s + 8 + 4 * h);
#pragma unroll
                    for (int jj = 0; jj < 4; ++jj) { t[jj] = vn[tb][8 * s + jj]; t[4 + jj] = vn[tb][8 * s + 4 + jj]; t2[jj] = t[jj] * ea[jj]; t2[4 + jj] = t[4 + jj] * eb[jj]; }
                    Vb[tb][s] = __builtin_bit_cast(bf16x8, pack8(t)); Vb2[tb][s] = __builtin_bit_cast(bf16x8, pack8(t2)); }
            LAS unsigned char* ot = L + SC_OT + (c & 1) * SC_OTB;
            { f32x16 y0, y1;
#pragma unroll
              for (int i = 0; i < 16; ++i) { y0[i] = 0.f; y1[i] = 0.f; }
              bf16x8 fa[4], fb[4], at[6];
              SC_LD4(fa, SC_Q, 0); SC_LD4(fb, SC_Q, 1); __builtin_amdgcn_sched_barrier(0);
              SC_MM4(y0, fa, 0); SC_LD4(fa, SC_Q, 2); __builtin_amdgcn_sched_barrier(0);
              SC_MM4(y0, fb, 1); SC_LD4(fb, SC_Q, 3); __builtin_amdgcn_sched_barrier(0);
              SC_MM4(y1, fa, 2);
#pragma unroll
              for (int s2 = 0; s2 < 2; ++s2) { at[s2] = frag8(buf + SC_A + r * 136 + (16 * s2 + 4 * h) * 2); at[2 + s2] = frag8(buf + SC_A + (32 + r) * 136 + (16 * s2 + 4 * h) * 2); at[4 + s2] = frag8(buf + SC_A + (32 + r) * 136 + (32 + 16 * s2 + 4 * h) * 2); }
              __builtin_amdgcn_sched_barrier(0);
              SC_MM4(y1, fb, 3);
#pragma unroll
              for (int g4 = 0; g4 < 4; ++g4) { const f32x4 ea = *(const LAS f32x4*)(e1 + 8 * g4 + 4 * h), eb = *(const LAS f32x4*)(e1 + 32 + 8 * g4 + 4 * h);
#pragma unroll
                  for (int t = 0; t < 4; ++t) { y0[4 * g4 + t] *= ea[t]; y1[4 * g4 + t] *= eb[t]; } }
              y0 = MFMA32(at[0], Vb[0][0], y0); y0 = MFMA32(at[1], Vb[0][1], y0);
              y1 = MFMA32(at[2], Vb[0][0], y1); y1 = MFMA32(at[3], Vb[0][1], y1); y1 = MFMA32(at[4], Vb[1][0], y1); y1 = MFMA32(at[5], Vb[1][1], y1);
#pragma unroll
              for (int reg = 0; reg < 16; reg += 2) { const unsigned p0 = cvtpk(y0[reg], y0[reg + 1]), p1 = cvtpk(y1[reg], y1[reg + 1]);
                  *(LAS unsigned short*)(ot + crow(reg, h) * 264 + (32 * w + r) * 2) = (unsigned short)(p0 & 0xffffu); *(LAS unsigned short*)(ot + crow(reg + 1, h) * 264 + (32 * w + r) * 2) = (unsigned short)(p0 >> 16);
                  *(LAS unsigned short*)(ot + (32 + crow(reg, h)) * 264 + (32 * w + r) * 2) = (unsigned short)(p1 & 0xffffu); *(LAS unsigned short*)(ot + (32 + crow(reg + 1, h)) * 264 + (32 * w + r) * 2) = (unsigned short)(p1 >> 16); } }
            { const float eg0 = e1[63] * 11.313708498984761f;
#define SC_LDK(dst, a) do { _Pragma("unroll") for (int q_ = 0; q_ < 4; ++q_) dst[q_] = frag8(buf + SC_KT + (32 * (a) + r) * 136 + (32 * (q_ >> 1) + 16 * (q_ & 1) + 4 * h) * 2); } while (0)
#define SC_MMK(a, src) do { _Pragma("unroll") for (int q_ = 0; q_ < 4; ++q_) Sx[a] = MFMA32(src[q_], Vb2[q_ >> 1][q_ & 1], Sx[a]); } while (0)
              bf16x8 fa[4], fb[4];
              SC_LDK(fa, 0); SC_LDK(fb, 1);
#pragma unroll
              for (int a = 0; a < 4; ++a)
#pragma unroll
                  for (int i = 0; i < 16; ++i) Sx[a][i] *= eg0;
              __builtin_amdgcn_sched_barrier(0);
              SC_MMK(0, fa); SC_LDK(fa, 2); __builtin_amdgcn_sched_barrier(0);
              SC_MMK(1, fb); SC_LDK(fb, 3); __builtin_amdgcn_sched_barrier(0);
              SC_MMK(2, fa); __builtin_amdgcn_sched_barrier(0);
              SC_MMK(3, fb); }
#undef SC_LDK
#undef SC_MMK
#undef SC_LD4
#undef SC_MM4
            __syncthreads();
        }
    }
}
__device__ __forceinline__ void moba_queue(Frame& F) {
    const unsigned x0 = xb_xcc_id() & 7u;
    for (unsigned k = 0; k < 8u;) {
        const unsigned x = (x0 + k) & 7u;
        __syncthreads();
        if (F.tid == 0) F.MISC[0] = __hip_atomic_fetch_add(F.ctl + CW_Q + 64 * x, 1u, __ATOMIC_RELAXED, __HIP_MEMORY_SCOPE_AGENT);
        __syncthreads();
        const unsigned q = F.MISC[0];
        if (q >= 64u) { ++k; continue; }
        const int bh = (int)((q >> 3) * 8u + x), jj = (int)(q & 7u); moba_unit(F, bh, 15 - jj); moba_unit(F, bh, jj);
    }
}
struct Args { const float* in[20]; float* out; unsigned char* ws; int ph_lo, ph_hi, li, pad; };
__global__ void __launch_bounds__(NWAVES * 64, 2) fwd(Args args) {
    extern __shared__ __attribute__((aligned(16))) unsigned char lds[];
    Frame F;
    F.lds = (LAS unsigned char*)lds;
    F.MISC = (volatile LAS unsigned*)(F.lds + MISC_OFF);
    F.tid = threadIdx.x; F.lane = F.tid & 63; F.wave = __builtin_amdgcn_readfirstlane(F.tid >> 6);
    F.G = gridDim.x; { const int bx = blockIdx.x; F.vcu = (F.G % 8 == 0) ? (bx % 8) * (F.G / 8) + bx / 8 : bx; }
    unsigned char* ws = args.ws;
    F.ctl = (unsigned*)(ws + WS_CTL); F.wsb = ws;
#pragma unroll
    for (int i = 0; i < 20; ++i) F.in[i] = args.in[i];
    F.out = args.out;
    for (int u = F.tid; u < (LDS_BYTES - MISC_OFF) / 4; u += NWAVES * 64) ((LAS unsigned*)(F.lds + MISC_OFF))[u] = 0u;
    __syncthreads();
    XcdBarrier bar; bar.bar = (unsigned*)(F.ctl + CW_BAR); bar.x = 0; bar.st = nullptr;
#if MK_SINGLE
    bar = xcd_barrier_post((unsigned*)(F.ctl + CW_BAR), F.MISC + 8);
#define GRID_BAR() xcd_barrier(bar)
#else
#define GRID_BAR() do { } while (0)
#endif
    const int lo = args.ph_lo, hi = args.ph_hi;
#define IN(k) (lo <= (k) && (k) < hi)
#define BOTH(k) (IN(k) && IN((k) + 1))
#ifndef PROBE_REP
#define PROBE_REP -1
#endif
#define REFRESH() do { int t_ = threadIdx.x; asm volatile("" : "+v"(t_)); F.tid = t_; F.lane = t_ & 63; F.wave = __builtin_amdgcn_readfirstlane(t_ >> 6); } while (0)
#define REP(k) _Pragma("unroll") for (int rep_ = 0; rep_ < ((PROBE_REP == (k)) ? 2 : 1); ++rep_)
    typedef pg8::bf16_t pb;
    REP(0) if (IN(0)) { REFRESH(); quant_ffn_gu(F, F.in[2], F.in[3], (float*)F.CM(0)); quant_wd(F, F.in[4], (float*)F.CMD(0)); rope_table(F);
        rms_rows_i8(F, F.in[0], F.in[1], (unsigned char*)F.H(), F.RS()); if (BOTH(0)) GRID_BAR(); }
    REP(1) if (IN(1)) { pg8::Gemm g{(const pb*)F.H(), (const pb*)F.WGU(), M, 2 * FF, DM}; pg8::StaticOrder S; S.init(M, 2 * FF, F.G, (int)blockIdx.x);
        pg8::EpiSwiGLUT<true> E{(pb*)F.ACT(), FF, F.RS(), (const float*)F.CM(0), F.RM(0)}; pg8::gemm_phase<pg8::EpiSwiGLUT<true>, pg8::StaticOrder, true, true, 3>(F.lds, g, S, E); if (BOTH(1)) GRID_BAR(); }
    REP(2) if (IN(2)) { REFRESH(); requant_rows(F, F.ACT(), F.ACT8(), F.RS()); GRID_BAR();
        pg8::Gemm g{(const pb*)F.ACT8(), (const pb*)F.WD(), M, DM, FF}; pg8::StaticOrder S; S.init(M, DM, F.G, (int)blockIdx.x);
        pg8::EpiResid8 E{F.in[0], F.out, DM, 0.5f, nullptr, nullptr, nullptr, F.RS(), (const float*)F.CMD(0)}; pg8::gemm_phase<pg8::EpiResid8, pg8::StaticOrder, true, true, 3>(F.lds, g, S, E); if (BOTH(2)) GRID_BAR(); }
    REP(3) if (IN(3)) { REFRESH(); convert_win(F); rms_rows_i8(F, F.out, F.in[5], F.H8(), F.RS(), F.H()); if (BOTH(3)) GRID_BAR(); }
    REP(4) if (IN(4)) { { pg8::Gemm g{(const pb*)F.H(), (const pb*)F.WB(), M, NPROJ, DM, 0}; pg8::StaticOrder S; S.init(M, NPROJ, F.G, (int)blockIdx.x);
          typedef pg8::EpiProjT<false, 0, PA_LD, 48, (long)((WS_PB - WS_BIG) / 2), PB_LD, 16, 0, PB_LD, 0> EP; EP E{(pb*)F.PA(), F.AB(), nullptr, nullptr}; pg8::gemm_phase<EP, pg8::StaticOrder, true, true>(F.lds, g, S, E); }
        { pg8::Gemm g{(const pb*)F.H8(), (const pb*)F.W8(), M, NGATE, DM, 0}; pg8::StaggerOrder S;
          { const int nb = (M / 256) * (NPROJ / 256), n8 = (M / 256) * (NGATE / 256), G = F.G; int c0 = nb % G, R0 = (n8 - 2 * (G - c0)) / G; if ((G & 7) || (c0 & 7) || R0 < 0) { c0 = 0; R0 = 0; }
            S.init2(M, NGATE, G, (int)blockIdx.x, R0, c0); }
          typedef pg8::EpiProjT<true, PA_MV, PA_LD, 8, (long)((WS_PB - WS_BIG) / 2) + PB_GG, PB_LD, 32, 0, PB_LD, 0> EP8; EP8 E{(pb*)F.PA(), F.AB(), F.RS(), (const float*)F.CMW()};
          pg8::gemm_phase<EP8, pg8::StaggerOrder, true, true, 3>(F.lds, g, S, E); }
        if (BOTH(4)) GRID_BAR(); }
    REP(5) if (IN(5)) { REFRESH(); prep_moba(F); prep_gdn(F); __syncthreads(); convert_branch(F); if (BOTH(5)) GRID_BAR(); }
    REP(6) if (IN(6)) { REFRESH(); gdn_local_phase(F); if (BOTH(6)) GRID_BAR(); }
    REP(7) if (IN(7)) { REFRESH(); for (int seq = blockIdx.x; seq < BATCH * 32; seq += F.G) gdn_scan_seq(F, seq); moba_queue(F); if (BOTH(7)) GRID_BAR(); }
    REP(8) if (IN(8)) { pg8::Gemm g{(const pb*)F.OG(), (const pb*)F.WBG(), M, DM, 4096}; pg8::StaticOrder S; S.init(M, DM, F.G, (int)blockIdx.x);
        pg8::EpiGate<true> E{(pb*)F.H(), DM, (const pb*)F.PB() + PB_GG, PB_LD}; pg8::gemm_phase<pg8::EpiGate<true>, pg8::StaticOrder, true, true>(F.lds, g, S, E); }
    REP(9) if (IN(9)) { pg8::Gemm g{(const pb*)F.OM(), (const pb*)F.WBM(), M, DM, 2048, 0x7b7b7b7b}; pg8::StaticOrder S; S.init(M, DM, F.G, (int)blockIdx.x);
        pg8::EpiGate<false> E{(pb*)F.H(), DM, (const pb*)F.PB() + PB_MG, PB_LD}; pg8::gemm_phase<pg8::EpiGate<false>, pg8::StaticOrder, true, true, true>(F.lds, g, S, E); if (BOTH(9)) GRID_BAR(); }
    REP(10) if (IN(10)) { pg8::Gemm g{(const pb*)F.H(), (const pb*)F.WO(), M, DM, DM}; pg8::StaticOrder S; S.init(M, DM, F.G, (int)blockIdx.x);
        pg8::EpiResid E{F.out, F.out, DM, 1.0f, nullptr, nullptr, nullptr, nullptr, nullptr}; pg8::gemm_phase<pg8::EpiResid, pg8::StaticOrder, true, true>(F.lds, g, S, E); if (BOTH(10)) GRID_BAR(); }
    REP(11) if (IN(11)) { REFRESH(); quant_ffn_gu(F, F.in[17], F.in[18], (float*)F.CM(1)); quant_wd(F, F.in[19], (float*)F.CMD(1)); rms_rows_i8(F, F.out, F.in[16], (unsigned char*)F.H(), F.RS()); if (BOTH(11)) GRID_BAR(); }
    REP(12) if (IN(12)) { pg8::Gemm g{(const pb*)F.H(), (const pb*)F.WGU(), M, 2 * FF, DM}; pg8::StaticOrder S; S.init(M, 2 * FF, F.G, (int)blockIdx.x);
        pg8::EpiSwiGLUT<true> E{(pb*)F.ACT(), FF, F.RS(), (const float*)F.CM(1), F.RM(1)}; pg8::gemm_phase<pg8::EpiSwiGLUT<true>, pg8::StaticOrder, true, true, 3>(F.lds, g, S, E); if (BOTH(12)) GRID_BAR(); }
    REP(13) if (IN(13)) { REFRESH(); requant_rows(F, F.ACT(), F.ACT8(), F.RS()); GRID_BAR();
        pg8::Gemm g{(const pb*)F.ACT8(), (const pb*)F.WD(), M, DM, FF}; pg8::StaticOrder S; S.init(M, DM, F.G, (int)blockIdx.x);
        pg8::EpiResid8 E{F.out, F.out, DM, 0.5f, nullptr, nullptr, nullptr, F.RS(), (const float*)F.CMD(1)}; pg8::gemm_phase<pg8::EpiResid8, pg8::StaticOrder, true, true, 3>(F.lds, g, S, E); }
#undef IN
#undef BOTH
}

extern "C" void kernel_launch(void* const* d_in, const int* in_sizes, int n_in, void* d_out, int out_size, void* d_ws, size_t ws_size, hipStream_t stream) {
    static int grid = 0;
    if (grid == 0) {
        if (n_in != 20 || out_size != M * DM || ws_size < WS_END) { fprintf(stderr, "kernel_launch: unexpected shapes (n_in %d out %d ws %zu)\n", n_in, out_size, ws_size); grid = -1; return; }
        int dev = 0, cus = 0;
        if (hipGetDevice(&dev) != hipSuccess || hipDeviceGetAttribute(&cus, hipDeviceAttributeMultiprocessorCount, dev) != hipSuccess) { grid = -1; return; }
        if (hipFuncSetAttribute((const void*)fwd, hipFuncAttributeMaxDynamicSharedMemorySize, LDS_BYTES) != hipSuccess) { fprintf(stderr, "kernel_launch: hipFuncSetAttribute failed\n"); grid = -1; return; }
        (void)hipGetLastError();
        grid = cus;
    }
    if (grid < 0) return;
    (void)hipMemsetAsync((char*)d_ws + WS_CTL, 0, CTL_ZERO_BYTES, stream);
    Args a{};
    for (int i = 0; i < 20; ++i) a.in[i] = (const float*)d_in[i];
    a.out = (float*)d_out; a.ws = (unsigned char*)d_ws;
#if MK_SINGLE
    a.ph_lo = 0; a.ph_hi = N_PHASES; a.li = 0;
    hipLaunchKernelGGL(fwd, dim3(grid), dim3(NWAVES * 64), LDS_BYTES, stream, a);
#else
    for (int p = 0; p < N_PHASES; ++p) { a.ph_lo = p; a.ph_hi = p + 1; a.li = p;
        hipLaunchKernelGGL(fwd, dim3(grid), dim3(NWAVES * 64), LDS_BYTES, stream, a); }
#endif
}
```

```cpp
#include <hip/hip_runtime.h>
#include <cstdio>
#include <cstdint>
#include <cmath>
namespace pg8 {
#define PG8_LAS __attribute__((address_space(3)))
typedef unsigned short bf16_t;
typedef short bf16x8 __attribute__((ext_vector_type(8)));
typedef float f32x4 __attribute__((ext_vector_type(4)));
typedef unsigned u32x4 __attribute__((ext_vector_type(4)));
constexpr int BM = 256, BK = 64, HALF = 128, HTB = HALF * BK * 2  , STAGE_BYTES = 8 * HTB, NXCD = 8, WGM = 8;

__host__ __device__ __forceinline__ int lds_byte(int r, int c) { const int st = (r >> 4) * 2 + (c >> 5), rr = r & 15, cc = c & 31, ob = rr * 64 + cc * 2; return st * 1024 + (ob ^ (((ob >> 9) & 1) << 5)); }
__host__ __device__ __forceinline__ void stage_rc(int b, int& R, int& C) { const int st = b / 1024, sb = b % 1024, swz = sb ^ (((sb >> 9) & 1) << 5); R = (st >> 1) * 16 + swz / 64; C = (st & 1) * 32 + (swz % 64) / 2; }
__host__ __device__ __forceinline__ int perm32(int rho) { const int n = rho >> 4, i = rho & 15; return 8 * (i >> 2) + 4 * n + (i & 3); }

struct Unit { int pm, pn; };
struct Gemm { const bf16_t* A; const bf16_t* Bt; int M, N, K; int sA; int nb16; };

struct StaticOrder {
    int nM, nN, nwg, G, c;
    __host__ __device__ void init(int M, int N, int G_, int c_) { nM = M / BM; nN = N / BM; nwg = nM * nN; G = G_; c = c_; }
    __host__ __device__ bool next(int i, Unit& u) const {
        const long L = (long)i * G + c; if (L >= nwg) return false;
        int wgid = (int)L; { const int q = nwg / NXCD, r = nwg % NXCD, xcd = wgid % NXCD, off = wgid / NXCD; wgid = (xcd < r ? xcd * (q + 1) : r * (q + 1) + (xcd - r) * q) + off; }
        const int nig = WGM * nN, gid = wgid / nig, fm = gid * WGM, gsz = (nM - fm) < WGM ? (nM - fm) : WGM;
        u.pm = fm + ((wgid % nig) % gsz); u.pn = (wgid % nig) / gsz; return true;
    }
    __device__ __forceinline__ void a_ready(const Unit&) const {}
    __device__ __forceinline__ void done(const Unit&) const {}
};
struct StaggerOrder : StaticOrder {
    int R0, c0;
    __host__ __device__ void init2(int M, int N, int G_, int c_, int R0_, int c0_) { init(M, N, G_, c_); R0 = R0_; c0 = c0_; }
    __host__ __device__ bool next(int i, Unit& u) const {
        long L;
        if (i < R0) L = (long)i * G + c; else { if (c < c0) return false; L = (long)R0 * G + (long)(i - R0) * (G - c0) + (c - c0); }
        if (L >= nwg) return false;
        int wgid = (int)L; { const int q = nwg / NXCD, r = nwg % NXCD, xcd = wgid % NXCD, off = wgid / NXCD; wgid = (xcd < r ? xcd * (q + 1) : r * (q + 1) + (xcd - r) * q) + off; }
        const int nig = WGM * nN, gid = wgid / nig, fm = gid * WGM, gsz = (nM - fm) < WGM ? (nM - fm) : WGM;
        u.pm = fm + ((wgid % nig) % gsz); u.pn = (wgid % nig) / gsz; return true;
    }
};
__device__ __forceinline__ unsigned cvt_pk_bf16(float lo, float hi) { unsigned r; asm volatile("v_cvt_pk_bf16_f32 %0, %1, %2" : "=v"(r) : "v"(lo), "v"(hi)); return r; }
__device__ __forceinline__ float sigmoid_fast(float x) { return __builtin_amdgcn_rcpf(1.0f + __expf(-x)); }
__device__ __forceinline__ float bf_lo(unsigned w) { return __uint_as_float(w << 16); }
__device__ __forceinline__ float bf_hi(unsigned w) { return __uint_as_float(w & 0xffff0000u); }
__device__ __forceinline__ float row_rstd(const unsigned long long* SS, size_t row) { const float s = (float)SS[row] * (1.0f / 16777216.0f); return 1.0f / sqrtf(s * (1.0f / 4096.0f) + 1e-6f); }
__device__ __forceinline__ float fq_sum(float v) {
    auto a = __builtin_amdgcn_permlane16_swap(__float_as_uint(v), __float_as_uint(v), false, false); v = __uint_as_float(a[0]) + __uint_as_float(a[1]);
    auto b = __builtin_amdgcn_permlane32_swap(__float_as_uint(v), __float_as_uint(v), false, false); return __uint_as_float(b[0]) + __uint_as_float(b[1]); }
__device__ __forceinline__ unsigned pk4_e4m3(float a, float b, float c, float d) { int w = 0; w = __builtin_amdgcn_cvt_pk_fp8_f32(a, b, w, false); w = __builtin_amdgcn_cvt_pk_fp8_f32(c, d, w, true); return (unsigned)w; }
__device__ __forceinline__ void had32_lanes(float (&x)[8], int fq) {
#pragma unroll
    for (int h = 1; h < 8; h <<= 1)
#pragma unroll
        for (int i = 0; i < 8; ++i) if (!(i & h)) { const float a = x[i], b = x[i + h]; x[i] = a + b; x[i + h] = a - b; }
#pragma unroll
    for (int i = 0; i < 8; ++i) { auto a = __builtin_amdgcn_permlane16_swap(__float_as_uint(x[i]), __float_as_uint(x[i]), false, false);
        const float lo = __uint_as_float(a[0]), hi = __uint_as_float(a[1]); x[i] = (fq & 1) ? lo - hi : lo + hi; }
#pragma unroll
    for (int i = 0; i < 8; ++i) { auto b = __builtin_amdgcn_permlane32_swap(__float_as_uint(x[i]), __float_as_uint(x[i]), false, false);
        const float lo = __uint_as_float(b[0]), hi = __uint_as_float(b[1]); x[i] = ((fq & 2) ? lo - hi : lo + hi) * 0.17677669529663687f; }
}
__device__ __forceinline__ float fq_max(float v) {
    auto a = __builtin_amdgcn_permlane16_swap(__float_as_uint(v), __float_as_uint(v), false, false); v = fmaxf(__uint_as_float(a[0]), __uint_as_float(a[1]));
    auto b = __builtin_amdgcn_permlane32_swap(__float_as_uint(v), __float_as_uint(v), false, false); return fmaxf(__uint_as_float(b[0]), __uint_as_float(b[1])); }
template <bool I8, bool HAD = false> struct EpiSwiGLUT {
    static constexpr bool PERM = true, AFTER_DRAIN = false;
    bf16_t* O; int ldc; const float* RS; const float* CS; unsigned* RM;
    __device__ __forceinline__ void operator()(const f32x4 (&acc)[2][2][4][2], const Unit& u, int wr, int wc, int fr, int fq) const {
        const unsigned row0 = u.pm * BM + wr * 64 + fr; const int col0 = u.pn * HALF + wc * 32 + 8 * fq;
        float rs[8]; f32x4 cg0, cg1, cu0, cu1;
        if constexpr (I8) {
#pragma unroll
            for (int i = 0; i < 8; ++i) rs[i] = RS[row0 + (i >> 2) * HALF + (i & 3) * 16] * (1.0f / 127.0f);
            const float* cp = CS + u.pn * BM + wc * 32 + 8 * fq; cg0 = *(const f32x4*)cp; cg1 = *(const f32x4*)(cp + 4); cu0 = *(const f32x4*)(cp + HALF); cu1 = *(const f32x4*)(cp + HALF + 4);
        }
#pragma unroll
        for (int ai = 0; ai < 2; ++ai)
#pragma unroll
            for (int m = 0; m < 4; ++m) { const unsigned row = row0 + ai * HALF + m * 16; bf16_t* rowp = O + (size_t)row * ldc + col0;
                float x[8];
#pragma unroll
                for (int j = 0; j < 4; ++j) { float g0, g1, u0, u1;
                    if constexpr (I8) { const float r = rs[ai * 4 + m];
                        g0 = (float)__float_as_int(acc[ai][0][m][0][j]) * (r * cg0[j]); g1 = (float)__float_as_int(acc[ai][0][m][1][j]) * (r * cg1[j]);
                        u0 = (float)__float_as_int(acc[ai][1][m][0][j]) * (r * cu0[j]); u1 = (float)__float_as_int(acc[ai][1][m][1][j]) * (r * cu1[j]); }
                    else { g0 = acc[ai][0][m][0][j]; g1 = acc[ai][0][m][1][j]; u0 = acc[ai][1][m][0][j]; u1 = acc[ai][1][m][1][j]; }
                    x[j] = g0 * sigmoid_fast(g0) * u0; x[4 + j] = g1 * sigmoid_fast(g1) * u1; }
                if constexpr (HAD) had32_lanes(x, fq);
                u32x4 w; w.x = cvt_pk_bf16(x[0], x[1]); w.y = cvt_pk_bf16(x[2], x[3]); w.z = cvt_pk_bf16(x[4], x[5]); w.w = cvt_pk_bf16(x[6], x[7]); *(u32x4*)rowp = w;
                if constexpr (HAD) {
                    float mx = fmaxf(fmaxf(fmaxf(fabsf(x[0]), fabsf(x[1])), fmaxf(fabsf(x[2]), fabsf(x[3]))), fmaxf(fmaxf(fabsf(x[4]), fabsf(x[5])), fmaxf(fabsf(x[6]), fabsf(x[7]))));
                    mx = fq_max(mx);
                    if (fq == 0) atomicMax(RM + row, __float_as_uint(mx)); } }
    }
};
template <bool NORM, bool FP8COPY, bool I8 = false> struct EpiResidT {
    static constexpr bool PERM = true, AFTER_DRAIN = false;
    const float* base; float* out; int ldc; float scale; bf16_t* Hb; unsigned char* H8; unsigned long long* SS; const float* RS; const float* CS;
    __device__ __forceinline__ void operator()(const f32x4 (&acc)[2][2][4][2], const Unit& u, int wr, int wc, int fr, int fq) const {
        const unsigned row0 = u.pm * BM + wr * 64 + fr, col0 = u.pn * BM + wc * 32 + 8 * fq;
        const char* bp = (const char*)base; char* op = (char*)out; char* hp = (char*)Hb; char* h8 = (char*)H8; char* sp = (char*)SS;
        f32x4 cb[4], nb[4]; float rs[8]; f32x4 cs[2][2];
        if constexpr (I8) {
#pragma unroll
            for (int i = 0; i < 8; ++i) rs[i] = RS[row0 + (i >> 2) * HALF + (i & 3) * 16] * (scale / 127.0f);
            const float* cp = CS + col0; cs[0][0] = *(const f32x4*)cp; cs[0][1] = *(const f32x4*)(cp + 4); cs[1][0] = *(const f32x4*)(cp + HALF); cs[1][1] = *(const f32x4*)(cp + HALF + 4);
        }
#define EPI_LD(dst, i) do { const unsigned o_ = ((row0 + ((i) >> 2) * HALF + ((i) & 3) * 16) * (unsigned)ldc + col0) * 4u; \
            dst[0] = __builtin_nontemporal_load((const f32x4*)(bp + o_)); dst[1] = __builtin_nontemporal_load((const f32x4*)(bp + (o_ + 16u))); dst[2] = __builtin_nontemporal_load((const f32x4*)(bp + (o_ + 512u))); dst[3] = __builtin_nontemporal_load((const f32x4*)(bp + (o_ + 528u))); } while (0)
        EPI_LD(cb, 0);
#pragma unroll
        for (int i = 0; i < 8; ++i) { const int ai = i >> 2, m = i & 3; const unsigned row = row0 + ai * HALF + m * 16, off = row * (unsigned)ldc + col0; float ss = 0.f;
            if (i + 1 < 8) EPI_LD(nb, i + 1);
#pragma unroll
            for (int bj = 0; bj < 2; ++bj) { const unsigned o = off + bj * HALF;
                f32x4 v0, v1;
                if constexpr (I8) { const float r = rs[i];
#pragma unroll
                    for (int j = 0; j < 4; ++j) { const float a0 = acc[ai][bj][m][0][j], a1 = acc[ai][bj][m][1][j];
                        v0[j] = cb[2 * bj][j] + (float)__float_as_int(a0) * (r * cs[bj][0][j]); v1[j] = cb[2 * bj + 1][j] + (float)__float_as_int(a1) * (r * cs[bj][1][j]); } }
                else { v0 = cb[2 * bj] + acc[ai][bj][m][0] * scale; v1 = cb[2 * bj + 1] + acc[ai][bj][m][1] * scale; }
                *(f32x4*)(op + o * 4u) = v0; *(f32x4*)(op + (o * 4u + 16u)) = v1;
                if constexpr (NORM) {
                    ss += (v0[0] * v0[0] + v0[1] * v0[1]) + (v0[2] * v0[2] + v0[3] * v0[3]) + (v1[0] * v1[0] + v1[1] * v1[1]) + (v1[2] * v1[2] + v1[3] * v1[3]);
                    u32x4 w; w.x = cvt_pk_bf16(v0[0], v0[1]); w.y = cvt_pk_bf16(v0[2], v0[3]); w.z = cvt_pk_bf16(v1[0], v1[1]); w.w = cvt_pk_bf16(v1[2], v1[3]);
                    *(u32x4*)(hp + o * 2u) = w;
                    if constexpr (FP8COPY) { typedef unsigned u32x2 __attribute__((ext_vector_type(2))); u32x2 w8; w8.x = pk4_e4m3(v0[0], v0[1], v0[2], v0[3]); w8.y = pk4_e4m3(v1[0], v1[1], v1[2], v1[3]); *(u32x2*)(h8 + o) = w8; } } }
            if constexpr (NORM) {
                ss = fq_sum(ss) * 16777216.0f;
                const unsigned hi = (unsigned)(ss * 2.3283064365386963e-10f), lo = (unsigned)(ss - (float)hi * 4294967296.0f);
                if (fq == 0) atomicAdd((unsigned long long*)(sp + row * 8u), ((unsigned long long)hi << 32) | lo); }
#pragma unroll
            for (int q = 0; q < 4; ++q) cb[q] = nb[q]; }
#undef EPI_LD
    }
};
typedef EpiResidT<false, false> EpiResid;
typedef EpiResidT<false, false, true> EpiResid8;
template <bool FP8COPY> using EpiResidN = EpiResidT<true, FP8COPY>;
template <bool I8, long oA, int ldA, int nA, long oB, int ldB, int nB, long oC, int ldC, int nC> struct EpiProjT {
    static constexpr bool PERM = true, AFTER_DRAIN = false;
    bf16_t* base; float* AB; const float* RS; const float* CS;
    __device__ __forceinline__ void operator()(const f32x4 (&acc)[2][2][4][2], const Unit& u, int wr, int wc, int fr, int fq) const {
        const int row0 = u.pm * BM + wr * 64 + fr;
        if (u.pn < nA + nB + nC) {
            const int sg = u.pn < nA ? 0 : (u.pn < nA + nB ? 1 : 2); bf16_t* O = base + (sg == 0 ? oA : (sg == 1 ? oB : oC)); const int ldc = sg == 0 ? ldA : (sg == 1 ? ldB : ldC);
            const int col0 = (sg == 0 ? u.pn : (sg == 1 ? u.pn - nA : u.pn - nA - nB)) * BM + wc * 32 + 8 * fq;
            float rs[8]; f32x4 cs[2][2];
            if constexpr (I8) {
#pragma unroll
                for (int i = 0; i < 8; ++i) rs[i] = RS[row0 + (i >> 2) * HALF + (i & 3) * 16] * (1.0f / 127.0f);
                const float* cp = CS + u.pn * BM + wc * 32 + 8 * fq; cs[0][0] = *(const f32x4*)cp; cs[0][1] = *(const f32x4*)(cp + 4); cs[1][0] = *(const f32x4*)(cp + HALF); cs[1][1] = *(const f32x4*)(cp + HALF + 4);
            }
#pragma unroll
            for (int ai = 0; ai < 2; ++ai)
#pragma unroll
                for (int m = 0; m < 4; ++m) { const size_t row = (size_t)(row0 + ai * HALF + m * 16); bf16_t* rowp = O + row * ldc + col0;
#pragma unroll
                    for (int bj = 0; bj < 2; ++bj) { f32x4 v0 = acc[ai][bj][m][0], v1 = acc[ai][bj][m][1];
                        if constexpr (I8) { const float r = rs[ai * 4 + m];
#pragma unroll
                            for (int j = 0; j < 4; ++j) { const float a0 = v0[j], a1 = v1[j]; v0[j] = (float)__float_as_int(a0) * (r * cs[bj][0][j]); v1[j] = (float)__float_as_int(a1) * (r * cs[bj][1][j]); } }
                        u32x4 w; w.x = cvt_pk_bf16(v0[0], v0[1]); w.y = cvt_pk_bf16(v0[2], v0[3]); w.z = cvt_pk_bf16(v1[0], v1[1]); w.w = cvt_pk_bf16(v1[2], v1[3]);
                        *(u32x4*)(rowp + bj * HALF) = w; } }
        } else if (wc < 2) {
#pragma unroll
            for (int ai = 0; ai < 2; ++ai)
#pragma unroll
                for (int m = 0; m < 4; ++m) { const size_t row = (size_t)(row0 + ai * HALF + m * 16); float* p = AB + row * 64 + wc * 32 + 8 * fq;
                    *(f32x4*)p = acc[ai][0][m][0]; *(f32x4*)(p + 4) = acc[ai][0][m][1]; }
        }
    }
};
template <bool FIRST> struct EpiGate {
    static constexpr bool PERM = true, AFTER_DRAIN = false;
    bf16_t* Y; int ldy; const bf16_t* gate; int ldg;
    __device__ __forceinline__ void operator()(const f32x4 (&acc)[2][2][4][2], const Unit& u, int wr, int wc, int fr, int fq) const {
        const unsigned row0 = u.pm * BM + wr * 64 + fr, col0 = u.pn * BM + wc * 32 + 8 * fq;
        const char* gp = (const char*)gate; char* yb = (char*)Y;
        u32x4 cg[2], ng[2], cy[2], ny[2];
#define EPI_LD(dg, dy, i) do { const unsigned r_ = row0 + ((i) >> 2) * HALF + ((i) & 3) * 16; const unsigned og_ = (r_ * (unsigned)ldg + col0) * 2u, oy_ = (r_ * (unsigned)ldy + col0) * 2u; \
            dg[0] = *(const u32x4*)(gp + og_); dg[1] = *(const u32x4*)(gp + (og_ + 256u)); if (!FIRST) { dy[0] = *(const u32x4*)(yb + oy_); dy[1] = *(const u32x4*)(yb + (oy_ + 256u)); } } while (0)
        EPI_LD(cg, cy, 0);
#pragma unroll
        for (int i = 0; i < 8; ++i) { const int ai = i >> 2, m = i & 3; const unsigned row = row0 + ai * HALF + m * 16;
            if (i + 1 < 8) EPI_LD(ng, ny, i + 1);
#pragma unroll
            for (int bj = 0; bj < 2; ++bj) { const u32x4 gw = cg[bj];
                f32x4 s0, s1; s0[0] = sigmoid_fast(bf_lo(gw.x)); s0[1] = sigmoid_fast(bf_hi(gw.x)); s0[2] = sigmoid_fast(bf_lo(gw.y)); s0[3] = sigmoid_fast(bf_hi(gw.y));
                s1[0] = sigmoid_fast(bf_lo(gw.z)); s1[1] = sigmoid_fast(bf_hi(gw.z)); s1[2] = sigmoid_fast(bf_lo(gw.w)); s1[3] = sigmoid_fast(bf_hi(gw.w));
                f32x4 v0 = acc[ai][bj][m][0] * s0, v1 = acc[ai][bj][m][1] * s1;
                if (!FIRST) { const u32x4 p = cy[bj]; v0[0] += bf_lo(p.x); v0[1] += bf_hi(p.x); v0[2] += bf_lo(p.y); v0[3] += bf_hi(p.y); v1[0] += bf_lo(p.z); v1[1] += bf_hi(p.z); v1[2] += bf_lo(p.w); v1[3] += bf_hi(p.w); }
                u32x4 w; w.x = cvt_pk_bf16(v0[0], v0[1]); w.y = cvt_pk_bf16(v0[2], v0[3]); w.z = cvt_pk_bf16(v1[0], v1[1]); w.w = cvt_pk_bf16(v1[2], v1[3]);
                *(u32x4*)(yb + ((row * (unsigned)ldy + col0) * 2u + bj * 256u)) = w; }
#pragma unroll
            for (int q = 0; q < 2; ++q) { cg[q] = ng[q]; if (!FIRST) cy[q] = ny[q]; } }
#undef EPI_LD
    }
};
template <class Epi, class Sched, bool ALIGN_EPI = false, bool SP2 = false, int FM = 0>
__device__ __forceinline__ void gemm_phase(PG8_LAS unsigned char* lds, const Gemm g, const Sched& S, const Epi& E) {
    int tid_o = threadIdx.x; asm volatile("" : "+v"(tid_o));
    const int tid = tid_o, wid = __builtin_amdgcn_readfirstlane(tid >> 6), lane = tid & 63, wr = wid >> 2, wc = wid & 3, fr = lane & 15, fq = lane >> 4;
    constexpr bool F8 = (FM == 1 || FM == 2); static_assert(FM != 2 || SP2, "mixed rows: SP2 only");
    constexpr int ES = (FM == 1 || FM == 3) ? 1 : 2;
    const int K = g.K, nt = K * ES / (BK * 2);
    const int f8_sw = 0x79797979, f8_sh = g.sA;
    unsigned voffA[2], voffB[2];
#pragma unroll
    for (int i = 0; i < 2; ++i) { int R, C; stage_rc(tid * 16 + i * 8192, R, C); const int Rb = Epi::PERM ? ((R & ~31) + perm32(R & 31)) : R;
        voffA[i] = (unsigned)(R * K) * ES + (unsigned)C * 2u; voffB[i] = (unsigned)(Rb * K) * ES + (unsigned)C * 2u; }
    const size_t kstep = (size_t)(BK * 2);
    const size_t hstep = (size_t)HALF * K * ES;
    const size_t tstep = 2 * hstep;
    const unsigned ldsw = (unsigned)wid * 1024u;
    const int aoff = lds_byte(wr * 64 + fr, fq * 8), boff = lds_byte(wc * 32 + fr, fq * 8);
#define PG8_SA(b, h) (((b) * 2 + (h)) * HTB)
#define PG8_SB(b, h) ((4 + (b) * 2 + (h)) * HTB)
#define PG8_STAGE(bufoff, gbase, voff) do { _Pragma("unroll") for (int _i = 0; _i < 2; ++_i) \
        __builtin_amdgcn_global_load_lds((const unsigned*)((const char*)(gbase) + (voff)[_i]), (PG8_LAS unsigned*)(lds + (bufoff) + ldsw + _i * 8192), 16, 0, 0); } while (0)
#define PG8_LDA(dst, b, h) do { _Pragma("unroll") for (int m = 0; m < 4; ++m) _Pragma("unroll") for (int k = 0; k < 2; ++k) dst[m][k] = *(const PG8_LAS bf16x8*)(lds + PG8_SA(b, h) + aoff + m * 2048 + k * 1024); } while (0)
#define PG8_LDB(dst, b, h) do { _Pragma("unroll") for (int n = 0; n < 2; ++n) _Pragma("unroll") for (int k = 0; k < 2; ++k) dst[n][k] = *(const PG8_LAS bf16x8*)(lds + PG8_SB(b, h) + boff + n * 2048 + k * 1024); } while (0)
#define PG8_MMA(ai, bj, At, Bt, F8X) do { __builtin_amdgcn_s_setprio(1); \
        if constexpr ((int)(F8X) == 1) { typedef int v4i_ __attribute__((ext_vector_type(4))); typedef int v8i_ __attribute__((ext_vector_type(8))); \
            const v8i_ b80 = __builtin_shufflevector(__builtin_bit_cast(v4i_, Bt[0][0]), __builtin_bit_cast(v4i_, Bt[0][1]), 0, 1, 2, 3, 4, 5, 6, 7); \
            const v8i_ b81 = __builtin_shufflevector(__builtin_bit_cast(v4i_, Bt[1][0]), __builtin_bit_cast(v4i_, Bt[1][1]), 0, 1, 2, 3, 4, 5, 6, 7); \
            const v8i_ a80 = __builtin_shufflevector(__builtin_bit_cast(v4i_, At[0][0]), __builtin_bit_cast(v4i_, At[0][1]), 0, 1, 2, 3, 4, 5, 6, 7); \
            const v8i_ a81 = __builtin_shufflevector(__builtin_bit_cast(v4i_, At[1][0]), __builtin_bit_cast(v4i_, At[1][1]), 0, 1, 2, 3, 4, 5, 6, 7); \
            const v8i_ a82 = __builtin_shufflevector(__builtin_bit_cast(v4i_, At[2][0]), __builtin_bit_cast(v4i_, At[2][1]), 0, 1, 2, 3, 4, 5, 6, 7); \
            const v8i_ a83 = __builtin_shufflevector(__builtin_bit_cast(v4i_, At[3][0]), __builtin_bit_cast(v4i_, At[3][1]), 0, 1, 2, 3, 4, 5, 6, 7); \
              \
            asm volatile("s_nop 1\n\t" \
                "v_mfma_scale_f32_16x16x128_f8f6f4 %0, %8, %10, %0, %14, %15 op_sel_hi:[0,0,0]\n\tv_mfma_scale_f32_16x16x128_f8f6f4 %1, %9, %10, %1, %14, %15 op_sel_hi:[0,0,0]\n\t" \
                "v_mfma_scale_f32_16x16x128_f8f6f4 %2, %8, %11, %2, %14, %15 op_sel_hi:[0,0,0]\n\tv_mfma_scale_f32_16x16x128_f8f6f4 %3, %9, %11, %3, %14, %15 op_sel_hi:[0,0,0]\n\t" \
                "v_mfma_scale_f32_16x16x128_f8f6f4 %4, %8, %12, %4, %14, %15 op_sel_hi:[0,0,0]\n\tv_mfma_scale_f32_16x16x128_f8f6f4 %5, %9, %12, %5, %14, %15 op_sel_hi:[0,0,0]\n\t" \
                "v_mfma_scale_f32_16x16x128_f8f6f4 %6, %8, %13, %6, %14, %15 op_sel_hi:[0,0,0]\n\tv_mfma_scale_f32_16x16x128_f8f6f4 %7, %9, %13, %7, %14, %15 op_sel_hi:[0,0,0]" \
                : "+v"(acc[ai][bj][0][0]), "+v"(acc[ai][bj][0][1]), "+v"(acc[ai][bj][1][0]), "+v"(acc[ai][bj][1][1]), "+v"(acc[ai][bj][2][0]), "+v"(acc[ai][bj][2][1]), "+v"(acc[ai][bj][3][0]), "+v"(acc[ai][bj][3][1]) \
                : "v"(b80), "v"(b81), "v"(a80), "v"(a81), "v"(a82), "v"(a83), "v"(f8_sw), "v"(f8_sh)); } \
        else if constexpr ((int)(F8X) == 3) { typedef int v4i_ __attribute__((ext_vector_type(4))); \
            _Pragma("unroll") for (int m = 0; m < 4; ++m) _Pragma("unroll") for (int n = 0; n < 2; ++n) _Pragma("unroll") for (int k = 0; k < 2; ++k) \
            acc[ai][bj][m][n] = __builtin_bit_cast(f32x4, __builtin_amdgcn_mfma_i32_16x16x64_i8(__builtin_bit_cast(v4i_, Bt[n][k]), __builtin_bit_cast(v4i_, At[m][k]), __builtin_bit_cast(v4i_, acc[ai][bj][m][n]), 0, 0, 0)); } \
        else { _Pragma("unroll") for (int m = 0; m < 4; ++m) _Pragma("unroll") for (int n = 0; n < 2; ++n) _Pragma("unroll") for (int k = 0; k < 2; ++k) \
            acc[ai][bj][m][n] = __builtin_amdgcn_mfma_f32_16x16x32_bf16(Bt[n][k], At[m][k], acc[ai][bj][m][n], 0, 0, 0); } \
        __builtin_amdgcn_s_setprio(0); } while (0)
#define PG8_WAIT_V(n) asm volatile("s_waitcnt vmcnt(" #n ")" ::: "memory")
#define PG8_WAIT_L(n) asm volatile("s_waitcnt lgkmcnt(" #n ")" ::: "memory")
#define PG8_BAR __builtin_amdgcn_s_barrier()
#define PG8_SCHED __builtin_amdgcn_sched_barrier(0)
#define PG8_KT2(F8X) do { \
            PG8_LDB(B0, 0, 0); PG8_LDB(B1, 0, 1); PG8_SCHED; PG8_LDA(At, 0, 0); PG8_STAGE(PG8_SA(1, 1), a1 + hstep, voffA); \
            PG8_WAIT_V(8); PG8_WAIT_L(0); PG8_BAR; PG8_MMA(0, 0, At, B0, F8X); PG8_MMA(0, 1, At, B1, F8X); PG8_BAR; PG8_SCHED; \
            PG8_LDA(At, 0, 1); PG8_STAGE(PG8_SB(0, 0), b2, voffB); PG8_STAGE(PG8_SB(0, 1), b2 + hstep, voffB); PG8_STAGE(PG8_SA(0, 0), a2, voffA); \
            PG8_WAIT_V(8); PG8_WAIT_L(0); PG8_BAR; PG8_MMA(1, 0, At, B0, F8X); PG8_MMA(1, 1, At, B1, F8X); PG8_BAR; PG8_SCHED; \
            PG8_LDB(B0, 1, 0); PG8_LDB(B1, 1, 1); PG8_SCHED; PG8_LDA(At, 1, 0); PG8_STAGE(PG8_SA(0, 1), a2 + hstep, voffA); \
            PG8_WAIT_V(8); PG8_WAIT_L(0); PG8_BAR; PG8_MMA(0, 0, At, B0, F8X); PG8_MMA(0, 1, At, B1, F8X); PG8_BAR; PG8_SCHED; \
            PG8_LDA(At, 1, 1); PG8_STAGE(PG8_SB(1, 0), b3, voffB); PG8_STAGE(PG8_SB(1, 1), b3 + hstep, voffB); PG8_STAGE(PG8_SA(1, 0), a3, voffA); \
            PG8_WAIT_V(8); PG8_WAIT_L(0); PG8_BAR; PG8_MMA(1, 0, At, B0, F8X); PG8_MMA(1, 1, At, B1, F8X); PG8_BAR; PG8_SCHED; } while (0)
    Unit cur, nxt; int ui = 0;
    if (!S.next(0, cur)) return;
    f32x4 acc[2][2][4][2];
#pragma unroll
    for (int a = 0; a < 2; ++a)
#pragma unroll
        for (int b = 0; b < 2; ++b)
#pragma unroll
            for (int m = 0; m < 4; ++m)
#pragma unroll
                for (int n = 0; n < 2; ++n) acc[a][b][m][n] = (f32x4){0.f, 0.f, 0.f, 0.f};
    bf16x8 At[4][2], B0[2][2], B1[2][2];
    const char* cA = (const char*)g.A + (size_t)cur.pm * tstep; const char* cB = (const char*)g.Bt + (size_t)cur.pn * tstep;
    S.a_ready(cur);
    if constexpr (SP2) {
        PG8_STAGE(PG8_SB(0, 0), cB, voffB); PG8_STAGE(PG8_SB(0, 1), cB + hstep, voffB); PG8_STAGE(PG8_SA(0, 0), cA, voffA); PG8_STAGE(PG8_SA(0, 1), cA + hstep, voffA);
        if (wr == 1) PG8_BAR;
        PG8_WAIT_V(2); PG8_BAR;
        PG8_STAGE(PG8_SB(1, 0), cB + kstep, voffB); PG8_STAGE(PG8_SA(1, 0), cA + kstep, voffA); PG8_STAGE(PG8_SB(1, 1), cB + hstep + kstep, voffB);
        PG8_WAIT_V(6); PG8_BAR;
    } else {
        PG8_STAGE(PG8_SB(0, 0), cB, voffB); PG8_STAGE(PG8_SA(0, 0), cA, voffA); PG8_STAGE(PG8_SB(0, 1), cB + hstep, voffB); PG8_STAGE(PG8_SA(0, 1), cA + hstep, voffA);
        if (wr == 1) PG8_BAR;
        PG8_WAIT_V(4); PG8_BAR;
        PG8_STAGE(PG8_SB(1, 0), cB + kstep, voffB); PG8_STAGE(PG8_SA(1, 0), cA + kstep, voffA); PG8_STAGE(PG8_SB(1, 1), cB + hstep + kstep, voffB);
        PG8_WAIT_V(6); PG8_BAR;
    }
    for (;;) {
        const bool has_next = S.next(ui + 1, nxt);
        const char* nA = has_next ? (const char*)g.A + (size_t)nxt.pm * tstep : cA; const char* nB = has_next ? (const char*)g.Bt + (size_t)nxt.pn * tstep : cB;
        int t = 0;
        if constexpr (FM == 2) {
            for (; t < g.nb16; t += 2) {
                const char* a1 = cA + (size_t)(t + 1) * kstep; const char* a2 = cA + (size_t)(t + 2) * kstep; const char* b2 = cB + (size_t)(t + 2) * kstep;
                const char* a3 = a2 + kstep; const char* b3 = b2 + kstep;
                PG8_KT2(false);
            }
        }
        for (; t < nt; t += 2) {
            const bool last = (t == nt - 2);
            const char* a1 = cA + (size_t)(t + 1) * kstep;
            const char* a2 = last ? nA : cA + (size_t)(t + 2) * kstep; const char* b2 = last ? nB : cB + (size_t)(t + 2) * kstep;
            const char* a3 = a2 + kstep; const char* b3 = b2 + kstep;
            if (last && has_next) S.a_ready(nxt);
            if constexpr (SP2) {
                PG8_KT2(FM == 2 ? 1 : FM);
            } else {
            PG8_LDB(B0, 0, 0); PG8_SCHED; PG8_LDA(At, 0, 0); PG8_STAGE(PG8_SA(1, 1), a1 + hstep, voffA);
            PG8_WAIT_L(8); PG8_BAR; PG8_WAIT_L(0); PG8_MMA(0, 0, At, B0, FM); PG8_BAR; PG8_SCHED;
            PG8_LDB(B1, 0, 1); PG8_STAGE(PG8_SB(0, 0), b2, voffB);
            PG8_BAR; PG8_WAIT_L(0); PG8_MMA(0, 1, At, B1, FM); PG8_BAR;
            PG8_LDA(At, 0, 1); PG8_STAGE(PG8_SA(0, 0), a2, voffA);
            PG8_BAR; PG8_WAIT_L(0); PG8_MMA(1, 0, At, B0, FM); PG8_BAR; PG8_SCHED;
            PG8_STAGE(PG8_SB(0, 1), b2 + hstep, voffB);
            PG8_WAIT_V(6); PG8_BAR; PG8_MMA(1, 1, At, B1, FM); PG8_BAR;
            PG8_LDB(B0, 1, 0); PG8_SCHED; PG8_LDA(At, 1, 0); PG8_STAGE(PG8_SA(0, 1), a2 + hstep, voffA);
            PG8_WAIT_L(8); PG8_BAR; PG8_WAIT_L(0); PG8_MMA(0, 0, At, B0, FM); PG8_BAR; PG8_SCHED;
            PG8_LDB(B1, 1, 1); PG8_STAGE(PG8_SB(1, 0), b3, voffB);
            PG8_BAR; PG8_WAIT_L(0); PG8_MMA(0, 1, At, B1, FM); PG8_BAR;
            PG8_LDA(At, 1, 1); PG8_STAGE(PG8_SA(1, 0), a3, voffA);
            PG8_BAR; PG8_WAIT_L(0); PG8_MMA(1, 0, At, B0, FM); PG8_BAR; PG8_SCHED;
            PG8_STAGE(PG8_SB(1, 1), b3 + hstep, voffB);
            PG8_WAIT_V(6); PG8_BAR; PG8_MMA(1, 1, At, B1, FM); PG8_BAR;
            }
        }
        if constexpr (F8) asm volatile("s_nop 15\n\ts_nop 15" ::: "memory");
        if constexpr (ALIGN_EPI) { if (wr == 0) PG8_BAR; }
        if constexpr (!Epi::AFTER_DRAIN) { E(acc, cur, wr, wc, fr, fq); S.done(cur); }
        if (!has_next) break;
#pragma unroll
        for (int a = 0; a < 2; ++a)
#pragma unroll
            for (int b = 0; b < 2; ++b)
#pragma unroll
                for (int m = 0; m < 4; ++m)
#pragma unroll
                    for (int n = 0; n < 2; ++n) acc[a][b][m][n] = (f32x4){0.f, 0.f, 0.f, 0.f};
        cur = nxt; cA = nA; cB = nB; ++ui;
        if constexpr (ALIGN_EPI) { if (wr == 1) PG8_BAR; }
    }
    PG8_WAIT_V(0);
    if constexpr (!ALIGN_EPI) { if (wr == 0) PG8_BAR; }
    PG8_BAR;
    if constexpr (Epi::AFTER_DRAIN) { E.fused(acc, cur, wr, wc, fr, fq, lds, wid, lane); S.done(cur); }
#undef PG8_SA
#undef PG8_SB
#undef PG8_STAGE
#undef PG8_LDA
#undef PG8_LDB
#undef PG8_MMA
#undef PG8_KT2
#undef PG8_WAIT_V
#undef PG8_WAIT_L
#undef PG8_BAR
#undef PG8_SCHED
}
}
#ifndef MK_SINGLE
#define MK_SINGLE 1
#endif
constexpr int NWAVES = 8;
constexpr int BATCH = 4, SEQ = 4096, DM = 4096, FF = 11008, M = BATCH * SEQ;
constexpr int NPROJ = 16640, NGATE = 10240, PA_LD = 14336, PB_LD = 12288;
constexpr int PA_GQ = 0, PA_GK = 2048, PA_GV = 4096, PA_MQ = 8192, PA_MK = 10240, PA_MV = 12288, PB_GZ = 0, PB_GG = 4096, PB_MG = 8192;
constexpr float NORM_EPS = 1e-6f;
constexpr int KB16 = 11008, KF8 = FF - KB16, ACT2_PITCH = 2 * KB16 + KF8;
static_assert(KB16 % 128 == 0 && KF8 % 256 == 0, "mixed K split");
constexpr int N_PHASES = 14;

constexpr size_t MiB = 1u << 20;
constexpr size_t WS_CTL = 0, CTL_ZERO_BYTES = 64 * 1024;
constexpr size_t WS_KMEAN = 1 * MiB, WS_ROPE = 2 * MiB, WS_AB = 4 * MiB, WS_G = 8 * MiB, WS_BETA = 10 * MiB;
constexpr size_t WS_WGU = 16 * MiB, WS_WD = 188 * MiB;
constexpr size_t WS_H = 274 * MiB;
constexpr size_t WS_WB = 402 * MiB;
constexpr size_t WS_BIG = 612 * MiB, WS_PB = 1060 * MiB;
constexpr size_t WS_OG = 1444 * MiB, WS_OM = 1572 * MiB, WS_WBG = 1636 * MiB, WS_WBM = 1668 * MiB, WS_WO = 1684 * MiB, WS_H8 = 1716 * MiB, WS_END = 1780 * MiB;
constexpr size_t WS_W8 = 548 * MiB;
constexpr size_t WS_QN = 16 * MiB, WS_KN = 80 * MiB, WS_VP = 144 * MiB, WS_KNT = 274 * MiB;
constexpr size_t WS_U = 612 * MiB, WS_W = 740 * MiB, WS_AT = 868 * MiB, WS_GC = 932 * MiB;
constexpr size_t WS_MQ = 402 * MiB, WS_MK = 466 * MiB, WS_MV = 530 * MiB;
constexpr size_t WS_Y1 = 16 * MiB;
static_assert(WS_WGU + (size_t)22016 * 4096 * 2 <= WS_WD && WS_WD + (size_t)4096 * 11008 * 2 <= WS_H && WS_H + (size_t)M * DM * 2 <= WS_WB, "ws map 1");
static_assert(WS_WB + (size_t)NPROJ * DM * 2 <= WS_BIG && WS_BIG + (size_t)M * PA_LD * 2 <= WS_PB && WS_PB + (size_t)M * PB_LD * 2 <= WS_OG && WS_MV + (size_t)M * 2048 * 2 <= WS_BIG && WS_Y1 + (size_t)M * DM * 4 <= WS_H && WS_GC + (size_t)8192 * 64 * 4 <= WS_PB, "ws map 2");
constexpr int CW_BAR = 4096, CW_Q = 64;

constexpr int RING_BYTES = 131072, TR_STRIDE = 16640, PREP_STRIDE = 17408, MISC_OFF = 159744, LDS_BYTES = 163840;
static_assert(8 * TR_STRIDE <= MISC_OFF, "LDS map");

#define GAS __attribute__((address_space(1)))
#define LAS __attribute__((address_space(3)))
typedef unsigned short bf16;
typedef unsigned v4u __attribute__((ext_vector_type(4)));
typedef unsigned v2u __attribute__((ext_vector_type(2)));
typedef float f32x4 __attribute__((ext_vector_type(4)));
typedef float f32x2 __attribute__((ext_vector_type(2)));
#define LDS_WAIT() asm volatile("s_waitcnt lgkmcnt(0)" ::: "memory")
#define VM_WAIT() asm volatile("s_waitcnt vmcnt(0)" ::: "memory")
__device__ __forceinline__ unsigned f2bf(float f) { unsigned u = __builtin_bit_cast(unsigned, f); return (u + 0x7fffu + ((u >> 16) & 1u)) >> 16; }
typedef __bf16 bf16x2_t __attribute__((ext_vector_type(2)));
__device__ __forceinline__ unsigned cvtpk(float lo, float hi) { f32x2 v = {lo, hi}; bf16x2_t b = __builtin_convertvector(v, bf16x2_t); return __builtin_bit_cast(unsigned, b); }
__device__ __forceinline__ unsigned pk2(float lo, float hi) { return cvtpk(lo, hi); }
__device__ __forceinline__ float bf2f(unsigned short b) { return __uint_as_float(((unsigned)b) << 16); }
__device__ __forceinline__ float blo(unsigned w) { return __uint_as_float(w << 16); }
__device__ __forceinline__ float bhi(unsigned w) { return __uint_as_float(w & 0xffff0000u); }
template <int CTRL, int RM> __device__ __forceinline__ float dpp_f(float v) { return __int_as_float(__builtin_amdgcn_update_dpp(0, __float_as_int(v), CTRL, RM, 0xf, true)); }
__device__ __forceinline__ float row_sum16(float v) { v += dpp_f<0xB1, 0xf>(v); v += dpp_f<0x4E, 0xf>(v); v += dpp_f<0x141, 0xf>(v); v += dpp_f<0x140, 0xf>(v); return v; }
__device__ __forceinline__ float half_sum32(float v) { v = row_sum16(v); v += dpp_f<0x142, 0xa>(v); return v; }
__device__ __forceinline__ float rd_lane(float v, int l) { return __int_as_float(__builtin_amdgcn_readlane(__float_as_int(v), l)); }
__device__ __forceinline__ float wave_sum(float v) { v = half_sum32(v); return rd_lane(v, 31) + rd_lane(v, 63); }
__device__ __forceinline__ float wave_max(float v) {
#pragma unroll
    for (int o = 1; o < 64; o <<= 1) v = fmaxf(v, __shfl_xor(v, o));
    return v;
}
__device__ __forceinline__ float xhalf_max(float v) { auto rr = __builtin_amdgcn_permlane32_swap(__float_as_uint(v), __float_as_uint(v), false, false); return fmaxf(__uint_as_float(rr[0]), __uint_as_float(rr[1])); }
__device__ __forceinline__ float xhalf_sum(float v) { auto rr = __builtin_amdgcn_permlane32_swap(__float_as_uint(v), __float_as_uint(v), false, false); return __uint_as_float(rr[0]) + __uint_as_float(rr[1]); }
#define XB_TMO      128
#define XB_XCNT(j)  (256  + 64 * (j))
#define XB_XSUB(j)  (1280 + 64 * (j))
#define XB_XGEN(j)  (2304 + 64 * (j))
#define XB_TOP      3328
#define XB_TOPGEN   3392
#define XCD_BAR_WORDS 3456
#define XB_SPIN_CAP (1u << 18)

__device__ __forceinline__ unsigned xb_ld(unsigned* p)              { return __hip_atomic_load(p, __ATOMIC_RELAXED, __HIP_MEMORY_SCOPE_AGENT); }
__device__ __forceinline__ unsigned xb_add(unsigned* p, unsigned v) { return __hip_atomic_fetch_add(p, v, __ATOMIC_RELAXED, __HIP_MEMORY_SCOPE_AGENT); }
__device__ __forceinline__ unsigned xb_xcc_id() { return (unsigned)__builtin_amdgcn_s_getreg((3 << 11) | 20) & 0xFu; }
#define XB_SPIN(cond, bar) do { unsigned _sp = 0; while (cond) { __builtin_amdgcn_s_sleep(1); \
    if ((++_sp & 255u) == 0u) { if (xb_ld(&(bar)[XB_TMO])) break; if (_sp > XB_SPIN_CAP) { atomicAdd(&(bar)[XB_TMO], 1u); break; } } } } while (0)

struct XcdBarrier {
    unsigned* bar; unsigned x;
    volatile LAS unsigned* st;
};

__device__ __forceinline__ XcdBarrier xcd_barrier_post(unsigned* bar, volatile LAS unsigned* st) {
    XcdBarrier b; b.bar = bar; b.x = xb_xcc_id(); b.st = st;
    if (threadIdx.x == 0) (void)xb_add(&bar[XB_XCNT(b.x)], 1u);
    return b;
}
__device__ __forceinline__ void xcd_barrier_complete(unsigned* bar, unsigned x, unsigned& nloc, unsigned& nx) {
    const unsigned G = gridDim.x * gridDim.y * gridDim.z;
    unsigned sum, cnt, mine, sp = 0u;
    for (;;) {
        sum = 0u; cnt = 0u; mine = 0u;
#pragma unroll
        for (unsigned j = 0; j < 16; ++j) { const unsigned c = xb_ld(&bar[XB_XCNT(j)]); sum += c; cnt += (c > 0u) ? 1u : 0u; mine = (j == x) ? c : mine; }
        if (sum == G) break;
        __builtin_amdgcn_s_sleep(1);
        if ((++sp & 255u) == 0u) { if (xb_ld(&bar[XB_TMO])) break; if (sp > XB_SPIN_CAP) { atomicAdd(&bar[XB_TMO], 1u); break; } }
    }
    nloc = mine > 0u ? mine : 1u; nx = cnt > 0u ? cnt : 1u;
}

__device__ __forceinline__ void xcd_barrier(const XcdBarrier& b) {
    asm volatile("s_waitcnt vmcnt(0)" ::: "memory");
    __syncthreads();
    if (threadIdx.x == 0) {
        unsigned* bar = b.bar;
        __builtin_amdgcn_s_waitcnt(0);
        unsigned nloc = b.st[0], nx = b.st[1];
        if (nloc == 0u) { xcd_barrier_complete(bar, b.x, nloc, nx); b.st[0] = nloc; b.st[1] = nx; }
        const unsigned old = xb_add(&bar[XB_XSUB(b.x)], 1u);
        const unsigned gen = old / nloc;
        if (old + 1u == (gen + 1u) * nloc) {
            __builtin_amdgcn_fence(__ATOMIC_RELEASE, "agent");
            asm volatile("s_waitcnt vmcnt(0)" ::: "memory");
            const unsigned og = xb_add(&bar[XB_TOP], 1u);
            const unsigned tg = og / nx;
            if (og + 1u == (tg + 1u) * nx) xb_add(&bar[XB_TOPGEN], 1u);
            else XB_SPIN(xb_ld(&bar[XB_TOPGEN]) == tg, bar);
            __builtin_amdgcn_fence(__ATOMIC_ACQUIRE, "agent");
            xb_add(&bar[XB_XGEN(b.x)], 1u);
            asm volatile("s_waitcnt vmcnt(0)" ::: "memory");
        } else {
            XB_SPIN(xb_ld(&bar[XB_XGEN(b.x)]) == gen, bar);
            __builtin_amdgcn_fence(__ATOMIC_ACQUIRE, "agent");
            asm volatile("s_waitcnt vmcnt(0)" ::: "memory");
        }
    }
    __syncthreads();
}
struct Frame {
    LAS unsigned char* lds;
    volatile LAS unsigned* MISC;
    unsigned* ctl;
    int tid, lane, wave, vcu, G; unsigned char* wsb;
    const float* in[20]; float* out;
    __device__ __forceinline__ bf16* WGU() const { return (bf16*)(wsb + WS_WGU); }
    __device__ __forceinline__ bf16* WD() const { return (bf16*)(wsb + WS_WD); }
    __device__ __forceinline__ bf16* H() const { return (bf16*)(wsb + WS_H); }
    __device__ __forceinline__ bf16* WB() const { return (bf16*)(wsb + WS_WB); }
    __device__ __forceinline__ bf16* PA() const { return (bf16*)(wsb + WS_BIG); }
    __device__ __forceinline__ bf16* PB() const { return (bf16*)(wsb + WS_PB); }
    __device__ __forceinline__ bf16* ACT() const { return (bf16*)(wsb + WS_BIG); }
    __device__ __forceinline__ bf16* OG() const { return (bf16*)(wsb + WS_OG); }
    __device__ __forceinline__ bf16* OM() const { return (bf16*)(wsb + WS_OM); }
    __device__ __forceinline__ bf16* WBG() const { return (bf16*)(wsb + WS_WBG); }
    __device__ __forceinline__ bf16* WBM() const { return (bf16*)(wsb + WS_WBM); }
    __device__ __forceinline__ bf16* WO() const { return (bf16*)(wsb + WS_WO); }
    __device__ __forceinline__ bf16* QN() const { return (bf16*)(wsb + WS_QN); }
    __device__ __forceinline__ bf16* KN() const { return (bf16*)(wsb + WS_KN); }
    __device__ __forceinline__ bf16* VP() const { return (bf16*)(wsb + WS_VP); }
    __device__ __forceinline__ bf16* KNT() const { return (bf16*)(wsb + WS_KNT); }
    __device__ __forceinline__ bf16* MQ() const { return (bf16*)(wsb + WS_MQ); }
    __device__ __forceinline__ bf16* MK() const { return (bf16*)(wsb + WS_MK); }
    __device__ __forceinline__ bf16* MV() const { return (bf16*)(wsb + WS_MV); }
    __device__ __forceinline__ bf16* U() const { return (bf16*)(wsb + WS_U); }
    __device__ __forceinline__ bf16* W() const { return (bf16*)(wsb + WS_W); }
    __device__ __forceinline__ bf16* AT() const { return (bf16*)(wsb + WS_AT); }
    __device__ __forceinline__ bf16* KMH() const { return (bf16*)(wsb + WS_KMEAN); }
    __device__ __forceinline__ bf16* KML() const { return (bf16*)(wsb + (WS_KMEAN + 262144)); }
    __device__ __forceinline__ float* AB() const { return (float*)(wsb + WS_AB); }
    __device__ __forceinline__ float* GG() const { return (float*)(wsb + WS_G); }
    __device__ __forceinline__ float* BETA() const { return (float*)(wsb + WS_BETA); }
    __device__ __forceinline__ float* Y1() const { return (float*)(wsb + WS_Y1); }
    __device__ __forceinline__ float* GC() const { return (float*)(wsb + WS_GC); }
    __device__ __forceinline__ f32x2* ROPE() const { return (f32x2*)(wsb + WS_ROPE); }
    __device__ __forceinline__ unsigned char* H8() const { return wsb + WS_H8; }
    __device__ __forceinline__ unsigned char* W8() const { return wsb + WS_W8; }
    __device__ __forceinline__ unsigned* CM(int f) const { return (unsigned*)(wsb + WS_CTL + (256 + 128 * f) * 1024); }
    __device__ __forceinline__ unsigned* CMW() const { return (unsigned*)(wsb + WS_CTL + 640 * 1024); }
    __device__ __forceinline__ unsigned* RM(int f) const { return (unsigned*)(wsb + WS_CTL + (768 + 64 * f) * 1024); }
    __device__ __forceinline__ unsigned* CMD(int f) const { return (unsigned*)(wsb + WS_CTL + (896 + 16 * f) * 1024); }
    __device__ __forceinline__ unsigned char* ACT8() const { return wsb + WS_PB; }
    __device__ __forceinline__ float* RS() const { return (float*)(wsb + WS_CTL + 512 * 1024); }
};

template <int MODE> __device__ __forceinline__ int rowmap(int n0) {
    if (MODE == 0) return n0;
    if (MODE == 1) return 256 * (n0 >> 7) + (n0 & 127);
    if (MODE == 2) return 256 * (n0 >> 7) + 128 + (n0 & 127);
    if (MODE == 3) return n0 < 8192 ? n0 : (n0 < 12288 ? n0 + 4096 : (n0 < 12352 ? 16384 + (n0 - 12288) : n0 - 4160));
    return n0 - 16448;
}
__device__ __forceinline__ bool win_i8(int n0) { return n0 >= 16448; }
__device__ __forceinline__ const float* tr_src(const float* W, int N, int item, int lane, int nblk_ = 0) { const int nblk = nblk_ ? nblk_ : (N >> 6), kb = item / nblk, nb = item - kb * nblk; return W + (size_t)(kb << 6) * N + (nb << 6) + lane; }
__device__ __forceinline__ void tr_load(const float* src, int N, float (&v)[64]) {
#pragma unroll
    for (int j = 0; j < 64; ++j) v[j] = __builtin_nontemporal_load(src + (size_t)j * N);
}
__device__ __forceinline__ void tr_put(LAS float* scr, const float (&v)[64], int lane) {
#pragma unroll
    for (int j = 0; j < 64; ++j) scr[j * 65 + lane] = v[j];
    LDS_WAIT();
}
template <int MODE> __device__ __forceinline__ void tr_out(int K, int N, bf16* WT, LAS float* scr, int item, int lane, int nblk_ = 0) {
    const int nblk = nblk_ ? nblk_ : (N >> 6), kb = item / nblk, nb = item - kb * nblk, k0 = kb << 6, n0 = nb << 6;
    const int c = lane & 7, r = lane >> 3, drow = rowmap<MODE>(n0);
#pragma unroll
    for (int j = 0; j < 8; ++j) { const int n = r + 8 * j; const LAS float* s = scr + (8 * c) * 65 + n;
        v4u o; o.x = pk2(s[0], s[65]); o.y = pk2(s[130], s[195]); o.z = pk2(s[260], s[325]); o.w = pk2(s[390], s[455]);
        *(v4u*)(WT + (size_t)(drow + n) * K + k0 + 8 * c) = o; }
    LDS_WAIT();
}
__device__ __forceinline__ unsigned pk4_fp8(float a, float b, float c, float d) { int w = 0; w = __builtin_amdgcn_cvt_pk_fp8_f32(a, b, w, false); w = __builtin_amdgcn_cvt_pk_fp8_f32(c, d, w, true); return (unsigned)w; }
__device__ __forceinline__ void tr_out8(int K, int N, unsigned char* WT, int drow, LAS float* scr, int item, int lane) {
    const int nblk = N >> 6, kb = item / nblk, nb = item - kb * nblk, k0 = kb << 6, n0 = nb << 6;
    const int c = lane & 7, r = lane >> 3;
#pragma unroll
    for (int j = 0; j < 8; ++j) { const int n = r + 8 * j; const LAS float* sp = scr + (8 * c) * 65 + n;
        v2u o; o.x = pk4_fp8(sp[0] * 64.f, sp[65] * 64.f, sp[130] * 64.f, sp[195] * 64.f); o.y = pk4_fp8(sp[260] * 64.f, sp[325] * 64.f, sp[390] * 64.f, sp[455] * 64.f);
        *(v2u*)(WT + (size_t)(drow + n0 + n) * K + k0 + 8 * c) = o; }
    LDS_WAIT();
}
__device__ __forceinline__ unsigned pk4_i8(float a, float b, float c, float d) {
    const int ia = (int)__builtin_rintf(a), ib = (int)__builtin_rintf(b), ic = (int)__builtin_rintf(c), id = (int)__builtin_rintf(d);
    return (unsigned)(ia & 0xff) | ((unsigned)(ib & 0xff) << 8) | ((unsigned)(ic & 0xff) << 16) | ((unsigned)id << 24); }
template <int MODE> __device__ __forceinline__ void tr_q_i8(int N, const unsigned* CM, int item, int lane, float (&q)[8]) {
    const int nblk = N >> 6, kb = item / nblk, nb = item - kb * nblk, n0 = nb << 6, r = lane >> 3, drow = rowmap<MODE>(n0);
#pragma unroll
    for (int j = 0; j < 8; ++j) q[j] = 127.0f / fmaxf(__uint_as_float(CM[drow + r + 8 * j]), 1e-30f);
}
template <int MODE> __device__ __forceinline__ void tr_out_i8(int K, int N, unsigned char* WT, const float (&q)[8], LAS float* scr, int item, int lane) {
    const int nblk = N >> 6, kb = item / nblk, nb = item - kb * nblk, k0 = kb << 6, n0 = nb << 6;
    const int c = lane & 7, r = lane >> 3, drow = rowmap<MODE>(n0);
#pragma unroll
    for (int j = 0; j < 8; ++j) { const int n = r + 8 * j; const LAS float* sp = scr + (8 * c) * 65 + n; const float qq = q[j];
        v2u o; o.x = pk4_i8(sp[0] * qq, sp[65] * qq, sp[130] * qq, sp[195] * qq); o.y = pk4_i8(sp[260] * qq, sp[325] * qq, sp[390] * qq, sp[455] * qq);
        *(v2u*)(WT + (size_t)(drow + n) * K + k0 + 8 * c) = o; }
    LDS_WAIT();
}
__device__ __forceinline__ void colmax_ffn(Frame& F, const float* wg, const float* wu, unsigned* CM) {
    const int gw = F.vcu * NWAVES + F.wave, NGW = F.G * NWAVES, lane = F.lane;
    constexpr int I1 = (DM / 64) * (FF / 64);
    for (int it = gw; it < 2 * I1; it += NGW) {
        const bool up = it >= I1; const int item = up ? it - I1 : it; const int nb = item % (FF / 64), n0 = nb << 6;
        const float* s = tr_src(up ? wu : wg, FF, item, lane);
        float v[64]; tr_load(s, FF, v);
        float mx = 0.f;
#pragma unroll
        for (int j = 0; j < 64; ++j) mx = fmaxf(mx, fabsf(v[j]));
        atomicMax(CM + (up ? rowmap<2>(n0) : rowmap<1>(n0)) + lane, __float_as_uint(mx));
    }
}
__device__ __forceinline__ void strip_quant_i8(Frame& F, const float* W, int N, int c0, int drow0, unsigned char* WT, float* CS) {
    LAS float* xch = (LAS float*)(F.lds + 150528);
    int lane_a = threadIdx.x & 63; asm volatile("" : "+v"(lane_a));
    const int r0 = F.wave * 512;
    const char* bu = (const char*)W + ((size_t)r0 * N + c0) * 4;
    const unsigned voff = (unsigned)(32 * (lane_a >> 5) * N + (lane_a & 31)) * 4u;
    unsigned v[128]; float mx = 0.f; float ta[32], tb[32];
#define SQ_LOAD(t, i) do { _Pragma("unroll") for (int j = 0; j < 32; ++j) t[j] = __builtin_nontemporal_load((const float*)(bu + (size_t)(64 * (i) + j) * N * 4 + voff)); } while (0)
#define SQ_PACK(t, i) do { _Pragma("unroll") for (int j = 0; j < 16; ++j) { unsigned w = pk2(t[2 * j], t[2 * j + 1]); mx = fmaxf(mx, fmaxf(fabsf(blo(w)), fabsf(bhi(w)))); asm volatile("" : "+v"(w)); v[16 * (i) + j] = w; }   \
        __builtin_amdgcn_sched_barrier(0); } while (0)
    SQ_LOAD(ta, 0);
#pragma unroll
    for (int i = 0; i < 8; i += 2) {
        SQ_LOAD(tb, i + 1); SQ_PACK(ta, i);
        if (i + 2 < 8) SQ_LOAD(ta, i + 2);
        SQ_PACK(tb, i + 1); }
#undef SQ_LOAD
#undef SQ_PACK
    int lane = threadIdx.x & 63; asm volatile("" : "+v"(lane));
    const int col = lane & 31, half = lane >> 5;
    mx = xhalf_max(mx);
    if (lane < 32) xch[F.wave * 32 + lane] = mx;
    __syncthreads();
    float cm = 0.f;
#pragma unroll
    for (int w = 0; w < 8; ++w) cm = fmaxf(cm, xch[w * 32 + col]);
    __syncthreads();
    if (F.wave == 0 && lane < 32) CS[drow0 + col] = cm;
    const float q = 127.0f / fmaxf(cm, 1e-30f);
    unsigned char* dst = WT + (size_t)(drow0 + col) * DM + r0 + 32 * half;
#pragma unroll
    for (int i = 0; i < 8; ++i) { v4u o0, o1;
        o0.x = pk4_i8(blo(v[16 * i + 0]) * q, bhi(v[16 * i + 0]) * q, blo(v[16 * i + 1]) * q, bhi(v[16 * i + 1]) * q); o0.y = pk4_i8(blo(v[16 * i + 2]) * q, bhi(v[16 * i + 2]) * q, blo(v[16 * i + 3]) * q, bhi(v[16 * i + 3]) * q);
        o0.z = pk4_i8(blo(v[16 * i + 4]) * q, bhi(v[16 * i + 4]) * q, blo(v[16 * i + 5]) * q, bhi(v[16 * i + 5]) * q); o0.w = pk4_i8(blo(v[16 * i + 6]) * q, bhi(v[16 * i + 6]) * q, blo(v[16 * i + 7]) * q, bhi(v[16 * i + 7]) * q);
        o1.x = pk4_i8(blo(v[16 * i + 8]) * q, bhi(v[16 * i + 8]) * q, blo(v[16 * i + 9]) * q, bhi(v[16 * i + 9]) * q); o1.y = pk4_i8(blo(v[16 * i + 10]) * q, bhi(v[16 * i + 10]) * q, blo(v[16 * i + 11]) * q, bhi(v[16 * i + 11]) * q);
        o1.z = pk4_i8(blo(v[16 * i + 12]) * q, bhi(v[16 * i + 12]) * q, blo(v[16 * i + 13]) * q, bhi(v[16 * i + 13]) * q); o1.w = pk4_i8(blo(v[16 * i + 14]) * q, bhi(v[16 * i + 14]) * q, blo(v[16 * i + 15]) * q, bhi(v[16 * i + 15]) * q);
        *(v4u*)(dst + 64 * i) = o0; *(v4u*)(dst + 64 * i + 16) = o1; }
}
__device__ __forceinline__ void strip_quant_wd(Frame& F, const float* W, int c0, unsigned char* WT, float* CS) {
    LAS float* xch = (LAS float*)(F.lds + 150528);
    int lane_a = threadIdx.x & 63; asm volatile("" : "+v"(lane_a));
    const int wave = F.wave, g0 = wave < 4 ? wave * 22 : 88 + (wave - 4) * 21, ng = wave < 4 ? 22 : 21;
    const char* bu = (const char*)W + ((size_t)(g0 * 64) * DM + c0) * 4;
    const int qa = lane_a >> 4; const unsigned voff = (unsigned)(16 * qa * DM + (lane_a & 15)) * 4u;
    unsigned v[176]; float mx = 0.f; float ta[16], tb[16];
#define WD_LOAD(t, i) do { _Pragma("unroll") for (int j = 0; j < 16; ++j) t[j] = *(const float*)(bu + (size_t)(64 * (i) + j) * DM * 4 + voff); } while (0)
#define WD_ROT(t, i) do { \
        _Pragma("unroll") for (int h = 1; h < 16; h <<= 1) _Pragma("unroll") for (int j = 0; j < 16; ++j) if (!(j & h)) { const float a = t[j], b = t[j + h]; t[j] = a + b; t[j + h] = a - b; } \
        _Pragma("unroll") for (int j = 0; j < 16; ++j) { auto a = __builtin_amdgcn_permlane16_swap(__float_as_uint(t[j]), __float_as_uint(t[j]), false, false); \
            const float lo = __uint_as_float(a[0]), hi = __uint_as_float(a[1]); t[j] = (qa & 1) ? lo - hi : lo + hi; } \
        _Pragma("unroll") for (int j = 0; j < 16; ++j) { auto b = __builtin_amdgcn_permlane32_swap(__float_as_uint(t[j]), __float_as_uint(t[j]), false, false); \
            const float lo = __uint_as_float(b[0]), hi = __uint_as_float(b[1]); t[j] = ((qa & 2) ? lo - hi : lo + hi) * 0.125f; } \
        _Pragma("unroll") for (int j = 0; j < 8; ++j) { unsigned w = pk2(t[2 * j], t[2 * j + 1]); mx = fmaxf(mx, fmaxf(fabsf(blo(w)), fabsf(bhi(w)))); asm volatile("" : "+v"(w)); v[8 * (i) + j] = w; } \
        __builtin_amdgcn_sched_barrier(0); } while (0)
    WD_LOAD(ta, 0);
#pragma unroll
    for (int i = 0; i < 16; i += 2) {
        WD_LOAD(tb, i + 1);
        WD_ROT(ta, i);
        if (i + 2 < 16) WD_LOAD(ta, i + 2);
        WD_ROT(tb, i + 1);
    }
#pragma unroll
    for (int i = 16; i < 22; ++i) {
        if (i < ng) { WD_LOAD(ta, i); WD_ROT(ta, i); } else {
#pragma unroll
            for (int j = 0; j < 8; ++j) v[8 * i + j] = 0u; }
    }
#undef WD_LOAD
#undef WD_ROT
    int lane = threadIdx.x & 63; asm volatile("" : "+v"(lane));
    const int col = lane & 15, q4 = lane >> 4;
    { auto a = __builtin_amdgcn_permlane16_swap(__float_as_uint(mx), __float_as_uint(mx), false, false); mx = fmaxf(__uint_as_float(a[0]), __uint_as_float(a[1]));
      auto b = __builtin_amdgcn_permlane32_swap(__float_as_uint(mx), __float_as_uint(mx), false, false); mx = fmaxf(__uint_as_float(b[0]), __uint_as_float(b[1])); }
    if (lane < 16) xch[wave * 16 + lane] = mx;
    __syncthreads();
    float cm = 0.f;
#pragma unroll
    for (int w = 0; w < 8; ++w) cm = fmaxf(cm, xch[w * 16 + col]);
    __syncthreads();
    if (wave == 0 && lane < 16) CS[c0 + col] = cm;
    const float qq = 127.0f / fmaxf(cm, 1e-30f);
    unsigned char* dst = WT + (size_t)(c0 + col) * FF + (size_t)g0 * 64 + 16 * q4;
#pragma unroll
    for (int i = 0; i < 22; ++i) if (i < ng) { v4u o;
        o.x = pk4_i8(blo(v[8 * i + 0]) * qq, bhi(v[8 * i + 0]) * qq, blo(v[8 * i + 1]) * qq, bhi(v[8 * i + 1]) * qq); o.y = pk4_i8(blo(v[8 * i + 2]) * qq, bhi(v[8 * i + 2]) * qq, blo(v[8 * i + 3]) * qq, bhi(v[8 * i + 3]) * qq);
        o.z = pk4_i8(blo(v[8 * i + 4]) * qq, bhi(v[8 * i + 4]) * qq, blo(v[8 * i + 5]) * qq, bhi(v[8 * i + 5]) * qq); o.w = pk4_i8(blo(v[8 * i + 6]) * qq, bhi(v[8 * i + 6]) * qq, blo(v[8 * i + 7]) * qq, bhi(v[8 * i + 7]) * qq);
        *(v4u*)(dst + 64 * i) = o; }
}
__device__ __forceinline__ void quant_wd(Frame& F, const float* wd, float* CS) { for (int s = F.vcu; s < DM / 16; s += F.G) strip_quant_wd(F, wd, 16 * s, (unsigned char*)F.WD(), CS); }
__device__ __forceinline__ void quant_ffn_gu(Frame& F, const float* wg, const float* wu, float* CS) {
    for (int s = blockIdx.x; s < 2 * (FF / 32); s += F.G) { const bool up = s >= FF / 32; const int c0 = (up ? s - FF / 32 : s) * 32;
        strip_quant_i8(F, up ? wu : wg, FF, c0, up ? rowmap<2>(c0) : rowmap<1>(c0), (unsigned char*)F.WGU(), CS); }
}
__device__ __forceinline__ void fwht32x2(float (&v)[64]) {
#pragma unroll
    for (int h = 1; h < 64; h <<= 1)
#pragma unroll
        for (int j = 0; j < 64; ++j) if (!(j & h)) { const float a = v[j], b = v[j + h]; v[j] = a + b; v[j + h] = a - b; }
#pragma unroll
    for (int j = 0; j < 64; ++j) v[j] *= 0.125f;
}
__device__ __forceinline__ void colmax_wd(Frame& F, const float* wd, unsigned* CMD) {
    const int gw = F.vcu * NWAVES + F.wave, NGW = F.G * NWAVES, lane = F.lane;
    constexpr int I2 = (FF / 64) * (DM / 64);
    for (int it = gw; it < I2; it += NGW) { const int n0 = (it % (DM / 64)) << 6;
        float v[64]; tr_load(tr_src(wd, DM, it, lane), DM, v);
        fwht32x2(v);
        float mx = 0.f;
#pragma unroll
        for (int j = 0; j < 64; ++j) mx = fmaxf(mx, fabsf(v[j]));
        atomicMax(CMD + n0 + lane, __float_as_uint(mx));
    }
}
__device__ __forceinline__ void requant_rows(Frame& F, const bf16* A, unsigned char* A8, float* RS) {
    const int gw = F.vcu * NWAVES + F.wave, NGW = F.G * NWAVES;
    constexpr int NV = FF / 8;
    const float s1 = (F.lane & 1) ? -1.0f : 1.0f, s2 = (F.lane & 2) ? -1.0f : 1.0f, s4 = (F.lane & 4) ? -1.0f : 1.0f;
    for (int m = gw; m < M; m += NGW) {
        const v4u* src = (const v4u*)(A + (size_t)m * FF); v2u* dst = (v2u*)(A8 + (size_t)m * FF);
        v4u w[22];
#pragma unroll
        for (int j = 0; j < 22; ++j) { const int idx = F.lane + 64 * j; w[j] = (v4u){0u, 0u, 0u, 0u}; if (idx < NV) w[j] = __builtin_nontemporal_load(src + idx); }
        float mx = 0.f;
#pragma unroll
        for (int j = 0; j < 22; ++j) {
            float x[8] = {blo(w[j].x), bhi(w[j].x), blo(w[j].y), bhi(w[j].y), blo(w[j].z), bhi(w[j].z), blo(w[j].w), bhi(w[j].w)};
#pragma unroll
            for (int h = 1; h < 8; h <<= 1)
#pragma unroll
                for (int i = 0; i < 8; ++i) if (!(i & h)) { const float a = x[i], b = x[i + h]; x[i] = a + b; x[i + h] = a - b; }
#pragma unroll
            for (int i = 0; i < 8; ++i) x[i] = __builtin_fmaf(s1, x[i], dpp_f<0xB1, 0xf>(x[i]));
#pragma unroll
            for (int i = 0; i < 8; ++i) x[i] = __builtin_fmaf(s2, x[i], dpp_f<0x4E, 0xf>(x[i]));
#pragma unroll
            for (int i = 0; i < 8; ++i) x[i] = __builtin_fmaf(s4, x[i], __int_as_float(__builtin_amdgcn_ds_swizzle(__float_as_int(x[i]), 0x101F))) * 0.125f;
            w[j].x = pk2(x[0], x[1]); w[j].y = pk2(x[2], x[3]); w[j].z = pk2(x[4], x[5]); w[j].w = pk2(x[6], x[7]);
            mx = fmaxf(mx, fmaxf(fmaxf(fmaxf(fabsf(blo(w[j].x)), fabsf(bhi(w[j].x))), fmaxf(fabsf(blo(w[j].y)), fabsf(bhi(w[j].y)))), fmaxf(fmaxf(fabsf(blo(w[j].z)), fabsf(bhi(w[j].z))), fmaxf(fabsf(blo(w[j].w)), fabsf(bhi(w[j].w))))));
        }
        mx = fmaxf(wave_max(mx), 1e-30f);
        const float q = 127.0f / mx;
#pragma unroll
        for (int j = 0; j < 22; ++j) { const int idx = F.lane + 64 * j;
            if (idx < NV) { v2u o; o.x = pk4_i8(blo(w[j].x) * q, bhi(w[j].x) * q, blo(w[j].y) * q, bhi(w[j].y) * q); o.y = pk4_i8(blo(w[j].z) * q, bhi(w[j].z) * q, blo(w[j].w) * q, bhi(w[j].w) * q); dst[idx] = o; } }
        if (F.lane == 0) RS[m] = mx * (1.0f / 127.0f);
    }
}
template <class SRC, class XF, class PRE, class OUT> __device__ __forceinline__ void tr_pipeline(int it0, int itEnd, int step, LAS float* scr, int lane, SRC srcf, XF xf, PRE pref, OUT outf) {
    if (it0 >= itEnd) return;
    float v[64]; const float* s; int N;
    srcf(it0, s, N); tr_load(s, N, v);
    for (int it = it0;;) {
        xf(it, v);
        tr_put(scr, v, lane);
        float q[8]; pref(it, q);
        const int nx = it + step;
        if (nx < itEnd) { srcf(nx, s, N); tr_load(s, N, v); }
        outf(it, q);
        if (nx >= itEnd) break;
        it = nx;
    }
}
__device__ __forceinline__ void convert_wd(Frame& F, const float* wd, const unsigned* CMD) {
    LAS float* scr = (LAS float*)(F.lds + F.wave * TR_STRIDE);
    const int gw = F.vcu * NWAVES + F.wave, NGW = F.G * NWAVES, lane = F.lane;
    constexpr int I2 = (FF / 64) * (DM / 64);
    unsigned char* wdt = (unsigned char*)F.WD();
    tr_pipeline(gw, I2, NGW, scr, lane,
        [&](int it, const float*& s, int& N) { s = tr_src(wd, DM, it, lane); N = DM; },
        [&](int, float (&v)[64]) { fwht32x2(v); },
        [&](int it, float (&q)[8]) { tr_q_i8<0>(DM, CMD, it, lane, q); },
        [&](int it, const float (&q)[8]) { tr_out_i8<0>(FF, DM, wdt, q, scr, it, lane); });
}
__device__ __forceinline__ void convert_win(Frame& F) {
    LAS float* scr = (LAS float*)(F.lds + F.wave * TR_STRIDE);
    const int gw = F.vcu * NWAVES + F.wave, NGW = F.G * NWAVES, lane = F.lane;
    constexpr int NB = 16448 / 64, I1 = (DM / 64) * NB;
    const float* win = F.in[6]; bf16* wb = F.WB();
    tr_pipeline(gw, I1, NGW, scr, lane,
        [&](int it, const float*& s, int& N) { s = tr_src(win, 26688, it, lane, NB); N = 26688; },
        [&](int, float (&)[64]) {},
        [&](int, float (&)[8]) {},
        [&](int it, const float (&)[8]) { tr_out<3>(DM, 26688, wb, scr, it, lane, NB); });
    __syncthreads();
    for (int s = blockIdx.x; s < (26688 - 16448) / 32; s += F.G) { const int c0 = 16448 + 32 * s; strip_quant_i8(F, win, 26688, c0, c0 - 16448, F.W8(), (float*)F.CMW()); }
}
__device__ __forceinline__ void colmax_win(Frame& F) {
    const int gw = F.vcu * NWAVES + F.wave, NGW = F.G * NWAVES, lane = F.lane;
    constexpr int NB = 26688 / 64, I1 = (DM / 64) * NB;
    unsigned* cm = F.CMW();
    for (int it = gw; it < I1; it += NGW) { const int n0 = (it % NB) << 6;
        if (!win_i8(n0)) continue;
        float v[64]; tr_load(tr_src(F.in[6], 26688, it, lane), 26688, v);
        float mx = 0.f;
#pragma unroll
        for (int j = 0; j < 64; ++j) mx = fmaxf(mx, fabsf(v[j]));
        atomicMax(cm + rowmap<4>(n0) + lane, __float_as_uint(mx));
    }
}
__device__ __forceinline__ void convert_branch(Frame& F) {
    LAS float* scr = (LAS float*)(F.lds + F.wave * TR_STRIDE);
    const int gw = F.vcu * NWAVES + F.wave, NGW = F.G * NWAVES, lane = F.lane;
    constexpr int IG = 64 * 64, IM = 32 * 64;
    const float* w13 = F.in[13]; const float* w14 = F.in[14]; const float* w15 = F.in[15]; bf16* wbg = F.WBG(); unsigned char* wbm = (unsigned char*)F.WBM(); bf16* wo = F.WO();
    tr_pipeline(gw, 2 * IG + IM, NGW, scr, lane,
        [&](int it, const float*& s, int& N) { N = 4096; if (it < IG) s = tr_src(w13, 4096, it, lane); else if (it < IG + IM) s = tr_src(w14, 4096, it - IG, lane); else s = tr_src(w15, 4096, it - IG - IM, lane); },
        [&](int, float (&)[64]) {},
        [&](int, float (&)[8]) {},
        [&](int it, const float (&)[8]) { if (it < IG) tr_out<0>(4096, 4096, wbg, scr, it, lane);
                      else if (it < IG + IM) tr_out8(2048, 4096, wbm, 0, scr, it - IG, lane);
                      else tr_out<0>(4096, 4096, wo, scr, it - IG - IM, lane); });
}
__device__ __forceinline__ void rms_rows(Frame& F, const float* X, const float* gain, bf16* O, unsigned char* O8 = nullptr) {
    LAS f32x4* gl = (LAS f32x4*)(F.lds + 8 * TR_STRIDE);
    for (int i = F.tid; i < DM / 4; i += NWAVES * 64) gl[i] = ((const f32x4*)gain)[i];
    __syncthreads();
    const int gw = F.vcu * NWAVES + F.wave, NGW = F.G * NWAVES;
    int m = gw; if (m >= M) return;
    f32x4 v[16], nv[16];
    { const f32x4* xr = (const f32x4*)(X + (size_t)m * DM) + F.lane;
#pragma unroll
      for (int j = 0; j < 16; ++j) v[j] = xr[64 * j]; }
    for (;;) {
        const int mn = m + NGW;
        if (mn < M) { const f32x4* xr = (const f32x4*)(X + (size_t)mn * DM) + F.lane;
#pragma unroll
            for (int j = 0; j < 16; ++j) nv[j] = xr[64 * j]; }
        float s = 0.f;
#pragma unroll
        for (int j = 0; j < 16; ++j) s += (v[j].x * v[j].x + v[j].y * v[j].y) + (v[j].z * v[j].z + v[j].w * v[j].w);
        const float r = 1.0f / sqrtf(wave_sum(s) * (1.0f / DM) + NORM_EPS);
        v2u* o8 = (v2u*)(O + (size_t)m * DM) + F.lane;
#pragma unroll
        for (int j = 0; j < 16; ++j) { const f32x4 g = gl[F.lane + 64 * j]; const float a = v[j].x * r * g.x, b = v[j].y * r * g.y, c = v[j].z * r * g.z, d = v[j].w * r * g.w;
            v2u w; w.x = pk2(a, b); w.y = pk2(c, d); o8[64 * j] = w;
            if (O8) ((unsigned*)(O8 + (size_t)m * DM))[F.lane + 64 * j] = pk4_fp8(a, b, c, d); }
        if (mn >= M) break;
#pragma unroll
        for (int j = 0; j < 16; ++j) v[j] = nv[j];
        m = mn;
    }
}
__device__ __forceinline__ void rms_rows_i8(Frame& F, const float* X, const float* gain, unsigned char* O, float* RS, bf16* Ob = nullptr) {
    LAS f32x4* gl = (LAS f32x4*)(F.lds + 8 * TR_STRIDE);
    for (int i = F.tid; i < DM / 4; i += NWAVES * 64) gl[i] = ((const f32x4*)gain)[i];
    __syncthreads();
    const int gw = F.vcu * NWAVES + F.wave, NGW = F.G * NWAVES;
    int m = gw; if (m >= M) return;
    f32x4 v[16], nv[16];
    { const f32x4* xr = (const f32x4*)(X + (size_t)m * DM) + F.lane;
#pragma unroll
      for (int j = 0; j < 16; ++j) v[j] = __builtin_nontemporal_load(xr + 64 * j); }
    for (;;) {
        const int mn = m + NGW;
        if (mn < M) { const f32x4* xr = (const f32x4*)(X + (size_t)mn * DM) + F.lane;
#pragma unroll
            for (int j = 0; j < 16; ++j) nv[j] = __builtin_nontemporal_load(xr + 64 * j); }
        float s = 0.f;
#pragma unroll
        for (int j = 0; j < 16; ++j) s += (v[j].x * v[j].x + v[j].y * v[j].y) + (v[j].z * v[j].z + v[j].w * v[j].w);
        const float r = 1.0f / sqrtf(wave_sum(s) * (1.0f / DM) + NORM_EPS);
        float mx = 0.f;
#pragma unroll
        for (int j = 0; j < 16; ++j) { const f32x4 g = gl[F.lane + 64 * j]; v[j].x *= r * g.x; v[j].y *= r * g.y; v[j].z *= r * g.z; v[j].w *= r * g.w;
            mx = fmaxf(fmaxf(mx, fmaxf(fabsf(v[j].x), fabsf(v[j].y))), fmaxf(fabsf(v[j].z), fabsf(v[j].w))); }
        if (Ob) { v2u* ob = (v2u*)(Ob + (size_t)m * DM) + F.lane;
#pragma unroll
            for (int j = 0; j < 16; ++j) { v2u w; w.x = pk2(v[j].x, v[j].y); w.y = pk2(v[j].z, v[j].w); ob[64 * j] = w; } }
        mx = fmaxf(wave_max(mx), 1e-30f);
        const float q = 127.0f / mx;
        unsigned* o = (unsigned*)(O + (size_t)m * DM) + F.lane;
#pragma unroll
        for (int j = 0; j < 16; ++j) o[64 * j] = pk4_i8(v[j].x * q, v[j].y * q, v[j].z * q, v[j].w * q);
        if (F.lane == 0) RS[m] = mx * (1.0f / 127.0f);
        if (mn >= M) break;
#pragma unroll
        for (int j = 0; j < 16; ++j) v[j] = nv[j];
        m = mn;
    }
}
__device__ __forceinline__ void rope_table(Frame& F) {
    const int gt = F.vcu * NWAVES * 64 + F.tid, NT = F.G * NWAVES * 64;
    for (int idx = gt; idx < SEQ * 64; idx += NT) {
        const int s = idx >> 6, i = idx & 63;
        double f = 1.0, bs = 0.8659643233600653; int e = i;
        while (e) { if (e & 1) f *= bs; bs *= bs; e >>= 1; }
        const float inv = (float)f; const float ang = (float)s * inv;
        const double a = (double)ang; const double k = __builtin_rint(a * 0.15915494309189535);
        double r = __builtin_fma(-k, 6.283185307179586, a); r = __builtin_fma(-k, 2.4492935982947064e-16, r);
        const double q = r * 0.25, q2 = q * q;
        const double sn = q * (1.0 + q2 * (-1.0 / 6 + q2 * (1.0 / 120 + q2 * (-1.0 / 5040 + q2 * (1.0 / 362880 + q2 * (-1.0 / 39916800 + q2 * (1.0 / 6227020800.0)))))));
        const double cs = 1.0 + q2 * (-0.5 + q2 * (1.0 / 24 + q2 * (-1.0 / 720 + q2 * (1.0 / 40320 + q2 * (-1.0 / 3628800 + q2 * (1.0 / 479001600 + q2 * (-1.0 / 87178291200.0)))))));
        const double s2 = 2.0 * sn * cs, c2 = 1.0 - 2.0 * sn * sn, s4 = 2.0 * s2 * c2, c4 = 1.0 - 2.0 * s2 * s2;
        F.ROPE()[idx] = (f32x2){(float)c4, (float)s4};
    }
}
__device__ __forceinline__ void prep_moba(Frame& F) {
    LAS float* red = (LAS float*)F.lds;
    const int w = F.wave, lane = F.lane, l = lane & 31, hh = lane >> 5;
    for (int item = blockIdx.x; item < BATCH * 16 * 16 * 3; item += F.G) {
        const int which = item % 3; int r = item / 3; const int h = r & 15; r >>= 4; const int j = r & 15; const int b = r >> 4;
        const int colbase = (which == 0 ? PA_MQ : which == 1 ? PA_MK : PA_MV) + h * 128;
        bf16* dst = (bf16*)(F.wsb + (which == 0 ? WS_MQ : which == 1 ? WS_MK : WS_MV)) + ((size_t)(b * 16 + h) * SEQ + j * 256) * 128;
        const bf16* src = F.PA() + (size_t)(b * SEQ + j * 256) * PA_LD + colbase;
        float k1a = 0.f, k1b = 0.f, k2a = 0.f, k2b = 0.f;
        if (which == 2) {
            LAS unsigned short* tl = (LAS unsigned short*)(F.lds + 4096);
#pragma unroll 8
            for (int i = 0; i < 32; ++i) { const int tt = w * 32 + i; const unsigned v = *(const unsigned*)(src + (size_t)tt * PA_LD + 2 * lane);
                tl[(2 * lane) * 258 + tt] = (unsigned short)(v & 0xffffu); tl[(2 * lane + 1) * 258 + tt] = (unsigned short)(v >> 16); }
            __syncthreads();
            bf16* vt = F.MV() + (size_t)(b * 16 + h) * 128 * SEQ + j * 256;
#pragma unroll 4
            for (int i = 0; i < 16; ++i) { const int d = w * 16 + i; const LAS unsigned* rp = (const LAS unsigned*)(tl + d * 258) + 2 * lane;
                *(v2u*)(vt + (size_t)d * SEQ + 4 * lane) = (v2u){rp[0], rp[1]}; }
        } else {
            const float* gq = F.in[11]; const float* gk = F.in[12];
            const f32x2 gqa = *(const f32x2*)(gq + 2 * l), gqb = *(const f32x2*)(gq + 64 + 2 * l), gka = *(const f32x2*)(gk + 2 * l), gkb = *(const f32x2*)(gk + 64 + 2 * l);
            const f32x2 g1 = which == 0 ? gqa : gka, g2 = which == 0 ? gqb : gkb;
#pragma unroll 4
            for (int it = 0; it < 16; ++it) { const int tt = w * 32 + 2 * it + hh, s = j * 256 + tt;
                const unsigned u1 = *(const unsigned*)(src + (size_t)tt * PA_LD + 2 * l), u2 = *(const unsigned*)(src + (size_t)tt * PA_LD + 64 + 2 * l);
                const f32x4 cs = *(const f32x4*)((const float*)F.ROPE() + (size_t)(s * 64 + 2 * l) * 2);
                const float x1a = blo(u1), x1b = bhi(u1), x2a = blo(u2), x2b = bhi(u2);
                const float hs = half_sum32((x1a * x1a + x1b * x1b) + (x2a * x2a + x2b * x2b));
                const float tot = hh ? rd_lane(hs, 63) : rd_lane(hs, 31);
                const float rr = 1.0f / sqrtf(tot * (1.0f / 128) + NORM_EPS);
                const float y1a = x1a * rr * g1.x, y1b = x1b * rr * g1.y, y2a = x2a * rr * g2.x, y2b = x2b * rr * g2.y;
                const float o1a = y1a * cs.x - y2a * cs.y, o2a = y2a * cs.x + y1a * cs.y, o1b = y1b * cs.z - y2b * cs.w, o2b = y2b * cs.z + y1b * cs.w;
                *(unsigned*)(dst + tt * 128 + 2 * l) = pk2(o1a, o1b); *(unsigned*)(dst + tt * 128 + 64 + 2 * l) = pk2(o2a, o2b);
                k1a += o1a; k1b += o1b; k2a += o2a; k2b += o2b; }
            k1a = xhalf_sum(k1a); k1b = xhalf_sum(k1b); k2a = xhalf_sum(k2a); k2b = xhalf_sum(k2b);
        }
        if (hh == 0) { *(LAS f32x2*)(red + w * 128 + 2 * l) = (f32x2){k1a, k1b}; *(LAS f32x2*)(red + w * 128 + 64 + 2 * l) = (f32x2){k2a, k2b}; }
        __syncthreads();
        if (which == 1 && F.tid < 128) { float s = 0.f;
#pragma unroll
            for (int ww = 0; ww < 8; ++ww) s += red[ww * 128 + F.tid];
            const float km = s * (1.0f / 256); const unsigned hi = f2bf(km); const float rem = km - __uint_as_float(hi << 16);
            F.KMH()[((size_t)(b * 16 + h) * 16 + j) * 128 + F.tid] = (bf16)hi; F.KML()[((size_t)(b * 16 + h) * 16 + j) * 128 + F.tid] = (bf16)f2bf(rem); }
        __syncthreads();
    }
}
__device__ __forceinline__ float bf_el(const v4u& x, int i) { const unsigned w = (i >> 1) == 0 ? x.x : (i >> 1) == 1 ? x.y : (i >> 1) == 2 ? x.z : x.w; return (i & 1) ? bhi(w) : blo(w); }
__device__ __forceinline__ void prep_gdn(Frame& F) {
    const int gw = F.vcu * NWAVES + F.wave, NGW = F.G * NWAVES, lane = F.lane, q = lane >> 4, li = lane & 15;
    const float* cw = F.in[7];
    LAS unsigned short* tl = (LAS unsigned short*)(F.lds + F.wave * PREP_STRIDE);
    for (int item = gw; item < BATCH * 64 * 64; item += NGW) {
        const int grp = item & 63, c = (item >> 6) & 63, b = item >> 12, t0 = b * SEQ + c * 64, ch = grp * 128 + 8 * li;
        float wt[4][8];
#pragma unroll
        for (int j = 0; j < 4; ++j) { const f32x4 wa = *(const f32x4*)(cw + j * 8192 + ch), wb = *(const f32x4*)(cw + j * 8192 + ch + 4);
            wt[j][0] = wa.x; wt[j][1] = wa.y; wt[j][2] = wa.z; wt[j][3] = wa.w; wt[j][4] = wb.x; wt[j][5] = wb.y; wt[j][6] = wb.z; wt[j][7] = wb.w; }
        const bf16* src = F.PA() + (size_t)(t0 + 16 * q) * PA_LD + ch;
        v4u xm3 = (v4u){0u, 0u, 0u, 0u}, xm2 = xm3, xm1 = xm3;
        if (c > 0 || q > 0) { xm3 = *(const v4u*)(src - 3 * (ptrdiff_t)PA_LD); xm2 = *(const v4u*)(src - 2 * (ptrdiff_t)PA_LD); xm1 = *(const v4u*)(src - (ptrdiff_t)PA_LD); }
#pragma unroll 4
        for (int s = 0; s < 16; ++s) { const int tt = 16 * q + s;
            const v4u x0 = *(const v4u*)(src + (size_t)s * PA_LD);
            float a[8]; float ss = 0.f;
#pragma unroll
            for (int i = 0; i < 8; ++i) { float v = wt[0][i] * bf_el(xm3, i) + wt[1][i] * bf_el(xm2, i) + wt[2][i] * bf_el(xm1, i) + wt[3][i] * bf_el(x0, i);
                v = v * __builtin_amdgcn_rcpf(1.0f + __expf(-v)); a[i] = v; ss += v * v; }
            xm3 = xm2; xm2 = xm1; xm1 = x0;
            if (grp < 32) { const float rr = __builtin_amdgcn_rsqf(row_sum16(ss) + NORM_EPS);
#pragma unroll
                for (int i = 0; i < 8; ++i) a[i] *= rr; }
            const v4u pk = (v4u){cvtpk(a[0], a[1]), cvtpk(a[2], a[3]), cvtpk(a[4], a[5]), cvtpk(a[6], a[7])};
            if (grp < 16) *(v4u*)(F.QN() + (size_t)(t0 + tt) * 2048 + grp * 128 + 8 * li) = pk;
            else { if (grp < 32) *(v4u*)(F.KN() + (size_t)(t0 + tt) * 2048 + (grp - 16) * 128 + 8 * li) = pk;
                   LAS unsigned short* tp = tl + (8 * li) * 68 + tt;
                   tp[0] = (unsigned short)(pk.x & 0xffffu); tp[68] = (unsigned short)(pk.x >> 16); tp[136] = (unsigned short)(pk.y & 0xffffu); tp[204] = (unsigned short)(pk.y >> 16);
                   tp[272] = (unsigned short)(pk.z & 0xffffu); tp[340] = (unsigned short)(pk.z >> 16); tp[408] = (unsigned short)(pk.w & 0xffffu); tp[476] = (unsigned short)(pk.w >> 16); }
        }
        if (grp >= 16) {
            LDS_WAIT();
            bf16* dst = (bf16*)(F.wsb + (grp < 32 ? WS_KNT : WS_VP)) + (grp < 32 ? ((size_t)(b * 16 + grp - 16) * 64 + c) : ((size_t)(b * 32 + grp - 32) * 64 + c)) * 8192;
#pragma unroll 4
            for (int i = 0; i < 16; ++i) { const int row = 8 * i + (lane >> 3), chk = lane & 7; const LAS v2u* rp = (const LAS v2u*)(tl + row * 68 + 8 * chk);
                const v2u lo = rp[0], hi = rp[1]; *(v4u*)(dst + row * 64 + 8 * chk) = (v4u){lo.x, lo.y, hi.x, hi.y}; }
            LDS_WAIT();
        }
    }
    const int gt = F.vcu * NWAVES * 64 + F.tid, NT = F.G * NWAVES * 64;
    for (int idx = gt; idx < M * 32; idx += NT) { const int hv = idx & 31, t = idx >> 5;
        const float a = F.AB()[(size_t)t * 64 + hv], bb = F.AB()[(size_t)t * 64 + 32 + hv];
        const float x = a + F.in[9][hv]; const float sp = fmaxf(x, 0.f) + log1pf(expf(-fabsf(x)));
        F.GG()[idx] = -expf(F.in[8][hv]) * sp; F.BETA()[idx] = 1.0f / (1.0f + expf(-bb)); }
}
typedef short bf16x8 __attribute__((ext_vector_type(8)));
typedef float f32x16 __attribute__((ext_vector_type(16)));
#define MFMA32(a, b, c) __builtin_amdgcn_mfma_f32_32x32x16_bf16((a), (b), (c), 0, 0, 0)
constexpr int MB_KT = 17408, MB_BUF = 34816;

__device__ __forceinline__ void moba_stage_load(const bf16* Kb, const bf16* Vb, int kpos0, int tid, v4u (&kr)[2], v4u (&vr)[2]) {
    const v4u* kp = (const v4u*)(Kb + (size_t)(kpos0 + (tid >> 3)) * 128 + (tid & 7) * 16); kr[0] = kp[0]; kr[1] = kp[1];
    const v4u* vp = (const v4u*)(Vb + (size_t)(tid >> 2) * SEQ + kpos0 + (tid & 3) * 16); vr[0] = vp[0]; vr[1] = vp[1];
}
__device__ __forceinline__ void moba_stage_store(LAS unsigned char* buf, int tid, const v4u (&kr)[2], const v4u (&vr)[2]) {
    LAS unsigned char* kd = buf + (tid >> 3) * 272 + (tid & 7) * 32; *(LAS v4u*)kd = kr[0]; *(LAS v4u*)(kd + 16) = kr[1];
    LAS unsigned char* vd = buf + MB_KT + (tid >> 2) * 136 + (tid & 3) * 32;
    *(LAS v2u*)vd = (v2u){vr[0].x, vr[0].y}; *(LAS v2u*)(vd + 8) = (v2u){vr[0].z, vr[0].w}; *(LAS v2u*)(vd + 16) = (v2u){vr[1].x, vr[1].y}; *(LAS v2u*)(vd + 24) = (v2u){vr[1].z, vr[1].w};
}
__device__ __forceinline__ void moba_unit(Frame& F, int bh, int j) {
    const int w = F.wave, lane = F.lane, r = lane & 31, h = lane >> 5, tid = F.tid;
    LAS unsigned char* L = F.lds;
    const bf16* Qb = F.MQ() + ((size_t)bh * SEQ + j * 256 + 32 * w) * 128;
    const bf16* Kb = F.MK() + (size_t)bh * SEQ * 128;
    const bf16* Vb = F.MV() + (size_t)bh * 128 * SEQ;
    bf16x8 qf[8];
#pragma unroll
    for (int ks = 0; ks < 8; ++ks) qf[ks] = *(const bf16x8*)(Qb + r * 128 + 16 * ks + 8 * h);
    unsigned selmask = 0u;
    if (j > 0) {
        f32x16 g;
#pragma unroll
        for (int i = 0; i < 16; ++i) g[i] = 0.f;
        const bf16* kmh = F.KMH() + ((size_t)bh * 16 + (r & 15)) * 128 + 8 * h; const bf16* kml = F.KML() + ((size_t)bh * 16 + (r & 15)) * 128 + 8 * h;
        bf16x8 ah[8], al[8];
#pragma unroll
        for (int ks = 0; ks < 8; ++ks) { ah[ks] = *(const bf16x8*)(kmh + 16 * ks); al[ks] = *(const bf16x8*)(kml + 16 * ks); }
#pragma unroll
        for (int ks = 0; ks < 8; ++ks) { g = MFMA32(ah[ks], qf[ks], g); g = MFMA32(al[ks], qf[ks], g); }
        unsigned key[16];
#pragma unroll
        for (int i = 0; i < 8; ++i) { const int base = (i & 3) + 8 * (i >> 2); const int n0 = base + 4 * h, n1 = base + 4 * (1 - h);
            auto rr = __builtin_amdgcn_permlane32_swap(__float_as_uint(g[i]), __float_as_uint(g[i]), false, false);
            const unsigned u0 = __float_as_uint(g[i]), u1 = h ? rr[0] : rr[1];
            const unsigned s0 = u0 ^ ((u0 >> 31) ? 0xffffffffu : 0x80000000u), s1 = u1 ^ ((u1 >> 31) ? 0xffffffffu : 0x80000000u);
            key[i] = n0 < j ? ((s0 & ~15u) | (unsigned)(15 - n0)) : 0u; key[8 + i] = n1 < j ? ((s1 & ~15u) | (unsigned)(15 - n1)) : 0u; }
#pragma unroll
        for (int rd = 0; rd < 3; ++rd) { unsigned best = key[0];
#pragma unroll
            for (int i = 1; i < 16; ++i) best = best > key[i] ? best : key[i];
            if (best != 0u) selmask |= 1u << (15u - (best & 15u));
#pragma unroll
            for (int i = 0; i < 16; ++i) key[i] = (key[i] == best) ? 0u : key[i]; }
    }
    f32x16 o[4];
#pragma unroll
    for (int b4 = 0; b4 < 4; ++b4)
#pragma unroll
        for (int i = 0; i < 16; ++i) o[b4][i] = 0.f;
    float m_run = -INFINITY, l_run = 0.f;
    const int nT = 4 * (j + 1), qpos = 32 * w + r;
    constexpr float C = 0.08838834764831845f * 1.4426950408889634f;
    v4u kr[2], vr[2];
    __syncthreads();
    moba_stage_load(Kb, Vb, j * 256, tid, kr, vr); moba_stage_store(L, tid, kr, vr);
    __syncthreads();
    for (int tt = 0; tt < nT; ++tt) {
        const bool own = tt < 4; const int blk = own ? j : ((tt - 4) >> 2), sub64 = own ? tt : ((tt - 4) & 3);
        if (tt + 1 < nT) { const int t1 = tt + 1; const int kp1 = (t1 < 4) ? j * 256 + 64 * t1 : ((t1 - 4) >> 2) * 256 + 64 * ((t1 - 4) & 3); moba_stage_load(Kb, Vb, kp1, tid, kr, vr); }
        {
        LAS unsigned char* Kt = L + (tt & 1) * MB_BUF; LAS unsigned char* Vt = Kt + MB_KT;
        const bool lane_sel = own ? true : (((selmask >> blk) & 1u) != 0u);
        const bool skip = own ? (64 * sub64 > 32 * w + 31) : (__ballot(lane_sel) == 0ull);
        if (!skip) {
            f32x16 x0, x1;
#pragma unroll
            for (int i = 0; i < 16; ++i) { x0[i] = 0.f; x1[i] = 0.f; }
#define MB_LDK(dst, g) do { dst[0] = *(const LAS bf16x8*)(Kt + r * 272 + 64 * (g) + 16 * h); dst[1] = *(const LAS bf16x8*)(Kt + (32 + r) * 272 + 64 * (g) + 16 * h); \
                            dst[2] = *(const LAS bf16x8*)(Kt + r * 272 + 64 * (g) + 32 + 16 * h); dst[3] = *(const LAS bf16x8*)(Kt + (32 + r) * 272 + 64 * (g) + 32 + 16 * h); } while (0)
#define MB_QK(src, g) do { x0 = MFMA32(src[0], qf[2 * (g)], x0); x1 = MFMA32(src[1], qf[2 * (g)], x1); x0 = MFMA32(src[2], qf[2 * (g) + 1], x0); x1 = MFMA32(src[3], qf[2 * (g) + 1], x1); } while (0)
            { bf16x8 fa[4], fb[4];
              MB_LDK(fa, 0); MB_LDK(fb, 1); __builtin_amdgcn_sched_barrier(0);
              MB_QK(fa, 0); MB_LDK(fa, 2); __builtin_amdgcn_sched_barrier(0);
              MB_QK(fb, 1); MB_LDK(fb, 3); __builtin_amdgcn_sched_barrier(0);
              MB_QK(fa, 2); __builtin_amdgcn_sched_barrier(0);
              MB_QK(fb, 3); }
#undef MB_LDK
#undef MB_QK
            if (own && (64 * sub64 + 63 > 32 * w)) {
#pragma unroll
                for (int i = 0; i < 16; ++i) { const int key0 = 64 * sub64 + (i & 3) + 8 * (i >> 2) + 4 * h;
                    x0[i] = (key0 <= qpos) ? x0[i] : -INFINITY; x1[i] = (key0 + 32 <= qpos) ? x1[i] : -INFINITY; }
            }
            float mx = fmaxf(x0[0], x1[0]);
#pragma unroll
            for (int i = 1; i < 16; ++i) mx = fmaxf(fmaxf(mx, x0[i]), x1[i]);
            mx = xhalf_max(mx);
            mx = lane_sel ? mx : -INFINITY;
            const float m_new = fmaxf(m_run, mx);
            if (__any(m_new != m_run)) {
                const float alpha = __builtin_amdgcn_exp2f((m_run - m_new) * C);
                l_run *= alpha;
#pragma unroll
                for (int b4 = 0; b4 < 4; ++b4)
#pragma unroll
                    for (int i = 0; i < 16; ++i) o[b4][i] *= alpha;
                m_run = m_new;
            }
            const float mC = -m_run * C;
            float rs = 0.f;
#pragma unroll
            for (int i = 0; i < 16; ++i) { x0[i] = __builtin_amdgcn_exp2f(fmaf(x0[i], C, mC)); x1[i] = __builtin_amdgcn_exp2f(fmaf(x1[i], C, mC)); rs += x0[i] + x1[i]; }
            rs = xhalf_sum(rs);
            l_run += lane_sel ? rs : 0.f;
            const unsigned pmask = lane_sel ? 0xffffffffu : 0u;
            bf16x8 pb[4];
#pragma unroll
            for (int st = 0; st < 4; ++st) { v4u pw; const int s8 = 8 * (st & 1);
                if (st < 2) { pw.x = cvtpk(x0[s8], x0[s8 + 1]); pw.y = cvtpk(x0[s8 + 2], x0[s8 + 3]); pw.z = cvtpk(x0[s8 + 4], x0[s8 + 5]); pw.w = cvtpk(x0[s8 + 6], x0[s8 + 7]); }
                else { pw.x = cvtpk(x1[s8], x1[s8 + 1]); pw.y = cvtpk(x1[s8 + 2], x1[s8 + 3]); pw.z = cvtpk(x1[s8 + 4], x1[s8 + 5]); pw.w = cvtpk(x1[s8 + 6], x1[s8 + 7]); }
                pw.x &= pmask; pw.y &= pmask; pw.z &= pmask; pw.w &= pmask; pb[st] = __builtin_bit_cast(bf16x8, pw); }
#define MB_LDV(dst, st) do { _Pragma("unroll") for (int b4 = 0; b4 < 4; ++b4) { const LAS unsigned char* vp = Vt + (32 * b4 + r) * 136 + (16 * (st) + 4 * h) * 2; \
                const v2u lo = *(const LAS v2u*)vp, hi = *(const LAS v2u*)(vp + 16); dst[b4] = __builtin_bit_cast(bf16x8, (v4u){lo.x, lo.y, hi.x, hi.y}); } } while (0)
#define MB_PV(src, st) do { _Pragma("unroll") for (int b4 = 0; b4 < 4; ++b4) o[b4] = MFMA32(src[b4], pb[st], o[b4]); } while (0)
            { bf16x8 va[4], vb[4];
              MB_LDV(va, 0); MB_LDV(vb, 1); __builtin_amdgcn_sched_barrier(0);
              MB_PV(va, 0); MB_LDV(va, 2); __builtin_amdgcn_sched_barrier(0);
              MB_PV(vb, 1); MB_LDV(vb, 3); __builtin_amdgcn_sched_barrier(0);
              MB_PV(va, 2); __builtin_amdgcn_sched_barrier(0);
              MB_PV(vb, 3); }
#undef MB_LDV
#undef MB_PV
        }
        }
        if (tt + 1 < nT) moba_stage_store(L + ((tt + 1) & 1) * MB_BUF, tid, kr, vr);
        __syncthreads();
    }
    const float inv = 16.0f / l_run; const int b = bh >> 4, hh = bh & 15;
    unsigned char* orow = (unsigned char*)F.OM() + (size_t)(b * SEQ + j * 256 + 32 * w + r) * 2048 + hh * 128;
#pragma unroll
    for (int b4 = 0; b4 < 4; ++b4)
#pragma unroll
        for (int gq = 0; gq < 4; ++gq) *(unsigned*)(orow + 32 * b4 + 8 * gq + 4 * h) = pk4_fp8(o[b4][4 * gq] * inv, o[b4][4 * gq + 1] * inv, o[b4][4 * gq + 2] * inv, o[b4][4 * gq + 3] * inv);
}
__device__ __forceinline__ void moba_phase(Frame& F) {
    for (int p = blockIdx.x; p < BATCH * 16 * 8; p += F.G) { const int bh = p >> 3, jj = p & 7; moba_unit(F, bh, 15 - jj); moba_unit(F, bh, jj); }
}
__device__ __forceinline__ int crow(int reg, int h) { return (reg & 3) + 8 * (reg >> 2) + 4 * h; }
__device__ __forceinline__ float rdlane(float v, int l) { return __int_as_float(__builtin_amdgcn_readlane(__float_as_int(v), l)); }
template <int TB, int CB> __device__ __forceinline__ float lsel(const f32x16& L00, const f32x16& L10, const f32x16& L11, int reg, int ln) {
    return TB == 0 ? rdlane(L00[reg], ln) : (CB == 0 ? rdlane(L10[reg], ln) : rdlane(L11[reg], ln)); }
__device__ __forceinline__ void sub_step(float& acc, float lv, int ln, float xk) { int tmp;
    asm volatile("s_nop 0\n\tv_readlane_b32 %1, %2, %3\n\ts_nop 1\n\tv_fma_f32 %0, -%1, %4, %0" : "+v"(acc), "=&s"(tmp) : "v"(lv), "s"(ln), "v"(xk)); }
__device__ __forceinline__ void sub_step4(float& a0, float& a1, float& a2, float& a3, float l0, float l1, float l2, float l3, int n0, int n1, int n2, int n3, float x0, float x1, float x2, float x3) {
    int t0, t1, t2, t3;
    asm volatile("s_nop 0\n\tv_readlane_b32 %4, %8, %12\n\tv_readlane_b32 %5, %9, %13\n\tv_readlane_b32 %6, %10, %14\n\tv_readlane_b32 %7, %11, %15\n\t"
                 "v_fma_f32 %0, -%4, %16, %0\n\tv_fma_f32 %1, -%5, %17, %1\n\tv_fma_f32 %2, -%6, %18, %2\n\tv_fma_f32 %3, -%7, %19, %3"
                 : "+v"(a0), "+v"(a1), "+v"(a2), "+v"(a3), "=&s"(t0), "=&s"(t1), "=&s"(t2), "=&s"(t3)
                 : "v"(l0), "v"(l1), "v"(l2), "v"(l3), "s"(n0), "s"(n1), "s"(n2), "s"(n3), "v"(x0), "v"(x1), "v"(x2), "v"(x3));
}
__device__ __forceinline__ v4u pack8(const float (&x)[8]) { v4u p; p.x = cvtpk(x[0], x[1]); p.y = cvtpk(x[2], x[3]); p.z = cvtpk(x[4], x[5]); p.w = cvtpk(x[6], x[7]); return p; }

__device__ __forceinline__ void t_frags(const float (&X)[64], float sv, bf16x8 (&F0)[4], bf16x8 (&F1)[4]) {
#pragma unroll
    for (int ks = 0; ks < 4; ++ks) {
        float lo[8], hi[8];
#pragma unroll
        for (int jj = 0; jj < 8; ++jj) { lo[jj] = X[16 * ks + jj] * rdlane(sv, 16 * ks + jj); hi[jj] = X[16 * ks + 8 + jj] * rdlane(sv, 16 * ks + 8 + jj); }
        const v4u pl = pack8(lo), ph = pack8(hi); v4u f0, f1;
        { auto rr = __builtin_amdgcn_permlane32_swap(pl.x, ph.x, false, false); f0.x = rr[0]; f1.x = rr[1]; }
        { auto rr = __builtin_amdgcn_permlane32_swap(pl.y, ph.y, false, false); f0.y = rr[0]; f1.y = rr[1]; }
        { auto rr = __builtin_amdgcn_permlane32_swap(pl.z, ph.z, false, false); f0.z = rr[0]; f1.z = rr[1]; }
        { auto rr = __builtin_amdgcn_permlane32_swap(pl.w, ph.w, false, false); f0.w = rr[0]; f1.w = rr[1]; }
        F0[ks] = __builtin_bit_cast(bf16x8, f0); F1[ks] = __builtin_bit_cast(bf16x8, f1);
    }
}
__device__ __forceinline__ void gdn_local_task(Frame& F, int task, LAS float* sm) {
    int lane_o = F.lane; asm volatile("" : "+v"(lane_o));
    const int lane = lane_o, r = lane & 31, h = lane >> 5;
    const int c = task & 63, bhv = task >> 6, hv = bhv & 31, b = bhv >> 5, hq = hv >> 1;
    const int t0 = b * SEQ + c * 64; const size_t tq = (size_t)(b * 16 + hq) * 64 + c;
    const float g = F.GG()[(size_t)(t0 + lane) * 32 + hv], bt = F.BETA()[(size_t)(t0 + lane) * 32 + hv];
    float gc = g;
#pragma unroll
    for (int o = 1; o < 64; o <<= 1) { const float t = __int_as_float(__builtin_amdgcn_ds_bpermute(4 * ((lane - o) & 63), __float_as_int(gc))); gc += (lane >= o) ? t : 0.f; }
    sm[lane] = gc; sm[64 + lane] = bt;
    F.GC()[(size_t)task * 64 + lane] = gc;
    LDS_WAIT();
    bf16x8 kf[2][8];
#pragma unroll
    for (int tb = 0; tb < 2; ++tb)
#pragma unroll
        for (int ks = 0; ks < 8; ++ks) kf[tb][ks] = *(const bf16x8*)(F.KN() + (size_t)(t0 + 32 * tb + r) * 2048 + hq * 128 + 16 * ks + 8 * h);
    f32x16 L00, L10, L11;
#pragma unroll
    for (int i = 0; i < 16; ++i) { L00[i] = 0.f; L10[i] = 0.f; L11[i] = 0.f; }
#pragma unroll
    for (int ks = 0; ks < 8; ++ks) { L00 = MFMA32(kf[0][ks], kf[0][ks], L00); L10 = MFMA32(kf[1][ks], kf[0][ks], L10); L11 = MFMA32(kf[1][ks], kf[1][ks], L11); }
    const float gci0 = sm[r], gci1 = sm[32 + r];
#pragma unroll
    for (int reg = 0; reg < 16; ++reg) { const int kr = crow(reg, h); const float gk0 = sm[kr], bk0 = sm[64 + kr], gk1 = sm[32 + kr], bk1 = sm[96 + kr];
        L00[reg] = (r < kr) ? L00[reg] * bk0 * __expf(gk0 - gci0) : 0.f;
        L10[reg] = L10[reg] * bk1 * __expf(gk1 - gci0);
        L11[reg] = (r < kr) ? L11[reg] * bk1 * __expf(gk1 - gci1) : 0.f; }
    { bf16* at = F.AT() + (size_t)task * 4096; const float sc = 0.08838834764831845f;
      { bf16x8 qf[8];
#pragma unroll
        for (int ks = 0; ks < 8; ++ks) qf[ks] = *(const bf16x8*)(F.QN() + (size_t)(t0 + r) * 2048 + hq * 128 + 16 * ks + 8 * h);
        f32x16 A00;
#pragma unroll
        for (int i = 0; i < 16; ++i) A00[i] = 0.f;
#pragma unroll
        for (int ks = 0; ks < 8; ++ks) A00 = MFMA32(kf[0][ks], qf[ks], A00);
#pragma unroll
        for (int g4 = 0; g4 < 4; ++g4) { float v[4];
#pragma unroll
            for (int t = 0; t < 4; ++t) { const int reg = 4 * g4 + t, jr = crow(reg, h); v[t] = (jr <= r) ? A00[reg] * sc * __expf(gci0 - sm[jr]) : 0.f; }
            *(v2u*)(at + r * 64 + 8 * g4 + 4 * h) = (v2u){cvtpk(v[0], v[1]), cvtpk(v[2], v[3])}; } }
      { bf16x8 qf[8];
#pragma unroll
        for (int ks = 0; ks < 8; ++ks) qf[ks] = *(const bf16x8*)(F.QN() + (size_t)(t0 + 32 + r) * 2048 + hq * 128 + 16 * ks + 8 * h);
        f32x16 A01, A11;
#pragma unroll
        for (int i = 0; i < 16; ++i) { A01[i] = 0.f; A11[i] = 0.f; }
#pragma unroll
        for (int ks = 0; ks < 8; ++ks) { A01 = MFMA32(kf[0][ks], qf[ks], A01); A11 = MFMA32(kf[1][ks], qf[ks], A11); }
#pragma unroll
        for (int g4 = 0; g4 < 4; ++g4) { float v[4], u[4];
#pragma unroll
            for (int t = 0; t < 4; ++t) { const int reg = 4 * g4 + t, jr = crow(reg, h); v[t] = A01[reg] * sc * __expf(gci1 - sm[jr]); u[t] = (jr <= r) ? A11[reg] * sc * __expf(gci1 - sm[32 + jr]) : 0.f; }
            *(v2u*)(at + (32 + r) * 64 + 8 * g4 + 4 * h) = (v2u){cvtpk(v[0], v[1]), cvtpk(v[2], v[3])};
            *(v2u*)(at + (32 + r) * 64 + 32 + 8 * g4 + 4 * h) = (v2u){cvtpk(u[0], u[1]), cvtpk(u[2], u[3])}; } } }
    asm volatile("" ::: "memory"); __builtin_amdgcn_sched_barrier(0);
    bf16x8 vfr[2][4];
    { const bf16* vt = F.VP() + (size_t)task * 8192;
#pragma unroll
      for (int db = 0; db < 2; ++db)
#pragma unroll
          for (int ks = 0; ks < 4; ++ks) vfr[db][ks] = *(const bf16x8*)(vt + (32 * db + r) * 64 + 16 * ks + 8 * h); }
    float X[64];
    asm volatile("s_nop 7" ::: "memory");
#define GL_LV(k, i) (((k) < 32) ? L00[(((k) & 31) & 3) + 4 * (((k) & 31) >> 3)] : (((i) < 32) ? L10[(((k) & 31) & 3) + 4 * (((k) & 31) >> 3)] : L11[(((k) & 31) & 3) + 4 * (((k) & 31) >> 3)]))
#define GL_LN(k, i) (((i) & 31) + 32 * ((((k) & 31) >> 2) & 1))
#pragma unroll
    for (int i = 63; i >= 0; --i) {
        float a0 = (lane == i) ? 1.f : 0.f, a1 = 0.f, a2 = 0.f, a3 = 0.f;
        const int n4 = (63 - i) >> 2;
#pragma unroll
        for (int g = 0; g < n4; ++g) { const int k = i + 1 + 4 * g;
            sub_step4(a0, a1, a2, a3, GL_LV(k, i), GL_LV(k + 1, i), GL_LV(k + 2, i), GL_LV(k + 3, i), GL_LN(k, i), GL_LN(k + 1, i), GL_LN(k + 2, i), GL_LN(k + 3, i), X[k], X[k + 1], X[k + 2], X[k + 3]); }
#pragma unroll
        for (int k = i + 1 + 4 * n4; k < 64; ++k) sub_step(a0, GL_LV(k, i), GL_LN(k, i), X[k]);
        X[i] = (a0 + a1) + (a2 + a3);
    }
#undef GL_LV
#undef GL_LN
    asm volatile("" ::: "memory"); __builtin_amdgcn_sched_barrier(0);
    bf16x8 F0[4], F1[4];
    t_frags(X, bt, F0, F1);
    { bf16* ub = F.U() + (size_t)task * 8192;
#pragma unroll
      for (int db = 0; db < 4; ++db) { f32x16 u0, u1;
#pragma unroll
          for (int i = 0; i < 16; ++i) { u0[i] = 0.f; u1[i] = 0.f; }
#pragma unroll
          for (int ks = 0; ks < 4; ++ks) { const bf16x8 vf = db < 2 ? vfr[db & 1][ks] : *(const bf16x8*)(F.VP() + (size_t)task * 8192 + (32 * db + r) * 64 + 16 * ks + 8 * h); if (ks < 2) u0 = MFMA32(F0[ks], vf, u0); u1 = MFMA32(F1[ks], vf, u1); }
          v4u* d0 = (v4u*)(ub + ((0 * 4 + db) * 64 + lane) * 16); v4u* d1 = (v4u*)(ub + ((1 * 4 + db) * 64 + lane) * 16);
          { float a[8], bb[8];
#pragma unroll
            for (int i = 0; i < 8; ++i) { a[i] = u0[i]; bb[i] = u0[8 + i]; }
            d0[0] = pack8(a); d0[1] = pack8(bb);
#pragma unroll
            for (int i = 0; i < 8; ++i) { a[i] = u1[i]; bb[i] = u1[8 + i]; }
            d1[0] = pack8(a); d1[1] = pack8(bb); } } }
    asm volatile("" ::: "memory"); __builtin_amdgcn_sched_barrier(0);
    t_frags(X, bt * __expf(gc), F0, F1);
    { const bf16* kt = F.KNT() + tq * 8192; bf16* wb = F.W() + (size_t)task * 8192;
#pragma unroll
      for (int a = 0; a < 4; ++a) { f32x16 w0, w1;
#pragma unroll
          for (int i = 0; i < 16; ++i) { w0[i] = 0.f; w1[i] = 0.f; }
#pragma unroll
          for (int ks = 0; ks < 4; ++ks) { const bf16x8 ktf = *(const bf16x8*)(kt + (32 * a + r) * 64 + 16 * ks + 8 * h); if (ks < 2) w0 = MFMA32(ktf, F0[ks], w0); w1 = MFMA32(ktf, F1[ks], w1); }
#pragma unroll
          for (int g4 = 0; g4 < 4; ++g4) {
              *(v2u*)(wb + r * 128 + 32 * a + 8 * g4 + 4 * h) = (v2u){cvtpk(w0[4 * g4], w0[4 * g4 + 1]), cvtpk(w0[4 * g4 + 2], w0[4 * g4 + 3])};
              *(v2u*)(wb + (32 + r) * 128 + 32 * a + 8 * g4 + 4 * h) = (v2u){cvtpk(w1[4 * g4], w1[4 * g4 + 1]), cvtpk(w1[4 * g4 + 2], w1[4 * g4 + 3])}; } } }
    LDS_WAIT();
}
__device__ __forceinline__ void gdn_local_phase(Frame& F) {
    LAS float* sm = (LAS float*)(F.lds + F.wave * 512);
    const int gw = F.vcu * NWAVES + F.wave, NGW = F.G * NWAVES;
    for (int task = gw; task < BATCH * 32 * 64; task += NGW) gdn_local_task(F, task, sm);
}

constexpr int SC_W = 0, SC_Q = 16896, SC_A = 33792, SC_KT = 42496, SC_E1 = 59904, SC_E2 = 60160, SC_BUF = 60416, SC_OT = 2 * SC_BUF, SC_OTB = 16896;
static_assert(SC_OT + 2 * SC_OTB <= MISC_OFF, "scan LDS map");
__device__ __forceinline__ bf16x8 frag8(const LAS unsigned char* p) { const v2u lo = *(const LAS v2u*)p, hi = *(const LAS v2u*)(p + 16); return __builtin_bit_cast(bf16x8, (v4u){lo.x, lo.y, hi.x, hi.y}); }
__device__ __forceinline__ void st16(LAS unsigned char* p, v4u v) { *(LAS v2u*)p = (v2u){v.x, v.y}; *(LAS v2u*)(p + 8) = (v2u){v.z, v.w}; }
struct ScanRegs { v4u rw[4], rq[4], ra[2], rk[4]; float gcv, glv; };
__device__ __forceinline__ void scan_issue(Frame& F, int lt, size_t task, size_t tq, int t0, int hq, ScanRegs& R) {
#pragma unroll
    for (int i = 0; i < 4; ++i) { const int idx = lt + 256 * i, row = idx >> 4, ch = idx & 15;
        R.rw[i] = *(const v4u*)(F.W() + task * 8192 + row * 128 + ch * 8); R.rq[i] = *(const v4u*)(F.QN() + (size_t)(t0 + row) * 2048 + hq * 128 + ch * 8); }
#pragma unroll
    for (int i = 0; i < 2; ++i) { const int idx = lt + 256 * i, row = idx >> 3, ch = idx & 7; R.ra[i] = *(const v4u*)(F.AT() + task * 4096 + row * 64 + ch * 8); }
#pragma unroll
    for (int i = 0; i < 4; ++i) { const int idx = lt + 256 * i, row = idx >> 3, ch = idx & 7; R.rk[i] = *(const v4u*)(F.KNT() + tq * 8192 + row * 64 + ch * 8); }
    R.gcv = 0.f; R.glv = 0.f;
    if (lt < 64) { R.gcv = F.GC()[task * 64 + lt]; R.glv = F.GC()[task * 64 + 63]; }
}
__device__ __forceinline__ void scan_store(int lt, const ScanRegs& R, LAS unsigned char* buf) {
#pragma unroll
    for (int i = 0; i < 4; ++i) { const int idx = lt + 256 * i, row = idx >> 4, ch = idx & 15; st16(buf + SC_W + row * 264 + ch * 16, R.rw[i]); st16(buf + SC_Q + row * 264 + ch * 16, R.rq[i]); }
#pragma unroll
    for (int i = 0; i < 2; ++i) { const int idx = lt + 256 * i, row = idx >> 3, ch = idx & 7; st16(buf + SC_A + row * 136 + ch * 16, R.ra[i]); }
#pragma unroll
    for (int i = 0; i < 4; ++i) { const int idx = lt + 256 * i, row = idx >> 3, ch = idx & 7; st16(buf + SC_KT + row * 136 + ch * 16, R.rk[i]); }
    if (lt < 64) { ((LAS float*)(buf + SC_E1))[lt] = __expf(R.gcv) * 0.08838834764831845f; ((LAS float*)(buf + SC_E2))[lt] = __expf(R.glv - R.gcv); }
}
__device__ __forceinline__ void scan_finalize(Frame& F, LAS unsigned char* L, int c, int t0, int lw, int lane, int hv, f32x2 gn, const unsigned (&zw)[16]) {
    const LAS unsigned char* ot = L + SC_OT + (c & 1) * SC_OTB;
#pragma unroll
    for (int hb = 0; hb < 2; ++hb) {
        float o0[8], o1[8], ss[8];
#pragma unroll
        for (int i = 0; i < 8; ++i) { const unsigned ow = *(const LAS unsigned*)(ot + (16 * lw + 8 * hb + i) * 264 + 4 * lane); o0[i] = blo(ow); o1[i] = bhi(ow); ss[i] = o0[i] * o0[i] + o1[i] * o1[i]; }
#pragma unroll
        for (int i = 0; i < 8; ++i) ss[i] = wave_sum(ss[i]);
#pragma unroll
        for (int i = 0; i < 8; ++i) { const float rr = __builtin_amdgcn_rsqf(ss[i] * (1.0f / 128) + NORM_EPS); const float z0 = blo(zw[8 * hb + i]), z1 = bhi(zw[8 * hb + i]);
            const float y0 = o0[i] * rr * gn.x * (z0 * __builtin_amdgcn_rcpf(1.0f + __expf(-z0))), y1 = o1[i] * rr * gn.y * (z1 * __builtin_amdgcn_rcpf(1.0f + __expf(-z1)));
            *(unsigned*)(F.OG() + (size_t)(t0 + 16 * lw + 8 * hb + i) * 4096 + hv * 128 + 2 * lane) = pk2(y0, y1); }
    }
}
__device__ __forceinline__ void gdn_scan_seq(Frame& F, int seq) {
    int tid_o = F.tid; asm volatile("" : "+v"(tid_o));
    const int tid = tid_o, w = __builtin_amdgcn_readfirstlane(tid >> 6), lane = tid & 63, r = lane & 31, h = lane >> 5;
    const int b = seq >> 5, hv = seq & 31, hq = hv >> 1;
    LAS unsigned char* L = F.lds;
    const size_t task0 = (size_t)seq * 64, tq0 = (size_t)(b * 16 + hq) * 64;
    __syncthreads();
    if (w >= 4) {
        const int lt = tid - 256, lw = w - 4;
        const float* onorm = F.in[10]; const f32x2 gn = *(const f32x2*)(onorm + 2 * lane);
        ScanRegs R0, R1;
        scan_issue(F, lt, task0, tq0, b * SEQ, hq, R0); scan_issue(F, lt, task0 + 1, tq0 + 1, b * SEQ + 64, hq, R1);
        scan_store(lt, R0, L);
        __syncthreads();
#define SCAN_LOADER_STEP(c, RA, RB) do { \
            const int t0 = b * SEQ + (c) * 64; \
            unsigned zw[16]; \
            _Pragma("unroll") for (int i = 0; i < 16; ++i) zw[i] = *(const unsigned*)(F.PB() + (size_t)(t0 + 16 * lw + i) * PB_LD + PB_GZ + hv * 128 + 2 * lane); \
            if ((c) + 2 < 64) scan_issue(F, lt, task0 + (c) + 2, tq0 + (c) + 2, b * SEQ + ((c) + 2) * 64, hq, RA); \
            if ((c) + 1 < 64) scan_store(lt, RB, L + (((c) + 1) & 1) * SC_BUF); \
            __syncthreads(); \
            scan_finalize(F, L, (c), t0, lw, lane, hv, gn, zw); } while (0)
        for (int c = 0; c < 64; c += 2) {
            SCAN_LOADER_STEP(c, R0, R1);
            SCAN_LOADER_STEP(c + 1, R1, R0);
        }
#undef SCAN_LOADER_STEP
    } else {
        f32x16 Sx[4];
#pragma unroll
        for (int a = 0; a < 4; ++a)
#pragma unroll
            for (int i = 0; i < 16; ++i) Sx[a][i] = 0.f;
        v4u ur[4];
        { const v4u* up = (const v4u*)(F.U() + task0 * 8192 + ((0 * 4 + w) * 64 + lane) * 16); ur[0] = up[0]; ur[1] = up[1];
          const v4u* up1 = (const v4u*)(F.U() + task0 * 8192 + ((1 * 4 + w) * 64 + lane) * 16); ur[2] = up1[0]; ur[3] = up1[1]; }
        __syncthreads();
        for (int c = 0; c < 64; ++c) {
            const LAS unsigned char* buf = L + (c & 1) * SC_BUF; const LAS float* e1 = (const LAS float*)(buf + SC_E1); const LAS float* e2 = (const LAS float*)(buf + SC_E2);
            bf16x8 Sb[4][2];
#pragma unroll
            for (int a = 0; a < 4; ++a)
#pragma unroll
                for (int s = 0; s < 2; ++s) { float t[8];
#pragma unroll
                    for (int jj = 0; jj < 8; ++jj) t[jj] = Sx[a][8 * s + jj];
                    Sb[a][s] = __builtin_bit_cast(bf16x8, pack8(t)); }
            f32x16 vn[2];
#define SC_LD4(dst, off, gi) do { _Pragma("unroll") for (int q_ = 0; q_ < 4; ++q_) dst[q_] = frag8(buf + (off) + (32 * ((gi) >> 1) + r) * 264 + (32 * (2 * ((gi) & 1) + (q_ >> 1)) + 16 * (q_ & 1) + 4 * h) * 2); } while (0)
#define SC_MM4(acc, src, gi) do { _Pragma("unroll") for (int q_ = 0; q_ < 4; ++q_) acc = MFMA32(src[q_], Sb[2 * ((gi) & 1) + (q_ >> 1)][q_ & 1], acc); } while (0)
            { f32x16 y0, y1;
#pragma unroll
              for (int i = 0; i < 16; ++i) { y0[i] = 0.f; y1[i] = 0.f; }
              bf16x8 fa[4], fb[4];
              SC_LD4(fa, SC_W, 0); SC_LD4(fb, SC_W, 1); __builtin_amdgcn_sched_barrier(0);
              SC_MM4(y0, fa, 0); SC_LD4(fa, SC_W, 2); __builtin_amdgcn_sched_barrier(0);
              SC_MM4(y0, fb, 1); SC_LD4(fb, SC_W, 3); __builtin_amdgcn_sched_barrier(0);
              SC_MM4(y1, fa, 2); __builtin_amdgcn_sched_barrier(0);
              SC_MM4(y1, fb, 3);
#pragma unroll
              for (int tb = 0; tb < 2; ++tb) { const v4u ua = ur[2 * tb], ub = ur[2 * tb + 1]; const f32x16& y = tb ? y1 : y0;
                vn[tb][0] = blo(ua.x) - y[0]; vn[tb][1] = bhi(ua.x) - y[1]; vn[tb][2] = blo(ua.y) - y[2]; vn[tb][3] = bhi(ua.y) - y[3];
                vn[tb][4] = blo(ua.z) - y[4]; vn[tb][5] = bhi(ua.z) - y[5]; vn[tb][6] = blo(ua.w) - y[6]; vn[tb][7] = bhi(ua.w) - y[7];
                vn[tb][8] = blo(ub.x) - y[8]; vn[tb][9] = bhi(ub.x) - y[9]; vn[tb][10] = blo(ub.y) - y[10]; vn[tb][11] = bhi(ub.y) - y[11];
                vn[tb][12] = blo(ub.z) - y[12]; vn[tb][13] = bhi(ub.z) - y[13]; vn[tb][14] = blo(ub.w) - y[14]; vn[tb][15] = bhi(ub.w) - y[15]; } }
            if (c + 1 < 64) { const v4u* up = (const v4u*)(F.U() + (task0 + c + 1) * 8192 + ((0 * 4 + w) * 64 + lane) * 16); ur[0] = up[0]; ur[1] = up[1];
                const v4u* up1 = (const v4u*)(F.U() + (task0 + c + 1) * 8192 + ((1 * 4 + w) * 64 + lane) * 16); ur[2] = up1[0]; ur[3] = up1[1]; }
            bf16x8 Vb[2][2], Vb2[2][2];
#pragma unroll
            for (int tb = 0; tb < 2; ++tb)
#pragma unroll
                for (int s = 0; s < 2; ++s) { float t[8], t2[8];
                    const f32x4 ea = *(const LAS f32x4*)(e2 + 32 * tb + 16 * s + 4 * h), eb = *(const LAS f32x4*)(e2 + 32 * tb + 16 * s + 8 + 4 * h);
#pragma unroll
                    for (int jj = 0; jj < 4; ++jj) { t[jj] = vn[tb][8 * s + jj]; t[4 + jj] = vn[tb][8 * s + 4 + jj]; t2[jj] = t[jj] * ea[jj]; t2[4 + jj] = t[4 + jj] * eb[jj]; }
                    Vb[tb][s] = __builtin_bit_cast(bf16x8, pack8(t)); Vb2[tb][s] = __builtin_bit_cast(bf16x8, pack8(t2)); }
            LAS unsigned char* ot = L + SC_OT + (c & 1) * SC_OTB;
            { f32x16 y0, y1;
#pragma unroll
              for (int i = 0; i < 16; ++i) { y0[i] = 0.f; y1[i] = 0.f; }
              bf16x8 fa[4], fb[4], at[6];
              SC_LD4(fa, SC_Q, 0); SC_LD4(fb, SC_Q, 1); __builtin_amdgcn_sched_barrier(0);
              SC_MM4(y0, fa, 0); SC_LD4(fa, SC_Q, 2); __builtin_amdgcn_sched_barrier(0);
              SC_MM4(y0, fb, 1); SC_LD4(fb, SC_Q, 3); __builtin_amdgcn_sched_barrier(0);
              SC_MM4(y1, fa, 2);
#pragma unroll
              for (int s2 = 0; s2 < 2; ++s2) { at[s2] = frag8(buf + SC_A + r * 136 + (16 * s2 + 4 * h) * 2); at[2 + s2] = frag8(buf + SC_A + (32 + r) * 136 + (16 * s2 + 4 * h) * 2); at[4 + s2] = frag8(buf + SC_A + (32 + r) * 136 + (32 + 16 * s2 + 4 * h) * 2); }
              __builtin_amdgcn_sched_barrier(0);
              SC_MM4(y1, fb, 3);
#pragma unroll
              for (int g4 = 0; g4 < 4; ++g4) { const f32x4 ea = *(const LAS f32x4*)(e1 + 8 * g4 + 4 * h), eb = *(const LAS f32x4*)(e1 + 32 + 8 * g4 + 4 * h);
#pragma unroll
                  for (int t = 0; t < 4; ++t) { y0[4 * g4 + t] *= ea[t]; y1[4 * g4 + t] *= eb[t]; } }
              y0 = MFMA32(at[0], Vb[0][0], y0); y0 = MFMA32(at[1], Vb[0][1], y0);
              y1 = MFMA32(at[2], Vb[0][0], y1); y1 = MFMA32(at[3], Vb[0][1], y1); y1 = MFMA32(at[4], Vb[1][0], y1); y1 = MFMA32(at[5], Vb[1][1], y1);
#pragma unroll
              for (int reg = 0; reg < 16; reg += 2) { const unsigned p0 = cvtpk(y0[reg], y0[reg + 1]), p1 = cvtpk(y1[reg], y1[reg + 1]);
                  *(LAS unsigned short*)(ot + crow(reg, h) * 264 + (32 * w + r) * 2) = (unsigned short)(p0 & 0xffffu); *(LAS unsigned short*)(ot + crow(reg + 1, h) * 264 + (32 * w + r) * 2) = (unsigned short)(p0 >> 16);
                  *(LAS unsigned short*)(ot + (32 + crow(reg, h)) * 264 + (32 * w + r) * 2) = (unsigned short)(p1 & 0xffffu); *(LAS unsigned short*)(ot + (32 + crow(reg + 1, h)) * 264 + (32 * w + r) * 2) = (unsigned short)(p1 >> 16); } }
            { const float eg0 = e1[63] * 11.313708498984761f;
#define SC_LDK(dst, a) do { _Pragma("unroll") for (int q_ = 0; q_ < 4; ++q_) dst[q_] = frag8(buf + SC_KT + (32 * (a) + r) * 136 + (32 * (q_ >> 1) + 16 * (q_ & 1) + 4 * h) * 2); } while (0)
#define SC_MMK(a, src) do { _Pragma("unroll") for (int q_ = 0; q_ < 4; ++q_) Sx[a] = MFMA32(src[q_], Vb2[q_ >> 1][q_ & 1], Sx[a]); } while (0)
              bf16x8 fa[4], fb[4];
              SC_LDK(fa, 0); SC_LDK(fb, 1);
#pragma unroll
              for (int a = 0; a < 4; ++a)
#pragma unroll
                  for (int i = 0; i < 16; ++i) Sx[a][i] *= eg0;
              __builtin_amdgcn_sched_barrier(0);
              SC_MMK(0, fa); SC_LDK(fa, 2); __builtin_amdgcn_sched_barrier(0);
              SC_MMK(1, fb); SC_LDK(fb, 3); __builtin_amdgcn_sched_barrier(0);
              SC_MMK(2, fa); __builtin_amdgcn_sched_barrier(0);
              SC_MMK(3, fb); }
#undef SC_LDK
#undef SC_MMK
#undef SC_LD4
#undef SC_MM4
            __syncthreads();
        }
    }
}
__device__ __forceinline__ void moba_queue(Frame& F) {
    const unsigned x0 = xb_xcc_id() & 7u;
    for (unsigned k = 0; k < 8u;) {
        const unsigned x = (x0 + k) & 7u;
        __syncthreads();
        if (F.tid == 0) F.MISC[0] = __hip_atomic_fetch_add(F.ctl + CW_Q + 64 * x, 1u, __ATOMIC_RELAXED, __HIP_MEMORY_SCOPE_AGENT);
        __syncthreads();
        const unsigned q = F.MISC[0];
        if (q >= 64u) { ++k; continue; }
        const int bh = (int)((q >> 3) * 8u + x), jj = (int)(q & 7u); moba_unit(F, bh, 15 - jj); moba_unit(F, bh, jj);
    }
}
struct Args { const float* in[20]; float* out; unsigned char* ws; int ph_lo, ph_hi, li, pad; };
__global__ void __launch_bounds__(NWAVES * 64, 2) fwd(Args args) {
    extern __shared__ __attribute__((aligned(16))) unsigned char lds[];
    Frame F;
    F.lds = (LAS unsigned char*)lds;
    F.MISC = (volatile LAS unsigned*)(F.lds + MISC_OFF);
    F.tid = threadIdx.x; F.lane = F.tid & 63; F.wave = __builtin_amdgcn_readfirstlane(F.tid >> 6);
    F.G = gridDim.x; { const int bx = blockIdx.x; F.vcu = (F.G % 8 == 0) ? (bx % 8) * (F.G / 8) + bx / 8 : bx; }
    unsigned char* ws = args.ws;
    F.ctl = (unsigned*)(ws + WS_CTL); F.wsb = ws;
#pragma unroll
    for (int i = 0; i < 20; ++i) F.in[i] = args.in[i];
    F.out = args.out;
    for (int u = F.tid; u < (LDS_BYTES - MISC_OFF) / 4; u += NWAVES * 64) ((LAS unsigned*)(F.lds + MISC_OFF))[u] = 0u;
    __syncthreads();
    XcdBarrier bar; bar.bar = (unsigned*)(F.ctl + CW_BAR); bar.x = 0; bar.st = nullptr;
#if MK_SINGLE
    bar = xcd_barrier_post((unsigned*)(F.ctl + CW_BAR), F.MISC + 8);
#define GRID_BAR() xcd_barrier(bar)
#else
#define GRID_BAR() do { } while (0)
#endif
    const int lo = args.ph_lo, hi = args.ph_hi;
#define IN(k) (lo <= (k) && (k) < hi)
#define BOTH(k) (IN(k) && IN((k) + 1))
#ifndef PROBE_REP
#define PROBE_REP -1
#endif
#define REFRESH() do { int t_ = threadIdx.x; asm volatile("" : "+v"(t_)); F.tid = t_; F.lane = t_ & 63; F.wave = __builtin_amdgcn_readfirstlane(t_ >> 6); } while (0)
#define REP(k) _Pragma("unroll") for (int rep_ = 0; rep_ < ((PROBE_REP == (k)) ? 2 : 1); ++rep_)
    typedef pg8::bf16_t pb;
    REP(0) if (IN(0)) { REFRESH(); quant_ffn_gu(F, F.in[2], F.in[3], (float*)F.CM(0)); quant_wd(F, F.in[4], (float*)F.CMD(0)); rope_table(F);
        rms_rows_i8(F, F.in[0], F.in[1], (unsigned char*)F.H(), F.RS()); if (BOTH(0)) GRID_BAR(); }
    REP(1) if (IN(1)) { pg8::Gemm g{(const pb*)F.H(), (const pb*)F.WGU(), M, 2 * FF, DM}; pg8::StaticOrder S; S.init(M, 2 * FF, F.G, (int)blockIdx.x);
        pg8::EpiSwiGLUT<true> E{(pb*)F.ACT(), FF, F.RS(), (const float*)F.CM(0), F.RM(0)}; pg8::gemm_phase<pg8::EpiSwiGLUT<true>, pg8::StaticOrder, true, true, 3>(F.lds, g, S, E); if (BOTH(1)) GRID_BAR(); }
    REP(2) if (IN(2)) { REFRESH(); requant_rows(F, F.ACT(), F.ACT8(), F.RS()); GRID_BAR();
        pg8::Gemm g{(const pb*)F.ACT8(), (const pb*)F.WD(), M, DM, FF}; pg8::StaticOrder S; S.init(M, DM, F.G, (int)blockIdx.x);
        pg8::EpiResid8 E{F.in[0], F.out, DM, 0.5f, nullptr, nullptr, nullptr, F.RS(), (const float*)F.CMD(0)}; pg8::gemm_phase<pg8::EpiResid8, pg8::StaticOrder, true, true, 3>(F.lds, g, S, E); if (BOTH(2)) GRID_BAR(); }
    REP(3) if (IN(3)) { REFRESH(); convert_win(F); rms_rows_i8(F, F.out, F.in[5], F.H8(), F.RS(), F.H()); if (BOTH(3)) GRID_BAR(); }
    REP(4) if (IN(4)) { { pg8::Gemm g{(const pb*)F.H(), (const pb*)F.WB(), M, NPROJ, DM, 0}; pg8::StaticOrder S; S.init(M, NPROJ, F.G, (int)blockIdx.x);
          typedef pg8::EpiProjT<false, 0, PA_LD, 48, (long)((WS_PB - WS_BIG) / 2), PB_LD, 16, 0, PB_LD, 0> EP; EP E{(pb*)F.PA(), F.AB(), nullptr, nullptr}; pg8::gemm_phase<EP, pg8::StaticOrder, true, true>(F.lds, g, S, E); }
        { pg8::Gemm g{(const pb*)F.H8(), (const pb*)F.W8(), M, NGATE, DM, 0}; pg8::StaggerOrder S;
          { const int nb = (M / 256) * (NPROJ / 256), n8 = (M / 256) * (NGATE / 256), G = F.G; int c0 = nb % G, R0 = (n8 - 2 * (G - c0)) / G; if ((G & 7) || (c0 & 7) || R0 < 0) { c0 = 0; R0 = 0; }
            S.init2(M, NGATE, G, (int)blockIdx.x, R0, c0); }
          typedef pg8::EpiProjT<true, PA_MV, PA_LD, 8, (long)((WS_PB - WS_BIG) / 2) + PB_GG, PB_LD, 32, 0, PB_LD, 0> EP8; EP8 E{(pb*)F.PA(), F.AB(), F.RS(), (const float*)F.CMW()};
          pg8::gemm_phase<EP8, pg8::StaggerOrder, true, true, 3>(F.lds, g, S, E); }
        if (BOTH(4)) GRID_BAR(); }
    REP(5) if (IN(5)) { REFRESH(); prep_moba(F); prep_gdn(F); __syncthreads(); convert_branch(F); if (BOTH(5)) GRID_BAR(); }
    REP(6) if (IN(6)) { REFRESH(); gdn_local_phase(F); if (BOTH(6)) GRID_BAR(); }
    REP(7) if (IN(7)) { REFRESH(); for (int seq = blockIdx.x; seq < BATCH * 32; seq += F.G) gdn_scan_seq(F, seq); moba_queue(F); if (BOTH(7)) GRID_BAR(); }
    REP(8) if (IN(8)) { pg8::Gemm g{(const pb*)F.OG(), (const pb*)F.WBG(), M, DM, 4096}; pg8::StaticOrder S; S.init(M, DM, F.G, (int)blockIdx.x);
        pg8::EpiGate<true> E{(pb*)F.H(), DM, (const pb*)F.PB() + PB_GG, PB_LD}; pg8::gemm_phase<pg8::EpiGate<true>, pg8::StaticOrder, true, true>(F.lds, g, S, E); }
    REP(9) if (IN(9)) { pg8::Gemm g{(const pb*)F.OM(), (const pb*)F.WBM(), M, DM, 2048, 0x7b7b7b7b}; pg8::StaticOrder S; S.init(M, DM, F.G, (int)blockIdx.x);
        pg8::EpiGate<false> E{(pb*)F.H(), DM, (const pb*)F.PB() + PB_MG, PB_LD}; pg8::gemm_phase<pg8::EpiGate<false>, pg8::StaticOrder, true, true, true>(F.lds, g, S, E); if (BOTH(9)) GRID_BAR(); }
    REP(10) if (IN(10)) { pg8::Gemm g{(const pb*)F.H(), (const pb*)F.WO(), M, DM, DM}; pg8::StaticOrder S; S.init(M, DM, F.G, (int)blockIdx.x);
        pg8::EpiResid E{F.out, F.out, DM, 1.0f, nullptr, nullptr, nullptr, nullptr, nullptr}; pg8::gemm_phase<pg8::EpiResid, pg8::StaticOrder, true, true>(F.lds, g, S, E); if (BOTH(10)) GRID_BAR(); }
    REP(11) if (IN(11)) { REFRESH(); quant_ffn_gu(F, F.in[17], F.in[18], (float*)F.CM(1)); quant_wd(F, F.in[19], (float*)F.CMD(1)); rms_rows_i8(F, F.out, F.in[16], (unsigned char*)F.H(), F.RS()); if (BOTH(11)) GRID_BAR(); }
    REP(12) if (IN(12)) { pg8::Gemm g{(const pb*)F.H(), (const pb*)F.WGU(), M, 2 * FF, DM}; pg8::StaticOrder S; S.init(M, 2 * FF, F.G, (int)blockIdx.x);
        pg8::EpiSwiGLUT<true> E{(pb*)F.ACT(), FF, F.RS(), (const float*)F.CM(1), F.RM(1)}; pg8::gemm_phase<pg8::EpiSwiGLUT<true>, pg8::StaticOrder, true, true, 3>(F.lds, g, S, E); if (BOTH(12)) GRID_BAR(); }
    REP(13) if (IN(13)) { REFRESH(); requant_rows(F, F.ACT(), F.ACT8(), F.RS()); GRID_BAR();
        pg8::Gemm g{(const pb*)F.ACT8(), (const pb*)F.WD(), M, DM, FF}; pg8::StaticOrder S; S.init(M, DM, F.G, (int)blockIdx.x);
        pg8::EpiResid8 E{F.out, F.out, DM, 0.5f, nullptr, nullptr, nullptr, F.RS(), (const float*)F.CMD(1)}; pg8::gemm_phase<pg8::EpiResid8, pg8::StaticOrder, true, true, 3>(F.lds, g, S, E); }
#undef IN
#undef BOTH
}

extern "C" void kernel_launch(void* const* d_in, const int* in_sizes, int n_in, void* d_out, int out_size, void* d_ws, size_t ws_size, hipStream_t stream) {
    static int grid = 0;
    if (grid == 0) {
        if (n_in != 20 || out_size != M * DM || ws_size < WS_END) { fprintf(stderr, "kernel_launch: unexpected shapes (n_in %d out %d ws %zu)\n", n_in, out_size, ws_size); grid = -1; return; }
        int dev = 0, cus = 0;
        if (hipGetDevice(&dev) != hipSuccess || hipDeviceGetAttribute(&cus, hipDeviceAttributeMultiprocessorCount, dev) != hipSuccess) { grid = -1; return; }
        if (hipFuncSetAttribute((const void*)fwd, hipFuncAttributeMaxDynamicSharedMemorySize, LDS_BYTES) != hipSuccess) { fprintf(stderr, "kernel_launch: hipFuncSetAttribute failed\n"); grid = -1; return; }
        (void)hipGetLastError();
        grid = cus;
    }
    if (grid < 0) return;
    (void)hipMemsetAsync((char*)d_ws + WS_CTL, 0, CTL_ZERO_BYTES, stream);
    Args a{};
    for (int i = 0; i < 20; ++i) a.in[i] = (const float*)d_in[i];
    a.out = (float*)d_out; a.ws = (unsigned char*)d_ws;
#if MK_SINGLE
    a.ph_lo = 0; a.ph_hi = N_PHASES; a.li = 0;
    hipLaunchKernelGGL(fwd, dim3(grid), dim3(NWAVES * 64), LDS_BYTES, stream, a);
#else
    for (int p = 0; p < N_PHASES; ++p) { a.ph_lo = p; a.ph_hi = p + 1; a.li = p;
        hipLaunchKernelGGL(fwd, dim3(grid), dim3(NWAVES * 64), LDS_BYTES, stream, a); }
#endif
}
```
